# Optimizing an MI355X kernel written in HIP

```python
import math
import jax, jax.numpy as jnp
from jax import lax
import numpy as np

D_MODEL = 1024
BATCH = 2
SEQ = 8192
DEPTH = 4

MEM_LEN = 256
N_HEADS = 8
HEAD_DIM = 64
KV_LATENT = 128
IDX_HEADS = 8
IDX_DIM = 32
INDEX_TOPK = 256
Q_BLOCK = 128
CONV_WIDTH = 512
CONV_K = 3
SSM_WIDTH = 512
SSM_GROUP = 16
SSM_GROUPS = SSM_WIDTH // SSM_GROUP
SSM_STATE = 64
MEM_HEADS = 4
MEM_HEAD_DIM = 128
N_BRANCH = 4
BRANCH_WIDTH = 512
N_EXPERTS = 32
TOP_K = 4
D_EXPERT = 1024
SWIGLU_LIMIT = 7.0
SWIGLU_ALPHA = 1.702
EXPERT_BLOCK = 256
LN_EPS = 1e-5
DEEPNORM_ALPHA = (2 * DEPTH) ** 0.25
DEEPNORM_BETA = (8 * DEPTH) ** -0.25

SPLITS = (N_HEADS * HEAD_DIM, KV_LATENT, IDX_HEADS * IDX_DIM, IDX_DIM, IDX_HEADS,
          CONV_WIDTH, CONV_WIDTH, CONV_WIDTH, SSM_WIDTH, MEM_HEADS * MEM_HEAD_DIM, N_BRANCH * D_MODEL)
D_IN = sum(SPLITS)

kernel_name = 'hybrid_dsa_conv_s5_mem_moe_deepnorm'


def layer_norm(x, g, b):
    xf = x.astype(jnp.float32)
    mu = jnp.mean(xf, axis=-1, keepdims=True)
    var = jnp.mean(jnp.square(xf - mu), axis=-1, keepdims=True)
    return ((xf - mu) * lax.rsqrt(var + LN_EPS) * g.astype(jnp.float32) + b.astype(jnp.float32)).astype(x.dtype)


def rms_norm(x, g):
    xf = x.astype(jnp.float32)
    return (xf * lax.rsqrt(jnp.mean(jnp.square(xf), axis=-1, keepdims=True) + LN_EPS) * g.astype(jnp.float32)).astype(x.dtype)


def dsa_attention(q, ckv, q_idx, k_idx, w_idx, w_uk, w_uv):
    bsz, seq = ckv.shape[:2]
    topk = min(INDEX_TOPK, seq // 4)
    n_blk = seq // Q_BLOCK
    q_lat = jnp.einsum('bthd,chd->bthc', q, w_uk) * (HEAD_DIM ** -0.5)

    def to_blocks(a):
        return jnp.moveaxis(a.reshape((bsz, n_blk, Q_BLOCK) + a.shape[2:]), 1, 0)

    k_pos = jnp.arange(seq)
    gather = jax.vmap(lambda table, idx: table[idx])

    def block(args):
        i, qb, qib, wb = args
        q_pos = i * Q_BLOCK + jnp.arange(Q_BLOCK)
        rel = jax.nn.relu(jnp.einsum('bqhd,bsd->bqhs', qib, k_idx))
        score = jnp.einsum('bqhs,bqh->bqs', rel, wb).astype(jnp.float32)
        causal = k_pos[None, :] <= q_pos[:, None]
        score = jnp.where(causal[None], score, -jnp.inf)
        _, sel = lax.top_k(score, topk)
        valid = sel <= q_pos[None, :, None]
        kv = gather(ckv, sel)
        logits = jnp.einsum('bqhc,bqkc->bqhk', qb, kv).astype(jnp.float32)
        logits = jnp.where(valid[:, :, None, :], logits, -jnp.inf)
        p = jax.nn.softmax(logits, axis=-1).astype(kv.dtype)
        return jnp.einsum('bqhk,bqkc->bqhc', p, kv)

    o_lat = lax.map(block, (jnp.arange(n_blk), to_blocks(q_lat), to_blocks(q_idx), to_blocks(w_idx)))
    o_lat = jnp.moveaxis(o_lat, 0, 1).reshape(bsz, seq, N_HEADS, KV_LATENT)
    return jnp.einsum('bthc,chd->bthd', o_lat, w_uv).reshape(bsz, seq, N_HEADS * HEAD_DIM)


def short_conv(u, gate_b, gate_c, conv_w, conv_b):
    v = gate_c * u
    y = lax.conv_general_dilated(v, conv_w[:, None, :], window_strides=(1,), padding=[(CONV_K - 1, 0)],
                                 dimension_numbers=('NWC', 'WIO', 'NWC'), feature_group_count=CONV_WIDTH)
    return gate_b * (y + conv_b)


def s5_mixer(u, lam_re, lam_im, b_re, b_im, c_re, c_im, d_skip, log_dt, w_glu, b_glu):
    f32 = jnp.float32
    bsz, seq, _ = u.shape
    uf = u.astype(f32).reshape(bsz, seq, SSM_GROUPS, SSM_GROUP)
    lam = lax.complex(lam_re.astype(f32), lam_im.astype(f32))
    dt = jnp.exp(log_dt.astype(f32))[:, None]
    a_bar = jnp.exp(lam * dt)
    b_bar = ((a_bar - 1.0) / lam)[:, :, None] * lax.complex(b_re.astype(f32), b_im.astype(f32))
    bu = lax.complex(jnp.einsum('gpn,btgn->btgp', jnp.real(b_bar), uf),
                     jnp.einsum('gpn,btgn->btgp', jnp.imag(b_bar), uf))
    a = jnp.broadcast_to(a_bar, bu.shape)

    def combine(left, right):
        a_l, b_l = left
        a_r, b_r = right
        return a_r * a_l, a_r * b_l + b_r

    _, h = lax.associative_scan(combine, (a, bu), axis=1)
    y = (jnp.einsum('gnp,btgp->btgn', c_re.astype(f32), jnp.real(h))
         - jnp.einsum('gnp,btgp->btgn', c_im.astype(f32), jnp.imag(h))
         + d_skip.astype(f32) * uf)
    y = y.reshape(bsz, seq, SSM_WIDTH).astype(u.dtype)
    z = jax.nn.gelu(y)
    return z * jax.nn.sigmoid(z @ w_glu + b_glu)


def memory_attention(q, mem, w_mem_kv):
    bsz, seq = q.shape[:2]
    mlen = mem.shape[1]
    kv = (mem @ w_mem_kv).reshape(bsz, mlen, 2, MEM_HEADS, MEM_HEAD_DIM)
    k, v = kv[:, :, 0], kv[:, :, 1]
    logits = jnp.einsum('bthd,bmhd->bhtm', q, k).astype(jnp.float32) * (MEM_HEAD_DIM ** -0.5)
    p = jax.nn.softmax(logits, axis=-1).astype(v.dtype)
    return jnp.einsum('bhtm,bmhd->bthd', p, v).reshape(bsz, seq, MEM_HEADS * MEM_HEAD_DIM)


def moe(x, w_router, b_router, w_up, b_up, w_down, b_down):
    bsz, seq, d = x.shape
    n_tok = bsz * seq
    xf = x.reshape(n_tok, d)
    logits = (xf @ w_router + b_router).astype(jnp.float32)
    top_v, top_e = lax.top_k(logits, TOP_K)
    gates = jax.nn.softmax(top_v, axis=-1)
    n_asg = n_tok * TOP_K
    e_flat = top_e.reshape(n_asg).astype(jnp.int32)
    tok_flat = jnp.arange(n_asg, dtype=jnp.int32) // TOP_K
    g_flat = gates.reshape(n_asg)
    order = jnp.argsort(e_flat)
    e_sorted = e_flat[order]
    counts = jnp.bincount(e_flat, length=N_EXPERTS)
    starts = jnp.cumsum(counts) - counts
    nblk_per = (counts + EXPERT_BLOCK - 1) // EXPERT_BLOCK
    blk_end = jnp.cumsum(nblk_per)
    pstarts = (blk_end - nblk_per) * EXPERT_BLOCK
    dest = pstarts[e_sorted] + (jnp.arange(n_asg) - starts[e_sorted])
    n_blocks = -(-n_asg // EXPERT_BLOCK) + N_EXPERTS
    n_rows = n_blocks * EXPERT_BLOCK
    row_tok = jnp.full((n_rows,), n_tok, jnp.int32).at[dest].set(tok_flat[order])
    row_gate = jnp.zeros((n_rows,), jnp.float32).at[dest].set(g_flat[order])
    blk_expert = jnp.minimum(jnp.searchsorted(blk_end, jnp.arange(n_blocks), side='right'), N_EXPERTS - 1)
    x_pad = jnp.concatenate([xf, jnp.zeros((1, d), xf.dtype)], axis=0)
    xs = x_pad[row_tok].reshape(n_blocks, EXPERT_BLOCK, d)

    def expert_rows(args):
        xb, e = args
        hdn = xb @ w_up[e] + b_up[e]
        h_glu = jnp.minimum(hdn[..., ::2], SWIGLU_LIMIT)
        h_lin = jnp.clip(hdn[..., 1::2], -SWIGLU_LIMIT, SWIGLU_LIMIT)
        act = h_glu * jax.nn.sigmoid(SWIGLU_ALPHA * h_glu) * (h_lin + 1.0)
        return act @ w_down[e] + b_down[e]

    ys = lax.map(expert_rows, (xs, blk_expert)).reshape(n_rows, d)
    y = jax.ops.segment_sum(ys * row_gate[:, None].astype(ys.dtype), row_tok, num_segments=n_tok + 1)[:n_tok]
    return y.reshape(bsz, seq, d)


def setup_inputs(seed: int = 0) -> dict:
    key = jax.random.key(seed)
    ks = jax.random.split(key, 40)
    f32 = jnp.float32
    L, G, P, N = DEPTH, SSM_GROUPS, SSM_STATE, SSM_GROUP
    beta = DEEPNORM_BETA

    def nrm(i, shape, scale):
        return scale * jax.random.normal(ks[i], shape, f32)

    n_idx = jnp.arange(P, dtype=f32)
    return {
        'x': nrm(0, (BATCH, SEQ, D_MODEL), 1.0),
        'mem': nrm(1, (BATCH, MEM_LEN, D_MODEL), 1.0),
        'ln_in_g': 1.0 + nrm(2, (D_MODEL,), 0.02),
        'ln_in_b': nrm(3, (D_MODEL,), 0.02),
        'w_in': nrm(4, (L, D_MODEL, D_IN), D_MODEL ** -0.5),
        'kv_norm_g': 1.0 + nrm(5, (L, KV_LATENT), 0.02),
        'w_uk': nrm(6, (L, KV_LATENT, N_HEADS, HEAD_DIM), KV_LATENT ** -0.5),
        'w_uv': nrm(7, (L, KV_LATENT, N_HEADS, HEAD_DIM), KV_LATENT ** -0.5 * beta),
        'conv_w': nrm(8, (L, CONV_K, CONV_WIDTH), CONV_K ** -0.5),
        'conv_b': nrm(9, (L, CONV_WIDTH), 0.01),
        'lam_re': -0.5 + nrm(10, (L, G, P), 0.01),
        'lam_im': math.pi * n_idx + nrm(11, (L, G, P), 0.01),
        'b_re': nrm(12, (L, G, P, N), (2 * N) ** -0.5),
        'b_im': nrm(13, (L, G, P, N), (2 * N) ** -0.5),
        'c_re': nrm(14, (L, G, N, P), (2 * P) ** -0.5),
        'c_im': nrm(15, (L, G, N, P), (2 * P) ** -0.5),
        'd_skip': nrm(16, (L, G, N), 1.0),
        'log_dt': jax.random.uniform(ks[17], (L, G), f32, math.log(1e-3), math.log(1e-1)),
        'w_glu': nrm(18, (L, SSM_WIDTH, SSM_WIDTH), SSM_WIDTH ** -0.5),
        'b_glu': nrm(19, (L, SSM_WIDTH), 0.01),
        'w_mem_kv': nrm(20, (L, D_MODEL, 2 * MEM_HEADS * MEM_HEAD_DIM), D_MODEL ** -0.5),
        'w_branch': nrm(21, (L, N_BRANCH, BRANCH_WIDTH, D_MODEL), BRANCH_WIDTH ** -0.5),
        'w_o': nrm(22, (L, D_MODEL, D_MODEL), D_MODEL ** -0.5 * beta),
        'ln1_g': 1.0 + nrm(23, (L, D_MODEL), 0.02),
        'ln1_b': nrm(24, (L, D_MODEL), 0.02),
        'w_router': nrm(25, (L, D_MODEL, N_EXPERTS), D_MODEL ** -0.5),
        'b_router': nrm(26, (L, N_EXPERTS), 0.01),
        'w_up': nrm(27, (L, N_EXPERTS, D_MODEL, 2 * D_EXPERT), D_MODEL ** -0.5),
        'b_up': nrm(28, (L, N_EXPERTS, 2 * D_EXPERT), 0.01),
        'w_down': nrm(29, (L, N_EXPERTS, D_EXPERT, D_MODEL), D_EXPERT ** -0.5 * beta),
        'b_down': nrm(30, (L, N_EXPERTS, D_MODEL), 0.01),
        'ln2_g': 1.0 + nrm(31, (L, D_MODEL), 0.02),
        'ln2_b': nrm(32, (L, D_MODEL), 0.02),
    }


def reference(x, mem, ln_in_g, ln_in_b, w_in, kv_norm_g, w_uk, w_uv, conv_w, conv_b,
              lam_re, lam_im, b_re, b_im, c_re, c_im, d_skip, log_dt, w_glu, b_glu,
              w_mem_kv, w_branch, w_o, ln1_g, ln1_b, w_router, b_router, w_up, b_up,
              w_down, b_down, ln2_g, ln2_b):
    bsz, seq, _ = x.shape
    split_points = np.cumsum(SPLITS)[:-1].tolist()
    h = layer_norm(x, ln_in_g, ln_in_b)
    for l in range(DEPTH):
        proj = h @ w_in[l]
        (q, ckv, q_idx, k_idx, w_idx, conv_u, conv_gb, conv_gc,
         ssm_u, mem_q, gate_logits) = jnp.split(proj, split_points, axis=-1)
        att = dsa_attention(q.reshape(bsz, seq, N_HEADS, HEAD_DIM), rms_norm(ckv, kv_norm_g[l]),
                            q_idx.reshape(bsz, seq, IDX_HEADS, IDX_DIM), k_idx, w_idx, w_uk[l], w_uv[l])
        cnv = short_conv(conv_u, conv_gb, conv_gc, conv_w[l], conv_b[l])
        ssm = s5_mixer(ssm_u, lam_re[l], lam_im[l], b_re[l], b_im[l], c_re[l], c_im[l],
                       d_skip[l], log_dt[l], w_glu[l], b_glu[l])
        mem_o = memory_attention(mem_q.reshape(bsz, seq, MEM_HEADS, MEM_HEAD_DIM), mem, w_mem_kv[l])
        branches = jnp.stack([att, cnv, ssm, mem_o], axis=2)
        gates = jax.nn.sigmoid(gate_logits.reshape(bsz, seq, N_BRANCH, D_MODEL))
        merged = jnp.sum(jnp.einsum('btrc,rcd->btrd', branches, w_branch[l]) * gates, axis=2)
        h = layer_norm(DEEPNORM_ALPHA * h + merged @ w_o[l], ln1_g[l], ln1_b[l])
        ffn = moe(h, w_router[l], b_router[l], w_up[l], b_up[l], w_down[l], b_down[l])
        h = layer_norm(DEEPNORM_ALPHA * h + ffn, ln2_g[l], ln2_b[l])
    return h
```

```cpp
#include <hip/hip_runtime.h>
#include <cstdio>
#include <cstdint>

#ifndef ONE_LAUNCH
#define ONE_LAUNCH 1
#endif

#define LAS __attribute__((address_space(3)))
#define GAS __attribute__((address_space(1)))
typedef unsigned short bf16;
typedef unsigned v4u __attribute__((ext_vector_type(4)));
typedef unsigned v2u __attribute__((ext_vector_type(2)));
typedef float f32x4 __attribute__((ext_vector_type(4)));
typedef float f32x2 __attribute__((ext_vector_type(2)));
typedef short bf16x8 __attribute__((ext_vector_type(8)));
typedef short v4i16_t __attribute__((ext_vector_type(4)));

namespace pg8 {
constexpr int BM = 256, BK = 64, HALF = 128, HTB = HALF * BK * 2, STAGE_BYTES = 8 * HTB, NXCD = 8, WGM = 8;
__host__ __device__ __forceinline__ int lds_byte(int r, int c) { const int st = (r >> 4) * 2 + (c >> 5), rr = r & 15, cc = c & 31, ob = rr * 64 + cc * 2; return st * 1024 + (ob ^ (((ob >> 9) & 1) << 5)); }
__host__ __device__ __forceinline__ void stage_rc(int b, int& R, int& C) { const int st = b / 1024, sb = b % 1024, swz = sb ^ (((sb >> 9) & 1) << 5); R = (st >> 1) * 16 + swz / 64; C = (st & 1) * 32 + (swz % 64) / 2; }
__host__ __device__ __forceinline__ int perm32(int rho) { const int n = rho >> 4, i = rho & 15; return 8 * (i >> 2) + 4 * n + (i & 3); }

struct Unit { int pm, pn, z; const char* A; const char* B; };
struct Dims { int lda, ldb, K; };
typedef int v8i_t __attribute__((ext_vector_type(8)));
typedef int v4i_t __attribute__((ext_vector_type(4)));

__device__ __forceinline__ void tile_of(int wgid, int nM, int nN, int& pm, int& pn) {
    const int nwg = nM * nN;
    { const int q = nwg / NXCD, r = nwg % NXCD, xcd = wgid % NXCD, off = wgid / NXCD; wgid = (xcd < r ? xcd * (q + 1) : r * (q + 1) + (xcd - r) * q) + off; }
    const int nig = WGM * nN, gid = wgid / nig, fm = gid * WGM, gsz = (nM - fm) < WGM ? (nM - fm) : WGM;
    pm = fm + ((wgid % nig) % gsz); pn = (wgid % nig) / gsz;
}
struct StaticOrder {
    int nM, nN, nwg, G, c; const char* A; const char* B; size_t at, bt;
    __device__ void init(int M, int N, int G_, int c_, const void* A_, int lda, const void* B_, int ldb) { nM = M / BM; nN = N / BM; nwg = nM * nN; G = G_; c = c_; A = (const char*)A_; B = (const char*)B_; at = (size_t)BM * lda; bt = (size_t)BM * ldb; }
    __device__ __forceinline__ bool next(int i, Unit& u) const {
        const long Lx = (long)i * G + c; if (Lx >= nwg) return false;
        int pm, pn; tile_of((int)Lx, nM, nN, pm, pn); u.pm = pm; u.pn = pn; u.z = 0; u.A = A + (size_t)pm * at; u.B = B + (size_t)pn * bt; return true;
    }
};

__device__ __forceinline__ unsigned cvt_pk_bf16(float lo, float hi) { unsigned r; asm volatile("v_cvt_pk_bf16_f32 %0, %1, %2" : "=v"(r) : "v"(lo), "v"(hi)); return r; }

template <class Epi, class Sched, bool ALIGN_EPI = false, bool SP2 = false, bool FP8 = false  ,
          bool GATHER = false  >
__device__ __forceinline__ void gemm_phase(LAS unsigned char* lds, const Dims g, const Sched& S, const Epi& E, int tid_in) {
    int tid = tid_in; asm volatile("" : "+v"(tid));
    const int wid = __builtin_amdgcn_readfirstlane(tid >> 6), lane = tid & 63, wr = wid >> 2, wc = wid & 3, fr = lane & 15, fq = lane >> 4;
    const int nt = g.K / (BK * 2);
    unsigned voffA[2], voffB[2];
#pragma unroll
    for (int i = 0; i < 2; ++i) { int R, C; stage_rc(tid * 16 + i * 8192, R, C); const int Rb = Epi::PERM ? ((R & ~31) + perm32(R & 31)) : R;
        voffA[i] = (unsigned)(R * g.lda + C * 2); voffB[i] = (unsigned)(Rb * g.ldb + C * 2); }
    static_assert(!GATHER || SP2, "gathered A rows: SP2 schedule only");
    unsigned vgc[2][2], vgn[2][2]; bool last_g = false; (void)last_g;
#define PG8_GOFF(u, vg) do { const int* tb_; int s0_, ce_; S.rowinfo(u, tb_, s0_, ce_); _Pragma("unroll") for (int _h = 0; _h < 2; ++_h) _Pragma("unroll") for (int _i = 0; _i < 2; ++_i) { int R, C; stage_rc(tid * 16 + _i * 8192, R, C); \
        const int s_ = s0_ + R + 128 * _h; vg[_h][_i] = (unsigned)tb_[s_ < ce_ ? s_ : 0] * 1024u + (unsigned)(C * 2); } } while (0)
#define PG8_STAGE_A(slot, ptr, half, SEL) do { if constexpr (GATHER) { if (SEL) { const unsigned vt_[2] = {last_g ? vgn[half][0] : vgc[half][0], last_g ? vgn[half][1] : vgc[half][1]}; PG8_STAGE(slot, ptr, vt_); } else PG8_STAGE(slot, ptr, vgc[half]); } else PG8_STAGE(slot, (ptr) + ((half) ? hstepA : (size_t)0), voffA); } while (0)
    const size_t kstep = (size_t)(BK * 2);
    const size_t hstepA = (size_t)HALF * g.lda, hstepB = (size_t)HALF * g.ldb;
    const unsigned ldsw = (unsigned)wid * 1024u;
    const int aoff0 = lds_byte(wr * 64 + fr, fq * 8), aoff1 = aoff0 + 1024;
    const int boff0 = lds_byte(wc * 32 + fr, fq * 8), boff1 = boff0 + 1024;
#define PG8_SA(b, h) (((b) * 2 + (h)) * HTB)
#define PG8_SB(b, h) ((4 + (b) * 2 + (h)) * HTB)
#define PG8_STAGE(bufoff, gbase, voff) do { _Pragma("unroll") for (int _i = 0; _i < 2; ++_i) \
        __builtin_amdgcn_global_load_lds((const unsigned*)((const char*)(gbase) + (voff)[_i]), (LAS unsigned*)(lds + (bufoff) + ldsw + _i * 8192), 16, 0, 0); } while (0)
#define PG8_LDA(dst, b, h) do { _Pragma("unroll") for (int m = 0; m < 4; ++m) _Pragma("unroll") for (int k = 0; k < 2; ++k) dst[m][k] = *(const LAS bf16x8*)(lds + PG8_SA(b, h) + (k ? aoff1 : aoff0) + m * 2048); } while (0)
#define PG8_LDB(dst, b, h) do { _Pragma("unroll") for (int n = 0; n < 2; ++n) _Pragma("unroll") for (int k = 0; k < 2; ++k) dst[n][k] = *(const LAS bf16x8*)(lds + PG8_SB(b, h) + (k ? boff1 : boff0) + n * 2048); } while (0)
#define PG8_MMA(ai, bj, At, Bt) do { __builtin_amdgcn_s_setprio(1); _Pragma("unroll") for (int m = 0; m < 4; ++m) _Pragma("unroll") for (int n = 0; n < 2; ++n) _Pragma("unroll") for (int k = 0; k < 2; ++k) { \
        if constexpr (FP8) acc[ai][bj][m][n] = __builtin_bit_cast(f32x4, __builtin_amdgcn_mfma_i32_16x16x64_i8(__builtin_bit_cast(v4i_t, Bt[n][k]), __builtin_bit_cast(v4i_t, At[m][k]), __builtin_bit_cast(v4i_t, acc[ai][bj][m][n]), 0, 0, 0)); \
        else acc[ai][bj][m][n] = __builtin_amdgcn_mfma_f32_16x16x32_bf16(Bt[n][k], At[m][k], acc[ai][bj][m][n], 0, 0, 0); } __builtin_amdgcn_s_setprio(0); } while (0)
#define PG8_WAIT_V(n) asm volatile("s_waitcnt vmcnt(" #n ")" ::: "memory")
#define PG8_WAIT_L(n) asm volatile("s_waitcnt lgkmcnt(" #n ")" ::: "memory")
#define PG8_BAR __builtin_amdgcn_s_barrier()
#define PG8_SCHED __builtin_amdgcn_sched_barrier(0)
    Unit cur, nxt; int ui = 0;
    if (!S.next(0, cur)) return;
    f32x4 acc[2][2][4][2];
    float zq = 0.f; asm volatile("" : "+v"(zq));
#pragma unroll
    for (int a = 0; a < 2; ++a)
#pragma unroll
        for (int b = 0; b < 2; ++b)
#pragma unroll
            for (int m = 0; m < 4; ++m)
#pragma unroll
                for (int n = 0; n < 2; ++n) acc[a][b][m][n] = (f32x4){zq, zq, zq, zq};
    bf16x8 At[4][2], B0[2][2], B1[2][2];
    const char* cA = cur.A; const char* cB = cur.B;
    if constexpr (SP2) {
        if constexpr (GATHER) PG8_GOFF(cur, vgc);
        PG8_STAGE(PG8_SB(0, 0), cB, voffB); PG8_STAGE(PG8_SB(0, 1), cB + hstepB, voffB); PG8_STAGE_A(PG8_SA(0, 0), cA, 0, 0); PG8_STAGE_A(PG8_SA(0, 1), cA, 1, 0);
        if (wr == 1) PG8_BAR;
        PG8_WAIT_V(2); PG8_BAR;
        PG8_STAGE(PG8_SB(1, 0), cB + kstep, voffB); PG8_STAGE_A(PG8_SA(1, 0), cA + kstep, 0, 0); PG8_STAGE(PG8_SB(1, 1), cB + hstepB + kstep, voffB);
        PG8_WAIT_V(6); PG8_BAR;
    } else {
        PG8_STAGE(PG8_SB(0, 0), cB, voffB); PG8_STAGE(PG8_SA(0, 0), cA, voffA); PG8_STAGE(PG8_SB(0, 1), cB + hstepB, voffB); PG8_STAGE(PG8_SA(0, 1), cA + hstepA, voffA);
        if (wr == 1) PG8_BAR;
        PG8_WAIT_V(4); PG8_BAR;
        PG8_STAGE(PG8_SB(1, 0), cB + kstep, voffB); PG8_STAGE(PG8_SA(1, 0), cA + kstep, voffA); PG8_STAGE(PG8_SB(1, 1), cB + hstepB + kstep, voffB);
        PG8_WAIT_V(6); PG8_BAR;
    }
    for (;;) {
        const bool has_next = S.next(ui + 1, nxt);
        const char* nA = has_next ? nxt.A : cA; const char* nB = has_next ? nxt.B : cB;
        if constexpr (GATHER) { if (has_next) PG8_GOFF(nxt, vgn); else {
#pragma unroll
            for (int _h = 0; _h < 2; ++_h) { vgn[_h][0] = vgc[_h][0]; vgn[_h][1] = vgc[_h][1]; } } }
#pragma unroll 1
        for (int t = 0; t < nt; t += 2) {
            const bool last = (t == nt - 2);
            const char* a1 = cA + (size_t)(t + 1) * kstep;
            const char* a2 = last ? nA : cA + (size_t)(t + 2) * kstep; const char* b2 = last ? nB : cB + (size_t)(t + 2) * kstep;
            const char* a3 = a2 + kstep; const char* b3 = b2 + kstep;
            if constexpr (SP2) {
            if constexpr (GATHER) last_g = last;
            PG8_LDB(B0, 0, 0); PG8_LDB(B1, 0, 1); PG8_SCHED; PG8_LDA(At, 0, 0); PG8_STAGE_A(PG8_SA(1, 1), a1, 1, 0);
            PG8_WAIT_V(8); PG8_WAIT_L(0); PG8_BAR; PG8_MMA(0, 0, At, B0); PG8_MMA(0, 1, At, B1); PG8_BAR; PG8_SCHED;
            PG8_LDA(At, 0, 1); PG8_STAGE(PG8_SB(0, 0), b2, voffB); PG8_STAGE(PG8_SB(0, 1), b2 + hstepB, voffB); PG8_STAGE_A(PG8_SA(0, 0), a2, 0, 1);
            PG8_WAIT_V(8); PG8_WAIT_L(0); PG8_BAR; PG8_MMA(1, 0, At, B0); PG8_MMA(1, 1, At, B1); PG8_BAR; PG8_SCHED;
            PG8_LDB(B0, 1, 0); PG8_LDB(B1, 1, 1); PG8_SCHED; PG8_LDA(At, 1, 0); PG8_STAGE_A(PG8_SA(0, 1), a2, 1, 1);
            PG8_WAIT_V(8); PG8_WAIT_L(0); PG8_BAR; PG8_MMA(0, 0, At, B0); PG8_MMA(0, 1, At, B1); PG8_BAR; PG8_SCHED;
            PG8_LDA(At, 1, 1); PG8_STAGE(PG8_SB(1, 0), b3, voffB); PG8_STAGE(PG8_SB(1, 1), b3 + hstepB, voffB); PG8_STAGE_A(PG8_SA(1, 0), a3, 0, 1);
            PG8_WAIT_V(8); PG8_WAIT_L(0); PG8_BAR; PG8_MMA(1, 0, At, B0); PG8_MMA(1, 1, At, B1); PG8_BAR; PG8_SCHED;
            } else {
            PG8_LDB(B0, 0, 0); PG8_SCHED; PG8_LDA(At, 0, 0); PG8_STAGE(PG8_SA(1, 1), a1 + hstepA, voffA);
            PG8_WAIT_L(8); PG8_BAR; PG8_WAIT_L(0); PG8_MMA(0, 0, At, B0); PG8_BAR; PG8_SCHED;
            PG8_LDB(B1, 0, 1); PG8_STAGE(PG8_SB(0, 0), b2, voffB);
            PG8_BAR; PG8_WAIT_L(0); PG8_MMA(0, 1, At, B1); PG8_BAR;
            PG8_LDA(At, 0, 1); PG8_STAGE(PG8_SA(0, 0), a2, voffA);
            PG8_BAR; PG8_WAIT_L(0); PG8_MMA(1, 0, At, B0); PG8_BAR; PG8_SCHED;
            PG8_STAGE(PG8_SB(0, 1), b2 + hstepB, voffB);
            PG8_WAIT_V(6); PG8_BAR; PG8_MMA(1, 1, At, B1); PG8_BAR;
            PG8_LDB(B0, 1, 0); PG8_SCHED; PG8_LDA(At, 1, 0); PG8_STAGE(PG8_SA(0, 1), a2 + hstepA, voffA);
            PG8_WAIT_L(8); PG8_BAR; PG8_WAIT_L(0); PG8_MMA(0, 0, At, B0); PG8_BAR; PG8_SCHED;
            PG8_LDB(B1, 1, 1); PG8_STAGE(PG8_SB(1, 0), b3, voffB);
            PG8_BAR; PG8_WAIT_L(0); PG8_MMA(0, 1, At, B1); PG8_BAR;
            PG8_LDA(At, 1, 1); PG8_STAGE(PG8_SA(1, 0), a3, voffA);
            PG8_BAR; PG8_WAIT_L(0); PG8_MMA(1, 0, At, B0); PG8_BAR; PG8_SCHED;
            PG8_STAGE(PG8_SB(1, 1), b3 + hstepB, voffB);
            PG8_WAIT_V(6); PG8_BAR; PG8_MMA(1, 1, At, B1); PG8_BAR;
            }
        }
        if constexpr (ALIGN_EPI) { if (wr == 0) PG8_BAR; }
        E(acc, cur, wr, wc, fr, fq);
        if (!has_next) break;
#pragma unroll
        for (int a = 0; a < 2; ++a)
#pragma unroll
            for (int b = 0; b < 2; ++b)
#pragma unroll
                for (int m = 0; m < 4; ++m)
#pragma unroll
                    for (int n = 0; n < 2; ++n) acc[a][b][m][n] = (f32x4){zq, zq, zq, zq};
        cur = nxt; cA = nA; cB = nB; ++ui;
        if constexpr (GATHER) {
#pragma unroll
            for (int _h = 0; _h < 2; ++_h) { vgc[_h][0] = vgn[_h][0]; vgc[_h][1] = vgn[_h][1]; } }
        if constexpr (ALIGN_EPI) { if (wr == 1) PG8_BAR; }
    }
    PG8_WAIT_V(0);
    if constexpr (!ALIGN_EPI) { if (wr == 0) PG8_BAR; }
    PG8_BAR;
#undef PG8_GOFF
#undef PG8_STAGE_A
#undef PG8_SA
#undef PG8_SB
#undef PG8_STAGE
#undef PG8_LDA
#undef PG8_LDB
#undef PG8_MMA
#undef PG8_WAIT_V
#undef PG8_WAIT_L
#undef PG8_BAR
#undef PG8_SCHED
}
}

constexpr int NB = 2, T = 8192, D = 1024, M = NB * T, NL = 4;
constexpr int DIN = 7592, NP = 8192;
constexpr int PC_QLAT = 0, PC_CKV = 1024, PC_KIDX = 1152, PC_WIDX = 1184, PC_QIDX = 1280, PC_CU = 1536, PC_GB = 2048, PC_GC = 2560, PC_SU = 3072, PC_MQ = 3584, PC_GATE = 4096;
constexpr int SC_Q = 0, SC_CKV = 512, SC_QIDX = 640, SC_KIDX = 896, SC_WIDX = 928, SC_CU = 936, SC_GB = 1448, SC_GC = 1960, SC_SU = 2472, SC_MQ = 2984, SC_GATE = 3496;
constexpr float QS_H = 127.f / 5.f, QS_WUP = 127.f / (4.5f * 0.03125f), QS_ACT = 127.f / 12.f, QS_WDN = 127.f / (4.5f * 0.013139006f), QS_WIN = 127.f / (4.5f * 0.03125f), QS_WQL = 8.f * QS_WIN;
constexpr int NE = 32, FE = 1024, MAXBLK = 288, MOE_ROWS = MAXBLK * 256;
constexpr int SSM_LC = 32, SSM_NC = T / SSM_LC, SSM_K = SSM_LC * 16 + 128;
constexpr float LN_EPS = 1e-5f;
constexpr float DN_ALPHA = 1.681792830507429f;

constexpr size_t MiB = 1u << 20;
constexpr size_t WS_CTL = 0, CTL_ZERO_BYTES = 1 * MiB;
constexpr size_t WS_WIN = 1 * MiB;
constexpr size_t WS_WGLU = WS_WIN + (size_t)NL * NP * D * 2;
constexpr size_t WS_WMKV = WS_WGLU + (size_t)NL * 512 * 512 * 2;
constexpr size_t WS_WUV = WS_WMKV + (size_t)NL * 1024 * 1024 * 2;
constexpr size_t WS_WBR = WS_WUV + (size_t)NL * 512 * 1024 * 2;
constexpr size_t WS_WO = WS_WBR + (size_t)NL * 4 * 1024 * 512 * 2;
constexpr size_t WS_WUP = WS_WO + (size_t)NL * 1024 * 1024 * 2;
constexpr size_t WS_WDN = WS_WUP + (size_t)NL * NE * 2048 * 1024 * 2;
constexpr size_t WS_S5A = WS_WDN + (size_t)NL * NE * 1024 * 1024 * 2;
constexpr size_t WS_S5B = WS_S5A + 1 * MiB;
constexpr size_t WS_MEMB = WS_S5B + 1 * MiB;
constexpr size_t WS_MKV = WS_MEMB + 1 * MiB;
constexpr size_t WS_H = WS_MKV + 4 * MiB;
constexpr size_t WS_HB = WS_H + (size_t)M * D * 4;
constexpr size_t WS_PROJ = WS_HB + (size_t)M * D * 2;
constexpr size_t WS_KVN = WS_PROJ + (size_t)M * NP * 2;
constexpr size_t WS_OLAT = WS_KVN + (size_t)M * 128 * 2;
constexpr size_t WS_BR = WS_OLAT + (size_t)M * 1024 * 2;
constexpr size_t WS_Z = WS_BR + (size_t)M * 2048 * 2;
constexpr size_t WS_MRG = WS_Z + (size_t)M * 512 * 2;
constexpr size_t WS_MRGB = WS_MRG + (size_t)M * D * 4;
constexpr size_t WS_V = WS_MRGB + (size_t)M * D * 2;
constexpr size_t WS_H1 = WS_V + (size_t)M * D * 4;
constexpr size_t WS_H1B = WS_H1 + (size_t)M * D * 4;
constexpr size_t WS_SSE = WS_H1B + (size_t)M * D * 2;
constexpr size_t WS_SSC = WS_SSE + (size_t)NB * SSM_NC * 32 * 64 * 8;
constexpr size_t WS_TOK = WS_SSC + (size_t)NB * SSM_NC * 32 * 64 * 8;
constexpr size_t WS_GATE = WS_TOK + (size_t)NE * M * 4;
constexpr size_t WS_SLOT = WS_GATE + (size_t)NE * M * 4;
constexpr size_t WS_XS = WS_SLOT + (size_t)M * 4 * 4;
constexpr size_t WS_ACT = WS_XS + (size_t)MOE_ROWS * 1024 * 2;
constexpr size_t WS_SCR = WS_ACT + (size_t)MOE_ROWS * 1024 * 2;
constexpr size_t WS_KIDX = WS_SCR + (size_t)256 * 2 * 8 * 8192 * 4;
constexpr size_t WS_WSSM = WS_KIDX + (size_t)M * 32 * 2;
constexpr size_t WS_AEXT = WS_WSSM + (size_t)NL * 32 * 512 * SSM_K * 2;
constexpr size_t WS_WE = WS_AEXT + (size_t)32 * 512 * SSM_K * 2;
constexpr size_t WS_END = WS_WE + (size_t)NL * 32 * 256 * 512 * 2;
constexpr int CW_TMO = 0, CW_BAR = 4096, CW_CNT = 16384, CW_Q0 = 2048;

constexpr int RING_BYTES = 131072, LDSCTL_OFF = RING_BYTES, MISC_OFF = LDSCTL_OFF + 320, LDS_BYTES = 147456;
constexpr int NWAVES = 8;

#define RLX_AGENT __ATOMIC_RELAXED, __HIP_MEMORY_SCOPE_AGENT
#define LDS_WAIT() asm volatile("s_waitcnt lgkmcnt(0)" ::: "memory")
#define VM_WAIT() asm volatile("s_waitcnt vmcnt(0)" ::: "memory")
__device__ __forceinline__ unsigned f2bf(float f) { unsigned u = __builtin_bit_cast(unsigned, f); return (u + 0x7fffu + ((u >> 16) & 1u)) >> 16; }
__device__ __forceinline__ unsigned pk2(float lo, float hi) { return f2bf(lo) | (f2bf(hi) << 16); }
__device__ __forceinline__ float bflo(unsigned w) { return __builtin_bit_cast(float, w << 16); }
__device__ __forceinline__ float bfhi(unsigned w) { return __builtin_bit_cast(float, w & 0xffff0000u); }
__device__ __forceinline__ float bf1(bf16 v) { return __builtin_bit_cast(float, (unsigned)v << 16); }
__device__ __forceinline__ unsigned q8_(float x, float s) { return (unsigned)(int)__builtin_rintf(fminf(fmaxf(x * s, -127.f), 127.f)) & 255u; }
__device__ __forceinline__ unsigned q8x4(float a, float b, float c, float d, float s) { return q8_(a, s) | (q8_(b, s) << 8) | (q8_(c, s) << 16) | (q8_(d, s) << 24); }
__device__ __forceinline__ float sigmoidf_(float x) { return __builtin_amdgcn_rcpf(1.f + __expf(-x)); }
__device__ __forceinline__ int lane_op() { int l = (int)__builtin_amdgcn_mbcnt_hi(~0u, __builtin_amdgcn_mbcnt_lo(~0u, 0u)); asm volatile("" : "+v"(l)); return l; }
template <class Tv> __device__ __forceinline__ Tv bperm_(int srcLane, Tv v) { return __builtin_bit_cast(Tv, __builtin_amdgcn_ds_bpermute(srcLane << 2, __builtin_bit_cast(int, v))); }
#define SHX(v, m, l) bperm_((l) ^ (m), (v))
#define SHD(v, o, l) bperm_((l) + (o), (v))
#define SHI(v, s) bperm_((s), (v))
__device__ __forceinline__ float wave_sum(float v) { const int l = lane_op();
#pragma unroll
    for (int o = 1; o < 64; o <<= 1) v += SHX(v, o, l);
    return v;
}
__device__ __forceinline__ float wave_max(float v) { const int l = lane_op();
#pragma unroll
    for (int o = 1; o < 64; o <<= 1) v = fmaxf(v, SHX(v, o, l));
    return v;
}

#define XB_TMO      128
#define XB_XCNT(j)  (256  + 64 * (j))
#define XB_XSUB(j)  (1280 + 64 * (j))
#define XB_XGEN(j)  (2304 + 64 * (j))
#define XB_TOP      3328
#define XB_TOPGEN   3392
#define XCD_BAR_WORDS 3456
#define XB_SPIN_CAP (1u << 18)
__device__ __forceinline__ unsigned xb_ld(unsigned* p)              { return __hip_atomic_load(p, __ATOMIC_RELAXED, __HIP_MEMORY_SCOPE_AGENT); }
__device__ __forceinline__ unsigned xb_add(unsigned* p, unsigned v) { return __hip_atomic_fetch_add(p, v, __ATOMIC_RELAXED, __HIP_MEMORY_SCOPE_AGENT); }
__device__ __forceinline__ unsigned xb_xcc_id() { return (unsigned)__builtin_amdgcn_s_getreg((3 << 11) | 20) & 0xFu; }
#define XB_SPIN(cond, bar) do { unsigned _sp = 0; while (cond) { __builtin_amdgcn_s_sleep(1); \
    if ((++_sp & 255u) == 0u) { if (xb_ld(&(bar)[XB_TMO])) break; if (_sp > XB_SPIN_CAP) { atomicAdd(&(bar)[XB_TMO], 1u); break; } } } } while (0)
struct XcdBarrier { unsigned* bar; unsigned x; volatile LAS unsigned* st; };
__device__ __forceinline__ XcdBarrier xcd_barrier_post(unsigned* bar, volatile LAS unsigned* st) {
    XcdBarrier b; b.bar = bar; b.x = xb_xcc_id(); b.st = st;
    if (threadIdx.x == 0) st[2] = xb_add(&bar[XB_XCNT(b.x)], 1u);
    return b;
}
__device__ __forceinline__ void xcd_barrier_complete(unsigned* bar, unsigned x, unsigned& nloc, unsigned& nx, unsigned& balanced) {
    const unsigned G = gridDim.x * gridDim.y * gridDim.z;
    unsigned sum, cnt, mine, sp = 0u, bal;
    for (;;) {
        sum = 0u; cnt = 0u; mine = 0u; bal = 1u;
#pragma unroll 1
        for (unsigned j = 0; j < 16; ++j) { const unsigned c = xb_ld(&bar[XB_XCNT(j)]); sum += c; cnt += (c > 0u) ? 1u : 0u; mine = (j == x) ? c : mine; bal = (c == (j < 8u ? (G >> 3) : 0u)) ? bal : 0u; }
        if (sum == G) break;
        __builtin_amdgcn_s_sleep(1);
        if ((++sp & 255u) == 0u) { if (xb_ld(&bar[XB_TMO])) break; if (sp > XB_SPIN_CAP) { atomicAdd(&bar[XB_TMO], 1u); break; } }
    }
    nloc = mine > 0u ? mine : 1u; nx = cnt > 0u ? cnt : 1u; balanced = ((G & 7u) == 0u && sum == G) ? bal : 0u;
}
__device__ __forceinline__ void xcd_barrier(const XcdBarrier& b, int tid_) {
    asm volatile("s_waitcnt vmcnt(0)" ::: "memory");
    __syncthreads();
    if (tid_ == 0) {
        unsigned* bar = b.bar;
        __builtin_amdgcn_s_waitcnt(0);
        unsigned nloc = b.st[0], nx = b.st[1];
        if (nloc == 0u) { unsigned bal_; xcd_barrier_complete(bar, b.x, nloc, nx, bal_); b.st[0] = nloc; b.st[1] = nx;
            b.st[3] = (bal_ ? b.st[2] * 8u + b.x : (unsigned)blockIdx.x) + 1u; }
        const unsigned old = xb_add(&bar[XB_XSUB(b.x)], 1u);
        const unsigned gen = old / nloc;
        if (old + 1u == (gen + 1u) * nloc) {
            __builtin_amdgcn_fence(__ATOMIC_RELEASE, "agent");
            asm volatile("s_waitcnt vmcnt(0)" ::: "memory");
            const unsigned og = xb_add(&bar[XB_TOP], 1u);
            const unsigned tg = og / nx;
            if (og + 1u == (tg + 1u) * nx) xb_add(&bar[XB_TOPGEN], 1u);
            else XB_SPIN(xb_ld(&bar[XB_TOPGEN]) == tg, bar);
            __builtin_amdgcn_fence(__ATOMIC_ACQUIRE, "agent");
            xb_add(&bar[XB_XGEN(b.x)], 1u);
            asm volatile("s_waitcnt vmcnt(0)" ::: "memory");
        } else {
            XB_SPIN(xb_ld(&bar[XB_XGEN(b.x)]) == gen, bar);
            __builtin_amdgcn_fence(__ATOMIC_ACQUIRE, "agent");
            asm volatile("s_waitcnt vmcnt(0)" ::: "memory");
        }
    }
    __syncthreads();
}

__device__ __forceinline__ unsigned long long ldp(volatile LAS unsigned long long* PT, int k) { const unsigned long long v = PT[k];
    const unsigned lo = __builtin_amdgcn_readfirstlane((unsigned)v), hi = __builtin_amdgcn_readfirstlane((unsigned)(v >> 32)); return ((unsigned long long)hi << 32) | lo; }
typedef __attribute__((address_space(1))) unsigned char gu8_t;
__device__ __forceinline__ unsigned char* gptr(unsigned long long v) { return (unsigned char*)(gu8_t*)v; }
struct Args { const float* in[33]; float* out; unsigned char* ws; int ph_lo, ph_hi; };

struct Frame {
    LAS unsigned char* lds;
    int tid, lane, wave, G, gw, NGW, bx;
};

using pg8::Unit; using pg8::cvt_pk_bf16; using pg8::v4i_t;
struct EpiBf16 {
    static constexpr bool PERM = true;
    bf16* O; int ldc;
    __device__ __forceinline__ void operator()(const f32x4 (&acc)[2][2][4][2], const Unit& u, int wr, int wc, int fr, int fq) const {
        const int row0 = u.pm * 256 + wr * 64 + fr, col0 = u.pn * 256 + wc * 32 + 8 * fq;
#pragma unroll
        for (int ai = 0; ai < 2; ++ai)
#pragma unroll
            for (int m = 0; m < 4; ++m) { bf16* rowp = O + (size_t)(row0 + ai * 128 + m * 16) * ldc + col0;
#pragma unroll
                for (int bj = 0; bj < 2; ++bj) { const f32x4 v0 = acc[ai][bj][m][0], v1 = acc[ai][bj][m][1];
                    v4u w; w.x = cvt_pk_bf16(v0[0], v0[1]); w.y = cvt_pk_bf16(v0[2], v0[3]); w.z = cvt_pk_bf16(v1[0], v1[1]); w.w = cvt_pk_bf16(v1[2], v1[3]);
                    *(v4u*)(rowp + bj * 128) = w; } }
    }
};
struct EpiProjQ {
    static constexpr bool PERM = true;
    bf16* O; int ldc; bf16* AX;
    __device__ __forceinline__ void operator()(const f32x4 (&acc)[2][2][4][2], const Unit& u, int wr, int wc, int fr, int fq) const {
        const int row0 = u.pm * 256 + wr * 64 + fr, col0 = u.pn * 256 + wc * 32 + 8 * fq; const float dq = 1.f / (QS_H * (u.pn < 4 ? QS_WQL : QS_WIN));
#pragma unroll
        for (int ai = 0; ai < 2; ++ai)
#pragma unroll
            for (int m = 0; m < 4; ++m) { bf16* rowp = O + (size_t)(row0 + ai * 128 + m * 16) * ldc + col0;
#pragma unroll
                for (int bj = 0; bj < 2; ++bj) { const v4i_t i0 = __builtin_bit_cast(v4i_t, acc[ai][bj][m][0]), i1 = __builtin_bit_cast(v4i_t, acc[ai][bj][m][1]);
                    v4u w; w.x = cvt_pk_bf16((float)i0[0] * dq, (float)i0[1] * dq); w.y = cvt_pk_bf16((float)i0[2] * dq, (float)i0[3] * dq); w.z = cvt_pk_bf16((float)i1[0] * dq, (float)i1[1] * dq); w.w = cvt_pk_bf16((float)i1[2] * dq, (float)i1[3] * dq);
                    if (u.pn == 12 || u.pn == 13) { const int m_ = row0 + ai * 128 + m * 16, ch = (u.pn - 12) * 256 + wc * 32 + 8 * fq + bj * 128, tl = m_ & (T - 1);
                        *(v4u*)(AX + ((size_t)((ch >> 4) * 512 + (m_ >> 13) * 256 + (tl >> 5))) * SSM_K + (tl & 31) * 16 + (ch & 15)) = w; }
                    else *(v4u*)(rowp + bj * 128) = w; } }
    }
};
struct EpiE {
    static constexpr bool PERM = true;
    float* E2;
    __device__ __forceinline__ void operator()(const f32x4 (&acc)[2][2][4][2], const Unit& u, int wr, int wc, int fr, int fq) const {
        const int row0 = u.pm * 256 + wr * 64 + fr, col0 = wc * 32 + 8 * fq;
#pragma unroll
        for (int ai = 0; ai < 2; ++ai)
#pragma unroll
            for (int m = 0; m < 4; ++m) { float* p = E2 + ((size_t)(row0 + ai * 128 + m * 16) * 32 + u.z) * 128 + col0; *(f32x4*)p = acc[ai][0][m][0]; *(f32x4*)(p + 4) = acc[ai][0][m][1]; }
    }
};
struct EOrder {
    int G, c; const char* A; const char* B;
    __device__ __forceinline__ bool next(int i, Unit& u) const {
        const int Lx = i * G + c; if (Lx >= 64) return false;
        const int g = Lx >> 1, pm = Lx & 1; u.pm = pm; u.pn = 0; u.z = g; u.A = A + ((size_t)g * 512 + pm * 256) * SSM_K * 2; u.B = B + (size_t)g * 256 * 512 * 2; return true;
    }
};
struct EpiMkv {
    static constexpr bool PERM = true;
    bf16* O;
    __device__ __forceinline__ void operator()(const f32x4 (&acc)[2][2][4][2], const Unit& u, int wr, int wc, int fr, int fq) const {
        EpiBf16 e{O + (size_t)u.z * 512 * 1024, 1024}; e(acc, u, wr, wc, fr, fq);
    }
};
struct EpiGlu {
    static constexpr bool PERM = true;
    const bf16* Z; int ldz; const float* bias; bf16* O; int ldo;
    __device__ __forceinline__ void operator()(const f32x4 (&acc)[2][2][4][2], const Unit& u, int wr, int wc, int fr, int fq) const {
        const int row0 = u.pm * 256 + wr * 64 + fr, col0 = u.pn * 256 + wc * 32 + 8 * fq;
        f32x4 bv[2][2];
#pragma unroll
        for (int bj = 0; bj < 2; ++bj)
#pragma unroll
            for (int n = 0; n < 2; ++n) bv[bj][n] = *(const f32x4*)(bias + col0 + bj * 128 + 4 * n);
#pragma unroll
        for (int ai = 0; ai < 2; ++ai) { v4u zq[4][2];
#pragma unroll
            for (int m = 0; m < 4; ++m)
#pragma unroll
                for (int bj = 0; bj < 2; ++bj) zq[m][bj] = *(const v4u*)(Z + (size_t)(row0 + ai * 128 + m * 16) * ldz + col0 + bj * 128);
#pragma unroll
            for (int m = 0; m < 4; ++m) { const size_t r = (size_t)(row0 + ai * 128 + m * 16);
#pragma unroll
                for (int bj = 0; bj < 2; ++bj) { const f32x4 v0 = acc[ai][bj][m][0] + bv[bj][0], v1 = acc[ai][bj][m][1] + bv[bj][1];
                    const v4u zz = zq[m][bj];
                    v4u w;
                    w.x = cvt_pk_bf16(bflo(zz.x) * sigmoidf_(v0[0]), bfhi(zz.x) * sigmoidf_(v0[1]));
                    w.y = cvt_pk_bf16(bflo(zz.y) * sigmoidf_(v0[2]), bfhi(zz.y) * sigmoidf_(v0[3]));
                    w.z = cvt_pk_bf16(bflo(zz.z) * sigmoidf_(v1[0]), bfhi(zz.z) * sigmoidf_(v1[1]));
                    w.w = cvt_pk_bf16(bflo(zz.w) * sigmoidf_(v1[2]), bfhi(zz.w) * sigmoidf_(v1[3]));
                    *(v4u*)(O + r * ldo + col0 + bj * 128) = w; } } }
    }
};
struct EpiMerge {
    static constexpr bool PERM = true;
    const bf16* G; int ldg; bf16* Mb;
    __device__ __forceinline__ void operator()(const f32x4 (&acc)[2][2][4][2], const Unit& u, int wr, int wc, int fr, int fq) const {
        const int row0 = u.pm * 256 + wr * 64 + fr, col0 = u.pn * 256 + wc * 32 + 8 * fq; const int r = u.z;
#pragma unroll
        for (int ai = 0; ai < 2; ++ai) { v4u gq[4][2], pq[4][2];
#pragma unroll
            for (int m = 0; m < 4; ++m) { const size_t rr = (size_t)(row0 + ai * 128 + m * 16);
#pragma unroll
                for (int bj = 0; bj < 2; ++bj) { const int c = col0 + bj * 128; gq[m][bj] = *(const v4u*)(G + rr * ldg + r * 1024 + c); pq[m][bj] = (v4u){0u, 0u, 0u, 0u}; if (r) pq[m][bj] = *(const v4u*)(Mb + rr * 1024 + c); } }
#pragma unroll
            for (int m = 0; m < 4; ++m) { const size_t rr = (size_t)(row0 + ai * 128 + m * 16);
#pragma unroll
                for (int bj = 0; bj < 2; ++bj) { const int c = col0 + bj * 128;
                    const v4u gg = gq[m][bj], pv = pq[m][bj]; bf16* mp = Mb + rr * 1024 + c;
                    f32x4 o0 = (f32x4){bflo(pv.x), bfhi(pv.x), bflo(pv.y), bfhi(pv.y)}, o1 = (f32x4){bflo(pv.z), bfhi(pv.z), bflo(pv.w), bfhi(pv.w)};
                    const f32x4 v0 = acc[ai][bj][m][0], v1 = acc[ai][bj][m][1];
                    o0[0] += sigmoidf_(bflo(gg.x)) * v0[0]; o0[1] += sigmoidf_(bfhi(gg.x)) * v0[1]; o0[2] += sigmoidf_(bflo(gg.y)) * v0[2]; o0[3] += sigmoidf_(bfhi(gg.y)) * v0[3];
                    o1[0] += sigmoidf_(bflo(gg.z)) * v1[0]; o1[1] += sigmoidf_(bfhi(gg.z)) * v1[1]; o1[2] += sigmoidf_(bflo(gg.w)) * v1[2]; o1[3] += sigmoidf_(bfhi(gg.w)) * v1[3];
                    v4u w; w.x = cvt_pk_bf16(o0[0], o0[1]); w.y = cvt_pk_bf16(o0[2], o0[3]); w.z = cvt_pk_bf16(o1[0], o1[1]); w.w = cvt_pk_bf16(o1[2], o1[3]); *(v4u*)mp = w; } } }
    }
};
struct EpiWo {
    static constexpr bool PERM = true;
    const bf16* H; bf16* V;
    __device__ __forceinline__ void operator()(const f32x4 (&acc)[2][2][4][2], const Unit& u, int wr, int wc, int fr, int fq) const {
        const int row0 = u.pm * 256 + wr * 64 + fr, col0 = u.pn * 256 + wc * 32 + 8 * fq;
#pragma unroll
        for (int ai = 0; ai < 2; ++ai) { v4u hq[4][2];
#pragma unroll
            for (int m = 0; m < 4; ++m)
#pragma unroll
                for (int bj = 0; bj < 2; ++bj) hq[m][bj] = *(const v4u*)(H + (size_t)(row0 + ai * 128 + m * 16) * 1024 + col0 + bj * 128);
#pragma unroll
            for (int m = 0; m < 4; ++m) { const size_t off = (size_t)(row0 + ai * 128 + m * 16) * 1024 + col0;
#pragma unroll
                for (int bj = 0; bj < 2; ++bj) { const v4u hh = hq[m][bj]; const f32x4 v0 = acc[ai][bj][m][0], v1 = acc[ai][bj][m][1];
                    v4u w; w.x = cvt_pk_bf16(bflo(hh.x) * DN_ALPHA + v0[0], bfhi(hh.x) * DN_ALPHA + v0[1]); w.y = cvt_pk_bf16(bflo(hh.y) * DN_ALPHA + v0[2], bfhi(hh.y) * DN_ALPHA + v0[3]);
                    w.z = cvt_pk_bf16(bflo(hh.z) * DN_ALPHA + v1[0], bfhi(hh.z) * DN_ALPHA + v1[1]); w.w = cvt_pk_bf16(bflo(hh.w) * DN_ALPHA + v1[2], bfhi(hh.w) * DN_ALPHA + v1[3]);
                    *(v4u*)(V + off + bj * 128) = w; } } }
    }
};
struct EpiUp {
    static constexpr bool PERM = true;
    const float* bup; unsigned char* ACT;
    __device__ __forceinline__ void operator()(const f32x4 (&acc)[2][2][4][2], const Unit& u, int wr, int wc, int fr, int fq) const {
        const int row0 = u.pm * 256 + wr * 64 + fr, col0 = u.pn * 256 + wc * 32 + 8 * fq; const float* bb = bup + (size_t)u.z * 2048; const float dq = 1.f / (QS_H * QS_WUP);
        f32x4 bv[2][2];
#pragma unroll
        for (int bj = 0; bj < 2; ++bj)
#pragma unroll
            for (int n = 0; n < 2; ++n) bv[bj][n] = *(const f32x4*)(bb + col0 + bj * 128 + 4 * n);
#pragma unroll
        for (int ai = 0; ai < 2; ++ai)
#pragma unroll
            for (int m = 0; m < 4; ++m) { const size_t r = (size_t)(row0 + ai * 128 + m * 16);
#pragma unroll
                for (int bj = 0; bj < 2; ++bj) { const v4i_t i0 = __builtin_bit_cast(v4i_t, acc[ai][bj][m][0]), i1 = __builtin_bit_cast(v4i_t, acc[ai][bj][m][1]);
                    const f32x4 v0 = (f32x4){(float)i0[0], (float)i0[1], (float)i0[2], (float)i0[3]} * dq + bv[bj][0], v1 = (f32x4){(float)i1[0], (float)i1[1], (float)i1[2], (float)i1[3]} * dq + bv[bj][1];
                    float a[4];
#pragma unroll
                    for (int j = 0; j < 4; ++j) { const float gx = j < 2 ? v0[2 * j] : v1[2 * j - 4], lx = j < 2 ? v0[2 * j + 1] : v1[2 * j - 3];
                        const float gl = fminf(gx, 7.0f), li = fminf(fmaxf(lx, -7.0f), 7.0f); a[j] = gl * sigmoidf_(1.702f * gl) * (li + 1.0f); }
                    *(unsigned*)(ACT + r * 1024 + ((col0 + bj * 128) >> 1)) = q8x4(a[0], a[1], a[2], a[3], QS_ACT); } }
    }
};
struct EpiDown {
    static constexpr bool PERM = true;
    const float* bdn; const float* grow; bf16* YS;
    __device__ __forceinline__ void operator()(const f32x4 (&acc)[2][2][4][2], const Unit& u, int wr, int wc, int fr, int fq) const {
        const int row0 = u.pm * 256 + wr * 64 + fr, col0 = u.pn * 256 + wc * 32 + 8 * fq; const float* bb = bdn + (size_t)u.z * 1024; const float dq = 1.f / (QS_ACT * QS_WDN);
        f32x4 bv[2][2];
#pragma unroll
        for (int bj = 0; bj < 2; ++bj)
#pragma unroll
            for (int n = 0; n < 2; ++n) bv[bj][n] = *(const f32x4*)(bb + col0 + bj * 128 + 4 * n);
        float gq[2][4];
#pragma unroll
        for (int ai = 0; ai < 2; ++ai)
#pragma unroll
            for (int m = 0; m < 4; ++m) gq[ai][m] = grow[(size_t)(row0 + ai * 128 + m * 16)];
#pragma unroll
        for (int ai = 0; ai < 2; ++ai)
#pragma unroll
            for (int m = 0; m < 4; ++m) { const size_t r = (size_t)(row0 + ai * 128 + m * 16); const float gt = gq[ai][m];
#pragma unroll
                for (int bj = 0; bj < 2; ++bj) { const v4i_t i0 = __builtin_bit_cast(v4i_t, acc[ai][bj][m][0]), i1 = __builtin_bit_cast(v4i_t, acc[ai][bj][m][1]);
                    const f32x4 v0 = ((f32x4){(float)i0[0], (float)i0[1], (float)i0[2], (float)i0[3]} * dq + bv[bj][0]) * gt, v1 = ((f32x4){(float)i1[0], (float)i1[1], (float)i1[2], (float)i1[3]} * dq + bv[bj][1]) * gt;
                    v4u w; w.x = cvt_pk_bf16(v0[0], v0[1]); w.y = cvt_pk_bf16(v0[2], v0[3]); w.z = cvt_pk_bf16(v1[0], v1[1]); w.w = cvt_pk_bf16(v1[2], v1[3]);
                    *(v4u*)(YS + r * 1024 + col0 + bj * 128) = w; } }
    }
};
struct EpiSsm {
    static constexpr bool PERM = true;
    bf16* Z;
    __device__ __forceinline__ void operator()(const f32x4 (&acc)[2][2][4][2], const Unit& u, int wr, int wc, int fr, int fq) const {
        const int row0 = u.pm * 256 + wr * 64 + fr, col0 = u.pn * 256 + wc * 32 + 8 * fq;
#pragma unroll
        for (int ai = 0; ai < 2; ++ai)
#pragma unroll
            for (int m = 0; m < 4; ++m) { const int row = row0 + ai * 128 + m * 16; const size_t tokb = (size_t)(row >> 8) * T + (size_t)(row & 255) * SSM_LC;
#pragma unroll
                for (int bj = 0; bj < 2; ++bj) { const int col = col0 + bj * 128; const f32x4 v0 = acc[ai][bj][m][0], v1 = acc[ai][bj][m][1]; float z[8];
#pragma unroll
                    for (int j = 0; j < 8; ++j) { const float y = j < 4 ? v0[j] : v1[j - 4]; const float x3 = 0.7978845608028654f * (y + 0.044715f * y * y * y); const float th = 1.f - 2.f * __builtin_amdgcn_rcpf(__expf(2.f * x3) + 1.f); z[j] = 0.5f * y * (1.f + th); }
                    v4u w; w.x = cvt_pk_bf16(z[0], z[1]); w.y = cvt_pk_bf16(z[2], z[3]); w.z = cvt_pk_bf16(z[4], z[5]); w.w = cvt_pk_bf16(z[6], z[7]);
                    *(v4u*)(Z + (tokb + (col >> 4)) * 512 + u.z * 16 + (col & 15)) = w; } }
    }
};
struct SsmOrder {
    int G, c; const char* A; const char* B;
    __device__ __forceinline__ bool next(int i, Unit& u) const {
        const int Lx = i * G + c; if (Lx >= 128) return false;
        const int g = Lx >> 2, pm = (Lx >> 1) & 1, pn = Lx & 1; u.pm = pm; u.pn = pn; u.z = g;
        u.A = A + ((size_t)g * 512 + pm * 256) * SSM_K * 2; u.B = B + ((size_t)g * 512 + pn * 256) * SSM_K * 2; return true;
    }
};
struct MkvOrder {
    int G, c; const char* A; const char* B;
    __device__ __forceinline__ bool next(int i, Unit& u) const {
        const int Lx = i * G + c; if (Lx >= NL * 8) return false;
        const int l = Lx >> 3, pm = (Lx >> 2) & 1, pn = Lx & 3; u.pm = pm; u.pn = pn; u.z = l;
        u.A = A + (size_t)pm * 256 * 1024 * 2; u.B = B + ((size_t)l * 1024 + pn * 256) * 1024 * 2; return true;
    }
};
struct MergeOrder {
    int G, c; const char* A; const char* B;
    __device__ __forceinline__ bool next(int i, Unit& u) const {
        const long Lx = (long)(i >> 2) * G + c; if (Lx >= 64 * 4) return false;
        int pm, pn; pg8::tile_of((int)Lx, 64, 4, pm, pn); const int r = i & 3; u.pm = pm; u.pn = pn; u.z = r;
        u.A = A + ((size_t)pm * 256 * 2048 + r * 512) * 2; u.B = B + ((size_t)r * 1024 + pn * 256) * 512 * 2; return true;
    }
};
struct MoeOrder {
    int G, c, nN, nunits; const LAS int* blk0; const char* A; const char* B; size_t atile, bexp, btile;
    const int* tok; const LAS int* cnt;
    __device__ __forceinline__ void rowinfo(const pg8::Unit& u, const int*& tb, int& s0, int& ce) const { const int e = u.z; tb = tok + (size_t)e * M; s0 = (u.pm - blk0[e]) * 256; ce = cnt[e]; }
    __device__ __forceinline__ bool next(int i, Unit& u) const {
        const int c2 = (G & 7) ? c : (c & 7) * (G >> 3) + (c >> 3);
        const long Lx = (long)i * G + c2; if (Lx >= nunits) return false;
        const int j = (int)(Lx / nN), pn = (int)(Lx % nN); int e = 0;
#pragma unroll
        for (int k = 1; k < 32; ++k) e += (j >= blk0[k]) ? 1 : 0;
        u.pm = j; u.pn = pn; u.z = e; u.A = A + (size_t)j * atile; u.B = B + (size_t)e * bexp + (size_t)pn * btile; return true;
    }
};

template <int QMODE = 0>
__device__ __forceinline__ void tr_item64(const float* W, int ldw, int c0, int nc, int K, bf16* WT, int r0, LAS unsigned char* scr, int item, int lane) {
    const int nblk = (nc + 63) >> 6, kb = item / nblk, nb = item % nblk, k0 = 64 * kb, n0 = 64 * nb;
    const int nn = 4 * (lane & 15), g = lane >> 4; const bool okn = (n0 + nn) < nc;
    const float* wp = W + (size_t)(k0 + g) * ldw + c0 + n0 + nn;
    f32x4 vv[16];
#pragma unroll
    for (int i = 0; i < 16; ++i) { vv[i] = (f32x4){0.f, 0.f, 0.f, 0.f}; if (okn) vv[i] = __builtin_nontemporal_load((const f32x4*)(wp + (size_t)(4 * i) * ldw)); }
#pragma unroll
    for (int i = 0; i < 16; ++i) { v2u w2; w2.x = pk2(vv[i][0], vv[i][1]); w2.y = pk2(vv[i][2], vv[i][3]); *(LAS v2u*)(scr + (4 * i + g) * 136 + nn * 2) = w2; }
    LDS_WAIT(); asm volatile("" ::: "memory");
    const int i16 = lane & 15, q = i16 >> 2, p = i16 & 3;
#pragma unroll
    for (int s = 0; s < 8; ++s) { const int nbk = s & 3, kbk = 4 * (s >> 2) + g;
        const v4i16_t lo = __builtin_amdgcn_ds_read_tr16_b64_v4i16((LAS v4i16_t*)(scr + (8 * kbk + q) * 136 + 32 * nbk + 8 * p));
        const v4i16_t hi = __builtin_amdgcn_ds_read_tr16_b64_v4i16((LAS v4i16_t*)(scr + (8 * kbk + 4 + q) * 136 + 32 * nbk + 8 * p));
        const bf16x8 o = __builtin_shufflevector(lo, hi, 0, 1, 2, 3, 4, 5, 6, 7); const int n = 16 * nbk + i16;
        if (n0 + n < nc) {
            if constexpr (QMODE == 0) *(bf16x8*)(WT + (size_t)(r0 + n0 + n) * K + k0 + 8 * kbk) = o;
            else { const v4u ou = __builtin_bit_cast(v4u, o); const float sc_ = QMODE == 1 ? QS_WUP : (QMODE == 2 ? QS_WDN : QS_WIN);
                *(v2u*)((unsigned char*)WT + (size_t)(r0 + n0 + n) * K + k0 + 8 * kbk) = (v2u){q8x4(bflo(ou.x), bfhi(ou.x), bflo(ou.y), bfhi(ou.y), sc_), q8x4(bflo(ou.z), bfhi(ou.z), bflo(ou.w), bfhi(ou.w), sc_)}; } } }
    LDS_WAIT(); asm volatile("" ::: "memory");
}
__device__ __forceinline__ void ln_rows(f32x4 (&v)[4], const float* g, const float* b, int lane) {
    float s = 0.f;
#pragma unroll
    for (int j = 0; j < 4; ++j) s += (v[j][0] + v[j][1]) + (v[j][2] + v[j][3]);
    const float mean = wave_sum(s) * (1.f / D); float s2 = 0.f;
#pragma unroll
    for (int j = 0; j < 4; ++j) { v[j] = v[j] - mean; s2 += (v[j][0] * v[j][0] + v[j][1] * v[j][1]) + (v[j][2] * v[j][2] + v[j][3] * v[j][3]); }
    const float rstd = 1.f / sqrtf(wave_sum(s2) * (1.f / D) + LN_EPS);
#pragma unroll
    for (int j = 0; j < 4; ++j) { const f32x4 gg = *(const f32x4*)(g + 4 * lane + 256 * j), bb = *(const f32x4*)(b + 4 * lane + 256 * j); v[j] = v[j] * rstd * gg + bb; }
}
struct LnAff { f32x4 g[4], b[4]; };
__device__ __forceinline__ LnAff ln_aff(const float* g, const float* b, int lane) { LnAff a;
#pragma unroll
    for (int j = 0; j < 4; ++j) { a.g[j] = *(const f32x4*)(g + 4 * lane + 256 * j); a.b[j] = *(const f32x4*)(b + 4 * lane + 256 * j); }
    return a; }
__device__ __forceinline__ void ln_rows_pre(f32x4 (&v)[4], const LnAff& a) {
    float s = 0.f;
#pragma unroll
    for (int j = 0; j < 4; ++j) s += (v[j][0] + v[j][1]) + (v[j][2] + v[j][3]);
    const float mean = wave_sum(s) * (1.f / D); float s2 = 0.f;
#pragma unroll
    for (int j = 0; j < 4; ++j) { v[j] = v[j] - mean; s2 += (v[j][0] * v[j][0] + v[j][1] * v[j][1]) + (v[j][2] * v[j][2] + v[j][3] * v[j][3]); }
    const float rstd = 1.f / sqrtf(wave_sum(s2) * (1.f / D) + LN_EPS);
#pragma unroll
    for (int j = 0; j < 4; ++j) v[j] = v[j] * rstd * a.g[j] + a.b[j];
}
__device__ __forceinline__ void store_row_f32_bf16(const f32x4 (&v)[4], float* of, bf16* ob, int lane) {
#pragma unroll
    for (int j = 0; j < 4; ++j) { if (of) *(f32x4*)(of + 4 * lane + 256 * j) = v[j];
        if (ob) { v2u w; w.x = pk2(v[j][0], v[j][1]); w.y = pk2(v[j][2], v[j][3]); *(v2u*)(ob + 4 * lane + 256 * j) = w; } }
}

typedef float f32x16 __attribute__((ext_vector_type(16)));
constexpr int DSA_LIST_OFF = LDSCTL_OFF + 2048, DSA_WCNT_OFF = DSA_LIST_OFF + 4096, DSA_SEL_OFF = DSA_WCNT_OFF + 256;
__device__ __forceinline__ unsigned mono_key(float x) { const unsigned u = __builtin_bit_cast(unsigned, x); return u ^ ((unsigned)((int)u >> 31) | 0x80000000u); }
__device__ __forceinline__ unsigned kv_off(unsigned row, unsigned ch) { return 256u * row + 16u * (ch ^ (((row & 3u) << 2) | ((row >> 2) & 3u))); }

#ifndef DUP_IDX
#define DUP_IDX 1
#endif
#ifndef DUP_SEL
#define DUP_SEL 1
#endif
#ifndef DUP_ATT
#define DUP_ATT 1
#endif
template <int LEVEL>
__device__ __forceinline__ void dsa2_level(LAS unsigned* hist, const unsigned (&kk)[128], int nreg, int lane, unsigned& prefix, unsigned& need) {
    constexpr int NBIN = LEVEL == 2 ? 1024 : 2048; constexpr int PB = NBIN / 64;
#pragma unroll
    for (int i = 0; i < PB / 4; ++i) *(LAS v4u*)(hist + lane * PB + 4 * i) = (v4u){0u, 0u, 0u, 0u};
    LDS_WAIT();
#pragma unroll
    for (int i = 0; i < 128; ++i) { if ((i & ~15) < nreg) { const unsigned k = kk[i]; bool part; unsigned bin;
            if (LEVEL == 0) { part = k != 0u; bin = k >> 21; }
            else if (LEVEL == 1) { part = (k != 0u) && ((k >> 21) == prefix); bin = (k >> 10) & 0x7FFu; }
            else { part = (k != 0u) && ((k >> 10) == prefix); bin = k & 0x3FFu; }
            if (part) (void)__hip_atomic_fetch_add(&hist[bin], 1u, __ATOMIC_RELAXED, __HIP_MEMORY_SCOPE_WORKGROUP); }
        if ((i & 7) == 7) __builtin_amdgcn_sched_barrier(0); }
    LDS_WAIT();
    unsigned hv[PB]; unsigned mine = 0u;
#pragma unroll
    for (int i = 0; i < PB / 4; ++i) { const v4u v = *(const LAS v4u*)(hist + lane * PB + 4 * i); hv[4 * i] = v.x; hv[4 * i + 1] = v.y; hv[4 * i + 2] = v.z; hv[4 * i + 3] = v.w; mine += (v.x + v.y) + (v.z + v.w); }
    unsigned incl = mine;
    const int lop779_ = lane_op();
#pragma unroll
    for (int o = 1; o < 64; o <<= 1) { const unsigned v = SHD(incl, o, lop779_); if (lane + o < 64) incl += v; }
    const unsigned above = incl - mine; const bool found = above < need && need <= above + mine;
    unsigned a = above; int bsel = 0; bool done = false;
#pragma unroll
    for (int i = PB - 1; i >= 0; --i) { const bool hit = !done && (need <= a + hv[i]); bsel = hit ? i : bsel; a = (done || hit) ? a : a + hv[i]; done = done || hit; }
    const int src = __builtin_ctzll(__ballot(found));
    const unsigned bfull = (unsigned)SHI(lane * PB + bsel, src); const unsigned aa = (unsigned)SHI((int)a, src);
    prefix = LEVEL == 0 ? bfull : (LEVEL == 1 ? ((prefix << 11) | bfull) : ((prefix << 10) | bfull)); need -= aa;
    LDS_WAIT();
}

__device__ __forceinline__ bool dsa2_sampled(LAS unsigned char* wl, const unsigned (&kk)[128], int nreg, int n, int lane) {
    LAS unsigned* hist = (LAS unsigned*)wl; LAS int* LIST = (LAS int*)(wl + 12288); LAS unsigned* h2 = (LAS unsigned*)(wl + 13312);
    LAS unsigned long long* PRIV = (LAS unsigned long long*)wl;
    const unsigned long long ltm = (1ull << lane) - 1ull;
#pragma unroll
    for (int i = 0; i < 8; ++i) *(LAS v4u*)(hist + lane * 32 + 4 * i) = (v4u){0u, 0u, 0u, 0u};
    LDS_WAIT();
#pragma unroll
    for (int i = 0; i < 128; i += 8) { if (i < nreg) { const unsigned k = kk[i]; if (k != 0u) (void)__hip_atomic_fetch_add(&hist[k >> 21], 1u, __ATOMIC_RELAXED, __HIP_MEMORY_SCOPE_WORKGROUP); } }
    LDS_WAIT();
    unsigned hv[32]; unsigned mine = 0u;
#pragma unroll
    for (int i = 0; i < 8; ++i) { const v4u v = *(const LAS v4u*)(hist + lane * 32 + 4 * i); hv[4 * i] = v.x; hv[4 * i + 1] = v.y; hv[4 * i + 2] = v.z; hv[4 * i + 3] = v.w; mine += (v.x + v.y) + (v.z + v.w); }
    unsigned incl = mine; const int lop_ = lane_op();
#pragma unroll
    for (int o = 1; o < 64; o <<= 1) { const unsigned v = SHD(incl, o, lop_); if (lane + o < 64) incl += v; }
    const unsigned above = incl - mine; const unsigned ns = SHI(incl, 0);
    const float E = (float)ns * 256.f / (float)n, mg = 3.f * sqrtf(E) + 3.f;
    const int rhi = (int)fmaxf(E - mg, 0.f), rlo = (int)(E + mg) + 1;
    int bhl = -1, bll = -1; { unsigned s = above;
#pragma unroll
        for (int i = 31; i >= 0; --i) { if ((int)s <= rhi) bhl = i; s += hv[i]; if (bll < 0 && (int)s >= rlo) bll = i; } }
    const bool hasH = ((int)above <= rhi) && ((int)incl > rhi || lane == 0), hasL = ((int)incl >= rlo) && ((int)above < rlo);
    const unsigned long long mH = __ballot(hasH), mL = __ballot(hasL);
    if (mH == 0ull) return false;
    const int sH = 63 - __builtin_clzll(mH);
    const unsigned bh = (unsigned)SHI(lane * 32 + (bhl < 0 ? 0 : bhl), sH);
    unsigned bl = 1u; if (mL != 0ull) { const int sL = 63 - __builtin_clzll(mL); bl = (unsigned)SHI(lane * 32 + (bll < 0 ? 0 : bll), sL); }
    bl = bl < 1u ? 1u : bl; if (bl > bh) bl = bh;
    int cur = 0; LAS unsigned* pp = (LAS unsigned*)(PRIV + lane);
#pragma unroll
    for (int i = 0; i < 128; ++i) { if ((i & ~15) < nreg) { const unsigned k = kk[i];
            if ((k >> 21) >= bl) { if (cur < 24) { pp[0] = (unsigned)(lane + 64 * i); pp[1] = k; } pp += 128; ++cur; } }
        __builtin_amdgcn_sched_barrier(0); }
    LDS_WAIT();
    int mxc = cur; { const int lq_ = lane_op();
#pragma unroll
        for (int o = 1; o < 64; o <<= 1) { const int t2 = SHX(mxc, o, lq_); mxc = t2 > mxc ? t2 : mxc; } }
    mxc = __builtin_amdgcn_readfirstlane(mxc);
    if (mxc > 24) return false;
    int A = 0, C = 0;
#pragma unroll 1
    for (int s = 0; s < mxc; ++s) { const bool vld = s < cur; const unsigned long long e = vld ? PRIV[s * 64 + lane] : 0ull; const unsigned k = (unsigned)(e >> 32), ix = (unsigned)e;
        const bool sure = vld && (k >> 21) > bh, cand = vld && !sure;
        const unsigned long long ms = __ballot(sure), mc = __ballot(cand);
        const int ps = A + __builtin_popcountll(ms & ltm), pc = C + __builtin_popcountll(mc & ltm);
        if (sure && ps < 256) LIST[ps] = (int)ix;
        if (cand) PRIV[pc] = ((unsigned long long)k << 13) | (unsigned long long)(8191u - ix);
        A += __builtin_popcountll(ms); C += __builtin_popcountll(mc); }
    if (A > 256 || A + C < 256) return false;
    LDS_WAIT();
    unsigned need = 256u - (unsigned)A; const int nit = (C + 63) >> 6;
    if (need > 0u) { unsigned long long prefix = 0ull; int shf = 45;
#pragma unroll 1
        for (int lev = 0; lev < 6; ++lev) { const int w = lev < 5 ? 8 : 5; const int sh = shf - w;
            { unsigned zq_ = 0u; asm volatile("" : "+v"(zq_)); *(LAS v4u*)(h2 + 4 * lane) = (v4u){zq_, zq_, zq_, zq_}; }
            LDS_WAIT();
            for (int it = 0; it < nit; ++it) { const int i = it * 64 + lane; if (i < C) { const unsigned long long c2 = PRIV[i]; if (lev == 0 || (c2 >> shf) == prefix) (void)__hip_atomic_fetch_add(&h2[(unsigned)(c2 >> sh) & ((1u << w) - 1u)], 1u, __ATOMIC_RELAXED, __HIP_MEMORY_SCOPE_WORKGROUP); } }
            LDS_WAIT();
            const v4u v = *(const LAS v4u*)(h2 + 4 * lane); const unsigned m4 = (v.x + v.y) + (v.z + v.w); unsigned in2 = m4; const int lq_ = lane_op();
#pragma unroll
            for (int o = 1; o < 64; o <<= 1) { const unsigned t2 = SHD(in2, o, lq_); if (lane + o < 64) in2 += t2; }
            const unsigned ab = in2 - m4; const bool fnd = ab < need && need <= ab + m4;
            unsigned a = ab; int bs = 0; bool dn = false; const unsigned h4[4] = {v.x, v.y, v.z, v.w};
#pragma unroll
            for (int i = 3; i >= 0; --i) { const bool hit = !dn && (need <= a + h4[i]); bs = hit ? i : bs; a = (dn || hit) ? a : a + h4[i]; dn = dn || hit; }
            const int src = __builtin_ctzll(__ballot(fnd));
            const unsigned bf = (unsigned)SHI(lane * 4 + bs, src); const unsigned aa = (unsigned)SHI((int)a, src); const unsigned hb = (unsigned)SHI((int)(bs == 3 ? h4[3] : bs == 2 ? h4[2] : bs == 1 ? h4[1] : h4[0]), src);
            prefix = (prefix << w) | bf; need -= aa; shf = sh;
            LDS_WAIT();
            if (hb == need) break; }
        int pos = A;
        for (int it = 0; it < nit; ++it) { const int i = it * 64 + lane; unsigned long long c2 = 0ull; if (i < C) c2 = PRIV[i];
            const bool take = (i < C) && ((c2 >> shf) >= prefix);
            const unsigned long long mt = __ballot(take);
            if (take) LIST[pos + __builtin_popcountll(mt & ltm)] = (int)(8191u - (unsigned)(c2 & 8191ull));
            pos += __builtin_popcountll(mt); }
    }
    LDS_WAIT();
    return true;
}

__device__ __forceinline__ void dsa2_unit(LAS unsigned char* lds, const bf16* PROJ, const bf16* KIDX, const bf16* KVN, bf16* OLAT, float* sbuf, int b, int t0, int tid) {
    asm volatile("" : "+v"(tid));
    const int lane = tid & 63, wave = __builtin_amdgcn_readfirstlane(tid >> 6), r = lane & 31, h = lane >> 5;
    const size_t rowb = (size_t)b * T;
    LAS unsigned char* wl = lds + wave * 16384; LAS unsigned* hist = (LAS unsigned*)wl; LAS int* LIST = (LAS int*)(wl + 12288);
    const int t = t0 + wave; int cnt;
    if (t0 >= 256) {
        { const int ntiles = (t0 >> 5) + 1, tpw = (ntiles + 7) >> 3, tile0 = wave * tpw; int tile1 = tile0 + tpw; tile1 = tile1 < ntiles ? tile1 : ntiles;
          const int ahead = (r & 3) + 4 * ((r >> 3) & 1), atok = ((r >> 2) & 1) + 2 * (r >> 4);
          const bf16* qpa = PROJ + (rowb + t0 + atok) * NP + PC_QIDX + ahead * 32 + 8 * h; const bf16* qpb = qpa + (size_t)4 * NP;
          const bf16x8 A0a = *(const bf16x8*)qpa, A1a = *(const bf16x8*)(qpa + 16), A0b = *(const bf16x8*)qpb, A1b = *(const bf16x8*)(qpb + 16);
          float wq[32];
#pragma unroll
          for (int gq = 0; gq < 4; ++gq) { const v4u w0 = *(const v4u*)(PROJ + (rowb + t0 + h + 2 * gq) * NP + PC_WIDX);
              wq[8 * gq] = 0.5f * bflo(w0.x); wq[8 * gq + 1] = 0.5f * bfhi(w0.x); wq[8 * gq + 2] = 0.5f * bflo(w0.y); wq[8 * gq + 3] = 0.5f * bfhi(w0.y); wq[8 * gq + 4] = 0.5f * bflo(w0.z); wq[8 * gq + 5] = 0.5f * bfhi(w0.z); wq[8 * gq + 6] = 0.5f * bflo(w0.w); wq[8 * gq + 7] = 0.5f * bfhi(w0.w); }
          v4u A0c = {0u, 0u, 0u, 0u}, A1c = {0u, 0u, 0u, 0u};
          if (r < 8) { const bf16* qrow = PROJ + (rowb + t0 + (r >> 2) + 2 * (r & 3)) * NP; const v4u wv = *(const v4u*)(qrow + PC_WIDX);
              const float wl_[8] = {bflo(wv.x), bfhi(wv.x), bflo(wv.y), bfhi(wv.y), bflo(wv.z), bfhi(wv.z), bflo(wv.w), bfhi(wv.w)};
              float a0[8], a1[8];
#pragma unroll
              for (int j = 0; j < 8; ++j) { a0[j] = 0.f; a1[j] = 0.f; }
#pragma unroll
              for (int hd = 0; hd < 8; ++hd) { const v4u q0 = *(const v4u*)(qrow + PC_QIDX + hd * 32 + 8 * h), q1 = *(const v4u*)(qrow + PC_QIDX + hd * 32 + 16 + 8 * h); const float hw = 0.5f * wl_[hd];
                  a0[0] += hw * bflo(q0.x); a0[1] += hw * bfhi(q0.x); a0[2] += hw * bflo(q0.y); a0[3] += hw * bfhi(q0.y); a0[4] += hw * bflo(q0.z); a0[5] += hw * bfhi(q0.z); a0[6] += hw * bflo(q0.w); a0[7] += hw * bfhi(q0.w);
                  a1[0] += hw * bflo(q1.x); a1[1] += hw * bfhi(q1.x); a1[2] += hw * bflo(q1.y); a1[3] += hw * bfhi(q1.y); a1[4] += hw * bflo(q1.z); a1[5] += hw * bfhi(q1.z); a1[6] += hw * bflo(q1.w); a1[7] += hw * bfhi(q1.w); }
              A0c = (v4u){pk2(a0[0], a0[1]), pk2(a0[2], a0[3]), pk2(a0[4], a0[5]), pk2(a0[6], a0[7])}; A1c = (v4u){pk2(a1[0], a1[1]), pk2(a1[2], a1[3]), pk2(a1[4], a1[5]), pk2(a1[6], a1[7])}; }
          const bf16x8 A0cb = __builtin_bit_cast(bf16x8, A0c), A1cb = __builtin_bit_cast(bf16x8, A1c);
          const bf16* kp = KIDX + (rowb + (size_t)tile0 * 32 + r) * 32 + 8 * h;
          bf16x8 Bq[4][2];
#pragma unroll
          for (int u = 0; u < 3; ++u) if (tile0 + u < tile1) { Bq[u][0] = *(const bf16x8*)(kp + (size_t)u * 1024); Bq[u][1] = *(const bf16x8*)(kp + (size_t)u * 1024 + 16); }
          for (int tileb = tile0; tileb < tile1; tileb += 4) {
#pragma unroll
          for (int u = 0; u < 4; ++u) { const int tile = tileb + u; if (tile < tile1) { const bf16x8 b0 = Bq[u][0], b1 = Bq[u][1];
              if (tile + 3 < tile1) { const bf16* kn = kp + (size_t)(tile + 3 - tile0) * 1024; Bq[(u + 3) & 3][0] = *(const bf16x8*)kn; Bq[(u + 3) & 3][1] = *(const bf16x8*)(kn + 16); }
              f32x16 da, db, dc;
#pragma unroll
              for (int i = 0; i < 16; ++i) { da[i] = 0.f; db[i] = 0.f; dc[i] = 0.f; }
              da = __builtin_amdgcn_mfma_f32_32x32x16_bf16(A0a, b0, da, 0, 0, 0); db = __builtin_amdgcn_mfma_f32_32x32x16_bf16(A0b, b0, db, 0, 0, 0); dc = __builtin_amdgcn_mfma_f32_32x32x16_bf16(A0cb, b0, dc, 0, 0, 0);
              da = __builtin_amdgcn_mfma_f32_32x32x16_bf16(A1a, b1, da, 0, 0, 0); db = __builtin_amdgcn_mfma_f32_32x32x16_bf16(A1b, b1, db, 0, 0, 0); dc = __builtin_amdgcn_mfma_f32_32x32x16_bf16(A1cb, b1, dc, 0, 0, 0);
              float s0 = dc[0], s1 = dc[1], s2 = dc[2], s3 = dc[3];
#pragma unroll
              for (int i = 0; i < 8; ++i) { s0 += wq[i] * __builtin_fabsf(da[i]); s1 += wq[8 + i] * __builtin_fabsf(da[8 + i]); s2 += wq[16 + i] * __builtin_fabsf(db[i]); s3 += wq[24 + i] * __builtin_fabsf(db[8 + i]); }
              float* sp = sbuf + (size_t)h * 8192 + tile * 32 + r;
              sp[0] = __builtin_bit_cast(float, mono_key(s0)); sp[2 * 8192] = __builtin_bit_cast(float, mono_key(s1)); sp[4 * 8192] = __builtin_bit_cast(float, mono_key(s2)); sp[6 * 8192] = __builtin_bit_cast(float, mono_key(s3)); } } } }
        asm volatile("s_waitcnt vmcnt(0)" ::: "memory");
        __syncthreads();
        const int n = t + 1, nreg = (n + 63) >> 6; const float* sr = sbuf + (size_t)wave * 8192;
        unsigned kk[128];
#ifndef DUP_KK
#define DUP_KK 1
#endif
        for (int repk = 0; repk < DUP_KK; ++repk)
#pragma unroll
        for (int gI = 0; gI < 4; ++gI) {
            if (gI * 32 < nreg) {
                float fv[32];
#pragma unroll
                for (int i = 0; i < 32; ++i) { const int key = lane + 64 * (gI * 32 + i); fv[i] = __hip_atomic_load(sr + (key < n ? key : n - 1), __ATOMIC_RELAXED, __HIP_MEMORY_SCOPE_AGENT); }
#pragma unroll
                for (int i = 0; i < 32; ++i) { const int key = lane + 64 * (gI * 32 + i); kk[gI * 32 + i] = key < n ? __builtin_bit_cast(unsigned, fv[i]) : 0u; }
            } else {
#pragma unroll
                for (int i = 0; i < 32; ++i) kk[gI * 32 + i] = 0u;
            }
        }
        unsigned prefix = 0u, need = 256u; int pos = 0, eqs = 0; const unsigned long long ltm = (1ull << lane) - 1ull;
        bool seldone = false; if (nreg > 16) seldone = dsa2_sampled(wl, kk, nreg, n, lane);
        if (!seldone)
        for (int reps = 0; reps < DUP_SEL; ++reps) { prefix = 0u; need = 256u; pos = 0; eqs = 0;
        dsa2_level<0>(hist, kk, nreg, lane, prefix, need);
        dsa2_level<1>(hist, kk, nreg, lane, prefix, need);
        dsa2_level<2>(hist, kk, nreg, lane, prefix, need);
        const unsigned tau = prefix;
#pragma unroll
        for (int i = 0; i < 128; ++i) { if ((i & ~15) < nreg) { const unsigned k = kk[i]; const bool gt = k > tau, eq = k == tau;
                const unsigned long long me = __ballot(eq);
                const bool take = gt || (eq && (eqs + __builtin_popcountll(me & ltm) < (int)need));
                const unsigned long long mt = __ballot(take);
                if (take) LIST[pos + __builtin_popcountll(mt & ltm)] = lane + 64 * i;
                pos += __builtin_popcountll(mt); eqs += __builtin_popcountll(me); }
            if ((i & 3) == 3) __builtin_amdgcn_sched_barrier(0); } }
        cnt = 256;
    } else {
#pragma unroll
        for (int j = 0; j < 4; ++j) LIST[lane + 64 * j] = lane + 64 * j;
        cnt = t + 1;
    }
    LDS_WAIT();
    int tid2 = tid; asm volatile("" : "+v"(tid2)); const int lane2 = tid2 & 63; const int nn = lane2 & 15, g = lane2 >> 4;
    bf16x8 qf[4];
#pragma unroll
    for (int s = 0; s < 4; ++s) { if (nn < 8) qf[s] = *(const bf16x8*)(PROJ + (rowb + t) * NP + PC_QLAT + nn * 128 + 32 * s + 8 * g); else qf[s] = (bf16x8){0, 0, 0, 0, 0, 0, 0, 0}; }
    f32x4 O[8]; float mrun, lrun;
    LAS unsigned char* buf = wl; const unsigned q4 = (unsigned)(nn >> 2), p = (unsigned)(lane2 & 3); const int nch = (cnt + 31) >> 5;
    for (int repa = 0; repa < DUP_ATT; ++repa) {
#pragma unroll
    for (int c = 0; c < 8; ++c) O[c] = (f32x4){0.f, 0.f, 0.f, 0.f};
    mrun = -INFINITY; lrun = 0.f;
    v4u pre[8];
#pragma unroll
    for (int it = 0; it < 8; ++it) { const int row = it * 4 + g; pre[it] = (v4u){0u, 0u, 0u, 0u}; if (row < cnt) { const int idx = LIST[row]; pre[it] = *(const v4u*)(KVN + (rowb + idx) * 128 + nn * 8); } }
#pragma unroll 1
    for (int ch = 0; ch < nch; ++ch) {
#pragma unroll
        for (int it = 0; it < 8; ++it) *(LAS v4u*)(buf + kv_off(it * 4 + g, nn)) = pre[it];
        if (ch + 1 < nch) {
#pragma unroll
            for (int it = 0; it < 8; ++it) { const int row = (ch + 1) * 32 + it * 4 + g; pre[it] = (v4u){0u, 0u, 0u, 0u}; if (row < cnt) { const int idx = LIST[row]; pre[it] = *(const v4u*)(KVN + (rowb + idx) * 128 + nn * 8); } } }
        LDS_WAIT();
        f32x4 S0 = {0.f, 0.f, 0.f, 0.f}, S1 = {0.f, 0.f, 0.f, 0.f};
        { const unsigned slot0 = 8u * (nn >> 2) + (nn & 3), slot1 = slot0 + 4u;
#pragma unroll
          for (int s = 0; s < 4; ++s) { const bf16x8 a0 = *(const LAS bf16x8*)(buf + kv_off(slot0, 4 * s + g)), a1 = *(const LAS bf16x8*)(buf + kv_off(slot1, 4 * s + g));
              S0 = __builtin_amdgcn_mfma_f32_16x16x32_bf16(a0, qf[s], S0, 0, 0, 0); S1 = __builtin_amdgcn_mfma_f32_16x16x32_bf16(a1, qf[s], S1, 0, 0, 0); } }
        if (ch * 32 + 32 > cnt) {
#pragma unroll
            for (int j = 0; j < 4; ++j) { if (ch * 32 + 8 * g + j >= cnt) S0[j] = -INFINITY; if (ch * 32 + 8 * g + 4 + j >= cnt) S1[j] = -INFINITY; } }
        float mc = fmaxf(fmaxf(fmaxf(S0[0], S0[1]), fmaxf(S0[2], S0[3])), fmaxf(fmaxf(S1[0], S1[1]), fmaxf(S1[2], S1[3])));
        const int lop891_ = lane_op(); mc = fmaxf(mc, SHX(mc, 16, lop891_)); mc = fmaxf(mc, SHX(mc, 32, lop891_));
        const float mnew = fmaxf(mrun, mc); const float alpha = __expf(mrun - mnew); mrun = mnew;
        float ps = 0.f;
#pragma unroll
        for (int j = 0; j < 4; ++j) { S0[j] = __expf(S0[j] - mnew); S1[j] = __expf(S1[j] - mnew); ps += S0[j] + S1[j]; }
        lrun = lrun * alpha + ps;
        v4u w; w.x = pk2(S0[0], S0[1]); w.y = pk2(S0[2], S0[3]); w.z = pk2(S1[0], S1[1]); w.w = pk2(S1[2], S1[3]); const bf16x8 Bp = __builtin_bit_cast(bf16x8, w);
#pragma unroll
        for (int c = 0; c < 8; ++c) { O[c] = O[c] * alpha;
            const v4i16_t lo = __builtin_amdgcn_ds_read_tr16_b64_v4i16((LAS v4i16_t*)(buf + kv_off(8u * g + q4, 2u * c + (p >> 1)) + 8u * (p & 1u)));
            const v4i16_t hi = __builtin_amdgcn_ds_read_tr16_b64_v4i16((LAS v4i16_t*)(buf + kv_off(8u * g + 4u + q4, 2u * c + (p >> 1)) + 8u * (p & 1u)));
            const bf16x8 a = __builtin_shufflevector(lo, hi, 0, 1, 2, 3, 4, 5, 6, 7);
            O[c] = __builtin_amdgcn_mfma_f32_16x16x32_bf16(a, Bp, O[c], 0, 0, 0); }
        LDS_WAIT();
    } }
    const int lop906_ = lane_op(); lrun += SHX(lrun, 16, lop906_); lrun += SHX(lrun, 32, lop906_);
    const float inv = 1.f / lrun;
    if (nn < 8) {
#pragma unroll
        for (int c = 0; c < 8; ++c) { v2u w; w.x = pk2(O[c][0] * inv, O[c][1] * inv); w.y = pk2(O[c][2] * inv, O[c][3] * inv); *(v2u*)(OLAT + (rowb + t) * 1024 + nn * 128 + 16 * c + 4 * g) = w; } }
}

__device__ __forceinline__ unsigned swap23(unsigned r) { return (r & ~12u) | ((r & 4u) << 1) | ((r & 8u) >> 1); }
__device__ __forceinline__ void memattn_unit(LAS unsigned char* lds, const bf16* PROJ, const bf16* MKVl, bf16* BR, int b, int hd, int qblk, int tid) {
    asm volatile("" : "+v"(tid));
    const int lane = tid & 63, wave = __builtin_amdgcn_readfirstlane(tid >> 6), r = lane & 31, hh = lane >> 5;
    LAS unsigned char* kimg = lds; LAS unsigned char* vimg = lds + 65536;
    { const bf16* kb = MKVl + (size_t)b * 256 * 1024 + hd * 128;
#pragma unroll 4
      for (int it = 0; it < 8; ++it) { const int row = it * 32 + (tid >> 4), ch = tid & 15;
          const v4u kv = *(const v4u*)(kb + (size_t)row * 1024 + ch * 8), vv = *(const v4u*)(kb + (size_t)row * 1024 + 512 + ch * 8);
          *(LAS v4u*)(kimg + kv_off(row, ch)) = kv; *(LAS v4u*)(vimg + kv_off(row, ch)) = vv; } }
    const size_t tok = (size_t)b * T + qblk * 256 + wave * 32 + r;
    bf16x8 qf[8];
#pragma unroll
    for (int s = 0; s < 8; ++s) qf[s] = *(const bf16x8*)(PROJ + tok * NP + PC_MQ + hd * 128 + 16 * s + 8 * hh);
    __syncthreads();
    f32x16 S[8];
#pragma unroll
    for (int kap = 0; kap < 8; ++kap) { f32x16 acc;
#pragma unroll
        for (int i = 0; i < 16; ++i) acc[i] = 0.f;
        const unsigned slot = 32u * kap + swap23((unsigned)r);
#pragma unroll
        for (int s = 0; s < 8; ++s) { const bf16x8 a = *(const LAS bf16x8*)(kimg + kv_off(slot, 2 * s + hh)); acc = __builtin_amdgcn_mfma_f32_32x32x16_bf16(a, qf[s], acc, 0, 0, 0); }
        S[kap] = acc; if (kap & 1) __builtin_amdgcn_sched_barrier(0); }
    float mx = -INFINITY;
#pragma unroll
    for (int kap = 0; kap < 8; ++kap)
#pragma unroll
        for (int i = 0; i < 16; ++i) mx = fmaxf(mx, S[kap][i]);
    const int lop945_ = lane_op(); mx = fmaxf(mx, SHX(mx, 32, lop945_));
    const float sc_ = 0.08838834764831845f * 1.4426950408889634f; float sum = 0.f;
#pragma unroll
    for (int kap = 0; kap < 8; ++kap)
#pragma unroll
        for (int i = 0; i < 16; ++i) { const float e = __builtin_amdgcn_exp2f((S[kap][i] - mx) * sc_); S[kap][i] = e; sum += e; }
    const int lop951_ = lane_op(); sum += SHX(sum, 32, lop951_);
    const float inv = 1.f / sum;
    bf16x8 Bp[16];
#pragma unroll
    for (int kap = 0; kap < 8; ++kap)
#pragma unroll
        for (int s = 0; s < 2; ++s) { v4u w; w.x = pk2(S[kap][8 * s], S[kap][8 * s + 1]); w.y = pk2(S[kap][8 * s + 2], S[kap][8 * s + 3]); w.z = pk2(S[kap][8 * s + 4], S[kap][8 * s + 5]); w.w = pk2(S[kap][8 * s + 6], S[kap][8 * s + 7]);
            Bp[2 * kap + s] = __builtin_bit_cast(bf16x8, w); }
    const unsigned blk = (lane >> 4) & 1, q4 = (lane & 15) >> 2, p = lane & 3;
    bf16* orow = BR + tok * 2048 + 1536 + hd * 128;
#pragma unroll
    for (int c = 0; c < 4; ++c) { f32x16 o;
#pragma unroll
        for (int i = 0; i < 16; ++i) o[i] = 0.f;
#pragma unroll
        for (int ks = 0; ks < 16; ++ks) {
            const v4i16_t lo = __builtin_amdgcn_ds_read_tr16_b64_v4i16((LAS v4i16_t*)(vimg + kv_off(16u * ks + 8u * hh + q4, 4u * c + 2u * blk + (p >> 1)) + 8u * (p & 1u)));
            const v4i16_t hi = __builtin_amdgcn_ds_read_tr16_b64_v4i16((LAS v4i16_t*)(vimg + kv_off(16u * ks + 8u * hh + 4u + q4, 4u * c + 2u * blk + (p >> 1)) + 8u * (p & 1u)));
            const bf16x8 a = __builtin_shufflevector(lo, hi, 0, 1, 2, 3, 4, 5, 6, 7);
            o = __builtin_amdgcn_mfma_f32_32x32x16_bf16(a, Bp[ks], o, 0, 0, 0); if ((ks & 3) == 3) __builtin_amdgcn_sched_barrier(0); }
#pragma unroll
        for (int i4 = 0; i4 < 4; ++i4) { v2u w; w.x = pk2(o[4 * i4] * inv, o[4 * i4 + 1] * inv); w.y = pk2(o[4 * i4 + 2] * inv, o[4 * i4 + 3] * inv);
            *(v2u*)(orow + 32 * c + 8 * i4 + 4 * hh) = w; } }
    __syncthreads();
}

__device__ __forceinline__ f32x4 ld4bf(const bf16* p) { const v2u w = *(const v2u*)p; return (f32x4){bflo(w.x), bfhi(w.x), bflo(w.y), bfhi(w.y)}; }
__device__ __forceinline__ void store_row_fp8(const f32x4 (&v)[4], unsigned char* o8, int lane) {
#pragma unroll
    for (int j = 0; j < 4; ++j) *(unsigned*)(o8 + 4 * lane + 256 * j) = q8x4(v[j][0], v[j][1], v[j][2], v[j][3], QS_H);
}
constexpr int PH_PER_LAYER = 11, NPHASE = 2 + NL * PH_PER_LAYER;

__global__ void __launch_bounds__(NWAVES * 64, 2) fwd(Args args) {
    extern __shared__ __attribute__((aligned(16))) unsigned char lds_raw[];
    Frame F;
    F.lds = (LAS unsigned char*)lds_raw;
    F.tid = threadIdx.x; F.lane = F.tid & 63; F.wave = __builtin_amdgcn_readfirstlane(F.tid >> 6);
    const int wave_s = F.wave;
    F.G = gridDim.x; F.gw = blockIdx.x * NWAVES + F.wave; F.NGW = F.G * NWAVES;
    volatile LAS unsigned* MISC = (volatile LAS unsigned*)(F.lds + MISC_OFF);
    for (int u = F.tid; u < (LDS_BYTES - LDSCTL_OFF) / 4; u += NWAVES * 64) ((LAS unsigned*)(F.lds + LDSCTL_OFF))[u] = 0u;
    __syncthreads();
#if ONE_LAUNCH
    XcdBarrier bar = xcd_barrier_post((unsigned*)(args.ws + WS_CTL) + CW_BAR, MISC + 8);
#define GRID_BAR() xcd_barrier(bar, tidq)
#else
#define GRID_BAR() do {} while (0)
#endif
    { volatile LAS unsigned long long* PT = (volatile LAS unsigned long long*)(F.lds + MISC_OFF + 512);
    if (F.tid == 0) {
#pragma unroll
        for (int i = 0; i < 33; ++i) PT[i] = (unsigned long long)args.in[i];
        PT[33] = (unsigned long long)args.out; PT[34] = (unsigned long long)args.ws;
    } }
    const int lo = args.ph_lo, hi = args.ph_hi;
    __syncthreads();
    int ph = 0;
#define IN(k) ((const float*)gptr(ldp(PT, k)))
#ifndef DUP_PHASE
#define DUP_PHASE (-1)
#endif
#ifndef PHMASK
#define PHMASK 0xFFFFull
#endif
#define PHASE_BEGIN(id) if (((PHMASK >> (id)) & 1ull) && lo <= ph && ph < hi) { unsigned ldsb_ = 0u; asm volatile("" : "+s"(ldsb_)); LAS unsigned char* ldsq = (LAS unsigned char*)lds_raw + ldsb_; \
    volatile LAS unsigned long long* PT = (volatile LAS unsigned long long*)(ldsq + MISC_OFF + 512); LAS int* BLK0 = (LAS int*)(ldsq + MISC_OFF + 128); (void)BLK0; unsigned char* ws = gptr(ldp(PT, 34)); int tidq = wave_s * 64 + lane_op(); asm volatile("" : "+v"(tidq)); const int lane = tidq & 63, wave = __builtin_amdgcn_readfirstlane(tidq >> 6); \
    Frame F; F.lds = ldsq; F.tid = tidq; F.lane = lane; F.wave = wave; { const unsigned vb1_ = ((volatile LAS unsigned*)(ldsq + MISC_OFF))[11]; int Gq_ = gridDim.x, bxq_ = __builtin_amdgcn_readfirstlane(vb1_ ? (int)vb1_ - 1 : (int)blockIdx.x); asm volatile("" : "+s"(Gq_), "+s"(bxq_)); F.G = Gq_; F.bx = bxq_; } F.gw = F.bx * NWAVES + wave; F.NGW = F.G * NWAVES; \
    bf16* WinT = (bf16*)(ws + WS_WIN); bf16* WgluT = (bf16*)(ws + WS_WGLU); bf16* WmkvT = (bf16*)(ws + WS_WMKV); bf16* WuvT = (bf16*)(ws + WS_WUV); \
    bf16* WbrT = (bf16*)(ws + WS_WBR); bf16* WoT = (bf16*)(ws + WS_WO); bf16* WupT = (bf16*)(ws + WS_WUP); bf16* WdnT = (bf16*)(ws + WS_WDN); \
    f32x2* S5A = (f32x2*)(ws + WS_S5A); f32x2* S5B = (f32x2*)(ws + WS_S5B); \
    bf16* MEMB = (bf16*)(ws + WS_MEMB); bf16* MKV = (bf16*)(ws + WS_MKV); \
    bf16* Hf = (bf16*)(ws + WS_H); bf16* Hb = (bf16*)(ws + WS_HB); bf16* PROJ = (bf16*)(ws + WS_PROJ); bf16* KVN = (bf16*)(ws + WS_KVN); \
    bf16* OLAT = (bf16*)(ws + WS_OLAT); bf16* BR = (bf16*)(ws + WS_BR); bf16* Zb = (bf16*)(ws + WS_Z); float* MRG = (float*)(ws + WS_MRG); bf16* MRGB = (bf16*)(ws + WS_MRGB); \
    bf16* Vf = (bf16*)(ws + WS_V); bf16* H1 = (bf16*)(ws + WS_H1); bf16* H1B = (bf16*)(ws + WS_H1B); \
    f32x2* SSE = (f32x2*)(ws + WS_SSE); f32x2* SSC = (f32x2*)(ws + WS_SSC); \
    int* TOK = (int*)(ws + WS_TOK); float* GATE = (float*)(ws + WS_GATE); int* SLOT = (int*)(ws + WS_SLOT); \
    bf16* XS = (bf16*)(ws + WS_XS); bf16* ACT = (bf16*)(ws + WS_ACT); bf16* YS = XS; float* SCR = (float*)(ws + WS_SCR); float* GROW = (float*)(ws + WS_SCR); bf16* KIDX = (bf16*)(ws + WS_KIDX); (void)KIDX; bf16* WSSM = (bf16*)(ws + WS_WSSM); bf16* AEXT = (bf16*)(ws + WS_AEXT); bf16* WEW = (bf16*)(ws + WS_WE); (void)WSSM; (void)AEXT; (void)WEW; \
    unsigned* CTLP = (unsigned*)(ws + WS_CTL); float* OUTP = (float*)gptr(ldp(PT, 33)); \
    (void)WinT; (void)WgluT; (void)WmkvT; (void)WuvT; (void)WbrT; (void)WoT; (void)WupT; (void)WdnT; (void)S5A; (void)S5B; (void)MEMB; (void)MKV; (void)Hf; (void)Hb; (void)PROJ; (void)KVN; (void)OLAT; (void)BR; (void)Zb; (void)MRG; (void)MRGB; \
    (void)Vf; (void)H1; (void)H1B; (void)SSE; (void)SSC; (void)TOK; (void)GATE; (void)SLOT; (void)XS; (void)ACT; (void)YS; (void)SCR; (void)GROW; (void)CTLP; (void)OUTP; \
    for (int rep_ = 0; rep_ < (((id) == DUP_PHASE) ? 2 : 1); ++rep_)
#define PHASE_END   if (ph + 1 < hi) GRID_BAR(); } ++ph;

    PHASE_BEGIN(0)
    {
        LAS unsigned char* scr = F.lds + wave * 16384;
        constexpr int I_CKV = 16 * 2, I_QIDX = 16 * 4, I_KIDX = 16, I_WIDX = 16, I_512 = 16 * 8, I_GATE = 16 * 64;
        constexpr int I_WIN = I_CKV + I_QIDX + I_KIDX + I_WIDX + 5 * I_512 + I_GATE;
        constexpr int I_GLU = 8 * 8, I_MKV = 16 * 16, I_BR = 8 * 16, I_WO = 16 * 16, I_UP = 16 * 32, I_DN = 16 * 16;
        constexpr int I_LAYER = I_WIN + I_GLU + I_MKV + 4 * I_BR + I_WO + NE * I_UP + NE * I_DN;
        const float* w_in = IN(4);
        { LAS float* wt = (LAS float*)F.lds; LAS float* uk = wt + 64 * 65;
          for (int it = F.bx; it < NL * 8 * 16; it += F.G) { const int l = it >> 7, h = (it >> 4) & 7, kb = it & 15;
            const float* Wl = w_in + (size_t)l * D * DIN + (size_t)(kb * 64) * DIN + h * 64; const float* wuk = IN(6) + (size_t)l * 128 * 512 + h * 64;
            { float t8[8], u16[16];
#pragma unroll
              for (int j = 0; j < 8; ++j) { const int i = F.tid + 512 * j; t8[j] = Wl[(size_t)(i >> 6) * DIN + (i & 63)]; }
#pragma unroll
              for (int j = 0; j < 16; ++j) { const int i = F.tid + 512 * j; u16[j] = wuk[(size_t)(i >> 6) * 512 + (i & 63)]; }
#pragma unroll
              for (int j = 0; j < 8; ++j) { const int i = F.tid + 512 * j; wt[(i >> 6) * 65 + (i & 63)] = t8[j]; }
#pragma unroll
              for (int j = 0; j < 16; ++j) { const int i = F.tid + 512 * j; uk[(i >> 6) * 65 + (i & 63)] = u16[j]; } }
            __syncthreads();
            const int c = F.tid >> 2, kq = F.tid & 3; float a[16];
#pragma unroll
            for (int j = 0; j < 16; ++j) a[j] = 0.f;
            for (int d = 0; d < 64; ++d) { const float wv = uk[c * 65 + d];
#pragma unroll
                for (int j = 0; j < 16; ++j) a[j] += wv * wt[(kq * 16 + j) * 65 + d]; }
            unsigned char* p = (unsigned char*)WinT + ((size_t)l * NP + PC_QLAT + h * 128 + c) * D + kb * 64 + kq * 16; const float sq = 0.125f * QS_WQL;
            *(v4u*)p = (v4u){q8x4(a[0], a[1], a[2], a[3], sq), q8x4(a[4], a[5], a[6], a[7], sq), q8x4(a[8], a[9], a[10], a[11], sq), q8x4(a[12], a[13], a[14], a[15], sq)};
            __syncthreads(); } }
        { LAS float* APr = (LAS float*)F.lds; LAS float* APi = APr + 33 * 64; LAS float* Br = APi + 33 * 64; LAS float* Bi = Br + 1024; LAS float* Cr = Bi + 1024; LAS float* Ci = Cr + 1024; LAS float* KD = Ci + 1024;
          for (int it = F.bx; it < NL * 32; it += F.G) { const int l = it >> 5, g = it & 31; const int lg = l * 32 + g;
            if (F.tid < 64) { const int p = F.tid; const int idx = lg * 64 + p; const float lr = IN(10)[idx], li = IN(11)[idx], dt = expf(IN(17)[lg]);
                const float er = expf(lr * dt); float sn, cs; sincosf(li * dt, &sn, &cs); const float ar = er * cs, ai = er * sn;
                float xr = 1.f, xi = 0.f;
                for (int d = 0; d <= 32; ++d) { APr[d * 64 + p] = xr; APi[d * 64 + p] = xi; const float nr = xr * ar - xi * ai, ni = xr * ai + xi * ar; xr = nr; xi = ni; }
                const float nr_ = ar - 1.f, ni_ = ai, den = lr * lr + li * li; const float fr_ = (nr_ * lr + ni_ * li) / den, fi_ = (ni_ * lr - nr_ * li) / den;
                { f32x4 br4[4], bi4[4];
#pragma unroll
                  for (int q = 0; q < 4; ++q) { br4[q] = *(const f32x4*)(IN(12) + (size_t)idx * 16 + 4 * q); bi4[q] = *(const f32x4*)(IN(13) + (size_t)idx * 16 + 4 * q); }
#pragma unroll
                  for (int n = 0; n < 16; ++n) { const float br = br4[n >> 2][n & 3], bi = bi4[n >> 2][n & 3]; Br[p * 16 + n] = fr_ * br - fi_ * bi; Bi[p * 16 + n] = fr_ * bi + fi_ * br; } } }
            for (int i = F.tid; i < 1024; i += 512) { Cr[i] = IN(14)[(size_t)lg * 1024 + i]; Ci[i] = IN(15)[(size_t)lg * 1024 + i]; }
            __syncthreads();
            { const int d = F.tid >> 4, n = F.tid & 15; float a[16];
#pragma unroll
              for (int m = 0; m < 16; ++m) a[m] = 0.f;
              for (int p = 0; p < 64; ++p) { const float cr = Cr[n * 64 + p], ci = Ci[n * 64 + p], xr = APr[d * 64 + p], xi = APi[d * 64 + p]; const float gr = cr * xr - ci * xi, gi = cr * xi + ci * xr;
#pragma unroll
                  for (int m = 0; m < 16; ++m) a[m] += gr * Br[p * 16 + m] - gi * Bi[p * 16 + m]; }
              if (d == 0) { const float dn = IN(16)[lg * 16 + n];
#pragma unroll
                  for (int m = 0; m < 16; ++m) if (m == n) a[m] += dn; }
#pragma unroll
              for (int m = 0; m < 16; ++m) KD[(d * 16 + n) * 16 + m] = a[m]; }
            __syncthreads();
            bf16* wb = WSSM + (size_t)lg * 512 * SSM_K;
            for (int q = F.tid; q < 512 * (SSM_K / 8); q += 512) { const int row = q / (SSM_K / 8), ch = q % (SSM_K / 8); const int t = row >> 4, n = row & 15; float v[8];
                if (ch < 64) { const int j = ch >> 1, m0 = (ch & 1) * 8;
#pragma unroll
                    for (int e = 0; e < 8; ++e) v[e] = (j <= t) ? KD[((t - j) * 16 + n) * 16 + m0 + e] : 0.f; }
                else { const int p2 = (ch - 64) * 8, part = p2 >> 6, p0 = p2 & 63;
#pragma unroll
                    for (int e = 0; e < 8; ++e) { const float cr = Cr[n * 64 + p0 + e], ci = Ci[n * 64 + p0 + e], ar = APr[(t + 1) * 64 + p0 + e], ai = APi[(t + 1) * 64 + p0 + e]; v[e] = part ? -(cr * ai + ci * ar) : (cr * ar - ci * ai); } }
                v4u o; o.x = pk2(v[0], v[1]); o.y = pk2(v[2], v[3]); o.z = pk2(v[4], v[5]); o.w = pk2(v[6], v[7]);
                *(v4u*)(wb + (size_t)row * SSM_K + ch * 8) = o; }
            { bf16* we = WEW + (size_t)lg * 256 * 512;
              for (int q = F.tid; q < 256 * 64; q += 512) { const int row = q >> 6, ch = q & 63; v4u o = {0u, 0u, 0u, 0u};
                  if (row < 128) { const int p = row & 63, part = row >> 6, j = ch >> 1, n0 = (ch & 1) * 8; const float ar = APr[(31 - j) * 64 + p], ai = APi[(31 - j) * 64 + p]; float v[8];
#pragma unroll
                      for (int e = 0; e < 8; ++e) { const float br = Br[p * 16 + n0 + e], bi = Bi[p * 16 + n0 + e]; v[e] = part ? (ar * bi + ai * br) : (ar * br - ai * bi); }
                      o.x = pk2(v[0], v[1]); o.y = pk2(v[2], v[3]); o.z = pk2(v[4], v[5]); o.w = pk2(v[6], v[7]); }
                  *(v4u*)(we + (size_t)row * 512 + ch * 8) = o; } }
            __syncthreads(); } }
        for (;;) { int base_ = 0; if (lane == 0) base_ = (int)__hip_atomic_fetch_add(CTLP + CW_Q0, 8u, RLX_AGENT); base_ = __builtin_amdgcn_readfirstlane(base_); if (base_ >= NL * I_LAYER) break;
        for (int it = base_; it < base_ + 8 && it < NL * I_LAYER; ++it) {
            const int l = it / I_LAYER; int r = it % I_LAYER;
            const float* Wl = w_in + (size_t)l * D * DIN; bf16* Wt = (bf16*)((unsigned char*)WinT + (size_t)l * NP * D);
            if (r < I_WIN) {
                if (r < I_CKV) { tr_item64<3>(Wl, DIN, SC_CKV, 128, D, Wt, PC_CKV, scr, r, lane); continue; } r -= I_CKV;
                if (r < I_QIDX) { tr_item64<3>(Wl, DIN, SC_QIDX, 256, D, Wt, PC_QIDX, scr, r, lane); continue; } r -= I_QIDX;
                if (r < I_KIDX) { tr_item64<3>(Wl, DIN, SC_KIDX, 32, D, Wt, PC_KIDX, scr, r, lane); continue; } r -= I_KIDX;
                if (r < I_WIDX) { tr_item64<3>(Wl, DIN, SC_WIDX, 8, D, Wt, PC_WIDX, scr, r, lane); continue; } r -= I_WIDX;
                if (r < 5 * I_512) { const int s = r / I_512; tr_item64<3>(Wl, DIN, SC_CU + 512 * s, 512, D, Wt, PC_CU + 512 * s, scr, r % I_512, lane); continue; } r -= 5 * I_512;
                tr_item64<3>(Wl, DIN, SC_GATE, 4096, D, Wt, PC_GATE, scr, r, lane); continue;
            }
            r -= I_WIN;
            if (r < I_GLU) { tr_item64(IN(18) + (size_t)l * 512 * 512, 512, 0, 512, 512, WgluT + (size_t)l * 512 * 512, 0, scr, r, lane); continue; } r -= I_GLU;
            if (r < I_MKV) { tr_item64(IN(20) + (size_t)l * 1024 * 1024, 1024, 0, 1024, 1024, WmkvT + (size_t)l * 1024 * 1024, 0, scr, r, lane); continue; } r -= I_MKV;
            if (r < 4 * I_BR) { const int b = r / I_BR; tr_item64(IN(21) + ((size_t)l * 4 + b) * 512 * 1024, 1024, 0, 1024, 512, WbrT + ((size_t)l * 4 + b) * 1024 * 512, 0, scr, r % I_BR, lane); continue; } r -= 4 * I_BR;
            if (r < I_WO) { tr_item64(IN(22) + (size_t)l * 1024 * 1024, 1024, 0, 1024, 1024, WoT + (size_t)l * 1024 * 1024, 0, scr, r, lane); continue; } r -= I_WO;
            if (r < NE * I_UP) { const int e = r / I_UP; tr_item64<1>(IN(27) + ((size_t)l * NE + e) * 1024 * 2048, 2048, 0, 2048, 1024, (bf16*)((unsigned char*)WupT + ((size_t)l * NE + e) * 2048 * 1024), 0, scr, r % I_UP, lane); continue; } r -= NE * I_UP;
            { const int e = r / I_DN; tr_item64<2>(IN(29) + ((size_t)l * NE + e) * 1024 * 1024, 1024, 0, 1024, 1024, (bf16*)((unsigned char*)WdnT + ((size_t)l * NE + e) * 1024 * 1024), 0, scr, r % I_DN, lane); }
        } }
        for (int it = F.gw; it < NL * (PC_QIDX - PC_WIDX - 8); it += F.NGW) { const int l = it / (PC_QIDX - PC_WIDX - 8), rr = PC_WIDX + 8 + it % (PC_QIDX - PC_WIDX - 8);
            *((v4u*)((unsigned char*)WinT + ((size_t)l * NP + rr) * D) + lane) = (v4u){0u, 0u, 0u, 0u}; }
        for (int it = F.gw; it < NL * 512; it += F.NGW) { const int l = it / 512, n = it % 512, h = n >> 6, d = n & 63; const float* wuv = IN(7) + (size_t)l * 128 * 512;
            bf16* p = WuvT + ((size_t)l * 512 + n) * 1024;
#pragma unroll
            for (int j = 0; j < 2; ++j) { const int k0 = 8 * lane + 512 * j; float v[8];
#pragma unroll
                for (int q = 0; q < 8; ++q) { const int k = k0 + q; const float x_ = wuv[(size_t)(k & 127) * 512 + h * 64 + d]; v[q] = ((k >> 7) == h) ? x_ : 0.f; }
                v4u o; o.x = pk2(v[0], v[1]); o.y = pk2(v[2], v[3]); o.z = pk2(v[4], v[5]); o.w = pk2(v[6], v[7]); *(v4u*)(p + k0) = o; } }
        for (int it = F.gw; it < NL * 32; it += F.NGW) { const int l = it >> 5, g = it & 31; const int idx = (l * 32 + g) * 64 + lane;
            const float lr = IN(10)[idx], li = IN(11)[idx], dt = expf(IN(17)[l * 32 + g]);
            const float er = expf(lr * dt); float sn, cs; sincosf(li * dt, &sn, &cs); const float ar = er * cs, ai = er * sn;
            S5A[idx] = (f32x2){ar, ai};
            float pr = ar, pi = ai;
#pragma unroll
            for (int q = 0; q < 5; ++q) { const float nr = pr * pr - pi * pi, ni = 2.f * pr * pi; pr = nr; pi = ni; }
            S5A[NL * 32 * 64 + idx] = (f32x2){pr, pi};
            const float nr_ = ar - 1.f, ni_ = ai, den = lr * lr + li * li; const float fr_ = (nr_ * lr + ni_ * li) / den, fi_ = (ni_ * lr - nr_ * li) / den;
            { f32x4 br4[4], bi4[4];
#pragma unroll
              for (int q = 0; q < 4; ++q) { br4[q] = *(const f32x4*)(IN(12) + (size_t)idx * 16 + 4 * q); bi4[q] = *(const f32x4*)(IN(13) + (size_t)idx * 16 + 4 * q); }
#pragma unroll
              for (int n = 0; n < 16; ++n) { const float br = br4[n >> 2][n & 3], bi = bi4[n >> 2][n & 3];
                  S5B[(size_t)idx * 16 + n] = (f32x2){fr_ * br - fi_ * bi, fr_ * bi + fi_ * br}; } } }
        for (int it = F.gw; it < 512; it += F.NGW) { const float* mp = IN(1) + (size_t)it * 1024; f32x4 v[4];
#pragma unroll
            for (int j = 0; j < 4; ++j) v[j] = *(const f32x4*)(mp + 4 * lane + 256 * j);
            store_row_f32_bf16(v, nullptr, MEMB + (size_t)it * 1024, lane); }
        const LnAff aff0 = ln_aff(IN(2), IN(3), lane);
        for (int m = F.gw; m < M; m += F.NGW) { const float* xp = IN(0) + (size_t)m * D; f32x4 v[4];
#pragma unroll
            for (int j = 0; j < 4; ++j) v[j] = *(const f32x4*)(xp + 4 * lane + 256 * j);
            ln_rows_pre(v, aff0); store_row_f32_bf16(v, nullptr, Hf + (size_t)m * D, lane); store_row_fp8(v, (unsigned char*)Hb + (size_t)m * D, lane); }
    }
    PHASE_END

    PHASE_BEGIN(1)
    {
        pg8::Dims g{2048, 2048, 2048}; MkvOrder S{F.G, F.bx, (const char*)MEMB, (const char*)WmkvT}; EpiMkv E{MKV};
        pg8::gemm_phase<EpiMkv, MkvOrder, true, true>(F.lds, g, S, E, F.tid);
    }
    PHASE_END

#define MOE_BLK0() do { if (F.tid < 32) CNTL[F.tid] = (int)__hip_atomic_load(CTLP + CW_CNT + l * 2048 + F.tid * 64, RLX_AGENT); __syncthreads(); \
        if (F.tid < 33) { int acc_ = 0; for (int k_ = 0; k_ < 32; ++k_) acc_ += (k_ < F.tid) ? ((CNTL[k_] + 255) >> 8) : 0; BLK0[F.tid] = acc_; } __syncthreads(); } while (0)
    for (int l = 0; l < NL; ++l) {
        PHASE_BEGIN(2)
        {
            pg8::Dims g{1024, 1024, 1024}; pg8::StaticOrder S; S.init(M, NP, F.G, F.bx, Hb, 1024, (const unsigned char*)WinT + (size_t)l * NP * D, 1024); EpiProjQ E{PROJ, NP, AEXT};
            pg8::gemm_phase<EpiProjQ, pg8::StaticOrder, true, true, true>(F.lds, g, S, E, F.tid);
        }
        PHASE_END

        PHASE_BEGIN(3)
        {
            { const float* kg = IN(5) + (size_t)l * 128; const float* cw = IN(8) + (size_t)l * 3 * 512; const float* cb = IN(9) + (size_t)l * 512;
              const float kg0 = kg[2 * lane], kg1 = kg[2 * lane + 1];
#pragma unroll 1
              for (int mb = F.gw; mb < M; mb += 4 * F.NGW) {
                unsigned cw2[4], kx[4]; v4u uu[4][3], gc[4][3], gb[4];
#pragma unroll
                for (int q = 0; q < 4; ++q) { int m = mb + q * F.NGW; m = m < M ? m : mb; const bf16* pr = PROJ + (size_t)m * NP; const int tl = m & (T - 1);
                    cw2[q] = *(const unsigned*)(pr + PC_CKV + 2 * lane); kx[q] = *(const unsigned*)(pr + PC_KIDX + 2 * (lane & 15)); gb[q] = *(const v4u*)(pr + PC_GB + 8 * lane);
#pragma unroll
                    for (int k = 0; k < 3; ++k) { const int back = 2 - k; const bf16* pp = pr - (size_t)(tl >= back ? back : 0) * NP;
                        uu[q][k] = *(const v4u*)(pp + PC_CU + 8 * lane); gc[q][k] = *(const v4u*)(pp + PC_GC + 8 * lane); } }
#pragma unroll
                for (int q = 0; q < 4; ++q) { const int m = mb + q * F.NGW; if (m < M) { const int tl = m & (T - 1);
                    const float c0 = bflo(cw2[q]), c1 = bfhi(cw2[q]);
                    const float rs = 1.f / sqrtf(wave_sum(c0 * c0 + c1 * c1) * (1.f / 128.f) + LN_EPS);
                    *(unsigned*)(KVN + (size_t)m * 128 + 2 * lane) = pk2(c0 * rs * kg0, c1 * rs * kg1);
                    if (lane < 16) *(unsigned*)(KIDX + (size_t)m * 32 + 2 * lane) = kx[q];
                    float y[8];
#pragma unroll
                    for (int i = 0; i < 8; ++i) y[i] = cb[8 * lane + i];
#pragma unroll
                    for (int k = 0; k < 3; ++k) { const int back = 2 - k; if (tl >= back) { const v4u u4 = uu[q][k], g4 = gc[q][k]; const float* wk = cw + k * 512 + 8 * lane;
                            y[0] += wk[0] * bflo(u4.x) * bflo(g4.x); y[1] += wk[1] * bfhi(u4.x) * bfhi(g4.x); y[2] += wk[2] * bflo(u4.y) * bflo(g4.y); y[3] += wk[3] * bfhi(u4.y) * bfhi(g4.y);
                            y[4] += wk[4] * bflo(u4.z) * bflo(g4.z); y[5] += wk[5] * bfhi(u4.z) * bfhi(g4.z); y[6] += wk[6] * bflo(u4.w) * bflo(g4.w); y[7] += wk[7] * bfhi(u4.w) * bfhi(g4.w); } }
                    const v4u b4 = gb[q];
                    v4u o; o.x = pk2(y[0] * bflo(b4.x), y[1] * bfhi(b4.x)); o.y = pk2(y[2] * bflo(b4.y), y[3] * bfhi(b4.y)); o.z = pk2(y[4] * bflo(b4.z), y[5] * bfhi(b4.z)); o.w = pk2(y[6] * bflo(b4.w), y[7] * bfhi(b4.w));
                    *(v4u*)(BR + (size_t)m * 2048 + 512 + 8 * lane) = o; } } } }
            __syncthreads();
            { pg8::Dims g{SSM_K * 2, 1024, 1024}; EOrder S{F.G, F.bx, (const char*)AEXT, (const char*)(WEW + (size_t)l * 32 * 256 * 512)}; EpiE E{(float*)SSE};
              pg8::gemm_phase<EpiE, EOrder, true, true>(F.lds, g, S, E, F.tid); }
            __syncthreads();
            __syncthreads();
            for (int u = F.bx; u < NB * 4 * (T / 256); u += F.G) { const int qblk = u % (T / 256), hd = (u / (T / 256)) & 3, b = u / (4 * (T / 256));
                memattn_unit(F.lds, PROJ, MKV + (size_t)l * 512 * 1024, BR, b, hd, qblk, F.tid); }
        }
        PHASE_END

        PHASE_BEGIN(4)
        {
            { int par = 0; float* sb0 = SCR + (size_t)F.bx * 2 * 8 * 8192;
              for (int i = 0; ; ++i) { const int rk = (i & 1) ? (i * F.G + (F.G - 1 - F.bx)) : (i * F.G + F.bx); if (rk >= M / 8) break;
                const int u = M / 8 - 1 - rk; const int b = u & 1, t0 = (u >> 1) * 8;
                dsa2_unit(F.lds, PROJ, KIDX, KVN, OLAT, sb0 + (size_t)par * 8 * 8192, b, t0, F.tid); if (t0 >= 256) par ^= 1; }
              __syncthreads(); }
#ifndef DUP_CARRY
#define DUP_CARRY 1
#endif
            for (int repc = 0; repc < DUP_CARRY; ++repc)
            for (int it = F.gw; it < NB * 32; it += F.NGW) { const int b = it >> 5, g = it & 31; const f32x2 aL = S5A[NL * 32 * 64 + (l * 32 + g) * 64 + lane];
                float hr = 0.f, hi_ = 0.f; bf16* ap = AEXT + ((size_t)(g * 512 + b * 256)) * SSM_K + 512 + lane;
                for (int c0 = 0; c0 < SSM_NC; c0 += 8) { f32x2 e[8];
#pragma unroll
                    for (int k = 0; k < 8; ++k) { const float* ep_ = (const float*)SSE + ((size_t)(b * SSM_NC + c0 + k) * 32 + g) * 128 + lane; e[k] = (f32x2){ep_[0], ep_[64]}; }
#pragma unroll
                    for (int k = 0; k < 8; ++k) { ap[(size_t)(c0 + k) * SSM_K] = (bf16)f2bf(hr); ap[(size_t)(c0 + k) * SSM_K + 64] = (bf16)f2bf(hi_);
                        const float nr = aL[0] * hr - aL[1] * hi_ + e[k][0], ni = aL[0] * hi_ + aL[1] * hr + e[k][1]; hr = nr; hi_ = ni; } } }
        }
        PHASE_END

        PHASE_BEGIN(5)
        {
            const int half = F.G >> 1;
            if (F.bx < half) {
                pg8::Dims g{SSM_K * 2, SSM_K * 2, SSM_K * 2}; SsmOrder S{half, F.bx, (const char*)AEXT, (const char*)(WSSM + (size_t)l * 32 * 512 * SSM_K)}; EpiSsm E{Zb};
                pg8::gemm_phase<EpiSsm, SsmOrder, true, true>(F.lds, g, S, E, F.tid);
            } else {
                pg8::Dims g{2048, 2048, 2048}; pg8::StaticOrder S; S.init(M, 512, F.G - half, F.bx - half, OLAT, 2048, WuvT + (size_t)l * 512 * 1024, 2048);
                EpiBf16 E{BR, 2048};
                pg8::gemm_phase<EpiBf16, pg8::StaticOrder, true, true>(F.lds, g, S, E, F.tid);
            }
        }
        PHASE_END

        PHASE_BEGIN(6)
        {
            pg8::Dims g{1024, 1024, 1024}; pg8::StaticOrder S; S.init(M, 512, F.G, F.bx, Zb, 1024, WgluT + (size_t)l * 512 * 512, 1024);
            EpiGlu E{Zb, 512, IN(19) + (size_t)l * 512, BR + 1024, 2048};
            pg8::gemm_phase<EpiGlu, pg8::StaticOrder, true, true>(F.lds, g, S, E, F.tid);
        }
        PHASE_END

        PHASE_BEGIN(7)
        {
            pg8::Dims g{4096, 1024, 1024}; MergeOrder S{F.G, F.bx, (const char*)BR, (const char*)(WbrT + (size_t)l * 4 * 1024 * 512)};
            EpiMerge E{PROJ + PC_GATE, NP, MRGB};
            pg8::gemm_phase<EpiMerge, MergeOrder, true, true>(F.lds, g, S, E, F.tid);
        }
        PHASE_END

        PHASE_BEGIN(8)
        {
            pg8::Dims g{2048, 2048, 2048}; pg8::StaticOrder S; S.init(M, 1024, F.G, F.bx, MRGB, 2048, WoT + (size_t)l * 1024 * 1024, 2048); EpiWo E{Hf, Vf};
            pg8::gemm_phase<EpiWo, pg8::StaticOrder, true, true>(F.lds, g, S, E, F.tid);
        }
        PHASE_END

        PHASE_BEGIN(9)
        {
            constexpr int HP = 2064, HLO_OFF = 16 * HP, PART_OFF = 66560;
            LAS unsigned char* hhi = F.lds; LAS unsigned char* hlo = F.lds + HLO_OFF; LAS float* part = (LAS float*)(F.lds + PART_OFF);
            LAS unsigned* wcnt = (LAS unsigned*)(F.lds + LDSCTL_OFF + 2048); LAS unsigned* wbase = wcnt + 32; LAS unsigned* asg = wcnt + 64; LAS float* asgg = (LAS float*)(asg + 256);
            const float* wr_ = IN(25) + (size_t)l * 1024 * 32; const float* brt = IN(26) + (size_t)l * 32;
            unsigned* cnt = CTLP + CW_CNT + l * 2048;
            const float* g1 = IN(23) + (size_t)l * D; const float* b1 = IN(24) + (size_t)l * D;
            const int fn = lane & 15, fkq = lane >> 4;
            v4u whi[4][2], wlo[4][2];
#pragma unroll
            for (int ks = 0; ks < 4; ++ks)
#pragma unroll
                for (int mt = 0; mt < 2; ++mt) { unsigned hh[8], ll[8];
#pragma unroll
                    for (int i = 0; i < 8; ++i) { const float f = wr_[(size_t)(128 * wave + 32 * ks + 8 * fkq + i) * 32 + 16 * mt + fn]; hh[i] = f2bf(f); ll[i] = f2bf(f - __builtin_bit_cast(float, hh[i] << 16)); }
                    whi[ks][mt] = (v4u){hh[0] | (hh[1] << 16), hh[2] | (hh[3] << 16), hh[4] | (hh[5] << 16), hh[6] | (hh[7] << 16)};
                    wlo[ks][mt] = (v4u){ll[0] | (ll[1] << 16), ll[2] | (ll[3] << 16), ll[4] | (ll[5] << 16), ll[6] | (ll[7] << 16)}; }
            const LnAff aff1 = ln_aff(g1, b1, lane);
            for (int blk = F.bx; blk < M / 64; blk += F.G) {
                if (F.tid < 32) wcnt[F.tid] = 0u;
                __syncthreads();
                v2u raw[2][4];
#pragma unroll
                for (int tk = 0; tk < 2; ++tk)
#pragma unroll
                    for (int j = 0; j < 4; ++j) raw[tk][j] = *(const v2u*)(Vf + (size_t)(blk * 64 + 2 * wave + tk) * D + 4 * lane + 256 * j);
#pragma unroll 1
                for (int rd = 0; rd < 4; ++rd) { const int m0 = blk * 64 + rd * 16 + 2 * wave;
#pragma unroll
                    for (int tk = 0; tk < 2; ++tk) { f32x4 v[4];
#pragma unroll
                        for (int j = 0; j < 4; ++j) v[j] = (f32x4){bflo(raw[tk][j].x), bfhi(raw[tk][j].x), bflo(raw[tk][j].y), bfhi(raw[tk][j].y)};
                        ln_rows_pre(v, aff1); store_row_f32_bf16(v, nullptr, H1 + (size_t)(m0 + tk) * D, lane); store_row_fp8(v, (unsigned char*)H1B + (size_t)(m0 + tk) * D, lane);
#pragma unroll
                        for (int j = 0; j < 4; ++j) { unsigned hh[4]; float rr[4];
#pragma unroll
                            for (int q = 0; q < 4; ++q) { hh[q] = f2bf(v[j][q]); rr[q] = v[j][q] - __builtin_bit_cast(float, hh[q] << 16); }
                            const int o_ = (2 * wave + tk) * HP + (4 * lane + 256 * j) * 2;
                            *(LAS v2u*)(hhi + o_) = (v2u){hh[0] | (hh[1] << 16), hh[2] | (hh[3] << 16)}; *(LAS v2u*)(hlo + o_) = (v2u){pk2(rr[0], rr[1]), pk2(rr[2], rr[3])}; } }
                    if (rd + 1 < 4) {
#pragma unroll
                        for (int tk = 0; tk < 2; ++tk)
#pragma unroll
                            for (int j = 0; j < 4; ++j) raw[tk][j] = *(const v2u*)(Vf + (size_t)(m0 + 16 + tk) * D + 4 * lane + 256 * j); }
                    __syncthreads();
                    { f32x4 acc[2] = {{0.f, 0.f, 0.f, 0.f}, {0.f, 0.f, 0.f, 0.f}};
#pragma unroll
                      for (int ks = 0; ks < 4; ++ks) { const int ko = fn * HP + (128 * wave + 32 * ks + 8 * fkq) * 2;
                          const bf16x8 bh = *(const LAS bf16x8*)(hhi + ko), bl = *(const LAS bf16x8*)(hlo + ko);
#pragma unroll
                          for (int mt = 0; mt < 2; ++mt) { const bf16x8 ah = __builtin_bit_cast(bf16x8, whi[ks][mt]), al = __builtin_bit_cast(bf16x8, wlo[ks][mt]);
                              acc[mt] = __builtin_amdgcn_mfma_f32_16x16x32_bf16(ah, bh, acc[mt], 0, 0, 0); acc[mt] = __builtin_amdgcn_mfma_f32_16x16x32_bf16(al, bh, acc[mt], 0, 0, 0);
                              acc[mt] = __builtin_amdgcn_mfma_f32_16x16x32_bf16(ah, bl, acc[mt], 0, 0, 0); } }
#pragma unroll
                      for (int mt = 0; mt < 2; ++mt) *(LAS f32x4*)(part + (wave * 16 + fn) * 32 + 16 * mt + 4 * fkq) = acc[mt]; }
                    __syncthreads();
                    const int eq = lane & 7; const int lopr_ = lane_op(); const f32x4 be4 = *(const f32x4*)(brt + 4 * eq);
#pragma unroll 1
                    for (int tk = 0; tk < 2; ++tk) { float cur[4] = {be4[0], be4[1], be4[2], be4[3]};
#pragma unroll
                        for (int w = 0; w < 8; ++w) { const f32x4 p = *(const LAS f32x4*)(part + (w * 16 + 2 * wave + tk) * 32 + 4 * eq);
#pragma unroll
                            for (int j = 0; j < 4; ++j) cur[j] += p[j]; }
                        float val[4]; int idx[4];
#pragma unroll
                        for (int k = 0; k < 4; ++k) { float bv = cur[0]; int bi = 4 * eq;
#pragma unroll
                            for (int j = 1; j < 4; ++j) if (cur[j] > bv) { bv = cur[j]; bi = 4 * eq + j; }
#pragma unroll
                            for (int o = 1; o < 8; o <<= 1) { const float ov = SHX(bv, o, lopr_); const int oi = SHX(bi, o, lopr_); if (ov > bv || (ov == bv && oi < bi)) { bv = ov; bi = oi; } }
                            val[k] = bv; idx[k] = bi;
#pragma unroll
                            for (int j = 0; j < 4; ++j) if (bi == 4 * eq + j) cur[j] = -INFINITY; }
                        const float e1 = __expf(val[1] - val[0]), e2 = __expf(val[2] - val[0]), e3 = __expf(val[3] - val[0]); const float inv = 1.f / (1.f + e1 + e2 + e3);
                        const float gt[4] = {inv, e1 * inv, e2 * inv, e3 * inv};
                        if (lane < 4) { int ee = idx[0]; float gg = gt[0];
#pragma unroll
                            for (int k = 1; k < 4; ++k) if (lane == k) { ee = idx[k]; gg = gt[k]; }
                            const unsigned rank = __hip_atomic_fetch_add(&wcnt[ee], 1u, __ATOMIC_RELAXED, __HIP_MEMORY_SCOPE_WORKGROUP);
                            const int tl_ = rd * 16 + 2 * wave + tk; asg[tl_ * 4 + lane] = (unsigned)ee | (rank << 8); asgg[tl_ * 4 + lane] = gg; } }
                    LDS_WAIT();
                }
                __syncthreads();
                if (F.tid < 32) { const unsigned c = wcnt[F.tid]; wbase[F.tid] = c ? __hip_atomic_fetch_add(cnt + F.tid * 64, c, RLX_AGENT) : 0u; }
                __syncthreads();
                if (F.tid < 256) { const unsigned a_ = asg[F.tid]; const int ee = (int)(a_ & 255u); const unsigned slot = wbase[ee] + (a_ >> 8); const int m = blk * 64 + (F.tid >> 2);
                    TOK[(size_t)ee * M + slot] = m; GATE[(size_t)ee * M + slot] = asgg[F.tid]; SLOT[(size_t)m * 4 + (F.tid & 3)] = ee * M + (int)slot; }
                __syncthreads();
            }
        }
        PHASE_END

        PHASE_BEGIN(11)
        {
            LAS int* CNTL = (LAS int*)(ldsq + MISC_OFF + 272);
            MOE_BLK0();
            for (int mb = F.gw; mb < M; mb += 16 * F.NGW) { const int m = mb + (lane >> 2) * F.NGW;
                if (m < M) { const int sl = SLOT[(size_t)m * 4 + (lane & 3)]; const int e = sl >> 14, s = sl & (M - 1); GROW[(size_t)BLK0[e] * 256 + s] = GATE[(size_t)e * M + s]; } }
            pg8::Dims g{1024, 1024, 1024}; MoeOrder S{F.G, F.bx, 8, BLK0[32] * 8, BLK0, (const char*)H1B, (const char*)WupT + (size_t)l * NE * 2048 * 1024, (size_t)0, (size_t)2048 * 1024, (size_t)256 * 1024, TOK, CNTL};
            EpiUp E{IN(28) + (size_t)l * NE * 2048, (unsigned char*)ACT};
            pg8::gemm_phase<EpiUp, MoeOrder, true, true, true, true>(F.lds, g, S, E, F.tid);
        }
        PHASE_END

        PHASE_BEGIN(12)
        {
            { LAS int* CNTL = (LAS int*)(ldsq + MISC_OFF + 272); MOE_BLK0(); }
            pg8::Dims g{1024, 1024, 1024}; MoeOrder S{F.G, F.bx, 4, BLK0[32] * 4, BLK0, (const char*)ACT, (const char*)WdnT + (size_t)l * NE * 1024 * 1024, (size_t)256 * 1024, (size_t)1024 * 1024, (size_t)256 * 1024, nullptr, nullptr};
            EpiDown E{IN(30) + (size_t)l * NE * 1024, GROW, YS};
            pg8::gemm_phase<EpiDown, MoeOrder, true, true, true>(F.lds, g, S, E, F.tid);
        }
        PHASE_END

        PHASE_BEGIN(13)
        {
            { LAS int* CNTL = (LAS int*)(ldsq + MISC_OFF + 272); MOE_BLK0(); }
#define LL_ISSUE(mm, s4, hh, yy) do { const unsigned ho_ = (unsigned)(mm) * 2048u + 8u * (unsigned)lane; \
                _Pragma("unroll") for (int j = 0; j < 4; ++j) hh[j] = *(const v2u*)((const char*)H1 + ho_ + 512 * j); \
                _Pragma("unroll") for (int k = 0; k < 4; ++k) { const unsigned sl = s4[k]; const unsigned ro_ = ((unsigned)BLK0[sl >> 14] * 256u + (sl & (unsigned)(M - 1))) * 2048u + 8u * (unsigned)lane; \
                    _Pragma("unroll") for (int j = 0; j < 4; ++j) yy[k][j] = *(const v2u*)((const char*)YS + ro_ + 512 * j); } } while (0)
#define LL_FIN(mm, hC, yC) { f32x4 v[4]; \
                  _Pragma("unroll") for (int j = 0; j < 4; ++j) { v[j] = (f32x4){bflo(hC[j].x), bfhi(hC[j].x), bflo(hC[j].y), bfhi(hC[j].y)} * DN_ALPHA; \
                      _Pragma("unroll") for (int k = 0; k < 4; ++k) { const v2u y2 = yC[k][j]; v[j][0] += bflo(y2.x); v[j][1] += bfhi(y2.x); v[j][2] += bflo(y2.y); v[j][3] += bfhi(y2.y); } } \
                  ln_rows_pre(v, aff2); \
                  if (l == NL - 1) store_row_f32_bf16(v, OUTP + (size_t)(mm) * D, nullptr, lane); \
                  else { store_row_f32_bf16(v, nullptr, Hf + (size_t)(mm) * D, lane); store_row_fp8(v, (unsigned char*)Hb + (size_t)(mm) * D, lane); } }
            const LnAff aff2 = ln_aff(IN(31) + (size_t)l * D, IN(32) + (size_t)l * D, lane);
            { int m = F.gw; const int st = F.NGW; v4u sa = *(const v4u*)(SLOT + (size_t)m * 4), sb = *(const v4u*)(SLOT + (size_t)(m + st < M ? m + st : m) * 4);
#pragma unroll 1
              for (; m < M; m += 2 * st) { const bool two = m + st < M; const int m1 = two ? m + st : m; v2u hA[4], yA[4][4], hB[4], yB[4][4];
                  LL_ISSUE(m, sa, hA, yA); LL_ISSUE(m1, sb, hB, yB);
                  { const int n0 = m + 2 * st; if (n0 < M) { sa = *(const v4u*)(SLOT + (size_t)n0 * 4); sb = *(const v4u*)(SLOT + (size_t)(n0 + st < M ? n0 + st : n0) * 4); } }
                  LL_FIN(m, hA, yA)
                  if (two) LL_FIN(m1, hB, yB) } }
#undef LL_FIN
#undef LL_ISSUE
        }
        PHASE_END
    }
#undef PHASE_BEGIN
#undef PHASE_END
}

extern "C" void kernel_launch(void* const* d_in, const int* in_sizes, int n_in, void* d_out, int out_size, void* d_ws, size_t ws_size, hipStream_t stream) {
    static int grid = 0;
    if (grid == 0) {
        if (n_in != 33 || out_size != M * D || ws_size < WS_END) { fprintf(stderr, "kernel_launch: unexpected shapes (n_in %d out %d ws %zu need %zu)\n", n_in, out_size, ws_size, (size_t)WS_END); grid = -1; return; }
        int dev = 0, cus = 0, per_cu = 0;
        if (hipGetDevice(&dev) != hipSuccess || hipDeviceGetAttribute(&cus, hipDeviceAttributeMultiprocessorCount, dev) != hipSuccess) { grid = -1; return; }
        if (hipFuncSetAttribute((const void*)fwd, hipFuncAttributeMaxDynamicSharedMemorySize, LDS_BYTES) != hipSuccess) { fprintf(stderr, "kernel_launch: hipFuncSetAttribute failed\n"); grid = -1; return; }
        if (hipOccupancyMaxActiveBlocksPerMultiprocessor(&per_cu, (const void*)fwd, NWAVES * 64, LDS_BYTES) != hipSuccess || per_cu < 1) fprintf(stderr, "kernel_launch: occupancy query says %d\n", per_cu);
        (void)hipGetLastError();
        grid = cus;
    }
    if (grid < 0) return;
    (void)hipMemsetAsync((char*)d_ws + WS_CTL, 0, CTL_ZERO_BYTES, stream);
    Args a{};
    for (int i = 0; i < 33; ++i) a.in[i] = (const float*)d_in[i];
    a.out = (float*)d_out; a.ws = (unsigned char*)d_ws;
#if ONE_LAUNCH
    a.ph_lo = 0; a.ph_hi = NPHASE;
    hipLaunchKernelGGL(fwd, dim3(grid), dim3(NWAVES * 64), LDS_BYTES, stream, a);
#else
    for (int p = 0; p < NPHASE; ++p) { a.ph_lo = p; a.ph_hi = p + 1; hipLaunchKernelGGL(fwd, dim3(grid), dim3(NWAVES * 64), LDS_BYTES, stream, a); }
#endif
}
```

```cpp
#include <hip/hip_runtime.h>
#include <cstdio>
#include <cstdint>

#ifndef ONE_LAUNCH
#define ONE_LAUNCH 1
#endif

#define LAS __attribute__((address_space(3)))
#define GAS __attribute__((address_space(1)))
typedef unsigned short bf16;
typedef unsigned v4u __attribute__((ext_vector_type(4)));
typedef unsigned v2u __attribute__((ext_vector_type(2)));
typedef float f32x4 __attribute__((ext_vector_type(4)));
typedef float f32x2 __attribute__((ext_vector_type(2)));
typedef short bf16x8 __attribute__((ext_vector_type(8)));
typedef short v4i16_t __attribute__((ext_vector_type(4)));

namespace pg8 {
constexpr int BM = 256, BK = 64, HALF = 128, HTB = HALF * BK * 2, STAGE_BYTES = 8 * HTB, NXCD = 8, WGM = 8;
__host__ __device__ __forceinline__ int lds_byte(int r, int c) { const int st = (r >> 4) * 2 + (c >> 5), rr = r & 15, cc = c & 31, ob = rr * 64 + cc * 2; return st * 1024 + (ob ^ (((ob >> 9) & 1) << 5)); }
__host__ __device__ __forceinline__ void stage_rc(int b, int& R, int& C) { const int st = b / 1024, sb = b % 1024, swz = sb ^ (((sb >> 9) & 1) << 5); R = (st >> 1) * 16 + swz / 64; C = (st & 1) * 32 + (swz % 64) / 2; }
__host__ __device__ __forceinline__ int perm32(int rho) { const int n = rho >> 4, i = rho & 15; return 8 * (i >> 2) + 4 * n + (i & 3); }

constexpr int GATHER_LIST_OFF = 131072 + 2048;
struct Unit { int pm, pn, z; const char* A; const char* B; };
struct Dims { int lda, ldb, K; };
typedef int v8i_t __attribute__((ext_vector_type(8)));
typedef int v4i_t __attribute__((ext_vector_type(4)));

__device__ __forceinline__ void tile_of(int wgid, int nM, int nN, int& pm, int& pn) {
    const int nwg = nM * nN;
    { const int q = nwg / NXCD, r = nwg % NXCD, xcd = wgid % NXCD, off = wgid / NXCD; wgid = (xcd < r ? xcd * (q + 1) : r * (q + 1) + (xcd - r) * q) + off; }
    const int nig = WGM * nN, gid = wgid / nig, fm = gid * WGM, gsz = (nM - fm) < WGM ? (nM - fm) : WGM;
    pm = fm + ((wgid % nig) % gsz); pn = (wgid % nig) / gsz;
}
struct StaticOrder {
    int nM, nN, nwg, G, c; const char* A; const char* B; size_t at, bt;
    __device__ void init(int M, int N, int G_, int c_, const void* A_, int lda, const void* B_, int ldb) { nM = M / BM; nN = N / BM; nwg = nM * nN; G = G_; c = c_; A = (const char*)A_; B = (const char*)B_; at = (size_t)BM * lda; bt = (size_t)BM * ldb; }
    __device__ __forceinline__ bool next(int i, Unit& u) const {
        const long Lx = (long)i * G + c; if (Lx >= nwg) return false;
        int pm, pn; tile_of((int)Lx, nM, nN, pm, pn); u.pm = pm; u.pn = pn; u.z = 0; u.A = A + (size_t)pm * at; u.B = B + (size_t)pn * bt; return true;
    }
};

__device__ __forceinline__ unsigned cvt_pk_bf16(float lo, float hi) { unsigned r; asm volatile("v_cvt_pk_bf16_f32 %0, %1, %2" : "=v"(r) : "v"(lo), "v"(hi)); return r; }

template <class Epi, class Sched, bool ALIGN_EPI = false, bool SP2 = false, bool FP8 = false  ,
          bool GATHER = false  >
__device__ __forceinline__ void gemm_phase(LAS unsigned char* lds, const Dims g, const Sched& S, const Epi& E, int tid_in) {
    int tid = tid_in; asm volatile("" : "+v"(tid));
    const int wid = __builtin_amdgcn_readfirstlane(tid >> 6), lane = tid & 63, wr = wid >> 2, wc = wid & 3, fr = lane & 15, fq = lane >> 4;
    const int nt = g.K / (BK * 2);
    unsigned voffA[2], voffB[2];
#pragma unroll
    for (int i = 0; i < 2; ++i) { int R, C; stage_rc(tid * 16 + i * 8192, R, C); const int Rb = Epi::PERM ? ((R & ~31) + perm32(R & 31)) : R;
        voffA[i] = (unsigned)(R * g.lda + C * 2); voffB[i] = (unsigned)(Rb * g.ldb + C * 2); }
    static_assert(!GATHER || SP2, "gathered A rows: SP2 schedule only");
    unsigned vgc[2][2]; bool last_g = false; int nxp_ = 0, gR_ = 0; unsigned gC_ = 0u; (void)last_g; (void)nxp_;
    if constexpr (GATHER) { int R, C; stage_rc(tid * 16, R, C); gR_ = R; gC_ = (unsigned)(C * 2); }
    LAS int* const ntok_ = (LAS int*)(lds + GATHER_LIST_OFF);
#define PG8_GLIST(u, par) do { if (tid < 256) { const int* tb_; int s0_, ce_; S.rowinfo(u, tb_, s0_, ce_); const int s_ = s0_ + tid; ntok_[(par) * 256 + tid] = tb_[s_ < ce_ ? s_ : 0]; } } while (0)
#define PG8_GOFF(par, vg) do { _Pragma("unroll") for (int _h = 0; _h < 2; ++_h) _Pragma("unroll") for (int _i = 0; _i < 2; ++_i) vg[_h][_i] = (unsigned)ntok_[(par) * 256 + gR_ + 64 * _i + 128 * _h] * 1024u + gC_; } while (0)
#define PG8_STAGE_A(slot, ptr, half, SEL) do { if constexpr (GATHER) { if (SEL) { unsigned vt_[2] = {vgc[half][0], vgc[half][1]}; if (last_g) { _Pragma("unroll") for (int _i = 0; _i < 2; ++_i) vt_[_i] = (unsigned)ntok_[nxp_ * 256 + gR_ + 64 * _i + 128 * (half)] * 1024u + gC_; } PG8_STAGE(slot, ptr, vt_); } else PG8_STAGE(slot, ptr, vgc[half]); } else PG8_STAGE(slot, (ptr) + ((half) ? hstepA : (size_t)0), voffA); } while (0)
    const size_t kstep = (size_t)(BK * 2);
    const size_t hstepA = (size_t)HALF * g.lda, hstepB = (size_t)HALF * g.ldb;
    const unsigned ldsw = (unsigned)wid * 1024u;
    const int aoff0 = lds_byte(wr * 64 + fr, fq * 8), aoff1 = aoff0 + 1024;
    const int boff0 = lds_byte(wc * 32 + fr, fq * 8), boff1 = boff0 + 1024;
#define PG8_SA(b, h) (((b) * 2 + (h)) * HTB)
#define PG8_SB(b, h) ((4 + (b) * 2 + (h)) * HTB)
#define PG8_STAGE(bufoff, gbase, voff) do { _Pragma("unroll") for (int _i = 0; _i < 2; ++_i) \
        __builtin_amdgcn_global_load_lds((const unsigned*)((const char*)(gbase) + (voff)[_i]), (LAS unsigned*)(lds + (bufoff) + ldsw + _i * 8192), 16, 0, 0); } while (0)
#define PG8_LDA(dst, b, h) do { _Pragma("unroll") for (int m = 0; m < 4; ++m) _Pragma("unroll") for (int k = 0; k < 2; ++k) dst[m][k] = *(const LAS bf16x8*)(lds + PG8_SA(b, h) + (k ? aoff1 : aoff0) + m * 2048); } while (0)
#define PG8_LDB(dst, b, h) do { _Pragma("unroll") for (int n = 0; n < 2; ++n) _Pragma("unroll") for (int k = 0; k < 2; ++k) dst[n][k] = *(const LAS bf16x8*)(lds + PG8_SB(b, h) + (k ? boff1 : boff0) + n * 2048); } while (0)
#define PG8_MMA(ai, bj, At, Bt) do { __builtin_amdgcn_s_setprio(1); _Pragma("unroll") for (int m = 0; m < 4; ++m) _Pragma("unroll") for (int n = 0; n < 2; ++n) _Pragma("unroll") for (int k = 0; k < 2; ++k) { \
        if constexpr (FP8) acc[ai][bj][m][n] = __builtin_bit_cast(f32x4, __builtin_amdgcn_mfma_i32_16x16x64_i8(__builtin_bit_cast(v4i_t, Bt[n][k]), __builtin_bit_cast(v4i_t, At[m][k]), __builtin_bit_cast(v4i_t, acc[ai][bj][m][n]), 0, 0, 0)); \
        else acc[ai][bj][m][n] = __builtin_amdgcn_mfma_f32_16x16x32_bf16(Bt[n][k], At[m][k], acc[ai][bj][m][n], 0, 0, 0); } __builtin_amdgcn_s_setprio(0); } while (0)
#define PG8_WAIT_V(n) asm volatile("s_waitcnt vmcnt(" #n ")" ::: "memory")
#define PG8_WAIT_L(n) asm volatile("s_waitcnt lgkmcnt(" #n ")" ::: "memory")
#define PG8_BAR __builtin_amdgcn_s_barrier()
#define PG8_SCHED __builtin_amdgcn_sched_barrier(0)
    Unit cur, nxt; int ui = 0;
    if (!S.next(0, cur)) return;
    f32x4 acc[2][2][4][2];
    float zq = 0.f; asm volatile("" : "+v"(zq));
#pragma unroll
    for (int a = 0; a < 2; ++a)
#pragma unroll
        for (int b = 0; b < 2; ++b)
#pragma unroll
            for (int m = 0; m < 4; ++m)
#pragma unroll
                for (int n = 0; n < 2; ++n) acc[a][b][m][n] = (f32x4){zq, zq, zq, zq};
    bf16x8 At[4][2], B0[2][2], B1[2][2];
    const char* cA = cur.A; const char* cB = cur.B;
    if constexpr (SP2) {
        if constexpr (GATHER) { PG8_GLIST(cur, 0); PG8_WAIT_L(0); PG8_BAR; PG8_GOFF(0, vgc); }
        PG8_STAGE(PG8_SB(0, 0), cB, voffB); PG8_STAGE(PG8_SB(0, 1), cB + hstepB, voffB); PG8_STAGE_A(PG8_SA(0, 0), cA, 0, 0); PG8_STAGE_A(PG8_SA(0, 1), cA, 1, 0);
        if (wr == 1) PG8_BAR;
        PG8_WAIT_V(2); PG8_BAR;
        PG8_STAGE(PG8_SB(1, 0), cB + kstep, voffB); PG8_STAGE_A(PG8_SA(1, 0), cA + kstep, 0, 0); PG8_STAGE(PG8_SB(1, 1), cB + hstepB + kstep, voffB);
        PG8_WAIT_V(6); PG8_BAR;
    } else {
        PG8_STAGE(PG8_SB(0, 0), cB, voffB); PG8_STAGE(PG8_SA(0, 0), cA, voffA); PG8_STAGE(PG8_SB(0, 1), cB + hstepB, voffB); PG8_STAGE(PG8_SA(0, 1), cA + hstepA, voffA);
        if (wr == 1) PG8_BAR;
        PG8_WAIT_V(4); PG8_BAR;
        PG8_STAGE(PG8_SB(1, 0), cB + kstep, voffB); PG8_STAGE(PG8_SA(1, 0), cA + kstep, voffA); PG8_STAGE(PG8_SB(1, 1), cB + hstepB + kstep, voffB);
        PG8_WAIT_V(6); PG8_BAR;
    }
    for (;;) {
        const bool has_next = S.next(ui + 1, nxt);
        const char* nA = has_next ? nxt.A : cA; const char* nB = has_next ? nxt.B : cB;
        if constexpr (GATHER) { if (has_next) PG8_GLIST(nxt, (ui + 1) & 1); }
#pragma unroll 1
        for (int t = 0; t < nt; t += 2) {
            const bool last = (t == nt - 2);
            const char* a1 = cA + (size_t)(t + 1) * kstep;
            const char* a2 = last ? nA : cA + (size_t)(t + 2) * kstep; const char* b2 = last ? nB : cB + (size_t)(t + 2) * kstep;
            const char* a3 = a2 + kstep; const char* b3 = b2 + kstep;
            if constexpr (SP2) {
            if constexpr (GATHER) { last_g = last && has_next; nxp_ = (ui + 1) & 1; }
            PG8_LDB(B0, 0, 0); PG8_LDB(B1, 0, 1); PG8_SCHED; PG8_LDA(At, 0, 0); PG8_STAGE_A(PG8_SA(1, 1), a1, 1, 0);
            PG8_WAIT_V(8); PG8_WAIT_L(0); PG8_BAR; PG8_MMA(0, 0, At, B0); PG8_MMA(0, 1, At, B1); PG8_BAR; PG8_SCHED;
            PG8_LDA(At, 0, 1); PG8_STAGE(PG8_SB(0, 0), b2, voffB); PG8_STAGE(PG8_SB(0, 1), b2 + hstepB, voffB); PG8_STAGE_A(PG8_SA(0, 0), a2, 0, 1);
            PG8_WAIT_V(8); PG8_WAIT_L(0); PG8_BAR; PG8_MMA(1, 0, At, B0); PG8_MMA(1, 1, At, B1); PG8_BAR; PG8_SCHED;
            PG8_LDB(B0, 1, 0); PG8_LDB(B1, 1, 1); PG8_SCHED; PG8_LDA(At, 1, 0); PG8_STAGE_A(PG8_SA(0, 1), a2, 1, 1);
            PG8_WAIT_V(8); PG8_WAIT_L(0); PG8_BAR; PG8_MMA(0, 0, At, B0); PG8_MMA(0, 1, At, B1); PG8_BAR; PG8_SCHED;
            PG8_LDA(At, 1, 1); PG8_STAGE(PG8_SB(1, 0), b3, voffB); PG8_STAGE(PG8_SB(1, 1), b3 + hstepB, voffB); PG8_STAGE_A(PG8_SA(1, 0), a3, 0, 1);
            PG8_WAIT_V(8); PG8_WAIT_L(0); PG8_BAR; PG8_MMA(1, 0, At, B0); PG8_MMA(1, 1, At, B1); PG8_BAR; PG8_SCHED;
            } else {
            PG8_LDB(B0, 0, 0); PG8_SCHED; PG8_LDA(At, 0, 0); PG8_STAGE(PG8_SA(1, 1), a1 + hstepA, voffA);
            PG8_WAIT_L(8); PG8_BAR; PG8_WAIT_L(0); PG8_MMA(0, 0, At, B0); PG8_BAR; PG8_SCHED;
            PG8_LDB(B1, 0, 1); PG8_STAGE(PG8_SB(0, 0), b2, voffB);
            PG8_BAR; PG8_WAIT_L(0); PG8_MMA(0, 1, At, B1); PG8_BAR;
            PG8_LDA(At, 0, 1); PG8_STAGE(PG8_SA(0, 0), a2, voffA);
            PG8_BAR; PG8_WAIT_L(0); PG8_MMA(1, 0, At, B0); PG8_BAR; PG8_SCHED;
            PG8_STAGE(PG8_SB(0, 1), b2 + hstepB, voffB);
            PG8_WAIT_V(6); PG8_BAR; PG8_MMA(1, 1, At, B1); PG8_BAR;
            PG8_LDB(B0, 1, 0); PG8_SCHED; PG8_LDA(At, 1, 0); PG8_STAGE(PG8_SA(0, 1), a2 + hstepA, voffA);
            PG8_WAIT_L(8); PG8_BAR; PG8_WAIT_L(0); PG8_MMA(0, 0, At, B0); PG8_BAR; PG8_SCHED;
            PG8_LDB(B1, 1, 1); PG8_STAGE(PG8_SB(1, 0), b3, voffB);
            PG8_BAR; PG8_WAIT_L(0); PG8_MMA(0, 1, At, B1); PG8_BAR;
            PG8_LDA(At, 1, 1); PG8_STAGE(PG8_SA(1, 0), a3, voffA);
            PG8_BAR; PG8_WAIT_L(0); PG8_MMA(1, 0, At, B0); PG8_BAR; PG8_SCHED;
            PG8_STAGE(PG8_SB(1, 1), b3 + hstepB, voffB);
            PG8_WAIT_V(6); PG8_BAR; PG8_MMA(1, 1, At, B1); PG8_BAR;
            }
        }
        if constexpr (ALIGN_EPI) { if (wr == 0) PG8_BAR; }
        E(acc, cur, wr, wc, fr, fq);
        if (!has_next) break;
#pragma unroll
        for (int a = 0; a < 2; ++a)
#pragma unroll
            for (int b = 0; b < 2; ++b)
#pragma unroll
                for (int m = 0; m < 4; ++m)
#pragma unroll
                    for (int n = 0; n < 2; ++n) acc[a][b][m][n] = (f32x4){zq, zq, zq, zq};
        cur = nxt; cA = nA; cB = nB; ++ui;
        if constexpr (GATHER) PG8_GOFF(ui & 1, vgc);
        if constexpr (ALIGN_EPI) { if (wr == 1) PG8_BAR; }
    }
    PG8_WAIT_V(0);
    if constexpr (!ALIGN_EPI) { if (wr == 0) PG8_BAR; }
    PG8_BAR;
#undef PG8_GOFF
#undef PG8_GLIST
#undef PG8_STAGE_A
#undef PG8_SA
#undef PG8_SB
#undef PG8_STAGE
#undef PG8_LDA
#undef PG8_LDB
#undef PG8_MMA
#undef PG8_WAIT_V
#undef PG8_WAIT_L
#undef PG8_BAR
#undef PG8_SCHED
}
}

constexpr int NB = 2, T = 8192, D = 1024, M = NB * T, NL = 4;
constexpr int DIN = 7592, NP = 8192;
constexpr int PC_QLAT = 0, PC_CKV = 1024, PC_KIDX = 1152, PC_WIDX = 1184, PC_QIDX = 1280, PC_CU = 1536, PC_GB = 2048, PC_GC = 2560, PC_SU = 3072, PC_MQ = 3584, PC_GATE = 4096;
constexpr int SC_Q = 0, SC_CKV = 512, SC_QIDX = 640, SC_KIDX = 896, SC_WIDX = 928, SC_CU = 936, SC_GB = 1448, SC_GC = 1960, SC_SU = 2472, SC_MQ = 2984, SC_GATE = 3496;
constexpr float QS_H = 127.f / 5.f, QS_WUP = 127.f / (4.5f * 0.03125f), QS_ACT = 127.f / 12.f, QS_WDN = 127.f / (4.5f * 0.013139006f), QS_WIN = 127.f / (4.5f * 0.03125f), QS_WQL = 8.f * QS_WIN;
constexpr int NE = 32, FE = 1024, MAXBLK = 288, MOE_ROWS = MAXBLK * 256;
constexpr int SSM_LC = 32, SSM_NC = T / SSM_LC, SSM_K = SSM_LC * 16 + 128;
constexpr float LN_EPS = 1e-5f;
constexpr float DN_ALPHA = 1.681792830507429f;

constexpr size_t MiB = 1u << 20;
constexpr size_t WS_CTL = 0, CTL_ZERO_BYTES = 1 * MiB;
constexpr size_t WS_WIN = 1 * MiB;
constexpr size_t WS_WGLU = WS_WIN + (size_t)NL * NP * D * 2;
constexpr size_t WS_WMKV = WS_WGLU + (size_t)NL * 512 * 512 * 2;
constexpr size_t WS_WUV = WS_WMKV + (size_t)NL * 1024 * 1024 * 2;
constexpr size_t WS_WBR = WS_WUV + (size_t)NL * 512 * 1024 * 2;
constexpr size_t WS_WO = WS_WBR + (size_t)NL * 4 * 1024 * 512 * 2;
constexpr size_t WS_WUP = WS_WO + (size_t)NL * 1024 * 1024 * 2;
constexpr size_t WS_WDN = WS_WUP + (size_t)NL * NE * 2048 * 1024 * 2;
constexpr size_t WS_S5A = WS_WDN + (size_t)NL * NE * 1024 * 1024 * 2;
constexpr size_t WS_S5B = WS_S5A + 1 * MiB;
constexpr size_t WS_MEMB = WS_S5B + 1 * MiB;
constexpr size_t WS_MKV = WS_MEMB + 1 * MiB;
constexpr size_t WS_H = WS_MKV + 4 * MiB;
constexpr size_t WS_HB = WS_H + (size_t)M * D * 4;
constexpr size_t WS_PROJ = WS_HB + (size_t)M * D * 2;
constexpr size_t WS_KVN = WS_PROJ + (size_t)M * NP * 2;
constexpr size_t WS_OLAT = WS_KVN + (size_t)M * 128 * 2;
constexpr size_t WS_BR = WS_OLAT + (size_t)M * 1024 * 2;
constexpr size_t WS_Z = WS_BR + (size_t)M * 2048 * 2;
constexpr size_t WS_MRG = WS_Z + (size_t)M * 512 * 2;
constexpr size_t WS_MRGB = WS_MRG + (size_t)M * D * 4;
constexpr size_t WS_V = WS_MRGB + (size_t)M * D * 2;
constexpr size_t WS_H1 = WS_V + (size_t)M * D * 4;
constexpr size_t WS_H1B = WS_H1 + (size_t)M * D * 4;
constexpr size_t WS_SSE = WS_H1B + (size_t)M * D * 2;
constexpr size_t WS_SSC = WS_SSE + (size_t)NB * SSM_NC * 32 * 64 * 8;
constexpr size_t WS_TOK = WS_SSC + (size_t)NB * SSM_NC * 32 * 64 * 8;
constexpr size_t WS_GATE = WS_TOK + (size_t)NE * M * 4;
constexpr size_t WS_SLOT = WS_GATE + (size_t)NE * M * 4;
constexpr size_t WS_XS = WS_SLOT + (size_t)M * 4 * 4;
constexpr size_t WS_ACT = WS_XS + (size_t)MOE_ROWS * 1024 * 2;
constexpr size_t WS_SCR = WS_ACT + (size_t)MOE_ROWS * 1024 * 2;
constexpr size_t WS_KIDX = WS_SCR + (size_t)256 * 2 * 8 * 8192 * 4;
constexpr size_t WS_WSSM = WS_KIDX + (size_t)M * 32 * 2;
constexpr size_t WS_AEXT = WS_WSSM + (size_t)NL * 32 * 512 * SSM_K * 2;
constexpr size_t WS_WE = WS_AEXT + (size_t)32 * 512 * SSM_K * 2;
constexpr size_t WS_END = WS_WE + (size_t)NL * 32 * 256 * 512 * 2;
constexpr int CW_TMO = 0, CW_BAR = 4096, CW_CNT = 16384, CW_Q0 = 2048;

constexpr int RING_BYTES = 131072, LDSCTL_OFF = RING_BYTES, MISC_OFF = LDSCTL_OFF + 320, LDS_BYTES = 147456;
constexpr int NWAVES = 8;

#define RLX_AGENT __ATOMIC_RELAXED, __HIP_MEMORY_SCOPE_AGENT
#define LDS_WAIT() asm volatile("s_waitcnt lgkmcnt(0)" ::: "memory")
#define VM_WAIT() asm volatile("s_waitcnt vmcnt(0)" ::: "memory")
__device__ __forceinline__ unsigned f2bf(float f) { unsigned u = __builtin_bit_cast(unsigned, f); return (u + 0x7fffu + ((u >> 16) & 1u)) >> 16; }
__device__ __forceinline__ unsigned pk2(float lo, float hi) { return f2bf(lo) | (f2bf(hi) << 16); }
__device__ __forceinline__ float bflo(unsigned w) { return __builtin_bit_cast(float, w << 16); }
__device__ __forceinline__ float bfhi(unsigned w) { return __builtin_bit_cast(float, w & 0xffff0000u); }
__device__ __forceinline__ float bf1(bf16 v) { return __builtin_bit_cast(float, (unsigned)v << 16); }
__device__ __forceinline__ unsigned q8_(float x, float s) { return (unsigned)(int)__builtin_rintf(fminf(fmaxf(x * s, -127.f), 127.f)) & 255u; }
__device__ __forceinline__ unsigned q8x4(float a, float b, float c, float d, float s) { return q8_(a, s) | (q8_(b, s) << 8) | (q8_(c, s) << 16) | (q8_(d, s) << 24); }
__device__ __forceinline__ float sigmoidf_(float x) { return __builtin_amdgcn_rcpf(1.f + __expf(-x)); }
__device__ __forceinline__ int lane_op() { int l = (int)__builtin_amdgcn_mbcnt_hi(~0u, __builtin_amdgcn_mbcnt_lo(~0u, 0u)); asm volatile("" : "+v"(l)); return l; }
template <class Tv> __device__ __forceinline__ Tv bperm_(int srcLane, Tv v) { return __builtin_bit_cast(Tv, __builtin_amdgcn_ds_bpermute(srcLane << 2, __builtin_bit_cast(int, v))); }
#define SHX(v, m, l) bperm_((l) ^ (m), (v))
#define SHD(v, o, l) bperm_((l) + (o), (v))
#define SHI(v, s) bperm_((s), (v))
__device__ __forceinline__ float wave_sum(float v) { const int l = lane_op();
#pragma unroll
    for (int o = 1; o < 64; o <<= 1) v += SHX(v, o, l);
    return v;
}
__device__ __forceinline__ float wave_max(float v) { const int l = lane_op();
#pragma unroll
    for (int o = 1; o < 64; o <<= 1) v = fmaxf(v, SHX(v, o, l));
    return v;
}

#define XB_TMO      128
#define XB_XCNT(j)  (256  + 64 * (j))
#define XB_XSUB(j)  (1280 + 64 * (j))
#define XB_XGEN(j)  (2304 + 64 * (j))
#define XB_TOP      3328
#define XB_TOPGEN   3392
#define XCD_BAR_WORDS 3456
#define XB_SPIN_CAP (1u << 18)
__device__ __forceinline__ unsigned xb_ld(unsigned* p)              { return __hip_atomic_load(p, __ATOMIC_RELAXED, __HIP_MEMORY_SCOPE_AGENT); }
__device__ __forceinline__ unsigned xb_add(unsigned* p, unsigned v) { return __hip_atomic_fetch_add(p, v, __ATOMIC_RELAXED, __HIP_MEMORY_SCOPE_AGENT); }
__device__ __forceinline__ unsigned xb_xcc_id() { return (unsigned)__builtin_amdgcn_s_getreg((3 << 11) | 20) & 0xFu; }
#define XB_SPIN(cond, bar) do { unsigned _sp = 0; while (cond) { __builtin_amdgcn_s_sleep(1); \
    if ((++_sp & 255u) == 0u) { if (xb_ld(&(bar)[XB_TMO])) break; if (_sp > XB_SPIN_CAP) { atomicAdd(&(bar)[XB_TMO], 1u); break; } } } } while (0)
struct XcdBarrier { unsigned* bar; unsigned x; volatile LAS unsigned* st; };
__device__ __forceinline__ XcdBarrier xcd_barrier_post(unsigned* bar, volatile LAS unsigned* st) {
    XcdBarrier b; b.bar = bar; b.x = xb_xcc_id(); b.st = st;
    if (threadIdx.x == 0) st[2] = xb_add(&bar[XB_XCNT(b.x)], 1u);
    return b;
}
__device__ __forceinline__ void xcd_barrier_complete(unsigned* bar, unsigned x, unsigned& nloc, unsigned& nx, unsigned& balanced) {
    const unsigned G = gridDim.x * gridDim.y * gridDim.z;
    unsigned sum, cnt, mine, sp = 0u, bal;
    for (;;) {
        sum = 0u; cnt = 0u; mine = 0u; bal = 1u;
#pragma unroll 1
        for (unsigned j = 0; j < 16; ++j) { const unsigned c = xb_ld(&bar[XB_XCNT(j)]); sum += c; cnt += (c > 0u) ? 1u : 0u; mine = (j == x) ? c : mine; bal = (c == (j < 8u ? (G >> 3) : 0u)) ? bal : 0u; }
        if (sum == G) break;
        __builtin_amdgcn_s_sleep(1);
        if ((++sp & 255u) == 0u) { if (xb_ld(&bar[XB_TMO])) break; if (sp > XB_SPIN_CAP) { atomicAdd(&bar[XB_TMO], 1u); break; } }
    }
    nloc = mine > 0u ? mine : 1u; nx = cnt > 0u ? cnt : 1u; balanced = ((G & 7u) == 0u && sum == G) ? bal : 0u;
}
__device__ __forceinline__ void xcd_barrier(const XcdBarrier& b, int tid_) {
    asm volatile("s_waitcnt vmcnt(0)" ::: "memory");
    __syncthreads();
    if (tid_ == 0) {
        unsigned* bar = b.bar;
        __builtin_amdgcn_s_waitcnt(0);
        unsigned nloc = b.st[0], nx = b.st[1];
        if (nloc == 0u) { unsigned bal_; xcd_barrier_complete(bar, b.x, nloc, nx, bal_); b.st[0] = nloc; b.st[1] = nx;
            b.st[3] = (bal_ ? b.st[2] * 8u + b.x : (unsigned)blockIdx.x) + 1u; }
        const unsigned old = xb_add(&bar[XB_XSUB(b.x)], 1u);
        const unsigned gen = old / nloc;
        if (old + 1u == (gen + 1u) * nloc) {
            __builtin_amdgcn_fence(__ATOMIC_RELEASE, "agent");
            asm volatile("s_waitcnt vmcnt(0)" ::: "memory");
            const unsigned og = xb_add(&bar[XB_TOP], 1u);
            const unsigned tg = og / nx;
            if (og + 1u == (tg + 1u) * nx) xb_add(&bar[XB_TOPGEN], 1u);
            else XB_SPIN(xb_ld(&bar[XB_TOPGEN]) == tg, bar);
            __builtin_amdgcn_fence(__ATOMIC_ACQUIRE, "agent");
            xb_add(&bar[XB_XGEN(b.x)], 1u);
            asm volatile("s_waitcnt vmcnt(0)" ::: "memory");
        } else {
            XB_SPIN(xb_ld(&bar[XB_XGEN(b.x)]) == gen, bar);
            __builtin_amdgcn_fence(__ATOMIC_ACQUIRE, "agent");
            asm volatile("s_waitcnt vmcnt(0)" ::: "memory");
        }
    }
    __syncthreads();
}

__device__ __forceinline__ unsigned long long ldp(volatile LAS unsigned long long* PT, int k) { const unsigned long long v = PT[k];
    const unsigned lo = __builtin_amdgcn_readfirstlane((unsigned)v), hi = __builtin_amdgcn_readfirstlane((unsigned)(v >> 32)); return ((unsigned long long)hi << 32) | lo; }
typedef __attribute__((address_space(1))) unsigned char gu8_t;
__device__ __forceinline__ unsigned char* gptr(unsigned long long v) { return (unsigned char*)(gu8_t*)v; }
struct Args { const float* in[33]; float* out; unsigned char* ws; int ph_lo, ph_hi; };

struct Frame {
    LAS unsigned char* lds;
    int tid, lane, wave, G, gw, NGW, bx;
};

using pg8::Unit; using pg8::cvt_pk_bf16; using pg8::v4i_t;
struct EpiBf16 {
    static constexpr bool PERM = true;
    bf16* O; int ldc;
    __device__ __forceinline__ void operator()(const f32x4 (&acc)[2][2][4][2], const Unit& u, int wr, int wc, int fr, int fq) const {
        const int row0 = u.pm * 256 + wr * 64 + fr, col0 = u.pn * 256 + wc * 32 + 8 * fq;
#pragma unroll
        for (int ai = 0; ai < 2; ++ai)
#pragma unroll
            for (int m = 0; m < 4; ++m) { bf16* rowp = O + (size_t)(row0 + ai * 128 + m * 16) * ldc + col0;
#pragma unroll
                for (int bj = 0; bj < 2; ++bj) { const f32x4 v0 = acc[ai][bj][m][0], v1 = acc[ai][bj][m][1];
                    v4u w; w.x = cvt_pk_bf16(v0[0], v0[1]); w.y = cvt_pk_bf16(v0[2], v0[3]); w.z = cvt_pk_bf16(v1[0], v1[1]); w.w = cvt_pk_bf16(v1[2], v1[3]);
                    *(v4u*)(rowp + bj * 128) = w; } }
    }
};
struct EpiProjQ {
    static constexpr bool PERM = true;
    bf16* O; int ldc; bf16* AX;
    __device__ __forceinline__ void operator()(const f32x4 (&acc)[2][2][4][2], const Unit& u, int wr, int wc, int fr, int fq) const {
        const int row0 = u.pm * 256 + wr * 64 + fr, col0 = u.pn * 256 + wc * 32 + 8 * fq; const float dq = 1.f / (QS_H * (u.pn < 4 ? QS_WQL : QS_WIN));
#pragma unroll
        for (int ai = 0; ai < 2; ++ai)
#pragma unroll
            for (int m = 0; m < 4; ++m) { bf16* rowp = O + (size_t)(row0 + ai * 128 + m * 16) * ldc + col0;
#pragma unroll
                for (int bj = 0; bj < 2; ++bj) { const v4i_t i0 = __builtin_bit_cast(v4i_t, acc[ai][bj][m][0]), i1 = __builtin_bit_cast(v4i_t, acc[ai][bj][m][1]);
                    v4u w; w.x = cvt_pk_bf16((float)i0[0] * dq, (float)i0[1] * dq); w.y = cvt_pk_bf16((float)i0[2] * dq, (float)i0[3] * dq); w.z = cvt_pk_bf16((float)i1[0] * dq, (float)i1[1] * dq); w.w = cvt_pk_bf16((float)i1[2] * dq, (float)i1[3] * dq);
                    if (u.pn == 12 || u.pn == 13) { const int m_ = row0 + ai * 128 + m * 16, ch = (u.pn - 12) * 256 + wc * 32 + 8 * fq + bj * 128, tl = m_ & (T - 1);
                        *(v4u*)(AX + ((size_t)((ch >> 4) * 512 + (m_ >> 13) * 256 + (tl >> 5))) * SSM_K + (tl & 31) * 16 + (ch & 15)) = w; }
                    else *(v4u*)(rowp + bj * 128) = w; } }
    }
};
struct EpiE {
    static constexpr bool PERM = true;
    float* E2;
    __device__ __forceinline__ void operator()(const f32x4 (&acc)[2][2][4][2], const Unit& u, int wr, int wc, int fr, int fq) const {
        const int row0 = u.pm * 256 + wr * 64 + fr, col0 = wc * 32 + 8 * fq;
#pragma unroll
        for (int ai = 0; ai < 2; ++ai)
#pragma unroll
            for (int m = 0; m < 4; ++m) { float* p = E2 + ((size_t)(row0 + ai * 128 + m * 16) * 32 + u.z) * 128 + col0; *(f32x4*)p = acc[ai][0][m][0]; *(f32x4*)(p + 4) = acc[ai][0][m][1]; }
    }
};
struct EOrder {
    int G, c; const char* A; const char* B;
    __device__ __forceinline__ bool next(int i, Unit& u) const {
        const int Lx = i * G + c; if (Lx >= 64) return false;
        const int g = Lx >> 1, pm = Lx & 1; u.pm = pm; u.pn = 0; u.z = g; u.A = A + ((size_t)g * 512 + pm * 256) * SSM_K * 2; u.B = B + (size_t)g * 256 * 512 * 2; return true;
    }
};
struct EpiMkv {
    static constexpr bool PERM = true;
    bf16* O;
    __device__ __forceinline__ void operator()(const f32x4 (&acc)[2][2][4][2], const Unit& u, int wr, int wc, int fr, int fq) const {
        EpiBf16 e{O + (size_t)u.z * 512 * 1024, 1024}; e(acc, u, wr, wc, fr, fq);
    }
};
struct EpiGlu {
    static constexpr bool PERM = true;
    const bf16* Z; int ldz; const float* bias; bf16* O; int ldo;
    __device__ __forceinline__ void operator()(const f32x4 (&acc)[2][2][4][2], const Unit& u, int wr, int wc, int fr, int fq) const {
        const int row0 = u.pm * 256 + wr * 64 + fr, col0 = u.pn * 256 + wc * 32 + 8 * fq;
        f32x4 bv[2][2];
#pragma unroll
        for (int bj = 0; bj < 2; ++bj)
#pragma unroll
            for (int n = 0; n < 2; ++n) bv[bj][n] = *(const f32x4*)(bias + col0 + bj * 128 + 4 * n);
#pragma unroll
        for (int ai = 0; ai < 2; ++ai) { v4u zq[4][2];
#pragma unroll
            for (int m = 0; m < 4; ++m)
#pragma unroll
                for (int bj = 0; bj < 2; ++bj) zq[m][bj] = *(const v4u*)(Z + (size_t)(row0 + ai * 128 + m * 16) * ldz + col0 + bj * 128);
#pragma unroll
            for (int m = 0; m < 4; ++m) { const size_t r = (size_t)(row0 + ai * 128 + m * 16);
#pragma unroll
                for (int bj = 0; bj < 2; ++bj) { const f32x4 v0 = acc[ai][bj][m][0] + bv[bj][0], v1 = acc[ai][bj][m][1] + bv[bj][1];
                    const v4u zz = zq[m][bj];
                    v4u w;
                    w.x = cvt_pk_bf16(bflo(zz.x) * sigmoidf_(v0[0]), bfhi(zz.x) * sigmoidf_(v0[1]));
                    w.y = cvt_pk_bf16(bflo(zz.y) * sigmoidf_(v0[2]), bfhi(zz.y) * sigmoidf_(v0[3]));
                    w.z = cvt_pk_bf16(bflo(zz.z) * sigmoidf_(v1[0]), bfhi(zz.z) * sigmoidf_(v1[1]));
                    w.w = cvt_pk_bf16(bflo(zz.w) * sigmoidf_(v1[2]), bfhi(zz.w) * sigmoidf_(v1[3]));
                    *(v4u*)(O + r * ldo + col0 + bj * 128) = w; } } }
    }
};
struct EpiMerge {
    static constexpr bool PERM = true;
    const bf16* G; int ldg; bf16* Mb;
    __device__ __forceinline__ void operator()(const f32x4 (&acc)[2][2][4][2], const Unit& u, int wr, int wc, int fr, int fq) const {
        const int row0 = u.pm * 256 + wr * 64 + fr, col0 = u.pn * 256 + wc * 32 + 8 * fq; const int r = u.z;
#pragma unroll
        for (int ai = 0; ai < 2; ++ai) { v4u gq[4][2], pq[4][2];
#pragma unroll
            for (int m = 0; m < 4; ++m) { const size_t rr = (size_t)(row0 + ai * 128 + m * 16);
#pragma unroll
                for (int bj = 0; bj < 2; ++bj) { const int c = col0 + bj * 128; gq[m][bj] = *(const v4u*)(G + rr * ldg + r * 1024 + c); pq[m][bj] = (v4u){0u, 0u, 0u, 0u}; if (r) pq[m][bj] = *(const v4u*)(Mb + rr * 1024 + c); } }
#pragma unroll
            for (int m = 0; m < 4; ++m) { const size_t rr = (size_t)(row0 + ai * 128 + m * 16);
#pragma unroll
                for (int bj = 0; bj < 2; ++bj) { const int c = col0 + bj * 128;
                    const v4u gg = gq[m][bj], pv = pq[m][bj]; bf16* mp = Mb + rr * 1024 + c;
                    f32x4 o0 = (f32x4){bflo(pv.x), bfhi(pv.x), bflo(pv.y), bfhi(pv.y)}, o1 = (f32x4){bflo(pv.z), bfhi(pv.z), bflo(pv.w), bfhi(pv.w)};
                    const f32x4 v0 = acc[ai][bj][m][0], v1 = acc[ai][bj][m][1];
                    o0[0] += sigmoidf_(bflo(gg.x)) * v0[0]; o0[1] += sigmoidf_(bfhi(gg.x)) * v0[1]; o0[2] += sigmoidf_(bflo(gg.y)) * v0[2]; o0[3] += sigmoidf_(bfhi(gg.y)) * v0[3];
                    o1[0] += sigmoidf_(bflo(gg.z)) * v1[0]; o1[1] += sigmoidf_(bfhi(gg.z)) * v1[1]; o1[2] += sigmoidf_(bflo(gg.w)) * v1[2]; o1[3] += sigmoidf_(bfhi(gg.w)) * v1[3];
                    v4u w; w.x = cvt_pk_bf16(o0[0], o0[1]); w.y = cvt_pk_bf16(o0[2], o0[3]); w.z = cvt_pk_bf16(o1[0], o1[1]); w.w = cvt_pk_bf16(o1[2], o1[3]); *(v4u*)mp = w; } } }
    }
};
struct EpiWo {
    static constexpr bool PERM = true;
    const bf16* H; bf16* V;
    __device__ __forceinline__ void operator()(const f32x4 (&acc)[2][2][4][2], const Unit& u, int wr, int wc, int fr, int fq) const {
        const int row0 = u.pm * 256 + wr * 64 + fr, col0 = u.pn * 256 + wc * 32 + 8 * fq;
#pragma unroll
        for (int ai = 0; ai < 2; ++ai) { v4u hq[4][2];
#pragma unroll
            for (int m = 0; m < 4; ++m)
#pragma unroll
                for (int bj = 0; bj < 2; ++bj) hq[m][bj] = *(const v4u*)(H + (size_t)(row0 + ai * 128 + m * 16) * 1024 + col0 + bj * 128);
#pragma unroll
            for (int m = 0; m < 4; ++m) { const size_t off = (size_t)(row0 + ai * 128 + m * 16) * 1024 + col0;
#pragma unroll
                for (int bj = 0; bj < 2; ++bj) { const v4u hh = hq[m][bj]; const f32x4 v0 = acc[ai][bj][m][0], v1 = acc[ai][bj][m][1];
                    v4u w; w.x = cvt_pk_bf16(bflo(hh.x) * DN_ALPHA + v0[0], bfhi(hh.x) * DN_ALPHA + v0[1]); w.y = cvt_pk_bf16(bflo(hh.y) * DN_ALPHA + v0[2], bfhi(hh.y) * DN_ALPHA + v0[3]);
                    w.z = cvt_pk_bf16(bflo(hh.z) * DN_ALPHA + v1[0], bfhi(hh.z) * DN_ALPHA + v1[1]); w.w = cvt_pk_bf16(bflo(hh.w) * DN_ALPHA + v1[2], bfhi(hh.w) * DN_ALPHA + v1[3]);
                    *(v4u*)(V + off + bj * 128) = w; } } }
    }
};
struct EpiUp {
    static constexpr bool PERM = true;
    const float* bup; unsigned char* ACT;
    __device__ __forceinline__ void operator()(const f32x4 (&acc)[2][2][4][2], const Unit& u, int wr, int wc, int fr, int fq) const {
        const int row0 = u.pm * 256 + wr * 64 + fr, col0 = u.pn * 256 + wc * 32 + 8 * fq; const float* bb = bup + (size_t)u.z * 2048; const float dq = 1.f / (QS_H * QS_WUP);
        f32x4 bv[2][2];
#pragma unroll
        for (int bj = 0; bj < 2; ++bj)
#pragma unroll
            for (int n = 0; n < 2; ++n) bv[bj][n] = *(const f32x4*)(bb + col0 + bj * 128 + 4 * n);
#pragma unroll
        for (int ai = 0; ai < 2; ++ai)
#pragma unroll
            for (int m = 0; m < 4; ++m) { const size_t r = (size_t)(row0 + ai * 128 + m * 16);
#pragma unroll
                for (int bj = 0; bj < 2; ++bj) { const v4i_t i0 = __builtin_bit_cast(v4i_t, acc[ai][bj][m][0]), i1 = __builtin_bit_cast(v4i_t, acc[ai][bj][m][1]);
                    const f32x4 v0 = (f32x4){(float)i0[0], (float)i0[1], (float)i0[2], (float)i0[3]} * dq + bv[bj][0], v1 = (f32x4){(float)i1[0], (float)i1[1], (float)i1[2], (float)i1[3]} * dq + bv[bj][1];
                    float a[4];
#pragma unroll
                    for (int j = 0; j < 4; ++j) { const float gx = j < 2 ? v0[2 * j] : v1[2 * j - 4], lx = j < 2 ? v0[2 * j + 1] : v1[2 * j - 3];
                        const float gl = fminf(gx, 7.0f), li = fminf(fmaxf(lx, -7.0f), 7.0f); a[j] = gl * sigmoidf_(1.702f * gl) * (li + 1.0f); }
                    *(unsigned*)(ACT + r * 1024 + ((col0 + bj * 128) >> 1)) = q8x4(a[0], a[1], a[2], a[3], QS_ACT); } }
    }
};
struct EpiDown {
    static constexpr bool PERM = true;
    const float* bdn; const float* grow; bf16* YS;
    __device__ __forceinline__ void operator()(const f32x4 (&acc)[2][2][4][2], const Unit& u, int wr, int wc, int fr, int fq) const {
        const int row0 = u.pm * 256 + wr * 64 + fr, col0 = u.pn * 256 + wc * 32 + 8 * fq; const float* bb = bdn + (size_t)u.z * 1024; const float dq = 1.f / (QS_ACT * QS_WDN);
        f32x4 bv[2][2];
#pragma unroll
        for (int bj = 0; bj < 2; ++bj)
#pragma unroll
            for (int n = 0; n < 2; ++n) bv[bj][n] = *(const f32x4*)(bb + col0 + bj * 128 + 4 * n);
        float gq[2][4];
#pragma unroll
        for (int ai = 0; ai < 2; ++ai)
#pragma unroll
            for (int m = 0; m < 4; ++m) gq[ai][m] = grow[(size_t)(row0 + ai * 128 + m * 16)];
#pragma unroll
        for (int ai = 0; ai < 2; ++ai)
#pragma unroll
            for (int m = 0; m < 4; ++m) { const size_t r = (size_t)(row0 + ai * 128 + m * 16); const float gt = gq[ai][m];
#pragma unroll
                for (int bj = 0; bj < 2; ++bj) { const v4i_t i0 = __builtin_bit_cast(v4i_t, acc[ai][bj][m][0]), i1 = __builtin_bit_cast(v4i_t, acc[ai][bj][m][1]);
                    const f32x4 v0 = ((f32x4){(float)i0[0], (float)i0[1], (float)i0[2], (float)i0[3]} * dq + bv[bj][0]) * gt, v1 = ((f32x4){(float)i1[0], (float)i1[1], (float)i1[2], (float)i1[3]} * dq + bv[bj][1]) * gt;
                    v4u w; w.x = cvt_pk_bf16(v0[0], v0[1]); w.y = cvt_pk_bf16(v0[2], v0[3]); w.z = cvt_pk_bf16(v1[0], v1[1]); w.w = cvt_pk_bf16(v1[2], v1[3]);
                    *(v4u*)(YS + r * 1024 + col0 + bj * 128) = w; } }
    }
};
struct EpiSsm {
    static constexpr bool PERM = true;
    bf16* Z;
    __device__ __forceinline__ void operator()(const f32x4 (&acc)[2][2][4][2], const Unit& u, int wr, int wc, int fr, int fq) const {
        const int row0 = u.pm * 256 + wr * 64 + fr, col0 = u.pn * 256 + wc * 32 + 8 * fq;
#pragma unroll
        for (int ai = 0; ai < 2; ++ai)
#pragma unroll
            for (int m = 0; m < 4; ++m) { const int row = row0 + ai * 128 + m * 16; const size_t tokb = (size_t)(row >> 8) * T + (size_t)(row & 255) * SSM_LC;
#pragma unroll
                for (int bj = 0; bj < 2; ++bj) { const int col = col0 + bj * 128; const f32x4 v0 = acc[ai][bj][m][0], v1 = acc[ai][bj][m][1]; float z[8];
#pragma unroll
                    for (int j = 0; j < 8; ++j) { const float y = j < 4 ? v0[j] : v1[j - 4]; const float x3 = 0.7978845608028654f * (y + 0.044715f * y * y * y); const float th = 1.f - 2.f * __builtin_amdgcn_rcpf(__expf(2.f * x3) + 1.f); z[j] = 0.5f * y * (1.f + th); }
                    v4u w; w.x = cvt_pk_bf16(z[0], z[1]); w.y = cvt_pk_bf16(z[2], z[3]); w.z = cvt_pk_bf16(z[4], z[5]); w.w = cvt_pk_bf16(z[6], z[7]);
                    *(v4u*)(Z + (tokb + (col >> 4)) * 512 + u.z * 16 + (col & 15)) = w; } }
    }
};
struct SsmOrder {
    int G, c; const char* A; const char* B;
    __device__ __forceinline__ bool next(int i, Unit& u) const {
        const int Lx = i * G + c; if (Lx >= 128) return false;
        const int g = Lx >> 2, pm = (Lx >> 1) & 1, pn = Lx & 1; u.pm = pm; u.pn = pn; u.z = g;
        u.A = A + ((size_t)g * 512 + pm * 256) * SSM_K * 2; u.B = B + ((size_t)g * 512 + pn * 256) * SSM_K * 2; return true;
    }
};
struct MkvOrder {
    int G, c; const char* A; const char* B;
    __device__ __forceinline__ bool next(int i, Unit& u) const {
        const int Lx = i * G + c; if (Lx >= NL * 8) return false;
        const int l = Lx >> 3, pm = (Lx >> 2) & 1, pn = Lx & 3; u.pm = pm; u.pn = pn; u.z = l;
        u.A = A + (size_t)pm * 256 * 1024 * 2; u.B = B + ((size_t)l * 1024 + pn * 256) * 1024 * 2; return true;
    }
};
struct MergeOrder {
    int G, c; const char* A; const char* B;
    __device__ __forceinline__ bool next(int i, Unit& u) const {
        const long Lx = (long)(i >> 2) * G + c; if (Lx >= 64 * 4) return false;
        int pm, pn; pg8::tile_of((int)Lx, 64, 4, pm, pn); const int r = i & 3; u.pm = pm; u.pn = pn; u.z = r;
        u.A = A + ((size_t)pm * 256 * 2048 + r * 512) * 2; u.B = B + ((size_t)r * 1024 + pn * 256) * 512 * 2; return true;
    }
};
struct MoeOrder {
    int G, c, nN, nunits; const LAS int* blk0; const char* A; const char* B; size_t atile, bexp, btile;
    const int* tok; const LAS int* cnt;
    __device__ __forceinline__ void rowinfo(const pg8::Unit& u, const int*& tb, int& s0, int& ce) const { const int e = u.z; tb = tok + (size_t)e * M; s0 = (u.pm - blk0[e]) * 256; ce = cnt[e]; }
    __device__ __forceinline__ bool next(int i, Unit& u) const {
        const int c2 = (G & 7) ? c : (c & 7) * (G >> 3) + (c >> 3);
        const long Lx = (long)i * G + c2; if (Lx >= nunits) return false;
        const int j = (int)(Lx / nN), pn = (int)(Lx % nN); int e = 0;
#pragma unroll
        for (int k = 1; k < 32; ++k) e += (j >= blk0[k]) ? 1 : 0;
        u.pm = j; u.pn = pn; u.z = e; u.A = A + (size_t)j * atile; u.B = B + (size_t)e * bexp + (size_t)pn * btile; return true;
    }
};

template <int QMODE = 0>
__device__ __forceinline__ void tr_item64(const float* W, int ldw, int c0, int nc, int K, bf16* WT, int r0, LAS unsigned char* scr, int item, int lane) {
    const int nblk = (nc + 63) >> 6, kb = item / nblk, nb = item % nblk, k0 = 64 * kb, n0 = 64 * nb;
    const int nn = 4 * (lane & 15), g = lane >> 4; const bool okn = (n0 + nn) < nc;
    const float* wp = W + (size_t)(k0 + g) * ldw + c0 + n0 + nn;
    f32x4 vv[16];
#pragma unroll
    for (int i = 0; i < 16; ++i) { vv[i] = (f32x4){0.f, 0.f, 0.f, 0.f}; if (okn) vv[i] = __builtin_nontemporal_load((const f32x4*)(wp + (size_t)(4 * i) * ldw)); }
#pragma unroll
    for (int i = 0; i < 16; ++i) { v2u w2; w2.x = pk2(vv[i][0], vv[i][1]); w2.y = pk2(vv[i][2], vv[i][3]); *(LAS v2u*)(scr + (4 * i + g) * 136 + nn * 2) = w2; }
    LDS_WAIT(); asm volatile("" ::: "memory");
    const int i16 = lane & 15, q = i16 >> 2, p = i16 & 3;
#pragma unroll
    for (int s = 0; s < 8; ++s) { const int nbk = s & 3, kbk = 4 * (s >> 2) + g;
        const v4i16_t lo = __builtin_amdgcn_ds_read_tr16_b64_v4i16((LAS v4i16_t*)(scr + (8 * kbk + q) * 136 + 32 * nbk + 8 * p));
        const v4i16_t hi = __builtin_amdgcn_ds_read_tr16_b64_v4i16((LAS v4i16_t*)(scr + (8 * kbk + 4 + q) * 136 + 32 * nbk + 8 * p));
        const bf16x8 o = __builtin_shufflevector(lo, hi, 0, 1, 2, 3, 4, 5, 6, 7); const int n = 16 * nbk + i16;
        if (n0 + n < nc) {
            if constexpr (QMODE == 0) *(bf16x8*)(WT + (size_t)(r0 + n0 + n) * K + k0 + 8 * kbk) = o;
            else { const v4u ou = __builtin_bit_cast(v4u, o); const float sc_ = QMODE == 1 ? QS_WUP : (QMODE == 2 ? QS_WDN : QS_WIN);
                *(v2u*)((unsigned char*)WT + (size_t)(r0 + n0 + n) * K + k0 + 8 * kbk) = (v2u){q8x4(bflo(ou.x), bfhi(ou.x), bflo(ou.y), bfhi(ou.y), sc_), q8x4(bflo(ou.z), bfhi(ou.z), bflo(ou.w), bfhi(ou.w), sc_)}; } } }
    LDS_WAIT(); asm volatile("" ::: "memory");
}
__device__ __forceinline__ void ln_rows(f32x4 (&v)[4], const float* g, const float* b, int lane) {
    float s = 0.f;
#pragma unroll
    for (int j = 0; j < 4; ++j) s += (v[j][0] + v[j][1]) + (v[j][2] + v[j][3]);
    const float mean = wave_sum(s) * (1.f / D); float s2 = 0.f;
#pragma unroll
    for (int j = 0; j < 4; ++j) { v[j] = v[j] - mean; s2 += (v[j][0] * v[j][0] + v[j][1] * v[j][1]) + (v[j][2] * v[j][2] + v[j][3] * v[j][3]); }
    const float rstd = 1.f / sqrtf(wave_sum(s2) * (1.f / D) + LN_EPS);
#pragma unroll
    for (int j = 0; j < 4; ++j) { const f32x4 gg = *(const f32x4*)(g + 4 * lane + 256 * j), bb = *(const f32x4*)(b + 4 * lane + 256 * j); v[j] = v[j] * rstd * gg + bb; }
}
struct LnAff { f32x4 g[4], b[4]; };
__device__ __forceinline__ LnAff ln_aff(const float* g, const float* b, int lane) { LnAff a;
#pragma unroll
    for (int j = 0; j < 4; ++j) { a.g[j] = *(const f32x4*)(g + 4 * lane + 256 * j); a.b[j] = *(const f32x4*)(b + 4 * lane + 256 * j); }
    return a; }
__device__ __forceinline__ void ln_rows_pre(f32x4 (&v)[4], const LnAff& a) {
    float s = 0.f;
#pragma unroll
    for (int j = 0; j < 4; ++j) s += (v[j][0] + v[j][1]) + (v[j][2] + v[j][3]);
    const float mean = wave_sum(s) * (1.f / D); float s2 = 0.f;
#pragma unroll
    for (int j = 0; j < 4; ++j) { v[j] = v[j] - mean; s2 += (v[j][0] * v[j][0] + v[j][1] * v[j][1]) + (v[j][2] * v[j][2] + v[j][3] * v[j][3]); }
    const float rstd = 1.f / sqrtf(wave_sum(s2) * (1.f / D) + LN_EPS);
#pragma unroll
    for (int j = 0; j < 4; ++j) v[j] = v[j] * rstd * a.g[j] + a.b[j];
}
__device__ __forceinline__ void store_row_f32_bf16(const f32x4 (&v)[4], float* of, bf16* ob, int lane) {
#pragma unroll
    for (int j = 0; j < 4; ++j) { if (of) *(f32x4*)(of + 4 * lane + 256 * j) = v[j];
        if (ob) { v2u w; w.x = pk2(v[j][0], v[j][1]); w.y = pk2(v[j][2], v[j][3]); *(v2u*)(ob + 4 * lane + 256 * j) = w; } }
}

typedef float f32x16 __attribute__((ext_vector_type(16)));
constexpr int DSA_LIST_OFF = LDSCTL_OFF + 2048, DSA_WCNT_OFF = DSA_LIST_OFF + 4096, DSA_SEL_OFF = DSA_WCNT_OFF + 256;
__device__ __forceinline__ unsigned mono_key(float x) { const unsigned u = __builtin_bit_cast(unsigned, x); return u ^ ((unsigned)((int)u >> 31) | 0x80000000u); }
__device__ __forceinline__ unsigned kv_off(unsigned row, unsigned ch) { return 256u * row + 16u * (ch ^ (((row & 3u) << 2) | ((row >> 2) & 3u))); }

#ifndef DUP_IDX
#define DUP_IDX 1
#endif
#ifndef DUP_SEL
#define DUP_SEL 1
#endif
#ifndef DUP_ATT
#define DUP_ATT 1
#endif
template <int LEVEL>
__device__ __forceinline__ void dsa2_level(LAS unsigned* hist, const unsigned (&kk)[128], int nreg, int lane, unsigned& prefix, unsigned& need) {
    constexpr int NBIN = LEVEL == 2 ? 1024 : 2048; constexpr int PB = NBIN / 64;
#pragma unroll
    for (int i = 0; i < PB / 4; ++i) *(LAS v4u*)(hist + lane * PB + 4 * i) = (v4u){0u, 0u, 0u, 0u};
    LDS_WAIT();
#pragma unroll
    for (int i = 0; i < 128; ++i) { if ((i & ~15) < nreg) { const unsigned k = kk[i]; bool part; unsigned bin;
            if (LEVEL == 0) { part = k != 0u; bin = k >> 21; }
            else if (LEVEL == 1) { part = (k != 0u) && ((k >> 21) == prefix); bin = (k >> 10) & 0x7FFu; }
            else { part = (k != 0u) && ((k >> 10) == prefix); bin = k & 0x3FFu; }
            if (part) (void)__hip_atomic_fetch_add(&hist[bin], 1u, __ATOMIC_RELAXED, __HIP_MEMORY_SCOPE_WORKGROUP); }
        if ((i & 7) == 7) __builtin_amdgcn_sched_barrier(0); }
    LDS_WAIT();
    unsigned hv[PB]; unsigned mine = 0u;
#pragma unroll
    for (int i = 0; i < PB / 4; ++i) { const v4u v = *(const LAS v4u*)(hist + lane * PB + 4 * i); hv[4 * i] = v.x; hv[4 * i + 1] = v.y; hv[4 * i + 2] = v.z; hv[4 * i + 3] = v.w; mine += (v.x + v.y) + (v.z + v.w); }
    unsigned incl = mine;
    const int lop779_ = lane_op();
#pragma unroll
    for (int o = 1; o < 64; o <<= 1) { const unsigned v = SHD(incl, o, lop779_); if (lane + o < 64) incl += v; }
    const unsigned above = incl - mine; const bool found = above < need && need <= above + mine;
    unsigned a = above; int bsel = 0; bool done = false;
#pragma unroll
    for (int i = PB - 1; i >= 0; --i) { const bool hit = !done && (need <= a + hv[i]); bsel = hit ? i : bsel; a = (done || hit) ? a : a + hv[i]; done = done || hit; }
    const int src = __builtin_ctzll(__ballot(found));
    const unsigned bfull = (unsigned)SHI(lane * PB + bsel, src); const unsigned aa = (unsigned)SHI((int)a, src);
    prefix = LEVEL == 0 ? bfull : (LEVEL == 1 ? ((prefix << 11) | bfull) : ((prefix << 10) | bfull)); need -= aa;
    LDS_WAIT();
}

__device__ __forceinline__ bool dsa2_sampled(LAS unsigned char* wl, const unsigned (&kk)[128], int nreg, int n, int lane) {
    LAS unsigned* hist = (LAS unsigned*)wl; LAS int* LIST = (LAS int*)(wl + 12288); LAS unsigned* h2 = (LAS unsigned*)(wl + 13312);
    LAS unsigned long long* PRIV = (LAS unsigned long long*)wl;
    const unsigned long long ltm = (1ull << lane) - 1ull;
#pragma unroll
    for (int i = 0; i < 8; ++i) *(LAS v4u*)(hist + lane * 32 + 4 * i) = (v4u){0u, 0u, 0u, 0u};
    LDS_WAIT();
#pragma unroll
    for (int i = 0; i < 128; i += 8) { if (i < nreg) { const unsigned k = kk[i]; if (k != 0u) (void)__hip_atomic_fetch_add(&hist[k >> 21], 1u, __ATOMIC_RELAXED, __HIP_MEMORY_SCOPE_WORKGROUP); } }
    LDS_WAIT();
    unsigned hv[32]; unsigned mine = 0u;
#pragma unroll
    for (int i = 0; i < 8; ++i) { const v4u v = *(const LAS v4u*)(hist + lane * 32 + 4 * i); hv[4 * i] = v.x; hv[4 * i + 1] = v.y; hv[4 * i + 2] = v.z; hv[4 * i + 3] = v.w; mine += (v.x + v.y) + (v.z + v.w); }
    unsigned incl = mine; const int lop_ = lane_op();
#pragma unroll
    for (int o = 1; o < 64; o <<= 1) { const unsigned v = SHD(incl, o, lop_); if (lane + o < 64) incl += v; }
    const unsigned above = incl - mine; const unsigned ns = SHI(incl, 0);
    const float E = (float)ns * 256.f / (float)n, mg = 3.f * sqrtf(E) + 3.f;
    const int rhi = (int)fmaxf(E - mg, 0.f), rlo = (int)(E + mg) + 1;
    int bhl = -1, bll = -1; { unsigned s = above;
#pragma unroll
        for (int i = 31; i >= 0; --i) { if ((int)s <= rhi) bhl = i; s += hv[i]; if (bll < 0 && (int)s >= rlo) bll = i; } }
    const bool hasH = ((int)above <= rhi) && ((int)incl > rhi || lane == 0), hasL = ((int)incl >= rlo) && ((int)above < rlo);
    const unsigned long long mH = __ballot(hasH), mL = __ballot(hasL);
    if (mH == 0ull) return false;
    const int sH = 63 - __builtin_clzll(mH);
    const unsigned bh = (unsigned)SHI(lane * 32 + (bhl < 0 ? 0 : bhl), sH);
    unsigned bl = 1u; if (mL != 0ull) { const int sL = 63 - __builtin_clzll(mL); bl = (unsigned)SHI(lane * 32 + (bll < 0 ? 0 : bll), sL); }
    bl = bl < 1u ? 1u : bl; if (bl > bh) bl = bh;
    int cur = 0; LAS unsigned* pp = (LAS unsigned*)(PRIV + lane);
#pragma unroll
    for (int i = 0; i < 128; ++i) { if ((i & ~15) < nreg) { const unsigned k = kk[i];
            if ((k >> 21) >= bl) { if (cur < 24) { pp[0] = (unsigned)(lane + 64 * i); pp[1] = k; } pp += 128; ++cur; } }
        __builtin_amdgcn_sched_barrier(0); }
    LDS_WAIT();
    int mxc = cur; { const int lq_ = lane_op();
#pragma unroll
        for (int o = 1; o < 64; o <<= 1) { const int t2 = SHX(mxc, o, lq_); mxc = t2 > mxc ? t2 : mxc; } }
    mxc = __builtin_amdgcn_readfirstlane(mxc);
    if (mxc > 24) return false;
    int A = 0, C = 0;
#pragma unroll 1
    for (int s = 0; s < mxc; ++s) { const bool vld = s < cur; const unsigned long long e = vld ? PRIV[s * 64 + lane] : 0ull; const unsigned k = (unsigned)(e >> 32), ix = (unsigned)e;
        const bool sure = vld && (k >> 21) > bh, cand = vld && !sure;
        const unsigned long long ms = __ballot(sure), mc = __ballot(cand);
        const int ps = A + __builtin_popcountll(ms & ltm), pc = C + __builtin_popcountll(mc & ltm);
        if (sure && ps < 256) LIST[ps] = (int)ix;
        if (cand) PRIV[pc] = ((unsigned long long)k << 13) | (unsigned long long)(8191u - ix);
        A += __builtin_popcountll(ms); C += __builtin_popcountll(mc); }
    if (A > 256 || A + C < 256) return false;
    LDS_WAIT();
    unsigned need = 256u - (unsigned)A; const int nit = (C + 63) >> 6;
    if (need > 0u) { unsigned long long prefix = 0ull; int shf = 45;
#pragma unroll 1
        for (int lev = 0; lev < 6; ++lev) { const int w = lev < 5 ? 8 : 5; const int sh = shf - w;
            { unsigned zq_ = 0u; asm volatile("" : "+v"(zq_)); *(LAS v4u*)(h2 + 4 * lane) = (v4u){zq_, zq_, zq_, zq_}; }
            LDS_WAIT();
            for (int it = 0; it < nit; ++it) { const int i = it * 64 + lane; if (i < C) { const unsigned long long c2 = PRIV[i]; if (lev == 0 || (c2 >> shf) == prefix) (void)__hip_atomic_fetch_add(&h2[(unsigned)(c2 >> sh) & ((1u << w) - 1u)], 1u, __ATOMIC_RELAXED, __HIP_MEMORY_SCOPE_WORKGROUP); } }
            LDS_WAIT();
            const v4u v = *(const LAS v4u*)(h2 + 4 * lane); const unsigned m4 = (v.x + v.y) + (v.z + v.w); unsigned in2 = m4; const int lq_ = lane_op();
#pragma unroll
            for (int o = 1; o < 64; o <<= 1) { const unsigned t2 = SHD(in2, o, lq_); if (lane + o < 64) in2 += t2; }
            const unsigned ab = in2 - m4; const bool fnd = ab < need && need <= ab + m4;
            unsigned a = ab; int bs = 0; bool dn = false; const unsigned h4[4] = {v.x, v.y, v.z, v.w};
#pragma unroll
            for (int i = 3; i >= 0; --i) { const bool hit = !dn && (need <= a + h4[i]); bs = hit ? i : bs; a = (dn || hit) ? a : a + h4[i]; dn = dn || hit; }
            const int src = __builtin_ctzll(__ballot(fnd));
            const unsigned bf = (unsigned)SHI(lane * 4 + bs, src); const unsigned aa = (unsigned)SHI((int)a, src); const unsigned hb = (unsigned)SHI((int)(bs == 3 ? h4[3] : bs == 2 ? h4[2] : bs == 1 ? h4[1] : h4[0]), src);
            prefix = (prefix << w) | bf; need -= aa; shf = sh;
            LDS_WAIT();
            if (hb == need) break; }
        int pos = A;
        for (int it = 0; it < nit; ++it) { const int i = it * 64 + lane; unsigned long long c2 = 0ull; if (i < C) c2 = PRIV[i];
            const bool take = (i < C) && ((c2 >> shf) >= prefix);
            const unsigned long long mt = __ballot(take);
            if (take) LIST[pos + __builtin_popcountll(mt & ltm)] = (int)(8191u - (unsigned)(c2 & 8191ull));
            pos += __builtin_popcountll(mt); }
    }
    LDS_WAIT();
    return true;
}

__device__ __forceinline__ void dsa2_unit(LAS unsigned char* lds, const bf16* PROJ, const bf16* KIDX, const bf16* KVN, bf16* OLAT, float* sbuf, int b, int t0, int tid) {
    asm volatile("" : "+v"(tid));
    const int lane = tid & 63, wave = __builtin_amdgcn_readfirstlane(tid >> 6), r = lane & 31, h = lane >> 5;
    const size_t rowb = (size_t)b * T;
    LAS unsigned char* wl = lds + wave * 16384; LAS unsigned* hist = (LAS unsigned*)wl; LAS int* LIST = (LAS int*)(wl + 12288);
    const int t = t0 + wave; int cnt;
    if (t0 >= 256) {
        { const int ntiles = (t0 >> 5) + 1, tpw = (ntiles + 7) >> 3, tile0 = wave * tpw; int tile1 = tile0 + tpw; tile1 = tile1 < ntiles ? tile1 : ntiles;
          const int ahead = (r & 3) + 4 * ((r >> 3) & 1), atok = ((r >> 2) & 1) + 2 * (r >> 4);
          const bf16* qpa = PROJ + (rowb + t0 + atok) * NP + PC_QIDX + ahead * 32 + 8 * h; const bf16* qpb = qpa + (size_t)4 * NP;
          const bf16x8 A0a = *(const bf16x8*)qpa, A1a = *(const bf16x8*)(qpa + 16), A0b = *(const bf16x8*)qpb, A1b = *(const bf16x8*)(qpb + 16);
          float wq[32];
#pragma unroll
          for (int gq = 0; gq < 4; ++gq) { const v4u w0 = *(const v4u*)(PROJ + (rowb + t0 + h + 2 * gq) * NP + PC_WIDX);
              wq[8 * gq] = 0.5f * bflo(w0.x); wq[8 * gq + 1] = 0.5f * bfhi(w0.x); wq[8 * gq + 2] = 0.5f * bflo(w0.y); wq[8 * gq + 3] = 0.5f * bfhi(w0.y); wq[8 * gq + 4] = 0.5f * bflo(w0.z); wq[8 * gq + 5] = 0.5f * bfhi(w0.z); wq[8 * gq + 6] = 0.5f * bflo(w0.w); wq[8 * gq + 7] = 0.5f * bfhi(w0.w); }
          v4u A0c = {0u, 0u, 0u, 0u}, A1c = {0u, 0u, 0u, 0u};
          if (r < 8) { const bf16* qrow = PROJ + (rowb + t0 + (r >> 2) + 2 * (r & 3)) * NP; const v4u wv = *(const v4u*)(qrow + PC_WIDX);
              const float wl_[8] = {bflo(wv.x), bfhi(wv.x), bflo(wv.y), bfhi(wv.y), bflo(wv.z), bfhi(wv.z), bflo(wv.w), bfhi(wv.w)};
              float a0[8], a1[8];
#pragma unroll
              for (int j = 0; j < 8; ++j) { a0[j] = 0.f; a1[j] = 0.f; }
#pragma unroll
              for (int hd = 0; hd < 8; ++hd) { const v4u q0 = *(const v4u*)(qrow + PC_QIDX + hd * 32 + 8 * h), q1 = *(const v4u*)(qrow + PC_QIDX + hd * 32 + 16 + 8 * h); const float hw = 0.5f * wl_[hd];
                  a0[0] += hw * bflo(q0.x); a0[1] += hw * bfhi(q0.x); a0[2] += hw * bflo(q0.y); a0[3] += hw * bfhi(q0.y); a0[4] += hw * bflo(q0.z); a0[5] += hw * bfhi(q0.z); a0[6] += hw * bflo(q0.w); a0[7] += hw * bfhi(q0.w);
                  a1[0] += hw * bflo(q1.x); a1[1] += hw * bfhi(q1.x); a1[2] += hw * bflo(q1.y); a1[3] += hw * bfhi(q1.y); a1[4] += hw * bflo(q1.z); a1[5] += hw * bfhi(q1.z); a1[6] += hw * bflo(q1.w); a1[7] += hw * bfhi(q1.w); }
              A0c = (v4u){pk2(a0[0], a0[1]), pk2(a0[2], a0[3]), pk2(a0[4], a0[5]), pk2(a0[6], a0[7])}; A1c = (v4u){pk2(a1[0], a1[1]), pk2(a1[2], a1[3]), pk2(a1[4], a1[5]), pk2(a1[6], a1[7])}; }
          const bf16x8 A0cb = __builtin_bit_cast(bf16x8, A0c), A1cb = __builtin_bit_cast(bf16x8, A1c);
          const bf16* kp = KIDX + (rowb + (size_t)tile0 * 32 + r) * 32 + 8 * h;
          bf16x8 Bq[4][2];
#pragma unroll
          for (int u = 0; u < 3; ++u) if (tile0 + u < tile1) { Bq[u][0] = *(const bf16x8*)(kp + (size_t)u * 1024); Bq[u][1] = *(const bf16x8*)(kp + (size_t)u * 1024 + 16); }
          for (int tileb = tile0; tileb < tile1; tileb += 4) {
#pragma unroll
          for (int u = 0; u < 4; ++u) { const int tile = tileb + u; if (tile < tile1) { const bf16x8 b0 = Bq[u][0], b1 = Bq[u][1];
              if (tile + 3 < tile1) { const bf16* kn = kp + (size_t)(tile + 3 - tile0) * 1024; Bq[(u + 3) & 3][0] = *(const bf16x8*)kn; Bq[(u + 3) & 3][1] = *(const bf16x8*)(kn + 16); }
              f32x16 da, db, dc;
#pragma unroll
              for (int i = 0; i < 16; ++i) { da[i] = 0.f; db[i] = 0.f; dc[i] = 0.f; }
              da = __builtin_amdgcn_mfma_f32_32x32x16_bf16(A0a, b0, da, 0, 0, 0); db = __builtin_amdgcn_mfma_f32_32x32x16_bf16(A0b, b0, db, 0, 0, 0); dc = __builtin_amdgcn_mfma_f32_32x32x16_bf16(A0cb, b0, dc, 0, 0, 0);
              da = __builtin_amdgcn_mfma_f32_32x32x16_bf16(A1a, b1, da, 0, 0, 0); db = __builtin_amdgcn_mfma_f32_32x32x16_bf16(A1b, b1, db, 0, 0, 0); dc = __builtin_amdgcn_mfma_f32_32x32x16_bf16(A1cb, b1, dc, 0, 0, 0);
              float s0 = dc[0], s1 = dc[1], s2 = dc[2], s3 = dc[3];
#pragma unroll
              for (int i = 0; i < 8; ++i) { s0 += wq[i] * __builtin_fabsf(da[i]); s1 += wq[8 + i] * __builtin_fabsf(da[8 + i]); s2 += wq[16 + i] * __builtin_fabsf(db[i]); s3 += wq[24 + i] * __builtin_fabsf(db[8 + i]); }
              float* sp = sbuf + (size_t)h * 8192 + tile * 32 + r;
              sp[0] = __builtin_bit_cast(float, mono_key(s0)); sp[2 * 8192] = __builtin_bit_cast(float, mono_key(s1)); sp[4 * 8192] = __builtin_bit_cast(float, mono_key(s2)); sp[6 * 8192] = __builtin_bit_cast(float, mono_key(s3)); } } } }
        asm volatile("s_waitcnt vmcnt(0)" ::: "memory");
        __syncthreads();
        const int n = t + 1, nreg = (n + 63) >> 6; const float* sr = sbuf + (size_t)wave * 8192;
        unsigned kk[128];
#ifndef DUP_KK
#define DUP_KK 1
#endif
        for (int repk = 0; repk < DUP_KK; ++repk)
#pragma unroll
        for (int gI = 0; gI < 4; ++gI) {
            if (gI * 32 < nreg) {
                float fv[32];
#pragma unroll
                for (int i = 0; i < 32; ++i) { const int key = lane + 64 * (gI * 32 + i); fv[i] = __hip_atomic_load(sr + (key < n ? key : n - 1), __ATOMIC_RELAXED, __HIP_MEMORY_SCOPE_AGENT); }
#pragma unroll
                for (int i = 0; i < 32; ++i) { const int key = lane + 64 * (gI * 32 + i); kk[gI * 32 + i] = key < n ? __builtin_bit_cast(unsigned, fv[i]) : 0u; }
            } else {
#pragma unroll
                for (int i = 0; i < 32; ++i) kk[gI * 32 + i] = 0u;
            }
        }
        unsigned prefix = 0u, need = 256u; int pos = 0, eqs = 0; const unsigned long long ltm = (1ull << lane) - 1ull;
        bool seldone = false; if (nreg > 16) seldone = dsa2_sampled(wl, kk, nreg, n, lane);
        if (!seldone)
        for (int reps = 0; reps < DUP_SEL; ++reps) { prefix = 0u; need = 256u; pos = 0; eqs = 0;
        dsa2_level<0>(hist, kk, nreg, lane, prefix, need);
        dsa2_level<1>(hist, kk, nreg, lane, prefix, need);
        dsa2_level<2>(hist, kk, nreg, lane, prefix, need);
        const unsigned tau = prefix;
#pragma unroll
        for (int i = 0; i < 128; ++i) { if ((i & ~15) < nreg) { const unsigned k = kk[i]; const bool gt = k > tau, eq = k == tau;
                const unsigned long long me = __ballot(eq);
                const bool take = gt || (eq && (eqs + __builtin_popcountll(me & ltm) < (int)need));
                const unsigned long long mt = __ballot(take);
                if (take) LIST[pos + __builtin_popcountll(mt & ltm)] = lane + 64 * i;
                pos += __builtin_popcountll(mt); eqs += __builtin_popcountll(me); }
            if ((i & 3) == 3) __builtin_amdgcn_sched_barrier(0); } }
        cnt = 256;
    } else {
#pragma unroll
        for (int j = 0; j < 4; ++j) LIST[lane + 64 * j] = lane + 64 * j;
        cnt = t + 1;
    }
    LDS_WAIT();
    int tid2 = tid; asm volatile("" : "+v"(tid2)); const int lane2 = tid2 & 63; const int nn = lane2 & 15, g = lane2 >> 4;
    bf16x8 qf[4];
#pragma unroll
    for (int s = 0; s < 4; ++s) { if (nn < 8) qf[s] = *(const bf16x8*)(PROJ + (rowb + t) * NP + PC_QLAT + nn * 128 + 32 * s + 8 * g); else qf[s] = (bf16x8){0, 0, 0, 0, 0, 0, 0, 0}; }
    f32x4 O[8]; float mrun, lrun;
    LAS unsigned char* buf = wl; const unsigned q4 = (unsigned)(nn >> 2), p = (unsigned)(lane2 & 3); const int nch = (cnt + 31) >> 5;
    for (int repa = 0; repa < DUP_ATT; ++repa) {
#pragma unroll
    for (int c = 0; c < 8; ++c) O[c] = (f32x4){0.f, 0.f, 0.f, 0.f};
    mrun = -INFINITY; lrun = 0.f;
    v4u pre[8];
#pragma unroll
    for (int it = 0; it < 8; ++it) { const int row = it * 4 + g; pre[it] = (v4u){0u, 0u, 0u, 0u}; if (row < cnt) { const int idx = LIST[row]; pre[it] = *(const v4u*)(KVN + (rowb + idx) * 128 + nn * 8); } }
#pragma unroll 1
    for (int ch = 0; ch < nch; ++ch) {
#pragma unroll
        for (int it = 0; it < 8; ++it) *(LAS v4u*)(buf + kv_off(it * 4 + g, nn)) = pre[it];
        if (ch + 1 < nch) {
#pragma unroll
            for (int it = 0; it < 8; ++it) { const int row = (ch + 1) * 32 + it * 4 + g; pre[it] = (v4u){0u, 0u, 0u, 0u}; if (row < cnt) { const int idx = LIST[row]; pre[it] = *(const v4u*)(KVN + (rowb + idx) * 128 + nn * 8); } } }
        LDS_WAIT();
        f32x4 S0 = {0.f, 0.f, 0.f, 0.f}, S1 = {0.f, 0.f, 0.f, 0.f};
        { const unsigned slot0 = 8u * (nn >> 2) + (nn & 3), slot1 = slot0 + 4u;
#pragma unroll
          for (int s = 0; s < 4; ++s) { const bf16x8 a0 = *(const LAS bf16x8*)(buf + kv_off(slot0, 4 * s + g)), a1 = *(const LAS bf16x8*)(buf + kv_off(slot1, 4 * s + g));
              S0 = __builtin_amdgcn_mfma_f32_16x16x32_bf16(a0, qf[s], S0, 0, 0, 0); S1 = __builtin_amdgcn_mfma_f32_16x16x32_bf16(a1, qf[s], S1, 0, 0, 0); } }
        if (ch * 32 + 32 > cnt) {
#pragma unroll
            for (int j = 0; j < 4; ++j) { if (ch * 32 + 8 * g + j >= cnt) S0[j] = -INFINITY; if (ch * 32 + 8 * g + 4 + j >= cnt) S1[j] = -INFINITY; } }
        float mc = fmaxf(fmaxf(fmaxf(S0[0], S0[1]), fmaxf(S0[2], S0[3])), fmaxf(fmaxf(S1[0], S1[1]), fmaxf(S1[2], S1[3])));
        const int lop891_ = lane_op(); mc = fmaxf(mc, SHX(mc, 16, lop891_)); mc = fmaxf(mc, SHX(mc, 32, lop891_));
        const float mnew = fmaxf(mrun, mc); const float alpha = __expf(mrun - mnew); mrun = mnew;
        float ps = 0.f;
#pragma unroll
        for (int j = 0; j < 4; ++j) { S0[j] = __expf(S0[j] - mnew); S1[j] = __expf(S1[j] - mnew); ps += S0[j] + S1[j]; }
        lrun = lrun * alpha + ps;
        v4u w; w.x = pk2(S0[0], S0[1]); w.y = pk2(S0[2], S0[3]); w.z = pk2(S1[0], S1[1]); w.w = pk2(S1[2], S1[3]); const bf16x8 Bp = __builtin_bit_cast(bf16x8, w);
#pragma unroll
        for (int c = 0; c < 8; ++c) { O[c] = O[c] * alpha;
            const v4i16_t lo = __builtin_amdgcn_ds_read_tr16_b64_v4i16((LAS v4i16_t*)(buf + kv_off(8u * g + q4, 2u * c + (p >> 1)) + 8u * (p & 1u)));
            const v4i16_t hi = __builtin_amdgcn_ds_read_tr16_b64_v4i16((LAS v4i16_t*)(buf + kv_off(8u * g + 4u + q4, 2u * c + (p >> 1)) + 8u * (p & 1u)));
            const bf16x8 a = __builtin_shufflevector(lo, hi, 0, 1, 2, 3, 4, 5, 6, 7);
            O[c] = __builtin_amdgcn_mfma_f32_16x16x32_bf16(a, Bp, O[c], 0, 0, 0); }
        LDS_WAIT();
    } }
    const int lop906_ = lane_op(); lrun += SHX(lrun, 16, lop906_); lrun += SHX(lrun, 32, lop906_);
    const float inv = 1.f / lrun;
    if (nn < 8) {
#pragma unroll
        for (int c = 0; c < 8; ++c) { v2u w; w.x = pk2(O[c][0] * inv, O[c][1] * inv); w.y = pk2(O[c][2] * inv, O[c][3] * inv); *(v2u*)(OLAT + (rowb + t) * 1024 + nn * 128 + 16 * c + 4 * g) = w; } }
}

__device__ __forceinline__ unsigned swap23(unsigned r) { return (r & ~12u) | ((r & 4u) << 1) | ((r & 8u) >> 1); }
__device__ __forceinline__ void memattn_unit(LAS unsigned char* lds, const bf16* PROJ, const bf16* MKVl, bf16* BR, int b, int hd, int qblk, int tid) {
    asm volatile("" : "+v"(tid));
    const int lane = tid & 63, wave = __builtin_amdgcn_readfirstlane(tid >> 6), r = lane & 31, hh = lane >> 5;
    LAS unsigned char* kimg = lds; LAS unsigned char* vimg = lds + 65536;
    { const bf16* kb = MKVl + (size_t)b * 256 * 1024 + hd * 128;
#pragma unroll 4
      for (int it = 0; it < 8; ++it) { const int row = it * 32 + (tid >> 4), ch = tid & 15;
          const v4u kv = *(const v4u*)(kb + (size_t)row * 1024 + ch * 8), vv = *(const v4u*)(kb + (size_t)row * 1024 + 512 + ch * 8);
          *(LAS v4u*)(kimg + kv_off(row, ch)) = kv; *(LAS v4u*)(vimg + kv_off(row, ch)) = vv; } }
    const size_t tok = (size_t)b * T + qblk * 256 + wave * 32 + r;
    bf16x8 qf[8];
#pragma unroll
    for (int s = 0; s < 8; ++s) qf[s] = *(const bf16x8*)(PROJ + tok * NP + PC_MQ + hd * 128 + 16 * s + 8 * hh);
    __syncthreads();
    f32x16 S[8];
#pragma unroll
    for (int kap = 0; kap < 8; ++kap) { f32x16 acc;
#pragma unroll
        for (int i = 0; i < 16; ++i) acc[i] = 0.f;
        const unsigned slot = 32u * kap + swap23((unsigned)r);
#pragma unroll
        for (int s = 0; s < 8; ++s) { const bf16x8 a = *(const LAS bf16x8*)(kimg + kv_off(slot, 2 * s + hh)); acc = __builtin_amdgcn_mfma_f32_32x32x16_bf16(a, qf[s], acc, 0, 0, 0); }
        S[kap] = acc; if (kap & 1) __builtin_amdgcn_sched_barrier(0); }
    float mx = -INFINITY;
#pragma unroll
    for (int kap = 0; kap < 8; ++kap)
#pragma unroll
        for (int i = 0; i < 16; ++i) mx = fmaxf(mx, S[kap][i]);
    const int lop945_ = lane_op(); mx = fmaxf(mx, SHX(mx, 32, lop945_));
    const float sc_ = 0.08838834764831845f * 1.4426950408889634f; float sum = 0.f;
#pragma unroll
    for (int kap = 0; kap < 8; ++kap)
#pragma unroll
        for (int i = 0; i < 16; ++i) { const float e = __builtin_amdgcn_exp2f((S[kap][i] - mx) * sc_); S[kap][i] = e; sum += e; }
    const int lop951_ = lane_op(); sum += SHX(sum, 32, lop951_);
    const float inv = 1.f / sum;
    bf16x8 Bp[16];
#pragma unroll
    for (int kap = 0; kap < 8; ++kap)
#pragma unroll
        for (int s = 0; s < 2; ++s) { v4u w; w.x = pk2(S[kap][8 * s], S[kap][8 * s + 1]); w.y = pk2(S[kap][8 * s + 2], S[kap][8 * s + 3]); w.z = pk2(S[kap][8 * s + 4], S[kap][8 * s + 5]); w.w = pk2(S[kap][8 * s + 6], S[kap][8 * s + 7]);
            Bp[2 * kap + s] = __builtin_bit_cast(bf16x8, w); }
    const unsigned blk = (lane >> 4) & 1, q4 = (lane & 15) >> 2, p = lane & 3;
    bf16* orow = BR + tok * 2048 + 1536 + hd * 128;
#pragma unroll
    for (int c = 0; c < 4; ++c) { f32x16 o;
#pragma unroll
        for (int i = 0; i < 16; ++i) o[i] = 0.f;
#pragma unroll
        for (int ks = 0; ks < 16; ++ks) {
            const v4i16_t lo = __builtin_amdgcn_ds_read_tr16_b64_v4i16((LAS v4i16_t*)(vimg + kv_off(16u * ks + 8u * hh + q4, 4u * c + 2u * blk + (p >> 1)) + 8u * (p & 1u)));
            const v4i16_t hi = __builtin_amdgcn_ds_read_tr16_b64_v4i16((LAS v4i16_t*)(vimg + kv_off(16u * ks + 8u * hh + 4u + q4, 4u * c + 2u * blk + (p >> 1)) + 8u * (p & 1u)));
            const bf16x8 a = __builtin_shufflevector(lo, hi, 0, 1, 2, 3, 4, 5, 6, 7);
            o = __builtin_amdgcn_mfma_f32_32x32x16_bf16(a, Bp[ks], o, 0, 0, 0); if ((ks & 3) == 3) __builtin_amdgcn_sched_barrier(0); }
#pragma unroll
        for (int i4 = 0; i4 < 4; ++i4) { v2u w; w.x = pk2(o[4 * i4] * inv, o[4 * i4 + 1] * inv); w.y = pk2(o[4 * i4 + 2] * inv, o[4 * i4 + 3] * inv);
            *(v2u*)(orow + 32 * c + 8 * i4 + 4 * hh) = w; } }
    __syncthreads();
}

__device__ __forceinline__ f32x4 ld4bf(const bf16* p) { const v2u w = *(const v2u*)p; return (f32x4){bflo(w.x), bfhi(w.x), bflo(w.y), bfhi(w.y)}; }
__device__ __forceinline__ void store_row_fp8(const f32x4 (&v)[4], unsigned char* o8, int lane) {
#pragma unroll
    for (int j = 0; j < 4; ++j) *(unsigned*)(o8 + 4 * lane + 256 * j) = q8x4(v[j][0], v[j][1], v[j][2], v[j][3], QS_H);
}
constexpr int PH_PER_LAYER = 11, NPHASE = 2 + NL * PH_PER_LAYER;

__global__ void __launch_bounds__(NWAVES * 64, 2) fwd(Args args) {
    extern __shared__ __attribute__((aligned(16))) unsigned char lds_raw[];
    Frame F;
    F.lds = (LAS unsigned char*)lds_raw;
    F.tid = threadIdx.x; F.lane = F.tid & 63; F.wave = __builtin_amdgcn_readfirstlane(F.tid >> 6);
    const int wave_s = F.wave;
    F.G = gridDim.x; F.gw = blockIdx.x * NWAVES + F.wave; F.NGW = F.G * NWAVES;
    volatile LAS unsigned* MISC = (volatile LAS unsigned*)(F.lds + MISC_OFF);
    for (int u = F.tid; u < (LDS_BYTES - LDSCTL_OFF) / 4; u += NWAVES * 64) ((LAS unsigned*)(F.lds + LDSCTL_OFF))[u] = 0u;
    __syncthreads();
#if ONE_LAUNCH
    XcdBarrier bar = xcd_barrier_post((unsigned*)(args.ws + WS_CTL) + CW_BAR, MISC + 8);
#define GRID_BAR() xcd_barrier(bar, tidq)
#else
#define GRID_BAR() do {} while (0)
#endif
    { volatile LAS unsigned long long* PT = (volatile LAS unsigned long long*)(F.lds + MISC_OFF + 512);
    if (F.tid == 0) {
#pragma unroll
        for (int i = 0; i < 33; ++i) PT[i] = (unsigned long long)args.in[i];
        PT[33] = (unsigned long long)args.out; PT[34] = (unsigned long long)args.ws;
    } }
    const int lo = args.ph_lo, hi = args.ph_hi;
    __syncthreads();
    int ph = 0;
#define IN(k) ((const float*)gptr(ldp(PT, k)))
#ifndef DUP_PHASE
#define DUP_PHASE (-1)
#endif
#ifndef PHMASK
#define PHMASK 0xFFFFull
#endif
#define PHASE_BEGIN(id) if (((PHMASK >> (id)) & 1ull) && lo <= ph && ph < hi) { unsigned ldsb_ = 0u; asm volatile("" : "+s"(ldsb_)); LAS unsigned char* ldsq = (LAS unsigned char*)lds_raw + ldsb_; \
    volatile LAS unsigned long long* PT = (volatile LAS unsigned long long*)(ldsq + MISC_OFF + 512); LAS int* BLK0 = (LAS int*)(ldsq + MISC_OFF + 128); (void)BLK0; unsigned char* ws = gptr(ldp(PT, 34)); int tidq = wave_s * 64 + lane_op(); asm volatile("" : "+v"(tidq)); const int lane = tidq & 63, wave = __builtin_amdgcn_readfirstlane(tidq >> 6); \
    Frame F; F.lds = ldsq; F.tid = tidq; F.lane = lane; F.wave = wave; { const unsigned vb1_ = ((volatile LAS unsigned*)(ldsq + MISC_OFF))[11]; int Gq_ = gridDim.x, bxq_ = __builtin_amdgcn_readfirstlane(vb1_ ? (int)vb1_ - 1 : (int)blockIdx.x); asm volatile("" : "+s"(Gq_), "+s"(bxq_)); F.G = Gq_; F.bx = bxq_; } F.gw = F.bx * NWAVES + wave; F.NGW = F.G * NWAVES; \
    bf16* WinT = (bf16*)(ws + WS_WIN); bf16* WgluT = (bf16*)(ws + WS_WGLU); bf16* WmkvT = (bf16*)(ws + WS_WMKV); bf16* WuvT = (bf16*)(ws + WS_WUV); \
    bf16* WbrT = (bf16*)(ws + WS_WBR); bf16* WoT = (bf16*)(ws + WS_WO); bf16* WupT = (bf16*)(ws + WS_WUP); bf16* WdnT = (bf16*)(ws + WS_WDN); \
    f32x2* S5A = (f32x2*)(ws + WS_S5A); f32x2* S5B = (f32x2*)(ws + WS_S5B); \
    bf16* MEMB = (bf16*)(ws + WS_MEMB); bf16* MKV = (bf16*)(ws + WS_MKV); \
    bf16* Hf = (bf16*)(ws + WS_H); bf16* Hb = (bf16*)(ws + WS_HB); bf16* PROJ = (bf16*)(ws + WS_PROJ); bf16* KVN = (bf16*)(ws + WS_KVN); \
    bf16* OLAT = (bf16*)(ws + WS_OLAT); bf16* BR = (bf16*)(ws + WS_BR); bf16* Zb = (bf16*)(ws + WS_Z); float* MRG = (float*)(ws + WS_MRG); bf16* MRGB = (bf16*)(ws + WS_MRGB); \
    bf16* Vf = (bf16*)(ws + WS_V); bf16* H1 = (bf16*)(ws + WS_H1); bf16* H1B = (bf16*)(ws + WS_H1B); \
    f32x2* SSE = (f32x2*)(ws + WS_SSE); f32x2* SSC = (f32x2*)(ws + WS_SSC); \
    int* TOK = (int*)(ws + WS_TOK); float* GATE = (float*)(ws + WS_GATE); int* SLOT = (int*)(ws + WS_SLOT); \
    bf16* XS = (bf16*)(ws + WS_XS); bf16* ACT = (bf16*)(ws + WS_ACT); bf16* YS = XS; float* SCR = (float*)(ws + WS_SCR); float* GROW = (float*)(ws + WS_SCR); bf16* KIDX = (bf16*)(ws + WS_KIDX); (void)KIDX; bf16* WSSM = (bf16*)(ws + WS_WSSM); bf16* AEXT = (bf16*)(ws + WS_AEXT); bf16* WEW = (bf16*)(ws + WS_WE); (void)WSSM; (void)AEXT; (void)WEW; \
    unsigned* CTLP = (unsigned*)(ws + WS_CTL); float* OUTP = (float*)gptr(ldp(PT, 33)); \
    (void)WinT; (void)WgluT; (void)WmkvT; (void)WuvT; (void)WbrT; (void)WoT; (void)WupT; (void)WdnT; (void)S5A; (void)S5B; (void)MEMB; (void)MKV; (void)Hf; (void)Hb; (void)PROJ; (void)KVN; (void)OLAT; (void)BR; (void)Zb; (void)MRG; (void)MRGB; \
    (void)Vf; (void)H1; (void)H1B; (void)SSE; (void)SSC; (void)TOK; (void)GATE; (void)SLOT; (void)XS; (void)ACT; (void)YS; (void)SCR; (void)GROW; (void)CTLP; (void)OUTP; \
    for (int rep_ = 0; rep_ < (((id) == DUP_PHASE) ? 2 : 1); ++rep_)
#define PHASE_END   if (ph + 1 < hi) GRID_BAR(); } ++ph;

    PHASE_BEGIN(0)
    {
        LAS unsigned char* scr = F.lds + wave * 16384;
        constexpr int I_CKV = 16 * 2, I_QIDX = 16 * 4, I_KIDX = 16, I_WIDX = 16, I_512 = 16 * 8, I_GATE = 16 * 64;
        constexpr int I_WIN = I_CKV + I_QIDX + I_KIDX + I_WIDX + 5 * I_512 + I_GATE;
        constexpr int I_GLU = 8 * 8, I_MKV = 16 * 16, I_BR = 8 * 16, I_WO = 16 * 16, I_UP = 16 * 32, I_DN = 16 * 16;
        constexpr int I_LAYER = I_WIN + I_GLU + I_MKV + 4 * I_BR + I_WO + NE * I_UP + NE * I_DN;
        const float* w_in = IN(4);
        { LAS float* wt = (LAS float*)F.lds; LAS float* uk = wt + 64 * 65;
          for (int it = F.bx; it < NL * 8 * 16; it += F.G) { const int l = it >> 7, h = (it >> 4) & 7, kb = it & 15;
            const float* Wl = w_in + (size_t)l * D * DIN + (size_t)(kb * 64) * DIN + h * 64; const float* wuk = IN(6) + (size_t)l * 128 * 512 + h * 64;
            { float t8[8], u16[16];
#pragma unroll
              for (int j = 0; j < 8; ++j) { const int i = F.tid + 512 * j; t8[j] = Wl[(size_t)(i >> 6) * DIN + (i & 63)]; }
#pragma unroll
              for (int j = 0; j < 16; ++j) { const int i = F.tid + 512 * j; u16[j] = wuk[(size_t)(i >> 6) * 512 + (i & 63)]; }
#pragma unroll
              for (int j = 0; j < 8; ++j) { const int i = F.tid + 512 * j; wt[(i >> 6) * 65 + (i & 63)] = t8[j]; }
#pragma unroll
              for (int j = 0; j < 16; ++j) { const int i = F.tid + 512 * j; uk[(i >> 6) * 65 + (i & 63)] = u16[j]; } }
            __syncthreads();
            const int c = F.tid >> 2, kq = F.tid & 3; float a[16];
#pragma unroll
            for (int j = 0; j < 16; ++j) a[j] = 0.f;
            for (int d = 0; d < 64; ++d) { const float wv = uk[c * 65 + d];
#pragma unroll
                for (int j = 0; j < 16; ++j) a[j] += wv * wt[(kq * 16 + j) * 65 + d]; }
            unsigned char* p = (unsigned char*)WinT + ((size_t)l * NP + PC_QLAT + h * 128 + c) * D + kb * 64 + kq * 16; const float sq = 0.125f * QS_WQL;
            *(v4u*)p = (v4u){q8x4(a[0], a[1], a[2], a[3], sq), q8x4(a[4], a[5], a[6], a[7], sq), q8x4(a[8], a[9], a[10], a[11], sq), q8x4(a[12], a[13], a[14], a[15], sq)};
            __syncthreads(); } }
        { LAS float* APr = (LAS float*)F.lds; LAS float* APi = APr + 33 * 64; LAS float* Br = APi + 33 * 64; LAS float* Bi = Br + 1024; LAS float* Cr = Bi + 1024; LAS float* Ci = Cr + 1024; LAS float* KD = Ci + 1024;
          for (int it = F.bx; it < NL * 32; it += F.G) { const int l = it >> 5, g = it & 31; const int lg = l * 32 + g;
            if (F.tid < 64) { const int p = F.tid; const int idx = lg * 64 + p; const float lr = IN(10)[idx], li = IN(11)[idx], dt = expf(IN(17)[lg]);
                const float er = expf(lr * dt); float sn, cs; sincosf(li * dt, &sn, &cs); const float ar = er * cs, ai = er * sn;
                float xr = 1.f, xi = 0.f;
                for (int d = 0; d <= 32; ++d) { APr[d * 64 + p] = xr; APi[d * 64 + p] = xi; const float nr = xr * ar - xi * ai, ni = xr * ai + xi * ar; xr = nr; xi = ni; }
                const float nr_ = ar - 1.f, ni_ = ai, den = lr * lr + li * li; const float fr_ = (nr_ * lr + ni_ * li) / den, fi_ = (ni_ * lr - nr_ * li) / den;
                { f32x4 br4[4], bi4[4];
#pragma unroll
                  for (int q = 0; q < 4; ++q) { br4[q] = *(const f32x4*)(IN(12) + (size_t)idx * 16 + 4 * q); bi4[q] = *(const f32x4*)(IN(13) + (size_t)idx * 16 + 4 * q); }
#pragma unroll
                  for (int n = 0; n < 16; ++n) { const float br = br4[n >> 2][n & 3], bi = bi4[n >> 2][n & 3]; Br[p * 16 + n] = fr_ * br - fi_ * bi; Bi[p * 16 + n] = fr_ * bi + fi_ * br; } } }
            for (int i = F.tid; i < 1024; i += 512) { Cr[i] = IN(14)[(size_t)lg * 1024 + i]; Ci[i] = IN(15)[(size_t)lg * 1024 + i]; }
            __syncthreads();
            { const int d = F.tid >> 4, n = F.tid & 15; float a[16];
#pragma unroll
              for (int m = 0; m < 16; ++m) a[m] = 0.f;
              for (int p = 0; p < 64; ++p) { const float cr = Cr[n * 64 + p], ci = Ci[n * 64 + p], xr = APr[d * 64 + p], xi = APi[d * 64 + p]; const float gr = cr * xr - ci * xi, gi = cr * xi + ci * xr;
#pragma unroll
                  for (int m = 0; m < 16; ++m) a[m] += gr * Br[p * 16 + m] - gi * Bi[p * 16 + m]; }
              if (d == 0) { const float dn = IN(16)[lg * 16 + n];
#pragma unroll
                  for (int m = 0; m < 16; ++m) if (m == n) a[m] += dn; }
#pragma unroll
              for (int m = 0; m < 16; ++m) KD[(d * 16 + n) * 16 + m] = a[m]; }
            __syncthreads();
            bf16* wb = WSSM + (size_t)lg * 512 * SSM_K;
            for (int q = F.tid; q < 512 * (SSM_K / 8); q += 512) { const int row = q / (SSM_K / 8), ch = q % (SSM_K / 8); const int t = row >> 4, n = row & 15; float v[8];
                if (ch < 64) { const int j = ch >> 1, m0 = (ch & 1) * 8;
#pragma unroll
                    for (int e = 0; e < 8; ++e) v[e] = (j <= t) ? KD[((t - j) * 16 + n) * 16 + m0 + e] : 0.f; }
                else { const int p2 = (ch - 64) * 8, part = p2 >> 6, p0 = p2 & 63;
#pragma unroll
                    for (int e = 0; e < 8; ++e) { const float cr = Cr[n * 64 + p0 + e], ci = Ci[n * 64 + p0 + e], ar = APr[(t + 1) * 64 + p0 + e], ai = APi[(t + 1) * 64 + p0 + e]; v[e] = part ? -(cr * ai + ci * ar) : (cr * ar - ci * ai); } }
                v4u o; o.x = pk2(v[0], v[1]); o.y = pk2(v[2], v[3]); o.z = pk2(v[4], v[5]); o.w = pk2(v[6], v[7]);
                *(v4u*)(wb + (size_t)row * SSM_K + ch * 8) = o; }
            { bf16* we = WEW + (size_t)lg * 256 * 512;
              for (int q = F.tid; q < 256 * 64; q += 512) { const int row = q >> 6, ch = q & 63; v4u o = {0u, 0u, 0u, 0u};
                  if (row < 128) { const int p = row & 63, part = row >> 6, j = ch >> 1, n0 = (ch & 1) * 8; const float ar = APr[(31 - j) * 64 + p], ai = APi[(31 - j) * 64 + p]; float v[8];
#pragma unroll
                      for (int e = 0; e < 8; ++e) { const float br = Br[p * 16 + n0 + e], bi = Bi[p * 16 + n0 + e]; v[e] = part ? (ar * bi + ai * br) : (ar * br - ai * bi); }
                      o.x = pk2(v[0], v[1]); o.y = pk2(v[2], v[3]); o.z = pk2(v[4], v[5]); o.w = pk2(v[6], v[7]); }
                  *(v4u*)(we + (size_t)row * 512 + ch * 8) = o; } }
            __syncthreads(); } }
        for (;;) { int base_ = 0; if (lane == 0) base_ = (int)__hip_atomic_fetch_add(CTLP + CW_Q0, 8u, RLX_AGENT); base_ = __builtin_amdgcn_readfirstlane(base_); if (base_ >= NL * I_LAYER) break;
        for (int it = base_; it < base_ + 8 && it < NL * I_LAYER; ++it) {
            const int l = it / I_LAYER; int r = it % I_LAYER;
            const float* Wl = w_in + (size_t)l * D * DIN; bf16* Wt = (bf16*)((unsigned char*)WinT + (size_t)l * NP * D);
            if (r < I_WIN) {
                if (r < I_CKV) { tr_item64<3>(Wl, DIN, SC_CKV, 128, D, Wt, PC_CKV, scr, r, lane); continue; } r -= I_CKV;
                if (r < I_QIDX) { tr_item64<3>(Wl, DIN, SC_QIDX, 256, D, Wt, PC_QIDX, scr, r, lane); continue; } r -= I_QIDX;
                if (r < I_KIDX) { tr_item64<3>(Wl, DIN, SC_KIDX, 32, D, Wt, PC_KIDX, scr, r, lane); continue; } r -= I_KIDX;
                if (r < I_WIDX) { tr_item64<3>(Wl, DIN, SC_WIDX, 8, D, Wt, PC_WIDX, scr, r, lane); continue; } r -= I_WIDX;
                if (r < 5 * I_512) { const int s = r / I_512; tr_item64<3>(Wl, DIN, SC_CU + 512 * s, 512, D, Wt, PC_CU + 512 * s, scr, r % I_512, lane); continue; } r -= 5 * I_512;
                tr_item64<3>(Wl, DIN, SC_GATE, 4096, D, Wt, PC_GATE, scr, r, lane); continue;
            }
            r -= I_WIN;
            if (r < I_GLU) { tr_item64(IN(18) + (size_t)l * 512 * 512, 512, 0, 512, 512, WgluT + (size_t)l * 512 * 512, 0, scr, r, lane); continue; } r -= I_GLU;
            if (r < I_MKV) { tr_item64(IN(20) + (size_t)l * 1024 * 1024, 1024, 0, 1024, 1024, WmkvT + (size_t)l * 1024 * 1024, 0, scr, r, lane); continue; } r -= I_MKV;
            if (r < 4 * I_BR) { const int b = r / I_BR; tr_item64(IN(21) + ((size_t)l * 4 + b) * 512 * 1024, 1024, 0, 1024, 512, WbrT + ((size_t)l * 4 + b) * 1024 * 512, 0, scr, r % I_BR, lane); continue; } r -= 4 * I_BR;
            if (r < I_WO) { tr_item64(IN(22) + (size_t)l * 1024 * 1024, 1024, 0, 1024, 1024, WoT + (size_t)l * 1024 * 1024, 0, scr, r, lane); continue; } r -= I_WO;
            if (r < NE * I_UP) { const int e = r / I_UP; tr_item64<1>(IN(27) + ((size_t)l * NE + e) * 1024 * 2048, 2048, 0, 2048, 1024, (bf16*)((unsigned char*)WupT + ((size_t)l * NE + e) * 2048 * 1024), 0, scr, r % I_UP, lane); continue; } r -= NE * I_UP;
            { const int e = r / I_DN; tr_item64<2>(IN(29) + ((size_t)l * NE + e) * 1024 * 1024, 1024, 0, 1024, 1024, (bf16*)((unsigned char*)WdnT + ((size_t)l * NE + e) * 1024 * 1024), 0, scr, r % I_DN, lane); }
        } }
        for (int it = F.gw; it < NL * (PC_QIDX - PC_WIDX - 8); it += F.NGW) { const int l = it / (PC_QIDX - PC_WIDX - 8), rr = PC_WIDX + 8 + it % (PC_QIDX - PC_WIDX - 8);
            *((v4u*)((unsigned char*)WinT + ((size_t)l * NP + rr) * D) + lane) = (v4u){0u, 0u, 0u, 0u}; }
        for (int it = F.gw; it < NL * 512; it += F.NGW) { const int l = it / 512, n = it % 512, h = n >> 6, d = n & 63; const float* wuv = IN(7) + (size_t)l * 128 * 512;
            bf16* p = WuvT + ((size_t)l * 512 + n) * 1024;
#pragma unroll
            for (int j = 0; j < 2; ++j) { const int k0 = 8 * lane + 512 * j; float v[8];
#pragma unroll
                for (int q = 0; q < 8; ++q) { const int k = k0 + q; const float x_ = wuv[(size_t)(k & 127) * 512 + h * 64 + d]; v[q] = ((k >> 7) == h) ? x_ : 0.f; }
                v4u o; o.x = pk2(v[0], v[1]); o.y = pk2(v[2], v[3]); o.z = pk2(v[4], v[5]); o.w = pk2(v[6], v[7]); *(v4u*)(p + k0) = o; } }
        for (int it = F.gw; it < NL * 32; it += F.NGW) { const int l = it >> 5, g = it & 31; const int idx = (l * 32 + g) * 64 + lane;
            const float lr = IN(10)[idx], li = IN(11)[idx], dt = expf(IN(17)[l * 32 + g]);
            const float er = expf(lr * dt); float sn, cs; sincosf(li * dt, &sn, &cs); const float ar = er * cs, ai = er * sn;
            S5A[idx] = (f32x2){ar, ai};
            float pr = ar, pi = ai;
#pragma unroll
            for (int q = 0; q < 5; ++q) { const float nr = pr * pr - pi * pi, ni = 2.f * pr * pi; pr = nr; pi = ni; }
            S5A[NL * 32 * 64 + idx] = (f32x2){pr, pi};
            const float nr_ = ar - 1.f, ni_ = ai, den = lr * lr + li * li; const float fr_ = (nr_ * lr + ni_ * li) / den, fi_ = (ni_ * lr - nr_ * li) / den;
            { f32x4 br4[4], bi4[4];
#pragma unroll
              for (int q = 0; q < 4; ++q) { br4[q] = *(const f32x4*)(IN(12) + (size_t)idx * 16 + 4 * q); bi4[q] = *(const f32x4*)(IN(13) + (size_t)idx * 16 + 4 * q); }
#pragma unroll
              for (int n = 0; n < 16; ++n) { const float br = br4[n >> 2][n & 3], bi = bi4[n >> 2][n & 3];
                  S5B[(size_t)idx * 16 + n] = (f32x2){fr_ * br - fi_ * bi, fr_ * bi + fi_ * br}; } } }
        for (int it = F.gw; it < 512; it += F.NGW) { const float* mp = IN(1) + (size_t)it * 1024; f32x4 v[4];
#pragma unroll
            for (int j = 0; j < 4; ++j) v[j] = *(const f32x4*)(mp + 4 * lane + 256 * j);
            store_row_f32_bf16(v, nullptr, MEMB + (size_t)it * 1024, lane); }
        const LnAff aff0 = ln_aff(IN(2), IN(3), lane);
        for (int m = F.gw; m < M; m += F.NGW) { const float* xp = IN(0) + (size_t)m * D; f32x4 v[4];
#pragma unroll
            for (int j = 0; j < 4; ++j) v[j] = *(const f32x4*)(xp + 4 * lane + 256 * j);
            ln_rows_pre(v, aff0); store_row_f32_bf16(v, nullptr, Hf + (size_t)m * D, lane); store_row_fp8(v, (unsigned char*)Hb + (size_t)m * D, lane); }
    }
    PHASE_END

    PHASE_BEGIN(1)
    {
        pg8::Dims g{2048, 2048, 2048}; MkvOrder S{F.G, F.bx, (const char*)MEMB, (const char*)WmkvT}; EpiMkv E{MKV};
        pg8::gemm_phase<EpiMkv, MkvOrder, true, true>(F.lds, g, S, E, F.tid);
    }
    PHASE_END

#define MOE_BLK0() do { if (F.tid < 32) CNTL[F.tid] = (int)__hip_atomic_load(CTLP + CW_CNT + l * 2048 + F.tid * 64, RLX_AGENT); __syncthreads(); \
        if (F.tid < 33) { int acc_ = 0; for (int k_ = 0; k_ < 32; ++k_) acc_ += (k_ < F.tid) ? ((CNTL[k_] + 255) >> 8) : 0; BLK0[F.tid] = acc_; } __syncthreads(); } while (0)
    for (int l = 0; l < NL; ++l) {
        PHASE_BEGIN(2)
        {
            pg8::Dims g{1024, 1024, 1024}; pg8::StaticOrder S; S.init(M, NP, F.G, F.bx, Hb, 1024, (const unsigned char*)WinT + (size_t)l * NP * D, 1024); EpiProjQ E{PROJ, NP, AEXT};
            pg8::gemm_phase<EpiProjQ, pg8::StaticOrder, true, true, true>(F.lds, g, S, E, F.tid);
        }
        PHASE_END

        PHASE_BEGIN(3)
        {
            { const float* kg = IN(5) + (size_t)l * 128; const float* cw = IN(8) + (size_t)l * 3 * 512; const float* cb = IN(9) + (size_t)l * 512;
              const float kg0 = kg[2 * lane], kg1 = kg[2 * lane + 1];
#pragma unroll 1
              for (int mb = F.gw; mb < M; mb += 4 * F.NGW) {
                unsigned cw2[4], kx[4]; v4u uu[4][3], gc[4][3], gb[4];
#pragma unroll
                for (int q = 0; q < 4; ++q) { int m = mb + q * F.NGW; m = m < M ? m : mb; const bf16* pr = PROJ + (size_t)m * NP; const int tl = m & (T - 1);
                    cw2[q] = *(const unsigned*)(pr + PC_CKV + 2 * lane); kx[q] = *(const unsigned*)(pr + PC_KIDX + 2 * (lane & 15)); gb[q] = *(const v4u*)(pr + PC_GB + 8 * lane);
#pragma unroll
                    for (int k = 0; k < 3; ++k) { const int back = 2 - k; const bf16* pp = pr - (size_t)(tl >= back ? back : 0) * NP;
                        uu[q][k] = *(const v4u*)(pp + PC_CU + 8 * lane); gc[q][k] = *(const v4u*)(pp + PC_GC + 8 * lane); } }
#pragma unroll
                for (int q = 0; q < 4; ++q) { const int m = mb + q * F.NGW; if (m < M) { const int tl = m & (T - 1);
                    const float c0 = bflo(cw2[q]), c1 = bfhi(cw2[q]);
                    const float rs = 1.f / sqrtf(wave_sum(c0 * c0 + c1 * c1) * (1.f / 128.f) + LN_EPS);
                    *(unsigned*)(KVN + (size_t)m * 128 + 2 * lane) = pk2(c0 * rs * kg0, c1 * rs * kg1);
                    if (lane < 16) *(unsigned*)(KIDX + (size_t)m * 32 + 2 * lane) = kx[q];
                    float y[8];
#pragma unroll
                    for (int i = 0; i < 8; ++i) y[i] = cb[8 * lane + i];
#pragma unroll
                    for (int k = 0; k < 3; ++k) { const int back = 2 - k; if (tl >= back) { const v4u u4 = uu[q][k], g4 = gc[q][k]; const float* wk = cw + k * 512 + 8 * lane;
                            y[0] += wk[0] * bflo(u4.x) * bflo(g4.x); y[1] += wk[1] * bfhi(u4.x) * bfhi(g4.x); y[2] += wk[2] * bflo(u4.y) * bflo(g4.y); y[3] += wk[3] * bfhi(u4.y) * bfhi(g4.y);
                            y[4] += wk[4] * bflo(u4.z) * bflo(g4.z); y[5] += wk[5] * bfhi(u4.z) * bfhi(g4.z); y[6] += wk[6] * bflo(u4.w) * bflo(g4.w); y[7] += wk[7] * bfhi(u4.w) * bfhi(g4.w); } }
                    const v4u b4 = gb[q];
                    v4u o; o.x = pk2(y[0] * bflo(b4.x), y[1] * bfhi(b4.x)); o.y = pk2(y[2] * bflo(b4.y), y[3] * bfhi(b4.y)); o.z = pk2(y[4] * bflo(b4.z), y[5] * bfhi(b4.z)); o.w = pk2(y[6] * bflo(b4.w), y[7] * bfhi(b4.w));
                    *(v4u*)(BR + (size_t)m * 2048 + 512 + 8 * lane) = o; } } } }
            __syncthreads();
            { pg8::Dims g{SSM_K * 2, 1024, 1024}; EOrder S{F.G, F.bx, (const char*)AEXT, (const char*)(WEW + (size_t)l * 32 * 256 * 512)}; EpiE E{(float*)SSE};
              pg8::gemm_phase<EpiE, EOrder, true, true>(F.lds, g, S, E, F.tid); }
            __syncthreads();
            __syncthreads();
            for (int u = F.bx; u < NB * 4 * (T / 256); u += F.G) { const int qblk = u % (T / 256), hd = (u / (T / 256)) & 3, b = u / (4 * (T / 256));
                memattn_unit(F.lds, PROJ, MKV + (size_t)l * 512 * 1024, BR, b, hd, qblk, F.tid); }
        }
        PHASE_END

        PHASE_BEGIN(4)
        {
            { int par = 0; float* sb0 = SCR + (size_t)F.bx * 2 * 8 * 8192;
              for (int i = 0; ; ++i) { const int rk = (i & 1) ? (i * F.G + (F.G - 1 - F.bx)) : (i * F.G + F.bx); if (rk >= M / 8) break;
                const int u = M / 8 - 1 - rk; const int b = u & 1, t0 = (u >> 1) * 8;
                dsa2_unit(F.lds, PROJ, KIDX, KVN, OLAT, sb0 + (size_t)par * 8 * 8192, b, t0, F.tid); if (t0 >= 256) par ^= 1; }
              __syncthreads(); }
#ifndef DUP_CARRY
#define DUP_CARRY 1
#endif
            for (int repc = 0; repc < DUP_CARRY; ++repc)
            for (int it = F.gw; it < NB * 32; it += F.NGW) { const int b = it >> 5, g = it & 31; const f32x2 aL = S5A[NL * 32 * 64 + (l * 32 + g) * 64 + lane];
                float hr = 0.f, hi_ = 0.f; bf16* ap = AEXT + ((size_t)(g * 512 + b * 256)) * SSM_K + 512 + lane;
                for (int c0 = 0; c0 < SSM_NC; c0 += 8) { f32x2 e[8];
#pragma unroll
                    for (int k = 0; k < 8; ++k) { const float* ep_ = (const float*)SSE + ((size_t)(b * SSM_NC + c0 + k) * 32 + g) * 128 + lane; e[k] = (f32x2){ep_[0], ep_[64]}; }
#pragma unroll
                    for (int k = 0; k < 8; ++k) { ap[(size_t)(c0 + k) * SSM_K] = (bf16)f2bf(hr); ap[(size_t)(c0 + k) * SSM_K + 64] = (bf16)f2bf(hi_);
                        const float nr = aL[0] * hr - aL[1] * hi_ + e[k][0], ni = aL[0] * hi_ + aL[1] * hr + e[k][1]; hr = nr; hi_ = ni; } } }
        }
        PHASE_END

        PHASE_BEGIN(5)
        {
            const int half = F.G >> 1;
            if (F.bx < half) {
                pg8::Dims g{SSM_K * 2, SSM_K * 2, SSM_K * 2}; SsmOrder S{half, F.bx, (const char*)AEXT, (const char*)(WSSM + (size_t)l * 32 * 512 * SSM_K)}; EpiSsm E{Zb};
                pg8::gemm_phase<EpiSsm, SsmOrder, true, true>(F.lds, g, S, E, F.tid);
            } else {
                pg8::Dims g{2048, 2048, 2048}; pg8::StaticOrder S; S.init(M, 512, F.G - half, F.bx - half, OLAT, 2048, WuvT + (size_t)l * 512 * 1024, 2048);
                EpiBf16 E{BR, 2048};
                pg8::gemm_phase<EpiBf16, pg8::StaticOrder, true, true>(F.lds, g, S, E, F.tid);
            }
        }
        PHASE_END

        PHASE_BEGIN(6)
        {
            pg8::Dims g{1024, 1024, 1024}; pg8::StaticOrder S; S.init(M, 512, F.G, F.bx, Zb, 1024, WgluT + (size_t)l * 512 * 512, 1024);
            EpiGlu E{Zb, 512, IN(19) + (size_t)l * 512, BR + 1024, 2048};
            pg8::gemm_phase<EpiGlu, pg8::StaticOrder, true, true>(F.lds, g, S, E, F.tid);
        }
        PHASE_END

        PHASE_BEGIN(7)
        {
            pg8::Dims g{4096, 1024, 1024}; MergeOrder S{F.G, F.bx, (const char*)BR, (const char*)(WbrT + (size_t)l * 4 * 1024 * 512)};
            EpiMerge E{PROJ + PC_GATE, NP, MRGB};
            pg8::gemm_phase<EpiMerge, MergeOrder, true, true>(F.lds, g, S, E, F.tid);
        }
        PHASE_END

        PHASE_BEGIN(8)
        {
            pg8::Dims g{2048, 2048, 2048}; pg8::StaticOrder S; S.init(M, 1024, F.G, F.bx, MRGB, 2048, WoT + (size_t)l * 1024 * 1024, 2048); EpiWo E{Hf, Vf};
            pg8::gemm_phase<EpiWo, pg8::StaticOrder, true, true>(F.lds, g, S, E, F.tid);
        }
        PHASE_END

        PHASE_BEGIN(9)
        {
            constexpr int HP = 2064, HLO_OFF = 16 * HP, PART_OFF = 66560;
            LAS unsigned char* hhi = F.lds; LAS unsigned char* hlo = F.lds + HLO_OFF; LAS float* part = (LAS float*)(F.lds + PART_OFF);
            LAS unsigned* wcnt = (LAS unsigned*)(F.lds + LDSCTL_OFF + 2048); LAS unsigned* wbase = wcnt + 32; LAS unsigned* asg = wcnt + 64; LAS float* asgg = (LAS float*)(asg + 256);
            const float* wr_ = IN(25) + (size_t)l * 1024 * 32; const float* brt = IN(26) + (size_t)l * 32;
            unsigned* cnt = CTLP + CW_CNT + l * 2048;
            const float* g1 = IN(23) + (size_t)l * D; const float* b1 = IN(24) + (size_t)l * D;
            const int fn = lane & 15, fkq = lane >> 4;
            v4u whi[4][2], wlo[4][2];
#pragma unroll
            for (int ks = 0; ks < 4; ++ks)
#pragma unroll
                for (int mt = 0; mt < 2; ++mt) { unsigned hh[8], ll[8];
#pragma unroll
                    for (int i = 0; i < 8; ++i) { const float f = wr_[(size_t)(128 * wave + 32 * ks + 8 * fkq + i) * 32 + 16 * mt + fn]; hh[i] = f2bf(f); ll[i] = f2bf(f - __builtin_bit_cast(float, hh[i] << 16)); }
                    whi[ks][mt] = (v4u){hh[0] | (hh[1] << 16), hh[2] | (hh[3] << 16), hh[4] | (hh[5] << 16), hh[6] | (hh[7] << 16)};
                    wlo[ks][mt] = (v4u){ll[0] | (ll[1] << 16), ll[2] | (ll[3] << 16), ll[4] | (ll[5] << 16), ll[6] | (ll[7] << 16)}; }
            const LnAff aff1 = ln_aff(g1, b1, lane);
            for (int blk = F.bx; blk < M / 64; blk += F.G) {
                if (F.tid < 32) wcnt[F.tid] = 0u;
                __syncthreads();
                v2u raw[2][4];
#pragma unroll
                for (int tk = 0; tk < 2; ++tk)
#pragma unroll
                    for (int j = 0; j < 4; ++j) raw[tk][j] = *(const v2u*)(Vf + (size_t)(blk * 64 + 2 * wave + tk) * D + 4 * lane + 256 * j);
#pragma unroll 1
                for (int rd = 0; rd < 4; ++rd) { const int m0 = blk * 64 + rd * 16 + 2 * wave;
#pragma unroll
                    for (int tk = 0; tk < 2; ++tk) { f32x4 v[4];
#pragma unroll
                        for (int j = 0; j < 4; ++j) v[j] = (f32x4){bflo(raw[tk][j].x), bfhi(raw[tk][j].x), bflo(raw[tk][j].y), bfhi(raw[tk][j].y)};
                        ln_rows_pre(v, aff1); store_row_f32_bf16(v, nullptr, H1 + (size_t)(m0 + tk) * D, lane); store_row_fp8(v, (unsigned char*)H1B + (size_t)(m0 + tk) * D, lane);
#pragma unroll
                        for (int j = 0; j < 4; ++j) { unsigned hh[4]; float rr[4];
#pragma unroll
                            for (int q = 0; q < 4; ++q) { hh[q] = f2bf(v[j][q]); rr[q] = v[j][q] - __builtin_bit_cast(float, hh[q] << 16); }
                            const int o_ = (2 * wave + tk) * HP + (4 * lane + 256 * j) * 2;
                            *(LAS v2u*)(hhi + o_) = (v2u){hh[0] | (hh[1] << 16), hh[2] | (hh[3] << 16)}; *(LAS v2u*)(hlo + o_) = (v2u){pk2(rr[0], rr[1]), pk2(rr[2], rr[3])}; } }
                    if (rd + 1 < 4) {
#pragma unroll
                        for (int tk = 0; tk < 2; ++tk)
#pragma unroll
                            for (int j = 0; j < 4; ++j) raw[tk][j] = *(const v2u*)(Vf + (size_t)(m0 + 16 + tk) * D + 4 * lane + 256 * j); }
                    __syncthreads();
                    { f32x4 acc[2] = {{0.f, 0.f, 0.f, 0.f}, {0.f, 0.f, 0.f, 0.f}};
#pragma unroll
                      for (int ks = 0; ks < 4; ++ks) { const int ko = fn * HP + (128 * wave + 32 * ks + 8 * fkq) * 2;
                          const bf16x8 bh = *(const LAS bf16x8*)(hhi + ko), bl = *(const LAS bf16x8*)(hlo + ko);
#pragma unroll
                          for (int mt = 0; mt < 2; ++mt) { const bf16x8 ah = __builtin_bit_cast(bf16x8, whi[ks][mt]), al = __builtin_bit_cast(bf16x8, wlo[ks][mt]);
                              acc[mt] = __builtin_amdgcn_mfma_f32_16x16x32_bf16(ah, bh, acc[mt], 0, 0, 0); acc[mt] = __builtin_amdgcn_mfma_f32_16x16x32_bf16(al, bh, acc[mt], 0, 0, 0);
                              acc[mt] = __builtin_amdgcn_mfma_f32_16x16x32_bf16(ah, bl, acc[mt], 0, 0, 0); } }
#pragma unroll
                      for (int mt = 0; mt < 2; ++mt) *(LAS f32x4*)(part + (wave * 16 + fn) * 32 + 16 * mt + 4 * fkq) = acc[mt]; }
                    __syncthreads();
                    const int eq = lane & 7; const int lopr_ = lane_op(); const f32x4 be4 = *(const f32x4*)(brt + 4 * eq);
#pragma unroll 1
                    for (int tk = 0; tk < 2; ++tk) { float cur[4] = {be4[0], be4[1], be4[2], be4[3]};
#pragma unroll
                        for (int w = 0; w < 8; ++w) { const f32x4 p = *(const LAS f32x4*)(part + (w * 16 + 2 * wave + tk) * 32 + 4 * eq);
#pragma unroll
                            for (int j = 0; j < 4; ++j) cur[j] += p[j]; }
                        float val[4]; int idx[4];
#pragma unroll
                        for (int k = 0; k < 4; ++k) { float bv = cur[0]; int bi = 4 * eq;
#pragma unroll
                            for (int j = 1; j < 4; ++j) if (cur[j] > bv) { bv = cur[j]; bi = 4 * eq + j; }
#pragma unroll
                            for (int o = 1; o < 8; o <<= 1) { const float ov = SHX(bv, o, lopr_); const int oi = SHX(bi, o, lopr_); if (ov > bv || (ov == bv && oi < bi)) { bv = ov; bi = oi; } }
                            val[k] = bv; idx[k] = bi;
#pragma unroll
                            for (int j = 0; j < 4; ++j) if (bi == 4 * eq + j) cur[j] = -INFINITY; }
                        const float e1 = __expf(val[1] - val[0]), e2 = __expf(val[2] - val[0]), e3 = __expf(val[3] - val[0]); const float inv = 1.f / (1.f + e1 + e2 + e3);
                        const float gt[4] = {inv, e1 * inv, e2 * inv, e3 * inv};
                        if (lane < 4) { int ee = idx[0]; float gg = gt[0];
#pragma unroll
                            for (int k = 1; k < 4; ++k) if (lane == k) { ee = idx[k]; gg = gt[k]; }
                            const unsigned rank = __hip_atomic_fetch_add(&wcnt[ee], 1u, __ATOMIC_RELAXED, __HIP_MEMORY_SCOPE_WORKGROUP);
                            const int tl_ = rd * 16 + 2 * wave + tk; asg[tl_ * 4 + lane] = (unsigned)ee | (rank << 8); asgg[tl_ * 4 + lane] = gg; } }
                    LDS_WAIT();
                }
                __syncthreads();
                if (F.tid < 32) { const unsigned c = wcnt[F.tid]; wbase[F.tid] = c ? __hip_atomic_fetch_add(cnt + F.tid * 64, c, RLX_AGENT) : 0u; }
                __syncthreads();
                if (F.tid < 256) { const unsigned a_ = asg[F.tid]; const int ee = (int)(a_ & 255u); const unsigned slot = wbase[ee] + (a_ >> 8); const int m = blk * 64 + (F.tid >> 2);
                    TOK[(size_t)ee * M + slot] = m; GATE[(size_t)ee * M + slot] = asgg[F.tid]; SLOT[(size_t)m * 4 + (F.tid & 3)] = ee * M + (int)slot; }
                __syncthreads();
            }
        }
        PHASE_END

        PHASE_BEGIN(11)
        {
            LAS int* CNTL = (LAS int*)(ldsq + MISC_OFF + 272);
            MOE_BLK0();
            for (int mb = F.gw; mb < M; mb += 16 * F.NGW) { const int m = mb + (lane >> 2) * F.NGW;
                if (m < M) { const int sl = SLOT[(size_t)m * 4 + (lane & 3)]; const int e = sl >> 14, s = sl & (M - 1); GROW[(size_t)BLK0[e] * 256 + s] = GATE[(size_t)e * M + s]; } }
            pg8::Dims g{1024, 1024, 1024}; MoeOrder S{F.G, F.bx, 8, BLK0[32] * 8, BLK0, (const char*)H1B, (const char*)WupT + (size_t)l * NE * 2048 * 1024, (size_t)0, (size_t)2048 * 1024, (size_t)256 * 1024, TOK, CNTL};
            EpiUp E{IN(28) + (size_t)l * NE * 2048, (unsigned char*)ACT};
            pg8::gemm_phase<EpiUp, MoeOrder, true, true, true, true>(F.lds, g, S, E, F.tid);
        }
        PHASE_END

        PHASE_BEGIN(12)
        {
            { LAS int* CNTL = (LAS int*)(ldsq + MISC_OFF + 272); MOE_BLK0(); }
            pg8::Dims g{1024, 1024, 1024}; MoeOrder S{F.G, F.bx, 4, BLK0[32] * 4, BLK0, (const char*)ACT, (const char*)WdnT + (size_t)l * NE * 1024 * 1024, (size_t)256 * 1024, (size_t)1024 * 1024, (size_t)256 * 1024, nullptr, nullptr};
            EpiDown E{IN(30) + (size_t)l * NE * 1024, GROW, YS};
            pg8::gemm_phase<EpiDown, MoeOrder, true, true, true>(F.lds, g, S, E, F.tid);
        }
        PHASE_END

        PHASE_BEGIN(13)
        {
            { LAS int* CNTL = (LAS int*)(ldsq + MISC_OFF + 272); MOE_BLK0(); }
#define LL_ISSUE(mm, s4, hh, yy) do { const unsigned ho_ = (unsigned)(mm) * 2048u + 8u * (unsigned)lane; \
                _Pragma("unroll") for (int j = 0; j < 4; ++j) hh[j] = *(const v2u*)((const char*)H1 + ho_ + 512 * j); \
                _Pragma("unroll") for (int k = 0; k < 4; ++k) { const unsigned sl = s4[k]; const unsigned ro_ = ((unsigned)BLK0[sl >> 14] * 256u + (sl & (unsigned)(M - 1))) * 2048u + 8u * (unsigned)lane; \
                    _Pragma("unroll") for (int j = 0; j < 4; ++j) yy[k][j] = *(const v2u*)((const char*)YS + ro_ + 512 * j); } } while (0)
#define LL_FIN(mm, hC, yC) { f32x4 v[4]; \
                  _Pragma("unroll") for (int j = 0; j < 4; ++j) { v[j] = (f32x4){bflo(hC[j].x), bfhi(hC[j].x), bflo(hC[j].y), bfhi(hC[j].y)} * DN_ALPHA; \
                      _Pragma("unroll") for (int k = 0; k < 4; ++k) { const v2u y2 = yC[k][j]; v[j][0] += bflo(y2.x); v[j][1] += bfhi(y2.x); v[j][2] += bflo(y2.y); v[j][3] += bfhi(y2.y); } } \
                  ln_rows_pre(v, aff2); \
                  if (l == NL - 1) store_row_f32_bf16(v, OUTP + (size_t)(mm) * D, nullptr, lane); \
                  else { store_row_f32_bf16(v, nullptr, Hf + (size_t)(mm) * D, lane); store_row_fp8(v, (unsigned char*)Hb + (size_t)(mm) * D, lane); } }
            const LnAff aff2 = ln_aff(IN(31) + (size_t)l * D, IN(32) + (size_t)l * D, lane);
            { int m = F.gw; const int st = F.NGW; v4u sa = *(const v4u*)(SLOT + (size_t)m * 4), sb = *(const v4u*)(SLOT + (size_t)(m + st < M ? m + st : m) * 4);
#pragma unroll 1
              for (; m < M; m += 2 * st) { const bool two = m + st < M; const int m1 = two ? m + st : m; v2u hA[4], yA[4][4], hB[4], yB[4][4];
                  LL_ISSUE(m, sa, hA, yA); LL_ISSUE(m1, sb, hB, yB);
                  { const int n0 = m + 2 * st; if (n0 < M) { sa = *(const v4u*)(SLOT + (size_t)n0 * 4); sb = *(const v4u*)(SLOT + (size_t)(n0 + st < M ? n0 + st : n0) * 4); } }
                  LL_FIN(m, hA, yA)
                  if (two) LL_FIN(m1, hB, yB) } }
#undef LL_FIN
#undef LL_ISSUE
        }
        PHASE_END
    }
#undef PHASE_BEGIN
#undef PHASE_END
}

extern "C" void kernel_launch(void* const* d_in, const int* in_sizes, int n_in, void* d_out, int out_size, void* d_ws, size_t ws_size, hipStream_t stream) {
    static int grid = 0;
    if (grid == 0) {
        if (n_in != 33 || out_size != M * D || ws_size < WS_END) { fprintf(stderr, "kernel_launch: unexpected shapes (n_in %d out %d ws %zu need %zu)\n", n_in, out_size, ws_size, (size_t)WS_END); grid = -1; return; }
        int dev = 0, cus = 0, per_cu = 0;
        if (hipGetDevice(&dev) != hipSuccess || hipDeviceGetAttribute(&cus, hipDeviceAttributeMultiprocessorCount, dev) != hipSuccess) { grid = -1; return; }
        if (hipFuncSetAttribute((const void*)fwd, hipFuncAttributeMaxDynamicSharedMemorySize, LDS_BYTES) != hipSuccess) { fprintf(stderr, "kernel_launch: hipFuncSetAttribute failed\n"); grid = -1; return; }
        if (hipOccupancyMaxActiveBlocksPerMultiprocessor(&per_cu, (const void*)fwd, NWAVES * 64, LDS_BYTES) != hipSuccess || per_cu < 1) fprintf(stderr, "kernel_launch: occupancy query says %d\n", per_cu);
        (void)hipGetLastError();
        grid = cus;
    }
    if (grid < 0) return;
    (void)hipMemsetAsync((char*)d_ws + WS_CTL, 0, CTL_ZERO_BYTES, stream);
    Args a{};
    for (int i = 0; i < 33; ++i) a.in[i] = (const float*)d_in[i];
    a.out = (float*)d_out; a.ws = (unsigned char*)d_ws;
#if ONE_LAUNCH
    a.ph_lo = 0; a.ph_hi = NPHASE;
    hipLaunchKernelGGL(fwd, dim3(grid), dim3(NWAVES * 64), LDS_BYTES, stream, a);
#else
    for (int p = 0; p < NPHASE; ++p) { a.ph_lo = p; a.ph_hi = p + 1; hipLaunchKernelGGL(fwd, dim3(grid), dim3(NWAVES * 64), LDS_BYTES, stream, a); }
#endif
}
```

```cpp
#include <hip/hip_runtime.h>
#include <cstdio>
#include <cstdint>

#ifndef ONE_LAUNCH
#define ONE_LAUNCH 1
#endif

#define LAS __attribute__((address_space(3)))
#define GAS __attribute__((address_space(1)))
typedef unsigned short bf16;
typedef unsigned v4u __attribute__((ext_vector_type(4)));
typedef unsigned v2u __attribute__((ext_vector_type(2)));
typedef float f32x4 __attribute__((ext_vector_type(4)));
typedef float f32x2 __attribute__((ext_vector_type(2)));
typedef short bf16x8 __attribute__((ext_vector_type(8)));
typedef short v4i16_t __attribute__((ext_vector_type(4)));

namespace pg8 {
constexpr int BM = 256, BK = 64, HALF = 128, HTB = HALF * BK * 2, STAGE_BYTES = 8 * HTB, NXCD = 8, WGM = 8;
__host__ __device__ __forceinline__ int lds_byte(int r, int c) { const int st = (r >> 4) * 2 + (c >> 5), rr = r & 15, cc = c & 31, ob = rr * 64 + cc * 2; return st * 1024 + (ob ^ (((ob >> 9) & 1) << 5)); }
__host__ __device__ __forceinline__ void stage_rc(int b, int& R, int& C) { const int st = b / 1024, sb = b % 1024, swz = sb ^ (((sb >> 9) & 1) << 5); R = (st >> 1) * 16 + swz / 64; C = (st & 1) * 32 + (swz % 64) / 2; }
__host__ __device__ __forceinline__ int perm32(int rho) { const int n = rho >> 4, i = rho & 15; return 8 * (i >> 2) + 4 * n + (i & 3); }

constexpr int GATHER_LIST_OFF = 131072 + 2048;
struct Unit { int pm, pn, z; const char* A; const char* B; };
struct Dims { int lda, ldb, K; };
typedef int v8i_t __attribute__((ext_vector_type(8)));
typedef int v4i_t __attribute__((ext_vector_type(4)));

__device__ __forceinline__ void tile_of(int wgid, int nM, int nN, int& pm, int& pn) {
    const int nwg = nM * nN;
    { const int q = nwg / NXCD, r = nwg % NXCD, xcd = wgid % NXCD, off = wgid / NXCD; wgid = (xcd < r ? xcd * (q + 1) : r * (q + 1) + (xcd - r) * q) + off; }
    const int nig = WGM * nN, gid = wgid / nig, fm = gid * WGM, gsz = (nM - fm) < WGM ? (nM - fm) : WGM;
    pm = fm + ((wgid % nig) % gsz); pn = (wgid % nig) / gsz;
}
struct StaticOrder {
    int nM, nN, nwg, G, c; const char* A; const char* B; size_t at, bt;
    __device__ void init(int M, int N, int G_, int c_, const void* A_, int lda, const void* B_, int ldb) { nM = M / BM; nN = N / BM; nwg = nM * nN; G = G_; c = c_; A = (const char*)A_; B = (const char*)B_; at = (size_t)BM * lda; bt = (size_t)BM * ldb; }
    __device__ __forceinline__ bool next(int i, Unit& u) const {
        const long Lx = (long)i * G + c; if (Lx >= nwg) return false;
        int pm, pn; tile_of((int)Lx, nM, nN, pm, pn); u.pm = pm; u.pn = pn; u.z = 0; u.A = A + (size_t)pm * at; u.B = B + (size_t)pn * bt; return true;
    }
};

__device__ __forceinline__ unsigned cvt_pk_bf16(float lo, float hi) { unsigned r; asm volatile("v_cvt_pk_bf16_f32 %0, %1, %2" : "=v"(r) : "v"(lo), "v"(hi)); return r; }

template <class Epi, class Sched, bool ALIGN_EPI = false, bool SP2 = false, bool FP8 = false  ,
          bool GATHER = false  >
__device__ __forceinline__ void gemm_phase(LAS unsigned char* lds, const Dims g, const Sched& S, const Epi& E, int tid_in) {
    int tid = tid_in; asm volatile("" : "+v"(tid));
    const int wid = __builtin_amdgcn_readfirstlane(tid >> 6), lane = tid & 63, wr = wid >> 2, wc = wid & 3, fr = lane & 15, fq = lane >> 4;
    const int nt = g.K / (BK * 2);
    unsigned voffA[2], voffB[2];
#pragma unroll
    for (int i = 0; i < 2; ++i) { int R, C; stage_rc(tid * 16 + i * 8192, R, C); const int Rb = Epi::PERM ? ((R & ~31) + perm32(R & 31)) : R;
        voffA[i] = (unsigned)(R * g.lda + C * 2); voffB[i] = (unsigned)(Rb * g.ldb + C * 2); }
    static_assert(!GATHER || SP2, "gathered A rows: SP2 schedule only");
    unsigned vgc[2][2]; bool last_g = false; int nxp_ = 0, gR_ = 0; unsigned gC_ = 0u; (void)last_g; (void)nxp_;
    if constexpr (GATHER) { int R, C; stage_rc(tid * 16, R, C); gR_ = R; gC_ = (unsigned)(C * 2); }
    LAS int* const ntok_ = (LAS int*)(lds + GATHER_LIST_OFF);
#define PG8_GLIST(u, par) do { if (tid < 256) { const int* tb_; int s0_, ce_; S.rowinfo(u, tb_, s0_, ce_); const int s_ = s0_ + tid; ntok_[(par) * 256 + tid] = tb_[s_ < ce_ ? s_ : 0]; } } while (0)
#define PG8_GOFF(par, vg) do { _Pragma("unroll") for (int _h = 0; _h < 2; ++_h) _Pragma("unroll") for (int _i = 0; _i < 2; ++_i) vg[_h][_i] = (unsigned)ntok_[(par) * 256 + gR_ + 64 * _i + 128 * _h] * 1024u + gC_; } while (0)
#define PG8_STAGE_A(slot, ptr, half, SEL) do { if constexpr (GATHER) { if (SEL) { unsigned vt_[2] = {vgc[half][0], vgc[half][1]}; if (last_g) { _Pragma("unroll") for (int _i = 0; _i < 2; ++_i) vt_[_i] = (unsigned)ntok_[nxp_ * 256 + gR_ + 64 * _i + 128 * (half)] * 1024u + gC_; } PG8_STAGE(slot, ptr, vt_); } else PG8_STAGE(slot, ptr, vgc[half]); } else PG8_STAGE(slot, (ptr) + ((half) ? hstepA : (size_t)0), voffA); } while (0)
    const size_t kstep = (size_t)(BK * 2);
    const size_t hstepA = (size_t)HALF * g.lda, hstepB = (size_t)HALF * g.ldb;
    const unsigned ldsw = (unsigned)wid * 1024u;
    const int aoff0 = lds_byte(wr * 64 + fr, fq * 8), aoff1 = aoff0 + 1024;
    const int boff0 = lds_byte(wc * 32 + fr, fq * 8), boff1 = boff0 + 1024;
#define PG8_SA(b, h) (((b) * 2 + (h)) * HTB)
#define PG8_SB(b, h) ((4 + (b) * 2 + (h)) * HTB)
#define PG8_STAGE(bufoff, gbase, voff) do { _Pragma("unroll") for (int _i = 0; _i < 2; ++_i) \
        __builtin_amdgcn_global_load_lds((const unsigned*)((const char*)(gbase) + (voff)[_i]), (LAS unsigned*)(lds + (bufoff) + ldsw + _i * 8192), 16, 0, 0); } while (0)
#define PG8_LDA(dst, b, h) do { _Pragma("unroll") for (int m = 0; m < 4; ++m) _Pragma("unroll") for (int k = 0; k < 2; ++k) dst[m][k] = *(const LAS bf16x8*)(lds + PG8_SA(b, h) + (k ? aoff1 : aoff0) + m * 2048); } while (0)
#define PG8_LDB(dst, b, h) do { _Pragma("unroll") for (int n = 0; n < 2; ++n) _Pragma("unroll") for (int k = 0; k < 2; ++k) dst[n][k] = *(const LAS bf16x8*)(lds + PG8_SB(b, h) + (k ? boff1 : boff0) + n * 2048); } while (0)
#define PG8_MMA(ai, bj, At, Bt) do { __builtin_amdgcn_s_setprio(1); _Pragma("unroll") for (int m = 0; m < 4; ++m) _Pragma("unroll") for (int n = 0; n < 2; ++n) _Pragma("unroll") for (int k = 0; k < 2; ++k) { \
        if constexpr (FP8) acc[ai][bj][m][n] = __builtin_bit_cast(f32x4, __builtin_amdgcn_mfma_i32_16x16x64_i8(__builtin_bit_cast(v4i_t, Bt[n][k]), __builtin_bit_cast(v4i_t, At[m][k]), __builtin_bit_cast(v4i_t, acc[ai][bj][m][n]), 0, 0, 0)); \
        else acc[ai][bj][m][n] = __builtin_amdgcn_mfma_f32_16x16x32_bf16(Bt[n][k], At[m][k], acc[ai][bj][m][n], 0, 0, 0); } __builtin_amdgcn_s_setprio(0); } while (0)
#define PG8_WAIT_V(n) asm volatile("s_waitcnt vmcnt(" #n ")" ::: "memory")
#define PG8_WAIT_L(n) asm volatile("s_waitcnt lgkmcnt(" #n ")" ::: "memory")
#define PG8_BAR __builtin_amdgcn_s_barrier()
#define PG8_SCHED __builtin_amdgcn_sched_barrier(0)
    Unit cur, nxt; int ui = 0;
    if (!S.next(0, cur)) return;
    f32x4 acc[2][2][4][2];
    float zq = 0.f; asm volatile("" : "+v"(zq));
#pragma unroll
    for (int a = 0; a < 2; ++a)
#pragma unroll
        for (int b = 0; b < 2; ++b)
#pragma unroll
            for (int m = 0; m < 4; ++m)
#pragma unroll
                for (int n = 0; n < 2; ++n) acc[a][b][m][n] = (f32x4){zq, zq, zq, zq};
    bf16x8 At[4][2], B0[2][2], B1[2][2];
    const char* cA = cur.A; const char* cB = cur.B;
    if constexpr (SP2) {
        if constexpr (GATHER) { PG8_GLIST(cur, 0); PG8_WAIT_L(0); PG8_BAR; PG8_GOFF(0, vgc); }
        PG8_STAGE(PG8_SB(0, 0), cB, voffB); PG8_STAGE(PG8_SB(0, 1), cB + hstepB, voffB); PG8_STAGE_A(PG8_SA(0, 0), cA, 0, 0); PG8_STAGE_A(PG8_SA(0, 1), cA, 1, 0);
        if (wr == 1) PG8_BAR;
        PG8_WAIT_V(2); PG8_BAR;
        PG8_STAGE(PG8_SB(1, 0), cB + kstep, voffB); PG8_STAGE_A(PG8_SA(1, 0), cA + kstep, 0, 0); PG8_STAGE(PG8_SB(1, 1), cB + hstepB + kstep, voffB);
        PG8_WAIT_V(6); PG8_BAR;
    } else {
        PG8_STAGE(PG8_SB(0, 0), cB, voffB); PG8_STAGE(PG8_SA(0, 0), cA, voffA); PG8_STAGE(PG8_SB(0, 1), cB + hstepB, voffB); PG8_STAGE(PG8_SA(0, 1), cA + hstepA, voffA);
        if (wr == 1) PG8_BAR;
        PG8_WAIT_V(4); PG8_BAR;
        PG8_STAGE(PG8_SB(1, 0), cB + kstep, voffB); PG8_STAGE(PG8_SA(1, 0), cA + kstep, voffA); PG8_STAGE(PG8_SB(1, 1), cB + hstepB + kstep, voffB);
        PG8_WAIT_V(6); PG8_BAR;
    }
    for (;;) {
        const bool has_next = S.next(ui + 1, nxt);
        const char* nA = has_next ? nxt.A : cA; const char* nB = has_next ? nxt.B : cB;
        if constexpr (GATHER) { if (has_next) PG8_GLIST(nxt, (ui + 1) & 1); }
#pragma unroll 1
        for (int t = 0; t < nt; t += 2) {
            const bool last = (t == nt - 2);
            const char* a1 = cA + (size_t)(t + 1) * kstep;
            const char* a2 = last ? nA : cA + (size_t)(t + 2) * kstep; const char* b2 = last ? nB : cB + (size_t)(t + 2) * kstep;
            const char* a3 = a2 + kstep; const char* b3 = b2 + kstep;
            if constexpr (SP2) {
            if constexpr (GATHER) { last_g = last && has_next; nxp_ = (ui + 1) & 1; }
            PG8_LDB(B0, 0, 0); PG8_LDB(B1, 0, 1); PG8_SCHED; PG8_LDA(At, 0, 0); PG8_STAGE_A(PG8_SA(1, 1), a1, 1, 0);
            PG8_WAIT_V(8); PG8_WAIT_L(0); PG8_BAR; PG8_MMA(0, 0, At, B0); PG8_MMA(0, 1, At, B1); PG8_BAR; PG8_SCHED;
            PG8_LDA(At, 0, 1); PG8_STAGE(PG8_SB(0, 0), b2, voffB); PG8_STAGE(PG8_SB(0, 1), b2 + hstepB, voffB); PG8_STAGE_A(PG8_SA(0, 0), a2, 0, 1);
            PG8_WAIT_V(8); PG8_WAIT_L(0); PG8_BAR; PG8_MMA(1, 0, At, B0); PG8_MMA(1, 1, At, B1); PG8_BAR; PG8_SCHED;
            PG8_LDB(B0, 1, 0); PG8_LDB(B1, 1, 1); PG8_SCHED; PG8_LDA(At, 1, 0); PG8_STAGE_A(PG8_SA(0, 1), a2, 1, 1);
            PG8_WAIT_V(8); PG8_WAIT_L(0); PG8_BAR; PG8_MMA(0, 0, At, B0); PG8_MMA(0, 1, At, B1); PG8_BAR; PG8_SCHED;
            PG8_LDA(At, 1, 1); PG8_STAGE(PG8_SB(1, 0), b3, voffB); PG8_STAGE(PG8_SB(1, 1), b3 + hstepB, voffB); PG8_STAGE_A(PG8_SA(1, 0), a3, 0, 1);
            PG8_WAIT_V(8); PG8_WAIT_L(0); PG8_BAR; PG8_MMA(1, 0, At, B0); PG8_MMA(1, 1, At, B1); PG8_BAR; PG8_SCHED;
            } else {
            PG8_LDB(B0, 0, 0); PG8_SCHED; PG8_LDA(At, 0, 0); PG8_STAGE(PG8_SA(1, 1), a1 + hstepA, voffA);
            PG8_WAIT_L(8); PG8_BAR; PG8_WAIT_L(0); PG8_MMA(0, 0, At, B0); PG8_BAR; PG8_SCHED;
            PG8_LDB(B1, 0, 1); PG8_STAGE(PG8_SB(0, 0), b2, voffB);
            PG8_BAR; PG8_WAIT_L(0); PG8_MMA(0, 1, At, B1); PG8_BAR;
            PG8_LDA(At, 0, 1); PG8_STAGE(PG8_SA(0, 0), a2, voffA);
            PG8_BAR; PG8_WAIT_L(0); PG8_MMA(1, 0, At, B0); PG8_BAR; PG8_SCHED;
            PG8_STAGE(PG8_SB(0, 1), b2 + hstepB, voffB);
            PG8_WAIT_V(6); PG8_BAR; PG8_MMA(1, 1, At, B1); PG8_BAR;
            PG8_LDB(B0, 1, 0); PG8_SCHED; PG8_LDA(At, 1, 0); PG8_STAGE(PG8_SA(0, 1), a2 + hstepA, voffA);
            PG8_WAIT_L(8); PG8_BAR; PG8_WAIT_L(0); PG8_MMA(0, 0, At, B0); PG8_BAR; PG8_SCHED;
            PG8_LDB(B1, 1, 1); PG8_STAGE(PG8_SB(1, 0), b3, voffB);
            PG8_BAR; PG8_WAIT_L(0); PG8_MMA(0, 1, At, B1); PG8_BAR;
            PG8_LDA(At, 1, 1); PG8_STAGE(PG8_SA(1, 0), a3, voffA);
            PG8_BAR; PG8_WAIT_L(0); PG8_MMA(1, 0, At, B0); PG8_BAR; PG8_SCHED;
            PG8_STAGE(PG8_SB(1, 1), b3 + hstepB, voffB);
            PG8_WAIT_V(6); PG8_BAR; PG8_MMA(1, 1, At, B1); PG8_BAR;
            }
        }
        if constexpr (ALIGN_EPI) { if (wr == 0) PG8_BAR; }
        E(acc, cur, wr, wc, fr, fq);
        if (!has_next) break;
#pragma unroll
        for (int a = 0; a < 2; ++a)
#pragma unroll
            for (int b = 0; b < 2; ++b)
#pragma unroll
                for (int m = 0; m < 4; ++m)
#pragma unroll
                    for (int n = 0; n < 2; ++n) acc[a][b][m][n] = (f32x4){zq, zq, zq, zq};
        cur = nxt; cA = nA; cB = nB; ++ui;
        if constexpr (GATHER) PG8_GOFF(ui & 1, vgc);
        if constexpr (ALIGN_EPI) { if (wr == 1) PG8_BAR; }
    }
    PG8_WAIT_V(0);
    if constexpr (!ALIGN_EPI) { if (wr == 0) PG8_BAR; }
    PG8_BAR;
#undef PG8_GOFF
#undef PG8_GLIST
#undef PG8_STAGE_A
#undef PG8_SA
#undef PG8_SB
#undef PG8_STAGE
#undef PG8_LDA
#undef PG8_LDB
#undef PG8_MMA
#undef PG8_WAIT_V
#undef PG8_WAIT_L
#undef PG8_BAR
#undef PG8_SCHED
}
}

constexpr int NB = 2, T = 8192, D = 1024, M = NB * T, NL = 4;
constexpr int DIN = 7592, NP = 8192;
constexpr int PC_QLAT = 0, PC_CKV = 1024, PC_KIDX = 1152, PC_WIDX = 1184, PC_QIDX = 1280, PC_CU = 1536, PC_GB = 2048, PC_GC = 2560, PC_SU = 3072, PC_MQ = 3584, PC_GATE = 4096;
constexpr int SC_Q = 0, SC_CKV = 512, SC_QIDX = 640, SC_KIDX = 896, SC_WIDX = 928, SC_CU = 936, SC_GB = 1448, SC_GC = 1960, SC_SU = 2472, SC_MQ = 2984, SC_GATE = 3496;
constexpr float QS_H = 127.f / 5.f, QS_WUP = 127.f / (4.5f * 0.03125f), QS_ACT = 127.f / 12.f, QS_WDN = 127.f / (4.5f * 0.013139006f), QS_WIN = 127.f / (4.5f * 0.03125f), QS_WQL = 8.f * QS_WIN;
constexpr int NE = 32, FE = 1024, MAXBLK = 288, MOE_ROWS = MAXBLK * 256;
constexpr int SSM_LC = 32, SSM_NC = T / SSM_LC, SSM_K = SSM_LC * 16 + 128;
constexpr float LN_EPS = 1e-5f;
constexpr float DN_ALPHA = 1.681792830507429f;

constexpr size_t MiB = 1u << 20;
constexpr size_t WS_CTL = 0, CTL_ZERO_BYTES = 1 * MiB;
constexpr size_t WS_WIN = 1 * MiB;
constexpr size_t WS_WGLU = WS_WIN + (size_t)NL * NP * D * 2;
constexpr size_t WS_WMKV = WS_WGLU + (size_t)NL * 512 * 512 * 2;
constexpr size_t WS_WUV = WS_WMKV + (size_t)NL * 1024 * 1024 * 2;
constexpr size_t WS_WBR = WS_WUV + (size_t)NL * 512 * 1024 * 2;
constexpr size_t WS_WO = WS_WBR + (size_t)NL * 4 * 1024 * 512 * 2;
constexpr size_t WS_WUP = WS_WO + (size_t)NL * 1024 * 1024 * 2;
constexpr size_t WS_WDN = WS_WUP + (size_t)NL * NE * 2048 * 1024 * 2;
constexpr size_t WS_S5A = WS_WDN + (size_t)NL * NE * 1024 * 1024 * 2;
constexpr size_t WS_S5B = WS_S5A + 1 * MiB;
constexpr size_t WS_MEMB = WS_S5B + 1 * MiB;
constexpr size_t WS_MKV = WS_MEMB + 1 * MiB;
constexpr size_t WS_H = WS_MKV + 4 * MiB;
constexpr size_t WS_HB = WS_H + (size_t)M * D * 4;
constexpr size_t WS_PROJ = WS_HB + (size_t)M * D * 2;
constexpr size_t WS_KVN = WS_PROJ + (size_t)M * NP * 2;
constexpr size_t WS_OLAT = WS_KVN + (size_t)M * 128 * 2;
constexpr size_t WS_BR = WS_OLAT + (size_t)M * 1024 * 2;
constexpr size_t WS_Z = WS_BR + (size_t)M * 2048 * 2;
constexpr size_t WS_MRG = WS_Z + (size_t)M * 512 * 2;
constexpr size_t WS_MRGB = WS_MRG + (size_t)M * D * 4;
constexpr size_t WS_V = WS_MRGB + (size_t)M * D * 2;
constexpr size_t WS_H1 = WS_V + (size_t)M * D * 4;
constexpr size_t WS_H1B = WS_H1 + (size_t)M * D * 4;
constexpr size_t WS_SSE = WS_H1B + (size_t)M * D * 2;
constexpr size_t WS_SSC = WS_SSE + (size_t)NB * SSM_NC * 32 * 64 * 8;
constexpr size_t WS_TOK = WS_SSC + (size_t)NB * SSM_NC * 32 * 64 * 8;
constexpr size_t WS_GATE = WS_TOK + (size_t)NE * M * 4;
constexpr size_t WS_SLOT = WS_GATE + (size_t)NE * M * 4;
constexpr size_t WS_XS = WS_SLOT + (size_t)M * 4 * 4;
constexpr size_t WS_ACT = WS_XS + (size_t)MOE_ROWS * 1024 * 2;
constexpr size_t WS_SCR = WS_ACT + (size_t)MOE_ROWS * 1024 * 2;
constexpr size_t WS_KIDX = WS_SCR + (size_t)256 * 2 * 8 * 8192 * 4;
constexpr size_t WS_WSSM = WS_KIDX + (size_t)M * 32 * 2;
constexpr size_t WS_AEXT = WS_WSSM + (size_t)NL * 32 * 512 * SSM_K * 2;
constexpr size_t WS_WE = WS_AEXT + (size_t)32 * 512 * SSM_K * 2;
constexpr size_t WS_END = WS_WE + (size_t)NL * 32 * 256 * 512 * 2;
constexpr int CW_TMO = 0, CW_BAR = 4096, CW_CNT = 16384, CW_Q0 = 2048;

constexpr int RING_BYTES = 131072, LDSCTL_OFF = RING_BYTES, MISC_OFF = LDSCTL_OFF + 320, LDS_BYTES = 147456;
constexpr int NWAVES = 8;

#define RLX_AGENT __ATOMIC_RELAXED, __HIP_MEMORY_SCOPE_AGENT
#define LDS_WAIT() asm volatile("s_waitcnt lgkmcnt(0)" ::: "memory")
#define VM_WAIT() asm volatile("s_waitcnt vmcnt(0)" ::: "memory")
__device__ __forceinline__ unsigned f2bf(float f) { unsigned u = __builtin_bit_cast(unsigned, f); return (u + 0x7fffu + ((u >> 16) & 1u)) >> 16; }
__device__ __forceinline__ unsigned pk2(float lo, float hi) { return f2bf(lo) | (f2bf(hi) << 16); }
__device__ __forceinline__ float bflo(unsigned w) { return __builtin_bit_cast(float, w << 16); }
__device__ __forceinline__ float bfhi(unsigned w) { return __builtin_bit_cast(float, w & 0xffff0000u); }
__device__ __forceinline__ float bf1(bf16 v) { return __builtin_bit_cast(float, (unsigned)v << 16); }
__device__ __forceinline__ unsigned q8_(float x, float s) { return (unsigned)(int)__builtin_rintf(fminf(fmaxf(x * s, -127.f), 127.f)) & 255u; }
__device__ __forceinline__ unsigned q8x4(float a, float b, float c, float d, float s) { return q8_(a, s) | (q8_(b, s) << 8) | (q8_(c, s) << 16) | (q8_(d, s) << 24); }
__device__ __forceinline__ float sigmoidf_(float x) { return __builtin_amdgcn_rcpf(1.f + __expf(-x)); }
__device__ __forceinline__ int lane_op() { int l = (int)__builtin_amdgcn_mbcnt_hi(~0u, __builtin_amdgcn_mbcnt_lo(~0u, 0u)); asm volatile("" : "+v"(l)); return l; }
template <class Tv> __device__ __forceinline__ Tv bperm_(int srcLane, Tv v) { return __builtin_bit_cast(Tv, __builtin_amdgcn_ds_bpermute(srcLane << 2, __builtin_bit_cast(int, v))); }
#define SHX(v, m, l) bperm_((l) ^ (m), (v))
#define SHD(v, o, l) bperm_((l) + (o), (v))
#define SHI(v, s) bperm_((s), (v))
__device__ __forceinline__ float wave_sum(float v) { const int l = lane_op();
#pragma unroll
    for (int o = 1; o < 64; o <<= 1) v += SHX(v, o, l);
    return v;
}
__device__ __forceinline__ float wave_max(float v) { const int l = lane_op();
#pragma unroll
    for (int o = 1; o < 64; o <<= 1) v = fmaxf(v, SHX(v, o, l));
    return v;
}

#define DPP_STEP_(T, v, ctrl, rm, idbits, OP) { const T t_ = __builtin_bit_cast(T, __builtin_amdgcn_update_dpp((int)(idbits), __builtin_bit_cast(int, v), ctrl, rm, 0xf, false)); v = OP(v, t_); }
#define DPP_ADD_(a, b) ((a) + (b))
__device__ __forceinline__ unsigned dpp_scan_add_u32(unsigned v) {
    DPP_STEP_(unsigned, v, 0x111, 0xf, 0, DPP_ADD_) DPP_STEP_(unsigned, v, 0x112, 0xf, 0, DPP_ADD_) DPP_STEP_(unsigned, v, 0x114, 0xf, 0, DPP_ADD_) DPP_STEP_(unsigned, v, 0x118, 0xf, 0, DPP_ADD_)
    DPP_STEP_(unsigned, v, 0x142, 0xa, 0, DPP_ADD_) DPP_STEP_(unsigned, v, 0x143, 0xc, 0, DPP_ADD_) return v; }
__device__ __forceinline__ float wave_sum_dpp(float v) {
    DPP_STEP_(float, v, 0x111, 0xf, 0, DPP_ADD_) DPP_STEP_(float, v, 0x112, 0xf, 0, DPP_ADD_) DPP_STEP_(float, v, 0x114, 0xf, 0, DPP_ADD_) DPP_STEP_(float, v, 0x118, 0xf, 0, DPP_ADD_)
    DPP_STEP_(float, v, 0x142, 0xa, 0, DPP_ADD_) DPP_STEP_(float, v, 0x143, 0xc, 0, DPP_ADD_)
    return __builtin_bit_cast(float, __builtin_amdgcn_readlane(__builtin_bit_cast(int, v), 63)); }
__device__ __forceinline__ float wave_max_dpp(float v) {
    DPP_STEP_(float, v, 0x111, 0xf, 0xff800000u, fmaxf) DPP_STEP_(float, v, 0x112, 0xf, 0xff800000u, fmaxf) DPP_STEP_(float, v, 0x114, 0xf, 0xff800000u, fmaxf) DPP_STEP_(float, v, 0x118, 0xf, 0xff800000u, fmaxf)
    DPP_STEP_(float, v, 0x142, 0xa, 0xff800000u, fmaxf) DPP_STEP_(float, v, 0x143, 0xc, 0xff800000u, fmaxf)
    return __builtin_bit_cast(float, __builtin_amdgcn_readlane(__builtin_bit_cast(int, v), 63)); }

#define XB_TMO      128
#define XB_XCNT(j)  (256  + 64 * (j))
#define XB_XSUB(j)  (1280 + 64 * (j))
#define XB_XGEN(j)  (2304 + 64 * (j))
#define XB_TOP      3328
#define XB_TOPGEN   3392
#define XCD_BAR_WORDS 3456
#define XB_SPIN_CAP (1u << 18)
__device__ __forceinline__ unsigned xb_ld(unsigned* p)              { return __hip_atomic_load(p, __ATOMIC_RELAXED, __HIP_MEMORY_SCOPE_AGENT); }
__device__ __forceinline__ unsigned xb_add(unsigned* p, unsigned v) { return __hip_atomic_fetch_add(p, v, __ATOMIC_RELAXED, __HIP_MEMORY_SCOPE_AGENT); }
__device__ __forceinline__ unsigned xb_xcc_id() { return (unsigned)__builtin_amdgcn_s_getreg((3 << 11) | 20) & 0xFu; }
#define XB_SPIN(cond, bar) do { unsigned _sp = 0; while (cond) { __builtin_amdgcn_s_sleep(1); \
    if ((++_sp & 255u) == 0u) { if (xb_ld(&(bar)[XB_TMO])) break; if (_sp > XB_SPIN_CAP) { atomicAdd(&(bar)[XB_TMO], 1u); break; } } } } while (0)
struct XcdBarrier { unsigned* bar; unsigned x; volatile LAS unsigned* st; };
__device__ __forceinline__ XcdBarrier xcd_barrier_post(unsigned* bar, volatile LAS unsigned* st) {
    XcdBarrier b; b.bar = bar; b.x = xb_xcc_id(); b.st = st;
    if (threadIdx.x == 0) st[2] = xb_add(&bar[XB_XCNT(b.x)], 1u);
    return b;
}
__device__ __forceinline__ void xcd_barrier_complete(unsigned* bar, unsigned x, unsigned& nloc, unsigned& nx, unsigned& balanced) {
    const unsigned G = gridDim.x * gridDim.y * gridDim.z;
    unsigned sum, cnt, mine, sp = 0u, bal;
    for (;;) {
        sum = 0u; cnt = 0u; mine = 0u; bal = 1u;
#pragma unroll 1
        for (unsigned j = 0; j < 16; ++j) { const unsigned c = xb_ld(&bar[XB_XCNT(j)]); sum += c; cnt += (c > 0u) ? 1u : 0u; mine = (j == x) ? c : mine; bal = (c == (j < 8u ? (G >> 3) : 0u)) ? bal : 0u; }
        if (sum == G) break;
        __builtin_amdgcn_s_sleep(1);
        if ((++sp & 255u) == 0u) { if (xb_ld(&bar[XB_TMO])) break; if (sp > XB_SPIN_CAP) { atomicAdd(&bar[XB_TMO], 1u); break; } }
    }
    nloc = mine > 0u ? mine : 1u; nx = cnt > 0u ? cnt : 1u; balanced = ((G & 7u) == 0u && sum == G) ? bal : 0u;
}
__device__ __forceinline__ void xcd_barrier(const XcdBarrier& b, int tid_) {
    asm volatile("s_waitcnt vmcnt(0)" ::: "memory");
    __syncthreads();
    if (tid_ == 0) {
        unsigned* bar = b.bar;
        __builtin_amdgcn_s_waitcnt(0);
        unsigned nloc = b.st[0], nx = b.st[1];
        if (nloc == 0u) { unsigned bal_; xcd_barrier_complete(bar, b.x, nloc, nx, bal_); b.st[0] = nloc; b.st[1] = nx;
            b.st[3] = (bal_ ? b.st[2] * 8u + b.x : (unsigned)blockIdx.x) + 1u; }
        const unsigned old = xb_add(&bar[XB_XSUB(b.x)], 1u);
        const unsigned gen = old / nloc;
        if (old + 1u == (gen + 1u) * nloc) {
            __builtin_amdgcn_fence(__ATOMIC_RELEASE, "agent");
            asm volatile("s_waitcnt vmcnt(0)" ::: "memory");
            const unsigned og = xb_add(&bar[XB_TOP], 1u);
            const unsigned tg = og / nx;
            if (og + 1u == (tg + 1u) * nx) xb_add(&bar[XB_TOPGEN], 1u);
            else XB_SPIN(xb_ld(&bar[XB_TOPGEN]) == tg, bar);
            __builtin_amdgcn_fence(__ATOMIC_ACQUIRE, "agent");
            xb_add(&bar[XB_XGEN(b.x)], 1u);
            asm volatile("s_waitcnt vmcnt(0)" ::: "memory");
        } else {
            XB_SPIN(xb_ld(&bar[XB_XGEN(b.x)]) == gen, bar);
            __builtin_amdgcn_fence(__ATOMIC_ACQUIRE, "agent");
            asm volatile("s_waitcnt vmcnt(0)" ::: "memory");
        }
    }
    __syncthreads();
}

__device__ __forceinline__ unsigned long long ldp(volatile LAS unsigned long long* PT, int k) { const unsigned long long v = PT[k];
    const unsigned lo = __builtin_amdgcn_readfirstlane((unsigned)v), hi = __builtin_amdgcn_readfirstlane((unsigned)(v >> 32)); return ((unsigned long long)hi << 32) | lo; }
typedef __attribute__((address_space(1))) unsigned char gu8_t;
__device__ __forceinline__ unsigned char* gptr(unsigned long long v) { return (unsigned char*)(gu8_t*)v; }
struct Args { const float* in[33]; float* out; unsigned char* ws; int ph_lo, ph_hi; };

struct Frame {
    LAS unsigned char* lds;
    int tid, lane, wave, G, gw, NGW, bx;
};

using pg8::Unit; using pg8::cvt_pk_bf16; using pg8::v4i_t;
struct EpiBf16 {
    static constexpr bool PERM = true;
    bf16* O; int ldc;
    __device__ __forceinline__ void operator()(const f32x4 (&acc)[2][2][4][2], const Unit& u, int wr, int wc, int fr, int fq) const {
        const int row0 = u.pm * 256 + wr * 64 + fr, col0 = u.pn * 256 + wc * 32 + 8 * fq;
#pragma unroll
        for (int ai = 0; ai < 2; ++ai)
#pragma unroll
            for (int m = 0; m < 4; ++m) { bf16* rowp = O + (size_t)(row0 + ai * 128 + m * 16) * ldc + col0;
#pragma unroll
                for (int bj = 0; bj < 2; ++bj) { const f32x4 v0 = acc[ai][bj][m][0], v1 = acc[ai][bj][m][1];
                    v4u w; w.x = cvt_pk_bf16(v0[0], v0[1]); w.y = cvt_pk_bf16(v0[2], v0[3]); w.z = cvt_pk_bf16(v1[0], v1[1]); w.w = cvt_pk_bf16(v1[2], v1[3]);
                    *(v4u*)(rowp + bj * 128) = w; } }
    }
};
struct EpiProjQ {
    static constexpr bool PERM = true;
    bf16* O; int ldc; bf16* AX;
    __device__ __forceinline__ void operator()(const f32x4 (&acc)[2][2][4][2], const Unit& u, int wr, int wc, int fr, int fq) const {
        const int row0 = u.pm * 256 + wr * 64 + fr, col0 = u.pn * 256 + wc * 32 + 8 * fq; const float dq = 1.f / (QS_H * (u.pn < 4 ? QS_WQL : QS_WIN));
#pragma unroll
        for (int ai = 0; ai < 2; ++ai)
#pragma unroll
            for (int m = 0; m < 4; ++m) { bf16* rowp = O + (size_t)(row0 + ai * 128 + m * 16) * ldc + col0;
#pragma unroll
                for (int bj = 0; bj < 2; ++bj) { const v4i_t i0 = __builtin_bit_cast(v4i_t, acc[ai][bj][m][0]), i1 = __builtin_bit_cast(v4i_t, acc[ai][bj][m][1]);
                    v4u w; w.x = cvt_pk_bf16((float)i0[0] * dq, (float)i0[1] * dq); w.y = cvt_pk_bf16((float)i0[2] * dq, (float)i0[3] * dq); w.z = cvt_pk_bf16((float)i1[0] * dq, (float)i1[1] * dq); w.w = cvt_pk_bf16((float)i1[2] * dq, (float)i1[3] * dq);
                    if (u.pn == 12 || u.pn == 13) { const int m_ = row0 + ai * 128 + m * 16, ch = (u.pn - 12) * 256 + wc * 32 + 8 * fq + bj * 128, tl = m_ & (T - 1);
                        *(v4u*)(AX + ((size_t)((ch >> 4) * 512 + (m_ >> 13) * 256 + (tl >> 5))) * SSM_K + (tl & 31) * 16 + (ch & 15)) = w; }
                    else *(v4u*)(rowp + bj * 128) = w; } }
    }
};
struct EpiE {
    static constexpr bool PERM = true;
    float* E2;
    __device__ __forceinline__ void operator()(const f32x4 (&acc)[2][2][4][2], const Unit& u, int wr, int wc, int fr, int fq) const {
        const int row0 = u.pm * 256 + wr * 64 + fr, col0 = wc * 32 + 8 * fq;
#pragma unroll
        for (int ai = 0; ai < 2; ++ai)
#pragma unroll
            for (int m = 0; m < 4; ++m) { float* p = E2 + ((size_t)(row0 + ai * 128 + m * 16) * 32 + u.z) * 128 + col0; *(f32x4*)p = acc[ai][0][m][0]; *(f32x4*)(p + 4) = acc[ai][0][m][1]; }
    }
};
struct EOrder {
    int G, c; const char* A; const char* B;
    __device__ __forceinline__ bool next(int i, Unit& u) const {
        const int Lx = i * G + c; if (Lx >= 64) return false;
        const int g = Lx >> 1, pm = Lx & 1; u.pm = pm; u.pn = 0; u.z = g; u.A = A + ((size_t)g * 512 + pm * 256) * SSM_K * 2; u.B = B + (size_t)g * 256 * 512 * 2; return true;
    }
};
struct EpiMkv {
    static constexpr bool PERM = true;
    bf16* O;
    __device__ __forceinline__ void operator()(const f32x4 (&acc)[2][2][4][2], const Unit& u, int wr, int wc, int fr, int fq) const {
        EpiBf16 e{O + (size_t)u.z * 512 * 1024, 1024}; e(acc, u, wr, wc, fr, fq);
    }
};
struct EpiGlu {
    static constexpr bool PERM = true;
    const bf16* Z; int ldz; const float* bias; bf16* O; int ldo;
    __device__ __forceinline__ void operator()(const f32x4 (&acc)[2][2][4][2], const Unit& u, int wr, int wc, int fr, int fq) const {
        const int row0 = u.pm * 256 + wr * 64 + fr, col0 = u.pn * 256 + wc * 32 + 8 * fq;
        f32x4 bv[2][2];
#pragma unroll
        for (int bj = 0; bj < 2; ++bj)
#pragma unroll
            for (int n = 0; n < 2; ++n) bv[bj][n] = *(const f32x4*)(bias + col0 + bj * 128 + 4 * n);
#pragma unroll
        for (int ai = 0; ai < 2; ++ai) { v4u zq[4][2];
#pragma unroll
            for (int m = 0; m < 4; ++m)
#pragma unroll
                for (int bj = 0; bj < 2; ++bj) zq[m][bj] = *(const v4u*)(Z + (size_t)(row0 + ai * 128 + m * 16) * ldz + col0 + bj * 128);
#pragma unroll
            for (int m = 0; m < 4; ++m) { const size_t r = (size_t)(row0 + ai * 128 + m * 16);
#pragma unroll
                for (int bj = 0; bj < 2; ++bj) { const f32x4 v0 = acc[ai][bj][m][0] + bv[bj][0], v1 = acc[ai][bj][m][1] + bv[bj][1];
                    const v4u zz = zq[m][bj];
                    v4u w;
                    w.x = cvt_pk_bf16(bflo(zz.x) * sigmoidf_(v0[0]), bfhi(zz.x) * sigmoidf_(v0[1]));
                    w.y = cvt_pk_bf16(bflo(zz.y) * sigmoidf_(v0[2]), bfhi(zz.y) * sigmoidf_(v0[3]));
                    w.z = cvt_pk_bf16(bflo(zz.z) * sigmoidf_(v1[0]), bfhi(zz.z) * sigmoidf_(v1[1]));
                    w.w = cvt_pk_bf16(bflo(zz.w) * sigmoidf_(v1[2]), bfhi(zz.w) * sigmoidf_(v1[3]));
                    *(v4u*)(O + r * ldo + col0 + bj * 128) = w; } } }
    }
};
struct EpiMerge {
    static constexpr bool PERM = true;
    const bf16* G; int ldg; bf16* Mb;
    __device__ __forceinline__ void operator()(const f32x4 (&acc)[2][2][4][2], const Unit& u, int wr, int wc, int fr, int fq) const {
        const int row0 = u.pm * 256 + wr * 64 + fr, col0 = u.pn * 256 + wc * 32 + 8 * fq; const int r = u.z;
#pragma unroll
        for (int ai = 0; ai < 2; ++ai) { v4u gq[4][2], pq[4][2];
#pragma unroll
            for (int m = 0; m < 4; ++m) { const size_t rr = (size_t)(row0 + ai * 128 + m * 16);
#pragma unroll
                for (int bj = 0; bj < 2; ++bj) { const int c = col0 + bj * 128; gq[m][bj] = *(const v4u*)(G + rr * ldg + r * 1024 + c); pq[m][bj] = (v4u){0u, 0u, 0u, 0u}; if (r) pq[m][bj] = *(const v4u*)(Mb + rr * 1024 + c); } }
#pragma unroll
            for (int m = 0; m < 4; ++m) { const size_t rr = (size_t)(row0 + ai * 128 + m * 16);
#pragma unroll
                for (int bj = 0; bj < 2; ++bj) { const int c = col0 + bj * 128;
                    const v4u gg = gq[m][bj], pv = pq[m][bj]; bf16* mp = Mb + rr * 1024 + c;
                    f32x4 o0 = (f32x4){bflo(pv.x), bfhi(pv.x), bflo(pv.y), bfhi(pv.y)}, o1 = (f32x4){bflo(pv.z), bfhi(pv.z), bflo(pv.w), bfhi(pv.w)};
                    const f32x4 v0 = acc[ai][bj][m][0], v1 = acc[ai][bj][m][1];
                    o0[0] += sigmoidf_(bflo(gg.x)) * v0[0]; o0[1] += sigmoidf_(bfhi(gg.x)) * v0[1]; o0[2] += sigmoidf_(bflo(gg.y)) * v0[2]; o0[3] += sigmoidf_(bfhi(gg.y)) * v0[3];
                    o1[0] += sigmoidf_(bflo(gg.z)) * v1[0]; o1[1] += sigmoidf_(bfhi(gg.z)) * v1[1]; o1[2] += sigmoidf_(bflo(gg.w)) * v1[2]; o1[3] += sigmoidf_(bfhi(gg.w)) * v1[3];
                    v4u w; w.x = cvt_pk_bf16(o0[0], o0[1]); w.y = cvt_pk_bf16(o0[2], o0[3]); w.z = cvt_pk_bf16(o1[0], o1[1]); w.w = cvt_pk_bf16(o1[2], o1[3]); *(v4u*)mp = w; } } }
    }
};
struct EpiWo {
    static constexpr bool PERM = true;
    const bf16* H; bf16* V;
    __device__ __forceinline__ void operator()(const f32x4 (&acc)[2][2][4][2], const Unit& u, int wr, int wc, int fr, int fq) const {
        const int row0 = u.pm * 256 + wr * 64 + fr, col0 = u.pn * 256 + wc * 32 + 8 * fq;
#pragma unroll
        for (int ai = 0; ai < 2; ++ai) { v4u hq[4][2];
#pragma unroll
            for (int m = 0; m < 4; ++m)
#pragma unroll
                for (int bj = 0; bj < 2; ++bj) hq[m][bj] = *(const v4u*)(H + (size_t)(row0 + ai * 128 + m * 16) * 1024 + col0 + bj * 128);
#pragma unroll
            for (int m = 0; m < 4; ++m) { const size_t off = (size_t)(row0 + ai * 128 + m * 16) * 1024 + col0;
#pragma unroll
                for (int bj = 0; bj < 2; ++bj) { const v4u hh = hq[m][bj]; const f32x4 v0 = acc[ai][bj][m][0], v1 = acc[ai][bj][m][1];
                    v4u w; w.x = cvt_pk_bf16(bflo(hh.x) * DN_ALPHA + v0[0], bfhi(hh.x) * DN_ALPHA + v0[1]); w.y = cvt_pk_bf16(bflo(hh.y) * DN_ALPHA + v0[2], bfhi(hh.y) * DN_ALPHA + v0[3]);
                    w.z = cvt_pk_bf16(bflo(hh.z) * DN_ALPHA + v1[0], bfhi(hh.z) * DN_ALPHA + v1[1]); w.w = cvt_pk_bf16(bflo(hh.w) * DN_ALPHA + v1[2], bfhi(hh.w) * DN_ALPHA + v1[3]);
                    *(v4u*)(V + off + bj * 128) = w; } } }
    }
};
struct EpiUp {
    static constexpr bool PERM = true;
    const float* bup; unsigned char* ACT;
    __device__ __forceinline__ void operator()(const f32x4 (&acc)[2][2][4][2], const Unit& u, int wr, int wc, int fr, int fq) const {
        const int row0 = u.pm * 256 + wr * 64 + fr, col0 = u.pn * 256 + wc * 32 + 8 * fq; const float* bb = bup + (size_t)u.z * 2048; const float dq = 1.f / (QS_H * QS_WUP);
        f32x4 bv[2][2];
#pragma unroll
        for (int bj = 0; bj < 2; ++bj)
#pragma unroll
            for (int n = 0; n < 2; ++n) bv[bj][n] = *(const f32x4*)(bb + col0 + bj * 128 + 4 * n);
#pragma unroll
        for (int ai = 0; ai < 2; ++ai)
#pragma unroll
            for (int m = 0; m < 4; ++m) { const size_t r = (size_t)(row0 + ai * 128 + m * 16);
#pragma unroll
                for (int bj = 0; bj < 2; ++bj) { const v4i_t i0 = __builtin_bit_cast(v4i_t, acc[ai][bj][m][0]), i1 = __builtin_bit_cast(v4i_t, acc[ai][bj][m][1]);
                    const f32x4 v0 = (f32x4){(float)i0[0], (float)i0[1], (float)i0[2], (float)i0[3]} * dq + bv[bj][0], v1 = (f32x4){(float)i1[0], (float)i1[1], (float)i1[2], (float)i1[3]} * dq + bv[bj][1];
                    float a[4];
#pragma unroll
                    for (int j = 0; j < 4; ++j) { const float gx = j < 2 ? v0[2 * j] : v1[2 * j - 4], lx = j < 2 ? v0[2 * j + 1] : v1[2 * j - 3];
                        const float gl = fminf(gx, 7.0f), li = fminf(fmaxf(lx, -7.0f), 7.0f); a[j] = gl * sigmoidf_(1.702f * gl) * (li + 1.0f); }
                    *(unsigned*)(ACT + r * 1024 + ((col0 + bj * 128) >> 1)) = q8x4(a[0], a[1], a[2], a[3], QS_ACT); } }
    }
};
struct EpiDown {
    static constexpr bool PERM = true;
    const float* bdn; const float* grow; bf16* YS;
    __device__ __forceinline__ void operator()(const f32x4 (&acc)[2][2][4][2], const Unit& u, int wr, int wc, int fr, int fq) const {
        const int row0 = u.pm * 256 + wr * 64 + fr, col0 = u.pn * 256 + wc * 32 + 8 * fq; const float* bb = bdn + (size_t)u.z * 1024; const float dq = 1.f / (QS_ACT * QS_WDN);
        f32x4 bv[2][2];
#pragma unroll
        for (int bj = 0; bj < 2; ++bj)
#pragma unroll
            for (int n = 0; n < 2; ++n) bv[bj][n] = *(const f32x4*)(bb + col0 + bj * 128 + 4 * n);
        float gq[2][4];
#pragma unroll
        for (int ai = 0; ai < 2; ++ai)
#pragma unroll
            for (int m = 0; m < 4; ++m) gq[ai][m] = grow[(size_t)(row0 + ai * 128 + m * 16)];
#pragma unroll
        for (int ai = 0; ai < 2; ++ai)
#pragma unroll
            for (int m = 0; m < 4; ++m) { const size_t r = (size_t)(row0 + ai * 128 + m * 16); const float gt = gq[ai][m];
#pragma unroll
                for (int bj = 0; bj < 2; ++bj) { const v4i_t i0 = __builtin_bit_cast(v4i_t, acc[ai][bj][m][0]), i1 = __builtin_bit_cast(v4i_t, acc[ai][bj][m][1]);
                    const f32x4 v0 = ((f32x4){(float)i0[0], (float)i0[1], (float)i0[2], (float)i0[3]} * dq + bv[bj][0]) * gt, v1 = ((f32x4){(float)i1[0], (float)i1[1], (float)i1[2], (float)i1[3]} * dq + bv[bj][1]) * gt;
                    v4u w; w.x = cvt_pk_bf16(v0[0], v0[1]); w.y = cvt_pk_bf16(v0[2], v0[3]); w.z = cvt_pk_bf16(v1[0], v1[1]); w.w = cvt_pk_bf16(v1[2], v1[3]);
                    *(v4u*)(YS + r * 1024 + col0 + bj * 128) = w; } }
    }
};
struct EpiSsm {
    static constexpr bool PERM = true;
    bf16* Z;
    __device__ __forceinline__ void operator()(const f32x4 (&acc)[2][2][4][2], const Unit& u, int wr, int wc, int fr, int fq) const {
        const int row0 = u.pm * 256 + wr * 64 + fr, col0 = u.pn * 256 + wc * 32 + 8 * fq;
#pragma unroll
        for (int ai = 0; ai < 2; ++ai)
#pragma unroll
            for (int m = 0; m < 4; ++m) { const int row = row0 + ai * 128 + m * 16; const size_t tokb = (size_t)(row >> 8) * T + (size_t)(row & 255) * SSM_LC;
#pragma unroll
                for (int bj = 0; bj < 2; ++bj) { const int col = col0 + bj * 128; const f32x4 v0 = acc[ai][bj][m][0], v1 = acc[ai][bj][m][1]; float z[8];
#pragma unroll
                    for (int j = 0; j < 8; ++j) { const float y = j < 4 ? v0[j] : v1[j - 4]; const float x3 = 0.7978845608028654f * (y + 0.044715f * y * y * y); const float th = 1.f - 2.f * __builtin_amdgcn_rcpf(__expf(2.f * x3) + 1.f); z[j] = 0.5f * y * (1.f + th); }
                    v4u w; w.x = cvt_pk_bf16(z[0], z[1]); w.y = cvt_pk_bf16(z[2], z[3]); w.z = cvt_pk_bf16(z[4], z[5]); w.w = cvt_pk_bf16(z[6], z[7]);
                    *(v4u*)(Z + (tokb + (col >> 4)) * 512 + u.z * 16 + (col & 15)) = w; } }
    }
};
struct SsmOrder {
    int G, c; const char* A; const char* B;
    __device__ __forceinline__ bool next(int i, Unit& u) const {
        const int Lx = i * G + c; if (Lx >= 128) return false;
        const int g = Lx >> 2, pm = (Lx >> 1) & 1, pn = Lx & 1; u.pm = pm; u.pn = pn; u.z = g;
        u.A = A + ((size_t)g * 512 + pm * 256) * SSM_K * 2; u.B = B + ((size_t)g * 512 + pn * 256) * SSM_K * 2; return true;
    }
};
struct MkvOrder {
    int G, c; const char* A; const char* B;
    __device__ __forceinline__ bool next(int i, Unit& u) const {
        const int Lx = i * G + c; if (Lx >= NL * 8) return false;
        const int l = Lx >> 3, pm = (Lx >> 2) & 1, pn = Lx & 3; u.pm = pm; u.pn = pn; u.z = l;
        u.A = A + (size_t)pm * 256 * 1024 * 2; u.B = B + ((size_t)l * 1024 + pn * 256) * 1024 * 2; return true;
    }
};
struct MergeOrder {
    int G, c; const char* A; const char* B;
    __device__ __forceinline__ bool next(int i, Unit& u) const {
        const long Lx = (long)(i >> 2) * G + c; if (Lx >= 64 * 4) return false;
        int pm, pn; pg8::tile_of((int)Lx, 64, 4, pm, pn); const int r = i & 3; u.pm = pm; u.pn = pn; u.z = r;
        u.A = A + ((size_t)pm * 256 * 2048 + r * 512) * 2; u.B = B + ((size_t)r * 1024 + pn * 256) * 512 * 2; return true;
    }
};
struct MoeOrder {
    int G, c, nN, nunits; const LAS int* blk0; const char* A; const char* B; size_t atile, bexp, btile;
    const int* tok; const LAS int* cnt;
    __device__ __forceinline__ void rowinfo(const pg8::Unit& u, const int*& tb, int& s0, int& ce) const { const int e = u.z; tb = tok + (size_t)e * M; s0 = (u.pm - blk0[e]) * 256; ce = cnt[e]; }
    __device__ __forceinline__ bool next(int i, Unit& u) const {
        const int c2 = (G & 7) ? c : (c & 7) * (G >> 3) + (c >> 3);
        const long Lx = (long)i * G + c2; if (Lx >= nunits) return false;
        const int j = (int)(Lx / nN), pn = (int)(Lx % nN); int e = 0;
#pragma unroll
        for (int k = 1; k < 32; ++k) e += (j >= blk0[k]) ? 1 : 0;
        u.pm = j; u.pn = pn; u.z = e; u.A = A + (size_t)j * atile; u.B = B + (size_t)e * bexp + (size_t)pn * btile; return true;
    }
};

template <int QMODE = 0>
__device__ __forceinline__ void tr_item64(const float* W, int ldw, int c0, int nc, int K, bf16* WT, int r0, LAS unsigned char* scr, int item, int lane) {
    const int nblk = (nc + 63) >> 6, kb = item / nblk, nb = item % nblk, k0 = 64 * kb, n0 = 64 * nb;
    const int nn = 4 * (lane & 15), g = lane >> 4; const bool okn = (n0 + nn) < nc;
    const float* wp = W + (size_t)(k0 + g) * ldw + c0 + n0 + nn;
    f32x4 vv[16];
#pragma unroll
    for (int i = 0; i < 16; ++i) { vv[i] = (f32x4){0.f, 0.f, 0.f, 0.f}; if (okn) vv[i] = __builtin_nontemporal_load((const f32x4*)(wp + (size_t)(4 * i) * ldw)); }
#pragma unroll
    for (int i = 0; i < 16; ++i) { v2u w2; w2.x = pk2(vv[i][0], vv[i][1]); w2.y = pk2(vv[i][2], vv[i][3]); *(LAS v2u*)(scr + (4 * i + g) * 136 + nn * 2) = w2; }
    LDS_WAIT(); asm volatile("" ::: "memory");
    const int i16 = lane & 15, q = i16 >> 2, p = i16 & 3;
#pragma unroll
    for (int s = 0; s < 8; ++s) { const int nbk = s & 3, kbk = 4 * (s >> 2) + g;
        const v4i16_t lo = __builtin_amdgcn_ds_read_tr16_b64_v4i16((LAS v4i16_t*)(scr + (8 * kbk + q) * 136 + 32 * nbk + 8 * p));
        const v4i16_t hi = __builtin_amdgcn_ds_read_tr16_b64_v4i16((LAS v4i16_t*)(scr + (8 * kbk + 4 + q) * 136 + 32 * nbk + 8 * p));
        const bf16x8 o = __builtin_shufflevector(lo, hi, 0, 1, 2, 3, 4, 5, 6, 7); const int n = 16 * nbk + i16;
        if (n0 + n < nc) {
            if constexpr (QMODE == 0) *(bf16x8*)(WT + (size_t)(r0 + n0 + n) * K + k0 + 8 * kbk) = o;
            else { const v4u ou = __builtin_bit_cast(v4u, o); const float sc_ = QMODE == 1 ? QS_WUP : (QMODE == 2 ? QS_WDN : QS_WIN);
                *(v2u*)((unsigned char*)WT + (size_t)(r0 + n0 + n) * K + k0 + 8 * kbk) = (v2u){q8x4(bflo(ou.x), bfhi(ou.x), bflo(ou.y), bfhi(ou.y), sc_), q8x4(bflo(ou.z), bfhi(ou.z), bflo(ou.w), bfhi(ou.w), sc_)}; } } }
    LDS_WAIT(); asm volatile("" ::: "memory");
}
__device__ __forceinline__ void ln_rows(f32x4 (&v)[4], const float* g, const float* b, int lane) {
    float s = 0.f;
#pragma unroll
    for (int j = 0; j < 4; ++j) s += (v[j][0] + v[j][1]) + (v[j][2] + v[j][3]);
    const float mean = wave_sum(s) * (1.f / D); float s2 = 0.f;
#pragma unroll
    for (int j = 0; j < 4; ++j) { v[j] = v[j] - mean; s2 += (v[j][0] * v[j][0] + v[j][1] * v[j][1]) + (v[j][2] * v[j][2] + v[j][3] * v[j][3]); }
    const float rstd = 1.f / sqrtf(wave_sum(s2) * (1.f / D) + LN_EPS);
#pragma unroll
    for (int j = 0; j < 4; ++j) { const f32x4 gg = *(const f32x4*)(g + 4 * lane + 256 * j), bb = *(const f32x4*)(b + 4 * lane + 256 * j); v[j] = v[j] * rstd * gg + bb; }
}
struct LnAff { f32x4 g[4], b[4]; };
__device__ __forceinline__ LnAff ln_aff(const float* g, const float* b, int lane) { LnAff a;
#pragma unroll
    for (int j = 0; j < 4; ++j) { a.g[j] = *(const f32x4*)(g + 4 * lane + 256 * j); a.b[j] = *(const f32x4*)(b + 4 * lane + 256 * j); }
    return a; }
__device__ __forceinline__ void ln_rows_pre(f32x4 (&v)[4], const LnAff& a) {
    float s = 0.f;
#pragma unroll
    for (int j = 0; j < 4; ++j) s += (v[j][0] + v[j][1]) + (v[j][2] + v[j][3]);
    const float mean = wave_sum(s) * (1.f / D); float s2 = 0.f;
#pragma unroll
    for (int j = 0; j < 4; ++j) { v[j] = v[j] - mean; s2 += (v[j][0] * v[j][0] + v[j][1] * v[j][1]) + (v[j][2] * v[j][2] + v[j][3] * v[j][3]); }
    const float rstd = 1.f / sqrtf(wave_sum(s2) * (1.f / D) + LN_EPS);
#pragma unroll
    for (int j = 0; j < 4; ++j) v[j] = v[j] * rstd * a.g[j] + a.b[j];
}
__device__ __forceinline__ void store_row_f32_bf16(const f32x4 (&v)[4], float* of, bf16* ob, int lane) {
#pragma unroll
    for (int j = 0; j < 4; ++j) { if (of) *(f32x4*)(of + 4 * lane + 256 * j) = v[j];
        if (ob) { v2u w; w.x = pk2(v[j][0], v[j][1]); w.y = pk2(v[j][2], v[j][3]); *(v2u*)(ob + 4 * lane + 256 * j) = w; } }
}

typedef float f32x16 __attribute__((ext_vector_type(16)));
constexpr int DSA_LIST_OFF = LDSCTL_OFF + 2048, DSA_WCNT_OFF = DSA_LIST_OFF + 4096, DSA_SEL_OFF = DSA_WCNT_OFF + 256;
__device__ __forceinline__ unsigned mono_key(float x) { const unsigned u = __builtin_bit_cast(unsigned, x); return u ^ ((unsigned)((int)u >> 31) | 0x80000000u); }
__device__ __forceinline__ unsigned kv_off(unsigned row, unsigned ch) { return 256u * row + 16u * (ch ^ (((row & 3u) << 2) | ((row >> 2) & 3u))); }

#ifndef DUP_IDX
#define DUP_IDX 1
#endif
#ifndef DUP_SEL
#define DUP_SEL 1
#endif
#ifndef DUP_ATT
#define DUP_ATT 1
#endif
template <int LEVEL>
__device__ __forceinline__ void dsa2_level(LAS unsigned* hist, const unsigned (&kk)[128], int nreg, int lane, unsigned& prefix, unsigned& need) {
    constexpr int NBIN = LEVEL == 2 ? 1024 : 2048; constexpr int PB = NBIN / 64;
#pragma unroll
    for (int i = 0; i < PB / 4; ++i) *(LAS v4u*)(hist + lane * PB + 4 * i) = (v4u){0u, 0u, 0u, 0u};
    LDS_WAIT();
#pragma unroll
    for (int i = 0; i < 128; ++i) { if ((i & ~15) < nreg) { const unsigned k = kk[i]; bool part; unsigned bin;
            if (LEVEL == 0) { part = k != 0u; bin = k >> 21; }
            else if (LEVEL == 1) { part = (k != 0u) && ((k >> 21) == prefix); bin = (k >> 10) & 0x7FFu; }
            else { part = (k != 0u) && ((k >> 10) == prefix); bin = k & 0x3FFu; }
            if (part) (void)__hip_atomic_fetch_add(&hist[bin], 1u, __ATOMIC_RELAXED, __HIP_MEMORY_SCOPE_WORKGROUP); }
        if ((i & 7) == 7) __builtin_amdgcn_sched_barrier(0); }
    LDS_WAIT();
    unsigned hv[PB]; unsigned mine = 0u;
#pragma unroll
    for (int i = 0; i < PB / 4; ++i) { const v4u v = *(const LAS v4u*)(hist + lane * PB + 4 * i); hv[4 * i] = v.x; hv[4 * i + 1] = v.y; hv[4 * i + 2] = v.z; hv[4 * i + 3] = v.w; mine += (v.x + v.y) + (v.z + v.w); }
    const unsigned pre779_ = dpp_scan_add_u32(mine); const unsigned incl = (unsigned)__builtin_amdgcn_readlane((int)pre779_, 63) - pre779_ + mine;
    const unsigned above = incl - mine; const bool found = above < need && need <= above + mine;
    unsigned a = above; int bsel = 0; bool done = false;
#pragma unroll
    for (int i = PB - 1; i >= 0; --i) { const bool hit = !done && (need <= a + hv[i]); bsel = hit ? i : bsel; a = (done || hit) ? a : a + hv[i]; done = done || hit; }
    const int src = __builtin_ctzll(__ballot(found));
    const unsigned bfull = (unsigned)SHI(lane * PB + bsel, src); const unsigned aa = (unsigned)SHI((int)a, src);
    prefix = LEVEL == 0 ? bfull : (LEVEL == 1 ? ((prefix << 11) | bfull) : ((prefix << 10) | bfull)); need -= aa;
    LDS_WAIT();
}

__device__ __forceinline__ bool dsa2_sampled(LAS unsigned char* wl, const unsigned (&kk)[128], int nreg, int n, int lane) {
    LAS unsigned* hist = (LAS unsigned*)wl; LAS int* LIST = (LAS int*)(wl + 12288); LAS unsigned* h2 = (LAS unsigned*)(wl + 13312);
    LAS unsigned long long* PRIV = (LAS unsigned long long*)wl;
    const unsigned long long ltm = (1ull << lane) - 1ull;
#pragma unroll
    for (int i = 0; i < 8; ++i) *(LAS v4u*)(hist + lane * 32 + 4 * i) = (v4u){0u, 0u, 0u, 0u};
    LDS_WAIT();
#pragma unroll
    for (int i = 0; i < 128; i += 8) { if (i < nreg) { const unsigned k = kk[i]; if (k != 0u) (void)__hip_atomic_fetch_add(&hist[k >> 21], 1u, __ATOMIC_RELAXED, __HIP_MEMORY_SCOPE_WORKGROUP); } }
    LDS_WAIT();
    unsigned hv[32]; unsigned mine = 0u;
#pragma unroll
    for (int i = 0; i < 8; ++i) { const v4u v = *(const LAS v4u*)(hist + lane * 32 + 4 * i); hv[4 * i] = v.x; hv[4 * i + 1] = v.y; hv[4 * i + 2] = v.z; hv[4 * i + 3] = v.w; mine += (v.x + v.y) + (v.z + v.w); }
    const unsigned pre_ = dpp_scan_add_u32(mine); const unsigned incl = (unsigned)__builtin_amdgcn_readlane((int)pre_, 63) - pre_ + mine; const int lop_ = lane_op(); (void)lop_;
    const unsigned above = incl - mine; const unsigned ns = SHI(incl, 0);
    const float E = (float)ns * 256.f / (float)n, mg = 3.f * sqrtf(E) + 3.f;
    const int rhi = (int)fmaxf(E - mg, 0.f), rlo = (int)(E + mg) + 1;
    int bhl = -1, bll = -1; { unsigned s = above;
#pragma unroll
        for (int i = 31; i >= 0; --i) { if ((int)s <= rhi) bhl = i; s += hv[i]; if (bll < 0 && (int)s >= rlo) bll = i; } }
    const bool hasH = ((int)above <= rhi) && ((int)incl > rhi || lane == 0), hasL = ((int)incl >= rlo) && ((int)above < rlo);
    const unsigned long long mH = __ballot(hasH), mL = __ballot(hasL);
    if (mH == 0ull) return false;
    const int sH = 63 - __builtin_clzll(mH);
    const unsigned bh = (unsigned)SHI(lane * 32 + (bhl < 0 ? 0 : bhl), sH);
    unsigned bl = 1u; if (mL != 0ull) { const int sL = 63 - __builtin_clzll(mL); bl = (unsigned)SHI(lane * 32 + (bll < 0 ? 0 : bll), sL); }
    bl = bl < 1u ? 1u : bl; if (bl > bh) bl = bh;
    int cur = 0; LAS unsigned* pp = (LAS unsigned*)(PRIV + lane);
#pragma unroll
    for (int i = 0; i < 128; ++i) { if ((i & ~15) < nreg) { const unsigned k = kk[i];
            if ((k >> 21) >= bl) { if (cur < 24) { pp[0] = (unsigned)(lane + 64 * i); pp[1] = k; } pp += 128; ++cur; } }
        __builtin_amdgcn_sched_barrier(0); }
    LDS_WAIT();
    int mxc = cur; { const int lq_ = lane_op();
#pragma unroll
        for (int o = 1; o < 64; o <<= 1) { const int t2 = SHX(mxc, o, lq_); mxc = t2 > mxc ? t2 : mxc; } }
    mxc = __builtin_amdgcn_readfirstlane(mxc);
    if (mxc > 24) return false;
    int A = 0, C = 0;
#pragma unroll 1
    for (int s = 0; s < mxc; ++s) { const bool vld = s < cur; const unsigned long long e = vld ? PRIV[s * 64 + lane] : 0ull; const unsigned k = (unsigned)(e >> 32), ix = (unsigned)e;
        const bool sure = vld && (k >> 21) > bh, cand = vld && !sure;
        const unsigned long long ms = __ballot(sure), mc = __ballot(cand);
        const int ps = A + __builtin_popcountll(ms & ltm), pc = C + __builtin_popcountll(mc & ltm);
        if (sure && ps < 256) LIST[ps] = (int)ix;
        if (cand) PRIV[pc] = ((unsigned long long)k << 13) | (unsigned long long)(8191u - ix);
        A += __builtin_popcountll(ms); C += __builtin_popcountll(mc); }
    if (A > 256 || A + C < 256) return false;
    LDS_WAIT();
    unsigned need = 256u - (unsigned)A; const int nit = (C + 63) >> 6;
    if (need > 0u) { unsigned long long prefix = 0ull; int shf = 45;
#pragma unroll 1
        for (int lev = 0; lev < 6; ++lev) { const int w = lev < 5 ? 8 : 5; const int sh = shf - w;
            { unsigned zq_ = 0u; asm volatile("" : "+v"(zq_)); *(LAS v4u*)(h2 + 4 * lane) = (v4u){zq_, zq_, zq_, zq_}; }
            LDS_WAIT();
            for (int it = 0; it < nit; ++it) { const int i = it * 64 + lane; if (i < C) { const unsigned long long c2 = PRIV[i]; if (lev == 0 || (c2 >> shf) == prefix) (void)__hip_atomic_fetch_add(&h2[(unsigned)(c2 >> sh) & ((1u << w) - 1u)], 1u, __ATOMIC_RELAXED, __HIP_MEMORY_SCOPE_WORKGROUP); } }
            LDS_WAIT();
            const v4u v = *(const LAS v4u*)(h2 + 4 * lane); const unsigned m4 = (v.x + v.y) + (v.z + v.w); const unsigned pr2_ = dpp_scan_add_u32(m4); const unsigned in2 = (unsigned)__builtin_amdgcn_readlane((int)pr2_, 63) - pr2_ + m4;
            const unsigned ab = in2 - m4; const bool fnd = ab < need && need <= ab + m4;
            unsigned a = ab; int bs = 0; bool dn = false; const unsigned h4[4] = {v.x, v.y, v.z, v.w};
#pragma unroll
            for (int i = 3; i >= 0; --i) { const bool hit = !dn && (need <= a + h4[i]); bs = hit ? i : bs; a = (dn || hit) ? a : a + h4[i]; dn = dn || hit; }
            const int src = __builtin_ctzll(__ballot(fnd));
            const unsigned bf = (unsigned)SHI(lane * 4 + bs, src); const unsigned aa = (unsigned)SHI((int)a, src); const unsigned hb = (unsigned)SHI((int)(bs == 3 ? h4[3] : bs == 2 ? h4[2] : bs == 1 ? h4[1] : h4[0]), src);
            prefix = (prefix << w) | bf; need -= aa; shf = sh;
            LDS_WAIT();
            if (hb == need) break; }
        int pos = A;
        for (int it = 0; it < nit; ++it) { const int i = it * 64 + lane; unsigned long long c2 = 0ull; if (i < C) c2 = PRIV[i];
            const bool take = (i < C) && ((c2 >> shf) >= prefix);
            const unsigned long long mt = __ballot(take);
            if (take) LIST[pos + __builtin_popcountll(mt & ltm)] = (int)(8191u - (unsigned)(c2 & 8191ull));
            pos += __builtin_popcountll(mt); }
    }
    LDS_WAIT();
    return true;
}

__device__ __forceinline__ void dsa2_unit(LAS unsigned char* lds, const bf16* PROJ, const bf16* KIDX, const bf16* KVN, bf16* OLAT, float* sbuf, int b, int t0, int tid) {
    asm volatile("" : "+v"(tid));
    const int lane = tid & 63, wave = __builtin_amdgcn_readfirstlane(tid >> 6), r = lane & 31, h = lane >> 5;
    const size_t rowb = (size_t)b * T;
    LAS unsigned char* wl = lds + wave * 16384; LAS unsigned* hist = (LAS unsigned*)wl; LAS int* LIST = (LAS int*)(wl + 12288);
    const int t = t0 + wave; int cnt;
    if (t0 >= 256) {
        { const int ntiles = (t0 >> 5) + 1, tpw = (ntiles + 7) >> 3, tile0 = wave * tpw; int tile1 = tile0 + tpw; tile1 = tile1 < ntiles ? tile1 : ntiles;
          const int ahead = (r & 3) + 4 * ((r >> 3) & 1), atok = ((r >> 2) & 1) + 2 * (r >> 4);
          const bf16* qpa = PROJ + (rowb + t0 + atok) * NP + PC_QIDX + ahead * 32 + 8 * h; const bf16* qpb = qpa + (size_t)4 * NP;
          const bf16x8 A0a = *(const bf16x8*)qpa, A1a = *(const bf16x8*)(qpa + 16), A0b = *(const bf16x8*)qpb, A1b = *(const bf16x8*)(qpb + 16);
          float wq[32];
#pragma unroll
          for (int gq = 0; gq < 4; ++gq) { const v4u w0 = *(const v4u*)(PROJ + (rowb + t0 + h + 2 * gq) * NP + PC_WIDX);
              wq[8 * gq] = 0.5f * bflo(w0.x); wq[8 * gq + 1] = 0.5f * bfhi(w0.x); wq[8 * gq + 2] = 0.5f * bflo(w0.y); wq[8 * gq + 3] = 0.5f * bfhi(w0.y); wq[8 * gq + 4] = 0.5f * bflo(w0.z); wq[8 * gq + 5] = 0.5f * bfhi(w0.z); wq[8 * gq + 6] = 0.5f * bflo(w0.w); wq[8 * gq + 7] = 0.5f * bfhi(w0.w); }
          v4u A0c = {0u, 0u, 0u, 0u}, A1c = {0u, 0u, 0u, 0u};
          if (r < 8) { const bf16* qrow = PROJ + (rowb + t0 + (r >> 2) + 2 * (r & 3)) * NP; const v4u wv = *(const v4u*)(qrow + PC_WIDX);
              const float wl_[8] = {bflo(wv.x), bfhi(wv.x), bflo(wv.y), bfhi(wv.y), bflo(wv.z), bfhi(wv.z), bflo(wv.w), bfhi(wv.w)};
              float a0[8], a1[8];
#pragma unroll
              for (int j = 0; j < 8; ++j) { a0[j] = 0.f; a1[j] = 0.f; }
#pragma unroll
              for (int hd = 0; hd < 8; ++hd) { const v4u q0 = *(const v4u*)(qrow + PC_QIDX + hd * 32 + 8 * h), q1 = *(const v4u*)(qrow + PC_QIDX + hd * 32 + 16 + 8 * h); const float hw = 0.5f * wl_[hd];
                  a0[0] += hw * bflo(q0.x); a0[1] += hw * bfhi(q0.x); a0[2] += hw * bflo(q0.y); a0[3] += hw * bfhi(q0.y); a0[4] += hw * bflo(q0.z); a0[5] += hw * bfhi(q0.z); a0[6] += hw * bflo(q0.w); a0[7] += hw * bfhi(q0.w);
                  a1[0] += hw * bflo(q1.x); a1[1] += hw * bfhi(q1.x); a1[2] += hw * bflo(q1.y); a1[3] += hw * bfhi(q1.y); a1[4] += hw * bflo(q1.z); a1[5] += hw * bfhi(q1.z); a1[6] += hw * bflo(q1.w); a1[7] += hw * bfhi(q1.w); }
              A0c = (v4u){pk2(a0[0], a0[1]), pk2(a0[2], a0[3]), pk2(a0[4], a0[5]), pk2(a0[6], a0[7])}; A1c = (v4u){pk2(a1[0], a1[1]), pk2(a1[2], a1[3]), pk2(a1[4], a1[5]), pk2(a1[6], a1[7])}; }
          const bf16x8 A0cb = __builtin_bit_cast(bf16x8, A0c), A1cb = __builtin_bit_cast(bf16x8, A1c);
          const bf16* kp = KIDX + (rowb + (size_t)tile0 * 32 + r) * 32 + 8 * h;
          bf16x8 Bq[4][2];
#pragma unroll
          for (int u = 0; u < 3; ++u) if (tile0 + u < tile1) { Bq[u][0] = *(const bf16x8*)(kp + (size_t)u * 1024); Bq[u][1] = *(const bf16x8*)(kp + (size_t)u * 1024 + 16); }
          for (int tileb = tile0; tileb < tile1; tileb += 4) {
#pragma unroll
          for (int u = 0; u < 4; ++u) { const int tile = tileb + u; if (tile < tile1) { const bf16x8 b0 = Bq[u][0], b1 = Bq[u][1];
              if (tile + 3 < tile1) { const bf16* kn = kp + (size_t)(tile + 3 - tile0) * 1024; Bq[(u + 3) & 3][0] = *(const bf16x8*)kn; Bq[(u + 3) & 3][1] = *(const bf16x8*)(kn + 16); }
              f32x16 da, db, dc;
#pragma unroll
              for (int i = 0; i < 16; ++i) { da[i] = 0.f; db[i] = 0.f; dc[i] = 0.f; }
              da = __builtin_amdgcn_mfma_f32_32x32x16_bf16(A0a, b0, da, 0, 0, 0); db = __builtin_amdgcn_mfma_f32_32x32x16_bf16(A0b, b0, db, 0, 0, 0); dc = __builtin_amdgcn_mfma_f32_32x32x16_bf16(A0cb, b0, dc, 0, 0, 0);
              da = __builtin_amdgcn_mfma_f32_32x32x16_bf16(A1a, b1, da, 0, 0, 0); db = __builtin_amdgcn_mfma_f32_32x32x16_bf16(A1b, b1, db, 0, 0, 0); dc = __builtin_amdgcn_mfma_f32_32x32x16_bf16(A1cb, b1, dc, 0, 0, 0);
              float s0 = dc[0], s1 = dc[1], s2 = dc[2], s3 = dc[3];
#pragma unroll
              for (int i = 0; i < 8; ++i) { s0 += wq[i] * __builtin_fabsf(da[i]); s1 += wq[8 + i] * __builtin_fabsf(da[8 + i]); s2 += wq[16 + i] * __builtin_fabsf(db[i]); s3 += wq[24 + i] * __builtin_fabsf(db[8 + i]); }
              float* sp = sbuf + (size_t)h * 8192 + tile * 32 + r;
              sp[0] = __builtin_bit_cast(float, mono_key(s0)); sp[2 * 8192] = __builtin_bit_cast(float, mono_key(s1)); sp[4 * 8192] = __builtin_bit_cast(float, mono_key(s2)); sp[6 * 8192] = __builtin_bit_cast(float, mono_key(s3)); } } } }
        asm volatile("s_waitcnt vmcnt(0)" ::: "memory");
        __syncthreads();
        const int n = t + 1, nreg = (n + 63) >> 6; const float* sr = sbuf + (size_t)wave * 8192;
        unsigned kk[128];
#ifndef DUP_KK
#define DUP_KK 1
#endif
        for (int repk = 0; repk < DUP_KK; ++repk)
#pragma unroll
        for (int gI = 0; gI < 4; ++gI) {
            if (gI * 32 < nreg) {
                float fv[32];
#pragma unroll
                for (int i = 0; i < 32; ++i) { const int key = lane + 64 * (gI * 32 + i); fv[i] = __hip_atomic_load(sr + (key < n ? key : n - 1), __ATOMIC_RELAXED, __HIP_MEMORY_SCOPE_AGENT); }
#pragma unroll
                for (int i = 0; i < 32; ++i) { const int key = lane + 64 * (gI * 32 + i); kk[gI * 32 + i] = key < n ? __builtin_bit_cast(unsigned, fv[i]) : 0u; }
            } else {
#pragma unroll
                for (int i = 0; i < 32; ++i) kk[gI * 32 + i] = 0u;
            }
        }
        unsigned prefix = 0u, need = 256u; int pos = 0, eqs = 0; const unsigned long long ltm = (1ull << lane) - 1ull;
        bool seldone = false; if (nreg > 16) seldone = dsa2_sampled(wl, kk, nreg, n, lane);
        if (!seldone)
        for (int reps = 0; reps < DUP_SEL; ++reps) { prefix = 0u; need = 256u; pos = 0; eqs = 0;
        dsa2_level<0>(hist, kk, nreg, lane, prefix, need);
        dsa2_level<1>(hist, kk, nreg, lane, prefix, need);
        dsa2_level<2>(hist, kk, nreg, lane, prefix, need);
        const unsigned tau = prefix;
#pragma unroll
        for (int i = 0; i < 128; ++i) { if ((i & ~15) < nreg) { const unsigned k = kk[i]; const bool gt = k > tau, eq = k == tau;
                const unsigned long long me = __ballot(eq);
                const bool take = gt || (eq && (eqs + __builtin_popcountll(me & ltm) < (int)need));
                const unsigned long long mt = __ballot(take);
                if (take) LIST[pos + __builtin_popcountll(mt & ltm)] = lane + 64 * i;
                pos += __builtin_popcountll(mt); eqs += __builtin_popcountll(me); }
            if ((i & 3) == 3) __builtin_amdgcn_sched_barrier(0); } }
        cnt = 256;
    } else {
#pragma unroll
        for (int j = 0; j < 4; ++j) LIST[lane + 64 * j] = lane + 64 * j;
        cnt = t + 1;
    }
    LDS_WAIT();
    int tid2 = tid; asm volatile("" : "+v"(tid2)); const int lane2 = tid2 & 63; const int nn = lane2 & 15, g = lane2 >> 4;
    bf16x8 qf[4];
#pragma unroll
    for (int s = 0; s < 4; ++s) { if (nn < 8) qf[s] = *(const bf16x8*)(PROJ + (rowb + t) * NP + PC_QLAT + nn * 128 + 32 * s + 8 * g); else qf[s] = (bf16x8){0, 0, 0, 0, 0, 0, 0, 0}; }
    f32x4 O[8]; float mrun, lrun;
    LAS unsigned char* buf = wl; const unsigned q4 = (unsigned)(nn >> 2), p = (unsigned)(lane2 & 3); const int nch = (cnt + 31) >> 5;
    for (int repa = 0; repa < DUP_ATT; ++repa) {
#pragma unroll
    for (int c = 0; c < 8; ++c) O[c] = (f32x4){0.f, 0.f, 0.f, 0.f};
    mrun = -INFINITY; lrun = 0.f;
    v4u pre[8];
#pragma unroll
    for (int it = 0; it < 8; ++it) { const int row = it * 4 + g; pre[it] = (v4u){0u, 0u, 0u, 0u}; if (row < cnt) { const int idx = LIST[row]; pre[it] = *(const v4u*)(KVN + (rowb + idx) * 128 + nn * 8); } }
#pragma unroll 1
    for (int ch = 0; ch < nch; ++ch) {
#pragma unroll
        for (int it = 0; it < 8; ++it) *(LAS v4u*)(buf + kv_off(it * 4 + g, nn)) = pre[it];
        if (ch + 1 < nch) {
#pragma unroll
            for (int it = 0; it < 8; ++it) { const int row = (ch + 1) * 32 + it * 4 + g; pre[it] = (v4u){0u, 0u, 0u, 0u}; if (row < cnt) { const int idx = LIST[row]; pre[it] = *(const v4u*)(KVN + (rowb + idx) * 128 + nn * 8); } } }
        LDS_WAIT();
        f32x4 S0 = {0.f, 0.f, 0.f, 0.f}, S1 = {0.f, 0.f, 0.f, 0.f};
        { const unsigned slot0 = 8u * (nn >> 2) + (nn & 3), slot1 = slot0 + 4u;
#pragma unroll
          for (int s = 0; s < 4; ++s) { const bf16x8 a0 = *(const LAS bf16x8*)(buf + kv_off(slot0, 4 * s + g)), a1 = *(const LAS bf16x8*)(buf + kv_off(slot1, 4 * s + g));
              S0 = __builtin_amdgcn_mfma_f32_16x16x32_bf16(a0, qf[s], S0, 0, 0, 0); S1 = __builtin_amdgcn_mfma_f32_16x16x32_bf16(a1, qf[s], S1, 0, 0, 0); } }
        if (ch * 32 + 32 > cnt) {
#pragma unroll
            for (int j = 0; j < 4; ++j) { if (ch * 32 + 8 * g + j >= cnt) S0[j] = -INFINITY; if (ch * 32 + 8 * g + 4 + j >= cnt) S1[j] = -INFINITY; } }
        float mc = fmaxf(fmaxf(fmaxf(S0[0], S0[1]), fmaxf(S0[2], S0[3])), fmaxf(fmaxf(S1[0], S1[1]), fmaxf(S1[2], S1[3])));
        const int lop891_ = lane_op(); mc = fmaxf(mc, SHX(mc, 16, lop891_)); mc = fmaxf(mc, SHX(mc, 32, lop891_));
        const float mnew = fmaxf(mrun, mc); const float alpha = __expf(mrun - mnew); mrun = mnew;
        float ps = 0.f;
#pragma unroll
        for (int j = 0; j < 4; ++j) { S0[j] = __expf(S0[j] - mnew); S1[j] = __expf(S1[j] - mnew); ps += S0[j] + S1[j]; }
        lrun = lrun * alpha + ps;
        v4u w; w.x = pk2(S0[0], S0[1]); w.y = pk2(S0[2], S0[3]); w.z = pk2(S1[0], S1[1]); w.w = pk2(S1[2], S1[3]); const bf16x8 Bp = __builtin_bit_cast(bf16x8, w);
#pragma unroll
        for (int c = 0; c < 8; ++c) { O[c] = O[c] * alpha;
            const v4i16_t lo = __builtin_amdgcn_ds_read_tr16_b64_v4i16((LAS v4i16_t*)(buf + kv_off(8u * g + q4, 2u * c + (p >> 1)) + 8u * (p & 1u)));
            const v4i16_t hi = __builtin_amdgcn_ds_read_tr16_b64_v4i16((LAS v4i16_t*)(buf + kv_off(8u * g + 4u + q4, 2u * c + (p >> 1)) + 8u * (p & 1u)));
            const bf16x8 a = __builtin_shufflevector(lo, hi, 0, 1, 2, 3, 4, 5, 6, 7);
            O[c] = __builtin_amdgcn_mfma_f32_16x16x32_bf16(a, Bp, O[c], 0, 0, 0); }
        LDS_WAIT();
    } }
    const int lop906_ = lane_op(); lrun += SHX(lrun, 16, lop906_); lrun += SHX(lrun, 32, lop906_);
    const float inv = 1.f / lrun;
    if (nn < 8) {
#pragma unroll
        for (int c = 0; c < 8; ++c) { v2u w; w.x = pk2(O[c][0] * inv, O[c][1] * inv); w.y = pk2(O[c][2] * inv, O[c][3] * inv); *(v2u*)(OLAT + (rowb + t) * 1024 + nn * 128 + 16 * c + 4 * g) = w; } }
}

__device__ __forceinline__ unsigned swap23(unsigned r) { return (r & ~12u) | ((r & 4u) << 1) | ((r & 8u) >> 1); }
__device__ __forceinline__ void memattn_unit(LAS unsigned char* lds, const bf16* PROJ, const bf16* MKVl, bf16* BR, int b, int hd, int qblk, int tid) {
    asm volatile("" : "+v"(tid));
    const int lane = tid & 63, wave = __builtin_amdgcn_readfirstlane(tid >> 6), r = lane & 31, hh = lane >> 5;
    LAS unsigned char* kimg = lds; LAS unsigned char* vimg = lds + 65536;
    { const bf16* kb = MKVl + (size_t)b * 256 * 1024 + hd * 128;
#pragma unroll 4
      for (int it = 0; it < 8; ++it) { const int row = it * 32 + (tid >> 4), ch = tid & 15;
          const v4u kv = *(const v4u*)(kb + (size_t)row * 1024 + ch * 8), vv = *(const v4u*)(kb + (size_t)row * 1024 + 512 + ch * 8);
          *(LAS v4u*)(kimg + kv_off(row, ch)) = kv; *(LAS v4u*)(vimg + kv_off(row, ch)) = vv; } }
    const size_t tok = (size_t)b * T + qblk * 256 + wave * 32 + r;
    bf16x8 qf[8];
#pragma unroll
    for (int s = 0; s < 8; ++s) qf[s] = *(const bf16x8*)(PROJ + tok * NP + PC_MQ + hd * 128 + 16 * s + 8 * hh);
    __syncthreads();
    f32x16 S[8];
#pragma unroll
    for (int kap = 0; kap < 8; ++kap) { f32x16 acc;
#pragma unroll
        for (int i = 0; i < 16; ++i) acc[i] = 0.f;
        const unsigned slot = 32u * kap + swap23((unsigned)r);
#pragma unroll
        for (int s = 0; s < 8; ++s) { const bf16x8 a = *(const LAS bf16x8*)(kimg + kv_off(slot, 2 * s + hh)); acc = __builtin_amdgcn_mfma_f32_32x32x16_bf16(a, qf[s], acc, 0, 0, 0); }
        S[kap] = acc; if (kap & 1) __builtin_amdgcn_sched_barrier(0); }
    float mx = -INFINITY;
#pragma unroll
    for (int kap = 0; kap < 8; ++kap)
#pragma unroll
        for (int i = 0; i < 16; ++i) mx = fmaxf(mx, S[kap][i]);
    const int lop945_ = lane_op(); mx = fmaxf(mx, SHX(mx, 32, lop945_));
    const float sc_ = 0.08838834764831845f * 1.4426950408889634f; float sum = 0.f;
#pragma unroll
    for (int kap = 0; kap < 8; ++kap)
#pragma unroll
        for (int i = 0; i < 16; ++i) { const float e = __builtin_amdgcn_exp2f((S[kap][i] - mx) * sc_); S[kap][i] = e; sum += e; }
    const int lop951_ = lane_op(); sum += SHX(sum, 32, lop951_);
    const float inv = 1.f / sum;
    bf16x8 Bp[16];
#pragma unroll
    for (int kap = 0; kap < 8; ++kap)
#pragma unroll
        for (int s = 0; s < 2; ++s) { v4u w; w.x = pk2(S[kap][8 * s], S[kap][8 * s + 1]); w.y = pk2(S[kap][8 * s + 2], S[kap][8 * s + 3]); w.z = pk2(S[kap][8 * s + 4], S[kap][8 * s + 5]); w.w = pk2(S[kap][8 * s + 6], S[kap][8 * s + 7]);
            Bp[2 * kap + s] = __builtin_bit_cast(bf16x8, w); }
    const unsigned blk = (lane >> 4) & 1, q4 = (lane & 15) >> 2, p = lane & 3;
    bf16* orow = BR + tok * 2048 + 1536 + hd * 128;
#pragma unroll
    for (int c = 0; c < 4; ++c) { f32x16 o;
#pragma unroll
        for (int i = 0; i < 16; ++i) o[i] = 0.f;
#pragma unroll
        for (int ks = 0; ks < 16; ++ks) {
            const v4i16_t lo = __builtin_amdgcn_ds_read_tr16_b64_v4i16((LAS v4i16_t*)(vimg + kv_off(16u * ks + 8u * hh + q4, 4u * c + 2u * blk + (p >> 1)) + 8u * (p & 1u)));
            const v4i16_t hi = __builtin_amdgcn_ds_read_tr16_b64_v4i16((LAS v4i16_t*)(vimg + kv_off(16u * ks + 8u * hh + 4u + q4, 4u * c + 2u * blk + (p >> 1)) + 8u * (p & 1u)));
            const bf16x8 a = __builtin_shufflevector(lo, hi, 0, 1, 2, 3, 4, 5, 6, 7);
            o = __builtin_amdgcn_mfma_f32_32x32x16_bf16(a, Bp[ks], o, 0, 0, 0); if ((ks & 3) == 3) __builtin_amdgcn_sched_barrier(0); }
#pragma unroll
        for (int i4 = 0; i4 < 4; ++i4) { v2u w; w.x = pk2(o[4 * i4] * inv, o[4 * i4 + 1] * inv); w.y = pk2(o[4 * i4 + 2] * inv, o[4 * i4 + 3] * inv);
            *(v2u*)(orow + 32 * c + 8 * i4 + 4 * hh) = w; } }
    __syncthreads();
}

__device__ __forceinline__ f32x4 ld4bf(const bf16* p) { const v2u w = *(const v2u*)p; return (f32x4){bflo(w.x), bfhi(w.x), bflo(w.y), bfhi(w.y)}; }
__device__ __forceinline__ void store_row_fp8(const f32x4 (&v)[4], unsigned char* o8, int lane) {
#pragma unroll
    for (int j = 0; j < 4; ++j) *(unsigned*)(o8 + 4 * lane + 256 * j) = q8x4(v[j][0], v[j][1], v[j][2], v[j][3], QS_H);
}
constexpr int PH_PER_LAYER = 11, NPHASE = 2 + NL * PH_PER_LAYER;

__global__ void __launch_bounds__(NWAVES * 64, 2) fwd(Args args) {
    extern __shared__ __attribute__((aligned(16))) unsigned char lds_raw[];
    Frame F;
    F.lds = (LAS unsigned char*)lds_raw;
    F.tid = threadIdx.x; F.lane = F.tid & 63; F.wave = __builtin_amdgcn_readfirstlane(F.tid >> 6);
    const int wave_s = F.wave;
    F.G = gridDim.x; F.gw = blockIdx.x * NWAVES + F.wave; F.NGW = F.G * NWAVES;
    volatile LAS unsigned* MISC = (volatile LAS unsigned*)(F.lds + MISC_OFF);
    for (int u = F.tid; u < (LDS_BYTES - LDSCTL_OFF) / 4; u += NWAVES * 64) ((LAS unsigned*)(F.lds + LDSCTL_OFF))[u] = 0u;
    __syncthreads();
#if ONE_LAUNCH
    XcdBarrier bar = xcd_barrier_post((unsigned*)(args.ws + WS_CTL) + CW_BAR, MISC + 8);
#define GRID_BAR() xcd_barrier(bar, tidq)
#else
#define GRID_BAR() do {} while (0)
#endif
    { volatile LAS unsigned long long* PT = (volatile LAS unsigned long long*)(F.lds + MISC_OFF + 512);
    if (F.tid == 0) {
#pragma unroll
        for (int i = 0; i < 33; ++i) PT[i] = (unsigned long long)args.in[i];
        PT[33] = (unsigned long long)args.out; PT[34] = (unsigned long long)args.ws;
    } }
    const int lo = args.ph_lo, hi = args.ph_hi;
    __syncthreads();
    int ph = 0;
#define IN(k) ((const float*)gptr(ldp(PT, k)))
#ifndef DUP_PHASE
#define DUP_PHASE (-1)
#endif
#ifndef PHMASK
#define PHMASK 0xFFFFull
#endif
#define PHASE_BEGIN(id) if (((PHMASK >> (id)) & 1ull) && lo <= ph && ph < hi) { unsigned ldsb_ = 0u; asm volatile("" : "+s"(ldsb_)); LAS unsigned char* ldsq = (LAS unsigned char*)lds_raw + ldsb_; \
    volatile LAS unsigned long long* PT = (volatile LAS unsigned long long*)(ldsq + MISC_OFF + 512); LAS int* BLK0 = (LAS int*)(ldsq + MISC_OFF + 128); (void)BLK0; unsigned char* ws = gptr(ldp(PT, 34)); int tidq = wave_s * 64 + lane_op(); asm volatile("" : "+v"(tidq)); const int lane = tidq & 63, wave = __builtin_amdgcn_readfirstlane(tidq >> 6); \
    Frame F; F.lds = ldsq; F.tid = tidq; F.lane = lane; F.wave = wave; { const unsigned vb1_ = ((volatile LAS unsigned*)(ldsq + MISC_OFF))[11]; int Gq_ = gridDim.x, bxq_ = __builtin_amdgcn_readfirstlane(vb1_ ? (int)vb1_ - 1 : (int)blockIdx.x); asm volatile("" : "+s"(Gq_), "+s"(bxq_)); F.G = Gq_; F.bx = bxq_; } F.gw = F.bx * NWAVES + wave; F.NGW = F.G * NWAVES; \
    bf16* WinT = (bf16*)(ws + WS_WIN); bf16* WgluT = (bf16*)(ws + WS_WGLU); bf16* WmkvT = (bf16*)(ws + WS_WMKV); bf16* WuvT = (bf16*)(ws + WS_WUV); \
    bf16* WbrT = (bf16*)(ws + WS_WBR); bf16* WoT = (bf16*)(ws + WS_WO); bf16* WupT = (bf16*)(ws + WS_WUP); bf16* WdnT = (bf16*)(ws + WS_WDN); \
    f32x2* S5A = (f32x2*)(ws + WS_S5A); f32x2* S5B = (f32x2*)(ws + WS_S5B); \
    bf16* MEMB = (bf16*)(ws + WS_MEMB); bf16* MKV = (bf16*)(ws + WS_MKV); \
    bf16* Hf = (bf16*)(ws + WS_H); bf16* Hb = (bf16*)(ws + WS_HB); bf16* PROJ = (bf16*)(ws + WS_PROJ); bf16* KVN = (bf16*)(ws + WS_KVN); \
    bf16* OLAT = (bf16*)(ws + WS_OLAT); bf16* BR = (bf16*)(ws + WS_BR); bf16* Zb = (bf16*)(ws + WS_Z); float* MRG = (float*)(ws + WS_MRG); bf16* MRGB = (bf16*)(ws + WS_MRGB); \
    bf16* Vf = (bf16*)(ws + WS_V); bf16* H1 = (bf16*)(ws + WS_H1); bf16* H1B = (bf16*)(ws + WS_H1B); \
    f32x2* SSE = (f32x2*)(ws + WS_SSE); f32x2* SSC = (f32x2*)(ws + WS_SSC); \
    int* TOK = (int*)(ws + WS_TOK); float* GATE = (float*)(ws + WS_GATE); int* SLOT = (int*)(ws + WS_SLOT); \
    bf16* XS = (bf16*)(ws + WS_XS); bf16* ACT = (bf16*)(ws + WS_ACT); bf16* YS = XS; float* SCR = (float*)(ws + WS_SCR); float* GROW = (float*)(ws + WS_SCR); bf16* KIDX = (bf16*)(ws + WS_KIDX); (void)KIDX; bf16* WSSM = (bf16*)(ws + WS_WSSM); bf16* AEXT = (bf16*)(ws + WS_AEXT); bf16* WEW = (bf16*)(ws + WS_WE); (void)WSSM; (void)AEXT; (void)WEW; \
    unsigned* CTLP = (unsigned*)(ws + WS_CTL); float* OUTP = (float*)gptr(ldp(PT, 33)); \
    (void)WinT; (void)WgluT; (void)WmkvT; (void)WuvT; (void)WbrT; (void)WoT; (void)WupT; (void)WdnT; (void)S5A; (void)S5B; (void)MEMB; (void)MKV; (void)Hf; (void)Hb; (void)PROJ; (void)KVN; (void)OLAT; (void)BR; (void)Zb; (void)MRG; (void)MRGB; \
    (void)Vf; (void)H1; (void)H1B; (void)SSE; (void)SSC; (void)TOK; (void)GATE; (void)SLOT; (void)XS; (void)ACT; (void)YS; (void)SCR; (void)GROW; (void)CTLP; (void)OUTP; \
    for (int rep_ = 0; rep_ < (((id) == DUP_PHASE) ? 2 : 1); ++rep_)
#define PHASE_END   if (ph + 1 < hi) GRID_BAR(); } ++ph;

    PHASE_BEGIN(0)
    {
        LAS unsigned char* scr = F.lds + wave * 16384;
        constexpr int I_CKV = 16 * 2, I_QIDX = 16 * 4, I_KIDX = 16, I_WIDX = 16, I_512 = 16 * 8, I_GATE = 16 * 64;
        constexpr int I_WIN = I_CKV + I_QIDX + I_KIDX + I_WIDX + 5 * I_512 + I_GATE;
        constexpr int I_GLU = 8 * 8, I_MKV = 16 * 16, I_BR = 8 * 16, I_WO = 16 * 16, I_UP = 16 * 32, I_DN = 16 * 16;
        constexpr int I_LAYER = I_WIN + I_GLU + I_MKV + 4 * I_BR + I_WO + NE * I_UP + NE * I_DN;
        const float* w_in = IN(4);
        { LAS float* wt = (LAS float*)F.lds; LAS float* uk = wt + 64 * 65;
          for (int it = F.bx; it < NL * 8 * 16; it += F.G) { const int l = it >> 7, h = (it >> 4) & 7, kb = it & 15;
            const float* Wl = w_in + (size_t)l * D * DIN + (size_t)(kb * 64) * DIN + h * 64; const float* wuk = IN(6) + (size_t)l * 128 * 512 + h * 64;
            { float t8[8], u16[16];
#pragma unroll
              for (int j = 0; j < 8; ++j) { const int i = F.tid + 512 * j; t8[j] = Wl[(size_t)(i >> 6) * DIN + (i & 63)]; }
#pragma unroll
              for (int j = 0; j < 16; ++j) { const int i = F.tid + 512 * j; u16[j] = wuk[(size_t)(i >> 6) * 512 + (i & 63)]; }
#pragma unroll
              for (int j = 0; j < 8; ++j) { const int i = F.tid + 512 * j; wt[(i >> 6) * 65 + (i & 63)] = t8[j]; }
#pragma unroll
              for (int j = 0; j < 16; ++j) { const int i = F.tid + 512 * j; uk[(i >> 6) * 65 + (i & 63)] = u16[j]; } }
            __syncthreads();
            const int c = F.tid >> 2, kq = F.tid & 3; float a[16];
#pragma unroll
            for (int j = 0; j < 16; ++j) a[j] = 0.f;
            for (int d = 0; d < 64; ++d) { const float wv = uk[c * 65 + d];
#pragma unroll
                for (int j = 0; j < 16; ++j) a[j] += wv * wt[(kq * 16 + j) * 65 + d]; }
            unsigned char* p = (unsigned char*)WinT + ((size_t)l * NP + PC_QLAT + h * 128 + c) * D + kb * 64 + kq * 16; const float sq = 0.125f * QS_WQL;
            *(v4u*)p = (v4u){q8x4(a[0], a[1], a[2], a[3], sq), q8x4(a[4], a[5], a[6], a[7], sq), q8x4(a[8], a[9], a[10], a[11], sq), q8x4(a[12], a[13], a[14], a[15], sq)};
            __syncthreads(); } }
        { LAS float* APr = (LAS float*)F.lds; LAS float* APi = APr + 33 * 64; LAS float* Br = APi + 33 * 64; LAS float* Bi = Br + 1024; LAS float* Cr = Bi + 1024; LAS float* Ci = Cr + 1024; LAS float* KD = Ci + 1024;
          for (int it = F.bx; it < NL * 32; it += F.G) { const int l = it >> 5, g = it & 31; const int lg = l * 32 + g;
            if (F.tid < 64) { const int p = F.tid; const int idx = lg * 64 + p; const float lr = IN(10)[idx], li = IN(11)[idx], dt = expf(IN(17)[lg]);
                const float er = expf(lr * dt); float sn, cs; sincosf(li * dt, &sn, &cs); const float ar = er * cs, ai = er * sn;
                float xr = 1.f, xi = 0.f;
                for (int d = 0; d <= 32; ++d) { APr[d * 64 + p] = xr; APi[d * 64 + p] = xi; const float nr = xr * ar - xi * ai, ni = xr * ai + xi * ar; xr = nr; xi = ni; }
                const float nr_ = ar - 1.f, ni_ = ai, den = lr * lr + li * li; const float fr_ = (nr_ * lr + ni_ * li) / den, fi_ = (ni_ * lr - nr_ * li) / den;
                { f32x4 br4[4], bi4[4];
#pragma unroll
                  for (int q = 0; q < 4; ++q) { br4[q] = *(const f32x4*)(IN(12) + (size_t)idx * 16 + 4 * q); bi4[q] = *(const f32x4*)(IN(13) + (size_t)idx * 16 + 4 * q); }
#pragma unroll
                  for (int n = 0; n < 16; ++n) { const float br = br4[n >> 2][n & 3], bi = bi4[n >> 2][n & 3]; Br[p * 16 + n] = fr_ * br - fi_ * bi; Bi[p * 16 + n] = fr_ * bi + fi_ * br; } } }
            for (int i = F.tid; i < 1024; i += 512) { Cr[i] = IN(14)[(size_t)lg * 1024 + i]; Ci[i] = IN(15)[(size_t)lg * 1024 + i]; }
            __syncthreads();
            { const int d = F.tid >> 4, n = F.tid & 15; float a[16];
#pragma unroll
              for (int m = 0; m < 16; ++m) a[m] = 0.f;
              for (int p = 0; p < 64; ++p) { const float cr = Cr[n * 64 + p], ci = Ci[n * 64 + p], xr = APr[d * 64 + p], xi = APi[d * 64 + p]; const float gr = cr * xr - ci * xi, gi = cr * xi + ci * xr;
#pragma unroll
                  for (int m = 0; m < 16; ++m) a[m] += gr * Br[p * 16 + m] - gi * Bi[p * 16 + m]; }
              if (d == 0) { const float dn = IN(16)[lg * 16 + n];
#pragma unroll
                  for (int m = 0; m < 16; ++m) if (m == n) a[m] += dn; }
#pragma unroll
              for (int m = 0; m < 16; ++m) KD[(d * 16 + n) * 16 + m] = a[m]; }
            __syncthreads();
            bf16* wb = WSSM + (size_t)lg * 512 * SSM_K;
            for (int q = F.tid; q < 512 * (SSM_K / 8); q += 512) { const int row = q / (SSM_K / 8), ch = q % (SSM_K / 8); const int t = row >> 4, n = row & 15; float v[8];
                if (ch < 64) { const int j = ch >> 1, m0 = (ch & 1) * 8;
#pragma unroll
                    for (int e = 0; e < 8; ++e) v[e] = (j <= t) ? KD[((t - j) * 16 + n) * 16 + m0 + e] : 0.f; }
                else { const int p2 = (ch - 64) * 8, part = p2 >> 6, p0 = p2 & 63;
#pragma unroll
                    for (int e = 0; e < 8; ++e) { const float cr = Cr[n * 64 + p0 + e], ci = Ci[n * 64 + p0 + e], ar = APr[(t + 1) * 64 + p0 + e], ai = APi[(t + 1) * 64 + p0 + e]; v[e] = part ? -(cr * ai + ci * ar) : (cr * ar - ci * ai); } }
                v4u o; o.x = pk2(v[0], v[1]); o.y = pk2(v[2], v[3]); o.z = pk2(v[4], v[5]); o.w = pk2(v[6], v[7]);
                *(v4u*)(wb + (size_t)row * SSM_K + ch * 8) = o; }
            { bf16* we = WEW + (size_t)lg * 256 * 512;
              for (int q = F.tid; q < 256 * 64; q += 512) { const int row = q >> 6, ch = q & 63; v4u o = {0u, 0u, 0u, 0u};
                  if (row < 128) { const int p = row & 63, part = row >> 6, j = ch >> 1, n0 = (ch & 1) * 8; const float ar = APr[(31 - j) * 64 + p], ai = APi[(31 - j) * 64 + p]; float v[8];
#pragma unroll
                      for (int e = 0; e < 8; ++e) { const float br = Br[p * 16 + n0 + e], bi = Bi[p * 16 + n0 + e]; v[e] = part ? (ar * bi + ai * br) : (ar * br - ai * bi); }
                      o.x = pk2(v[0], v[1]); o.y = pk2(v[2], v[3]); o.z = pk2(v[4], v[5]); o.w = pk2(v[6], v[7]); }
                  *(v4u*)(we + (size_t)row * 512 + ch * 8) = o; } }
            __syncthreads(); } }
        for (;;) { int base_ = 0; if (lane == 0) base_ = (int)__hip_atomic_fetch_add(CTLP + CW_Q0, 8u, RLX_AGENT); base_ = __builtin_amdgcn_readfirstlane(base_); if (base_ >= NL * I_LAYER) break;
        for (int it = base_; it < base_ + 8 && it < NL * I_LAYER; ++it) {
            const int l = it / I_LAYER; int r = it % I_LAYER;
            const float* Wl = w_in + (size_t)l * D * DIN; bf16* Wt = (bf16*)((unsigned char*)WinT + (size_t)l * NP * D);
            if (r < I_WIN) {
                if (r < I_CKV) { tr_item64<3>(Wl, DIN, SC_CKV, 128, D, Wt, PC_CKV, scr, r, lane); continue; } r -= I_CKV;
                if (r < I_QIDX) { tr_item64<3>(Wl, DIN, SC_QIDX, 256, D, Wt, PC_QIDX, scr, r, lane); continue; } r -= I_QIDX;
                if (r < I_KIDX) { tr_item64<3>(Wl, DIN, SC_KIDX, 32, D, Wt, PC_KIDX, scr, r, lane); continue; } r -= I_KIDX;
                if (r < I_WIDX) { tr_item64<3>(Wl, DIN, SC_WIDX, 8, D, Wt, PC_WIDX, scr, r, lane); continue; } r -= I_WIDX;
                if (r < 5 * I_512) { const int s = r / I_512; tr_item64<3>(Wl, DIN, SC_CU + 512 * s, 512, D, Wt, PC_CU + 512 * s, scr, r % I_512, lane); continue; } r -= 5 * I_512;
                tr_item64<3>(Wl, DIN, SC_GATE, 4096, D, Wt, PC_GATE, scr, r, lane); continue;
            }
            r -= I_WIN;
            if (r < I_GLU) { tr_item64(IN(18) + (size_t)l * 512 * 512, 512, 0, 512, 512, WgluT + (size_t)l * 512 * 512, 0, scr, r, lane); continue; } r -= I_GLU;
            if (r < I_MKV) { tr_item64(IN(20) + (size_t)l * 1024 * 1024, 1024, 0, 1024, 1024, WmkvT + (size_t)l * 1024 * 1024, 0, scr, r, lane); continue; } r -= I_MKV;
            if (r < 4 * I_BR) { const int b = r / I_BR; tr_item64(IN(21) + ((size_t)l * 4 + b) * 512 * 1024, 1024, 0, 1024, 512, WbrT + ((size_t)l * 4 + b) * 1024 * 512, 0, scr, r % I_BR, lane); continue; } r -= 4 * I_BR;
            if (r < I_WO) { tr_item64(IN(22) + (size_t)l * 1024 * 1024, 1024, 0, 1024, 1024, WoT + (size_t)l * 1024 * 1024, 0, scr, r, lane); continue; } r -= I_WO;
            if (r < NE * I_UP) { const int e = r / I_UP; tr_item64<1>(IN(27) + ((size_t)l * NE + e) * 1024 * 2048, 2048, 0, 2048, 1024, (bf16*)((unsigned char*)WupT + ((size_t)l * NE + e) * 2048 * 1024), 0, scr, r % I_UP, lane); continue; } r -= NE * I_UP;
            { const int e = r / I_DN; tr_item64<2>(IN(29) + ((size_t)l * NE + e) * 1024 * 1024, 1024, 0, 1024, 1024, (bf16*)((unsigned char*)WdnT + ((size_t)l * NE + e) * 1024 * 1024), 0, scr, r % I_DN, lane); }
        } }
        for (int it = F.gw; it < NL * (PC_QIDX - PC_WIDX - 8); it += F.NGW) { const int l = it / (PC_QIDX - PC_WIDX - 8), rr = PC_WIDX + 8 + it % (PC_QIDX - PC_WIDX - 8);
            *((v4u*)((unsigned char*)WinT + ((size_t)l * NP + rr) * D) + lane) = (v4u){0u, 0u, 0u, 0u}; }
        for (int it = F.gw; it < NL * 512; it += F.NGW) { const int l = it / 512, n = it % 512, h = n >> 6, d = n & 63; const float* wuv = IN(7) + (size_t)l * 128 * 512;
            bf16* p = WuvT + ((size_t)l * 512 + n) * 1024;
#pragma unroll
            for (int j = 0; j < 2; ++j) { const int k0 = 8 * lane + 512 * j; float v[8];
#pragma unroll
                for (int q = 0; q < 8; ++q) { const int k = k0 + q; const float x_ = wuv[(size_t)(k & 127) * 512 + h * 64 + d]; v[q] = ((k >> 7) == h) ? x_ : 0.f; }
                v4u o; o.x = pk2(v[0], v[1]); o.y = pk2(v[2], v[3]); o.z = pk2(v[4], v[5]); o.w = pk2(v[6], v[7]); *(v4u*)(p + k0) = o; } }
        for (int it = F.gw; it < NL * 32; it += F.NGW) { const int l = it >> 5, g = it & 31; const int idx = (l * 32 + g) * 64 + lane;
            const float lr = IN(10)[idx], li = IN(11)[idx], dt = expf(IN(17)[l * 32 + g]);
            const float er = expf(lr * dt); float sn, cs; sincosf(li * dt, &sn, &cs); const float ar = er * cs, ai = er * sn;
            S5A[idx] = (f32x2){ar, ai};
            float pr = ar, pi = ai;
#pragma unroll
            for (int q = 0; q < 5; ++q) { const float nr = pr * pr - pi * pi, ni = 2.f * pr * pi; pr = nr; pi = ni; }
            S5A[NL * 32 * 64 + idx] = (f32x2){pr, pi};
            const float nr_ = ar - 1.f, ni_ = ai, den = lr * lr + li * li; const float fr_ = (nr_ * lr + ni_ * li) / den, fi_ = (ni_ * lr - nr_ * li) / den;
            { f32x4 br4[4], bi4[4];
#pragma unroll
              for (int q = 0; q < 4; ++q) { br4[q] = *(const f32x4*)(IN(12) + (size_t)idx * 16 + 4 * q); bi4[q] = *(const f32x4*)(IN(13) + (size_t)idx * 16 + 4 * q); }
#pragma unroll
              for (int n = 0; n < 16; ++n) { const float br = br4[n >> 2][n & 3], bi = bi4[n >> 2][n & 3];
                  S5B[(size_t)idx * 16 + n] = (f32x2){fr_ * br - fi_ * bi, fr_ * bi + fi_ * br}; } } }
        for (int it = F.gw; it < 512; it += F.NGW) { const float* mp = IN(1) + (size_t)it * 1024; f32x4 v[4];
#pragma unroll
            for (int j = 0; j < 4; ++j) v[j] = *(const f32x4*)(mp + 4 * lane + 256 * j);
            store_row_f32_bf16(v, nullptr, MEMB + (size_t)it * 1024, lane); }
        const LnAff aff0 = ln_aff(IN(2), IN(3), lane);
        for (int m = F.gw; m < M; m += F.NGW) { const float* xp = IN(0) + (size_t)m * D; f32x4 v[4];
#pragma unroll
            for (int j = 0; j < 4; ++j) v[j] = *(const f32x4*)(xp + 4 * lane + 256 * j);
            ln_rows_pre(v, aff0); store_row_f32_bf16(v, nullptr, Hf + (size_t)m * D, lane); store_row_fp8(v, (unsigned char*)Hb + (size_t)m * D, lane); }
    }
    PHASE_END

    PHASE_BEGIN(1)
    {
        pg8::Dims g{2048, 2048, 2048}; MkvOrder S{F.G, F.bx, (const char*)MEMB, (const char*)WmkvT}; EpiMkv E{MKV};
        pg8::gemm_phase<EpiMkv, MkvOrder, true, true>(F.lds, g, S, E, F.tid);
    }
    PHASE_END

#define MOE_BLK0() do { if (F.tid < 32) CNTL[F.tid] = (int)__hip_atomic_load(CTLP + CW_CNT + l * 2048 + F.tid * 64, RLX_AGENT); __syncthreads(); \
        if (F.tid < 33) { int acc_ = 0; for (int k_ = 0; k_ < 32; ++k_) acc_ += (k_ < F.tid) ? ((CNTL[k_] + 255) >> 8) : 0; BLK0[F.tid] = acc_; } __syncthreads(); } while (0)
    for (int l = 0; l < NL; ++l) {
        PHASE_BEGIN(2)
        {
            pg8::Dims g{1024, 1024, 1024}; pg8::StaticOrder S; S.init(M, NP, F.G, F.bx, Hb, 1024, (const unsigned char*)WinT + (size_t)l * NP * D, 1024); EpiProjQ E{PROJ, NP, AEXT};
            pg8::gemm_phase<EpiProjQ, pg8::StaticOrder, true, true, true>(F.lds, g, S, E, F.tid);
        }
        PHASE_END

        PHASE_BEGIN(3)
        {
            { const float* kg = IN(5) + (size_t)l * 128; const float* cw = IN(8) + (size_t)l * 3 * 512; const float* cb = IN(9) + (size_t)l * 512;
              const float kg0 = kg[2 * lane], kg1 = kg[2 * lane + 1];
#pragma unroll 1
              for (int mb = F.gw; mb < M; mb += 4 * F.NGW) {
                unsigned cw2[4], kx[4]; v4u uu[4][3], gc[4][3], gb[4];
#pragma unroll
                for (int q = 0; q < 4; ++q) { int m = mb + q * F.NGW; m = m < M ? m : mb; const bf16* pr = PROJ + (size_t)m * NP; const int tl = m & (T - 1);
                    cw2[q] = *(const unsigned*)(pr + PC_CKV + 2 * lane); kx[q] = *(const unsigned*)(pr + PC_KIDX + 2 * (lane & 15)); gb[q] = *(const v4u*)(pr + PC_GB + 8 * lane);
#pragma unroll
                    for (int k = 0; k < 3; ++k) { const int back = 2 - k; const bf16* pp = pr - (size_t)(tl >= back ? back : 0) * NP;
                        uu[q][k] = *(const v4u*)(pp + PC_CU + 8 * lane); gc[q][k] = *(const v4u*)(pp + PC_GC + 8 * lane); } }
#pragma unroll
                for (int q = 0; q < 4; ++q) { const int m = mb + q * F.NGW; if (m < M) { const int tl = m & (T - 1);
                    const float c0 = bflo(cw2[q]), c1 = bfhi(cw2[q]);
                    const float rs = 1.f / sqrtf(wave_sum(c0 * c0 + c1 * c1) * (1.f / 128.f) + LN_EPS);
                    *(unsigned*)(KVN + (size_t)m * 128 + 2 * lane) = pk2(c0 * rs * kg0, c1 * rs * kg1);
                    if (lane < 16) *(unsigned*)(KIDX + (size_t)m * 32 + 2 * lane) = kx[q];
                    float y[8];
#pragma unroll
                    for (int i = 0; i < 8; ++i) y[i] = cb[8 * lane + i];
#pragma unroll
                    for (int k = 0; k < 3; ++k) { const int back = 2 - k; if (tl >= back) { const v4u u4 = uu[q][k], g4 = gc[q][k]; const float* wk = cw + k * 512 + 8 * lane;
                            y[0] += wk[0] * bflo(u4.x) * bflo(g4.x); y[1] += wk[1] * bfhi(u4.x) * bfhi(g4.x); y[2] += wk[2] * bflo(u4.y) * bflo(g4.y); y[3] += wk[3] * bfhi(u4.y) * bfhi(g4.y);
                            y[4] += wk[4] * bflo(u4.z) * bflo(g4.z); y[5] += wk[5] * bfhi(u4.z) * bfhi(g4.z); y[6] += wk[6] * bflo(u4.w) * bflo(g4.w); y[7] += wk[7] * bfhi(u4.w) * bfhi(g4.w); } }
                    const v4u b4 = gb[q];
                    v4u o; o.x = pk2(y[0] * bflo(b4.x), y[1] * bfhi(b4.x)); o.y = pk2(y[2] * bflo(b4.y), y[3] * bfhi(b4.y)); o.z = pk2(y[4] * bflo(b4.z), y[5] * bfhi(b4.z)); o.w = pk2(y[6] * bflo(b4.w), y[7] * bfhi(b4.w));
                    *(v4u*)(BR + (size_t)m * 2048 + 512 + 8 * lane) = o; } } } }
            __syncthreads();
            { pg8::Dims g{SSM_K * 2, 1024, 1024}; EOrder S{F.G, F.bx, (const char*)AEXT, (const char*)(WEW + (size_t)l * 32 * 256 * 512)}; EpiE E{(float*)SSE};
              pg8::gemm_phase<EpiE, EOrder, true, true>(F.lds, g, S, E, F.tid); }
            __syncthreads();
            __syncthreads();
            for (int u = F.bx; u < NB * 4 * (T / 256); u += F.G) { const int qblk = u % (T / 256), hd = (u / (T / 256)) & 3, b = u / (4 * (T / 256));
                memattn_unit(F.lds, PROJ, MKV + (size_t)l * 512 * 1024, BR, b, hd, qblk, F.tid); }
        }
        PHASE_END

        PHASE_BEGIN(4)
        {
            { int par = 0; float* sb0 = SCR + (size_t)F.bx * 2 * 8 * 8192;
              for (int i = 0; ; ++i) { const int rk = (i & 1) ? (i * F.G + (F.G - 1 - F.bx)) : (i * F.G + F.bx); if (rk >= M / 8) break;
                const int u = M / 8 - 1 - rk; const int b = u & 1, t0 = (u >> 1) * 8;
                dsa2_unit(F.lds, PROJ, KIDX, KVN, OLAT, sb0 + (size_t)par * 8 * 8192, b, t0, F.tid); if (t0 >= 256) par ^= 1; }
              __syncthreads(); }
#ifndef DUP_CARRY
#define DUP_CARRY 1
#endif
            for (int repc = 0; repc < DUP_CARRY; ++repc)
            for (int it = F.gw; it < NB * 32; it += F.NGW) { const int b = it >> 5, g = it & 31; const f32x2 aL = S5A[NL * 32 * 64 + (l * 32 + g) * 64 + lane];
                float hr = 0.f, hi_ = 0.f; bf16* ap = AEXT + ((size_t)(g * 512 + b * 256)) * SSM_K + 512 + lane;
                for (int c0 = 0; c0 < SSM_NC; c0 += 8) { f32x2 e[8];
#pragma unroll
                    for (int k = 0; k < 8; ++k) { const float* ep_ = (const float*)SSE + ((size_t)(b * SSM_NC + c0 + k) * 32 + g) * 128 + lane; e[k] = (f32x2){ep_[0], ep_[64]}; }
#pragma unroll
                    for (int k = 0; k < 8; ++k) { ap[(size_t)(c0 + k) * SSM_K] = (bf16)f2bf(hr); ap[(size_t)(c0 + k) * SSM_K + 64] = (bf16)f2bf(hi_);
                        const float nr = aL[0] * hr - aL[1] * hi_ + e[k][0], ni = aL[0] * hi_ + aL[1] * hr + e[k][1]; hr = nr; hi_ = ni; } } }
        }
        PHASE_END

        PHASE_BEGIN(5)
        {
            const int half = F.G >> 1;
            if (F.bx < half) {
                pg8::Dims g{SSM_K * 2, SSM_K * 2, SSM_K * 2}; SsmOrder S{half, F.bx, (const char*)AEXT, (const char*)(WSSM + (size_t)l * 32 * 512 * SSM_K)}; EpiSsm E{Zb};
                pg8::gemm_phase<EpiSsm, SsmOrder, true, true>(F.lds, g, S, E, F.tid);
            } else {
                pg8::Dims g{2048, 2048, 2048}; pg8::StaticOrder S; S.init(M, 512, F.G - half, F.bx - half, OLAT, 2048, WuvT + (size_t)l * 512 * 1024, 2048);
                EpiBf16 E{BR, 2048};
                pg8::gemm_phase<EpiBf16, pg8::StaticOrder, true, true>(F.lds, g, S, E, F.tid);
            }
        }
        PHASE_END

        PHASE_BEGIN(6)
        {
            pg8::Dims g{1024, 1024, 1024}; pg8::StaticOrder S; S.init(M, 512, F.G, F.bx, Zb, 1024, WgluT + (size_t)l * 512 * 512, 1024);
            EpiGlu E{Zb, 512, IN(19) + (size_t)l * 512, BR + 1024, 2048};
            pg8::gemm_phase<EpiGlu, pg8::StaticOrder, true, true>(F.lds, g, S, E, F.tid);
        }
        PHASE_END

        PHASE_BEGIN(7)
        {
            pg8::Dims g{4096, 1024, 1024}; MergeOrder S{F.G, F.bx, (const char*)BR, (const char*)(WbrT + (size_t)l * 4 * 1024 * 512)};
            EpiMerge E{PROJ + PC_GATE, NP, MRGB};
            pg8::gemm_phase<EpiMerge, MergeOrder, true, true>(F.lds, g, S, E, F.tid);
        }
        PHASE_END

        PHASE_BEGIN(8)
        {
            pg8::Dims g{2048, 2048, 2048}; pg8::StaticOrder S; S.init(M, 1024, F.G, F.bx, MRGB, 2048, WoT + (size_t)l * 1024 * 1024, 2048); EpiWo E{Hf, Vf};
            pg8::gemm_phase<EpiWo, pg8::StaticOrder, true, true>(F.lds, g, S, E, F.tid);
        }
        PHASE_END

        PHASE_BEGIN(9)
        {
            constexpr int HP = 2064, HLO_OFF = 16 * HP, PART_OFF = 66560;
            LAS unsigned char* hhi = F.lds; LAS unsigned char* hlo = F.lds + HLO_OFF; LAS float* part = (LAS float*)(F.lds + PART_OFF);
            LAS unsigned* wcnt = (LAS unsigned*)(F.lds + LDSCTL_OFF + 2048); LAS unsigned* wbase = wcnt + 32; LAS unsigned* asg = wcnt + 64; LAS float* asgg = (LAS float*)(asg + 256);
            const float* wr_ = IN(25) + (size_t)l * 1024 * 32; const float* brt = IN(26) + (size_t)l * 32;
            unsigned* cnt = CTLP + CW_CNT + l * 2048;
            const float* g1 = IN(23) + (size_t)l * D; const float* b1 = IN(24) + (size_t)l * D;
            const int fn = lane & 15, fkq = lane >> 4;
            v4u whi[4][2], wlo[4][2];
#pragma unroll
            for (int ks = 0; ks < 4; ++ks)
#pragma unroll
                for (int mt = 0; mt < 2; ++mt) { unsigned hh[8], ll[8];
#pragma unroll
                    for (int i = 0; i < 8; ++i) { const float f = wr_[(size_t)(128 * wave + 32 * ks + 8 * fkq + i) * 32 + 16 * mt + fn]; hh[i] = f2bf(f); ll[i] = f2bf(f - __builtin_bit_cast(float, hh[i] << 16)); }
                    whi[ks][mt] = (v4u){hh[0] | (hh[1] << 16), hh[2] | (hh[3] << 16), hh[4] | (hh[5] << 16), hh[6] | (hh[7] << 16)};
                    wlo[ks][mt] = (v4u){ll[0] | (ll[1] << 16), ll[2] | (ll[3] << 16), ll[4] | (ll[5] << 16), ll[6] | (ll[7] << 16)}; }
            const LnAff aff1 = ln_aff(g1, b1, lane);
            for (int blk = F.bx; blk < M / 64; blk += F.G) {
                if (F.tid < 32) wcnt[F.tid] = 0u;
                __syncthreads();
                v2u raw[2][4];
#pragma unroll
                for (int tk = 0; tk < 2; ++tk)
#pragma unroll
                    for (int j = 0; j < 4; ++j) raw[tk][j] = *(const v2u*)(Vf + (size_t)(blk * 64 + 2 * wave + tk) * D + 4 * lane + 256 * j);
#pragma unroll 1
                for (int rd = 0; rd < 4; ++rd) { const int m0 = blk * 64 + rd * 16 + 2 * wave;
#pragma unroll
                    for (int tk = 0; tk < 2; ++tk) { f32x4 v[4];
#pragma unroll
                        for (int j = 0; j < 4; ++j) v[j] = (f32x4){bflo(raw[tk][j].x), bfhi(raw[tk][j].x), bflo(raw[tk][j].y), bfhi(raw[tk][j].y)};
                        ln_rows_pre(v, aff1); store_row_f32_bf16(v, nullptr, H1 + (size_t)(m0 + tk) * D, lane); store_row_fp8(v, (unsigned char*)H1B + (size_t)(m0 + tk) * D, lane);
#pragma unroll
                        for (int j = 0; j < 4; ++j) { unsigned hh[4]; float rr[4];
#pragma unroll
                            for (int q = 0; q < 4; ++q) { hh[q] = f2bf(v[j][q]); rr[q] = v[j][q] - __builtin_bit_cast(float, hh[q] << 16); }
                            const int o_ = (2 * wave + tk) * HP + (4 * lane + 256 * j) * 2;
                            *(LAS v2u*)(hhi + o_) = (v2u){hh[0] | (hh[1] << 16), hh[2] | (hh[3] << 16)}; *(LAS v2u*)(hlo + o_) = (v2u){pk2(rr[0], rr[1]), pk2(rr[2], rr[3])}; } }
                    if (rd + 1 < 4) {
#pragma unroll
                        for (int tk = 0; tk < 2; ++tk)
#pragma unroll
                            for (int j = 0; j < 4; ++j) raw[tk][j] = *(const v2u*)(Vf + (size_t)(m0 + 16 + tk) * D + 4 * lane + 256 * j); }
                    __syncthreads();
                    { f32x4 acc[2] = {{0.f, 0.f, 0.f, 0.f}, {0.f, 0.f, 0.f, 0.f}};
#pragma unroll
                      for (int ks = 0; ks < 4; ++ks) { const int ko = fn * HP + (128 * wave + 32 * ks + 8 * fkq) * 2;
                          const bf16x8 bh = *(const LAS bf16x8*)(hhi + ko), bl = *(const LAS bf16x8*)(hlo + ko);
#pragma unroll
                          for (int mt = 0; mt < 2; ++mt) { const bf16x8 ah = __builtin_bit_cast(bf16x8, whi[ks][mt]), al = __builtin_bit_cast(bf16x8, wlo[ks][mt]);
                              acc[mt] = __builtin_amdgcn_mfma_f32_16x16x32_bf16(ah, bh, acc[mt], 0, 0, 0); acc[mt] = __builtin_amdgcn_mfma_f32_16x16x32_bf16(al, bh, acc[mt], 0, 0, 0);
                              acc[mt] = __builtin_amdgcn_mfma_f32_16x16x32_bf16(ah, bl, acc[mt], 0, 0, 0); } }
#pragma unroll
                      for (int mt = 0; mt < 2; ++mt) *(LAS f32x4*)(part + (wave * 16 + fn) * 32 + 16 * mt + 4 * fkq) = acc[mt]; }
                    __syncthreads();
                    const int eq = lane & 7; const int lopr_ = lane_op(); const f32x4 be4 = *(const f32x4*)(brt + 4 * eq);
#pragma unroll 1
                    for (int tk = 0; tk < 2; ++tk) { float cur[4] = {be4[0], be4[1], be4[2], be4[3]};
#pragma unroll
                        for (int w = 0; w < 8; ++w) { const f32x4 p = *(const LAS f32x4*)(part + (w * 16 + 2 * wave + tk) * 32 + 4 * eq);
#pragma unroll
                            for (int j = 0; j < 4; ++j) cur[j] += p[j]; }
                        float val[4]; int idx[4];
#pragma unroll
                        for (int k = 0; k < 4; ++k) { float bv = cur[0]; int bi = 4 * eq;
#pragma unroll
                            for (int j = 1; j < 4; ++j) if (cur[j] > bv) { bv = cur[j]; bi = 4 * eq + j; }
#pragma unroll
                            for (int o = 1; o < 8; o <<= 1) { const float ov = SHX(bv, o, lopr_); const int oi = SHX(bi, o, lopr_); if (ov > bv || (ov == bv && oi < bi)) { bv = ov; bi = oi; } }
                            val[k] = bv; idx[k] = bi;
#pragma unroll
                            for (int j = 0; j < 4; ++j) if (bi == 4 * eq + j) cur[j] = -INFINITY; }
                        const float e1 = __expf(val[1] - val[0]), e2 = __expf(val[2] - val[0]), e3 = __expf(val[3] - val[0]); const float inv = 1.f / (1.f + e1 + e2 + e3);
                        const float gt[4] = {inv, e1 * inv, e2 * inv, e3 * inv};
                        if (lane < 4) { int ee = idx[0]; float gg = gt[0];
#pragma unroll
                            for (int k = 1; k < 4; ++k) if (lane == k) { ee = idx[k]; gg = gt[k]; }
                            const unsigned rank = __hip_atomic_fetch_add(&wcnt[ee], 1u, __ATOMIC_RELAXED, __HIP_MEMORY_SCOPE_WORKGROUP);
                            const int tl_ = rd * 16 + 2 * wave + tk; asg[tl_ * 4 + lane] = (unsigned)ee | (rank << 8); asgg[tl_ * 4 + lane] = gg; } }
                    LDS_WAIT();
                }
                __syncthreads();
                if (F.tid < 32) { const unsigned c = wcnt[F.tid]; wbase[F.tid] = c ? __hip_atomic_fetch_add(cnt + F.tid * 64, c, RLX_AGENT) : 0u; }
                __syncthreads();
                if (F.tid < 256) { const unsigned a_ = asg[F.tid]; const int ee = (int)(a_ & 255u); const unsigned slot = wbase[ee] + (a_ >> 8); const int m = blk * 64 + (F.tid >> 2);
                    TOK[(size_t)ee * M + slot] = m; GATE[(size_t)ee * M + slot] = asgg[F.tid]; SLOT[(size_t)m * 4 + (F.tid & 3)] = ee * M + (int)slot; }
                __syncthreads();
            }
        }
        PHASE_END

        PHASE_BEGIN(11)
        {
            LAS int* CNTL = (LAS int*)(ldsq + MISC_OFF + 272);
            MOE_BLK0();
            for (int mb = F.gw; mb < M; mb += 16 * F.NGW) { const int m = mb + (lane >> 2) * F.NGW;
                if (m < M) { const int sl = SLOT[(size_t)m * 4 + (lane & 3)]; const int e = sl >> 14, s = sl & (M - 1); GROW[(size_t)BLK0[e] * 256 + s] = GATE[(size_t)e * M + s]; } }
            pg8::Dims g{1024, 1024, 1024}; MoeOrder S{F.G, F.bx, 8, BLK0[32] * 8, BLK0, (const char*)H1B, (const char*)WupT + (size_t)l * NE * 2048 * 1024, (size_t)0, (size_t)2048 * 1024, (size_t)256 * 1024, TOK, CNTL};
            EpiUp E{IN(28) + (size_t)l * NE * 2048, (unsigned char*)ACT};
            pg8::gemm_phase<EpiUp, MoeOrder, true, true, true, true>(F.lds, g, S, E, F.tid);
        }
        PHASE_END

        PHASE_BEGIN(12)
        {
            { LAS int* CNTL = (LAS int*)(ldsq + MISC_OFF + 272); MOE_BLK0(); }
            pg8::Dims g{1024, 1024, 1024}; MoeOrder S{F.G, F.bx, 4, BLK0[32] * 4, BLK0, (const char*)ACT, (const char*)WdnT + (size_t)l * NE * 1024 * 1024, (size_t)256 * 1024, (size_t)1024 * 1024, (size_t)256 * 1024, nullptr, nullptr};
            EpiDown E{IN(30) + (size_t)l * NE * 1024, GROW, YS};
            pg8::gemm_phase<EpiDown, MoeOrder, true, true, true>(F.lds, g, S, E, F.tid);
        }
        PHASE_END

        PHASE_BEGIN(13)
        {
            { LAS int* CNTL = (LAS int*)(ldsq + MISC_OFF + 272); MOE_BLK0(); }
#define LL_ISSUE(mm, s4, hh, yy) do { const unsigned ho_ = (unsigned)(mm) * 2048u + 8u * (unsigned)lane; \
                _Pragma("unroll") for (int j = 0; j < 4; ++j) hh[j] = *(const v2u*)((const char*)H1 + ho_ + 512 * j); \
                _Pragma("unroll") for (int k = 0; k < 4; ++k) { const unsigned sl = s4[k]; const unsigned ro_ = ((unsigned)BLK0[sl >> 14] * 256u + (sl & (unsigned)(M - 1))) * 2048u + 8u * (unsigned)lane; \
                    _Pragma("unroll") for (int j = 0; j < 4; ++j) yy[k][j] = *(const v2u*)((const char*)YS + ro_ + 512 * j); } } while (0)
#define LL_FIN(mm, hC, yC) { f32x4 v[4]; \
                  _Pragma("unroll") for (int j = 0; j < 4; ++j) { v[j] = (f32x4){bflo(hC[j].x), bfhi(hC[j].x), bflo(hC[j].y), bfhi(hC[j].y)} * DN_ALPHA; \
                      _Pragma("unroll") for (int k = 0; k < 4; ++k) { const v2u y2 = yC[k][j]; v[j][0] += bflo(y2.x); v[j][1] += bfhi(y2.x); v[j][2] += bflo(y2.y); v[j][3] += bfhi(y2.y); } } \
                  ln_rows_pre(v, aff2); \
                  if (l == NL - 1) store_row_f32_bf16(v, OUTP + (size_t)(mm) * D, nullptr, lane); \
                  else { store_row_f32_bf16(v, nullptr, Hf + (size_t)(mm) * D, lane); store_row_fp8(v, (unsigned char*)Hb + (size_t)(mm) * D, lane); } }
            const LnAff aff2 = ln_aff(IN(31) + (size_t)l * D, IN(32) + (size_t)l * D, lane);
            { int m = F.gw; const int st = F.NGW; v4u sa = *(const v4u*)(SLOT + (size_t)m * 4), sb = *(const v4u*)(SLOT + (size_t)(m + st < M ? m + st : m) * 4);
#pragma unroll 1
              for (; m < M; m += 2 * st) { const bool two = m + st < M; const int m1 = two ? m + st : m; v2u hA[4], yA[4][4], hB[4], yB[4][4];
                  LL_ISSUE(m, sa, hA, yA); LL_ISSUE(m1, sb, hB, yB);
                  { const int n0 = m + 2 * st; if (n0 < M) { sa = *(const v4u*)(SLOT + (size_t)n0 * 4); sb = *(const v4u*)(SLOT + (size_t)(n0 + st < M ? n0 + st : n0) * 4); } }
                  LL_FIN(m, hA, yA)
                  if (two) LL_FIN(m1, hB, yB) } }
#undef LL_FIN
#undef LL_ISSUE
        }
        PHASE_END
    }
#undef PHASE_BEGIN
#undef PHASE_END
}

extern "C" void kernel_launch(void* const* d_in, const int* in_sizes, int n_in, void* d_out, int out_size, void* d_ws, size_t ws_size, hipStream_t stream) {
    static int grid = 0;
    if (grid == 0) {
        if (n_in != 33 || out_size != M * D || ws_size < WS_END) { fprintf(stderr, "kernel_launch: unexpected shapes (n_in %d out %d ws %zu need %zu)\n", n_in, out_size, ws_size, (size_t)WS_END); grid = -1; return; }
        int dev = 0, cus = 0, per_cu = 0;
        if (hipGetDevice(&dev) != hipSuccess || hipDeviceGetAttribute(&cus, hipDeviceAttributeMultiprocessorCount, dev) != hipSuccess) { grid = -1; return; }
        if (hipFuncSetAttribute((const void*)fwd, hipFuncAttributeMaxDynamicSharedMemorySize, LDS_BYTES) != hipSuccess) { fprintf(stderr, "kernel_launch: hipFuncSetAttribute failed\n"); grid = -1; return; }
        if (hipOccupancyMaxActiveBlocksPerMultiprocessor(&per_cu, (const void*)fwd, NWAVES * 64, LDS_BYTES) != hipSuccess || per_cu < 1) fprintf(stderr, "kernel_launch: occupancy query says %d\n", per_cu);
        (void)hipGetLastError();
        grid = cus;
    }
    if (grid < 0) return;
    (void)hipMemsetAsync((char*)d_ws + WS_CTL, 0, CTL_ZERO_BYTES, stream);
    Args a{};
    for (int i = 0; i < 33; ++i) a.in[i] = (const float*)d_in[i];
    a.out = (float*)d_out; a.ws = (unsigned char*)d_ws;
#if ONE_LAUNCH
    a.ph_lo = 0; a.ph_hi = NPHASE;
    hipLaunchKernelGGL(fwd, dim3(grid), dim3(NWAVES * 64), LDS_BYTES, stream, a);
#else
    for (int p = 0; p < NPHASE; ++p) { a.ph_lo = p; a.ph_hi = p + 1; hipLaunchKernelGGL(fwd, dim3(grid), dim3(NWAVES * 64), LDS_BYTES, stream, a); }
#endif
}
```

```cpp
#include <hip/hip_runtime.h>
#include <cstdio>
#include <cstdint>

#ifndef ONE_LAUNCH
#define ONE_LAUNCH 1
#endif

#define LAS __attribute__((address_space(3)))
#define GAS __attribute__((address_space(1)))
typedef unsigned short bf16;
typedef unsigned v4u __attribute__((ext_vector_type(4)));
typedef unsigned v2u __attribute__((ext_vector_type(2)));
typedef float f32x4 __attribute__((ext_vector_type(4)));
typedef float f32x2 __attribute__((ext_vector_type(2)));
typedef short bf16x8 __attribute__((ext_vector_type(8)));
typedef short v4i16_t __attribute__((ext_vector_type(4)));

namespace pg8 {
constexpr int BM = 256, BK = 64, HALF = 128, HTB = HALF * BK * 2, STAGE_BYTES = 8 * HTB, NXCD = 8, WGM = 8;
__host__ __device__ __forceinline__ int lds_byte(int r, int c) { const int st = (r >> 4) * 2 + (c >> 5), rr = r & 15, cc = c & 31, ob = rr * 64 + cc * 2; return st * 1024 + (ob ^ (((ob >> 9) & 1) << 5)); }
__host__ __device__ __forceinline__ void stage_rc(int b, int& R, int& C) { const int st = b / 1024, sb = b % 1024, swz = sb ^ (((sb >> 9) & 1) << 5); R = (st >> 1) * 16 + swz / 64; C = (st & 1) * 32 + (swz % 64) / 2; }
__host__ __device__ __forceinline__ int perm32(int rho) { const int n = rho >> 4, i = rho & 15; return 8 * (i >> 2) + 4 * n + (i & 3); }

constexpr int GATHER_LIST_OFF = 131072 + 2048;
struct Unit { int pm, pn, z; const char* A; const char* B; };
struct Dims { int lda, ldb, K; };
typedef int v8i_t __attribute__((ext_vector_type(8)));
typedef int v4i_t __attribute__((ext_vector_type(4)));

__device__ __forceinline__ void tile_of(int wgid, int nM, int nN, int& pm, int& pn) {
    const int nwg = nM * nN;
    { const int q = nwg / NXCD, r = nwg % NXCD, xcd = wgid % NXCD, off = wgid / NXCD; wgid = (xcd < r ? xcd * (q + 1) : r * (q + 1) + (xcd - r) * q) + off; }
    const int nig = WGM * nN, gid = wgid / nig, fm = gid * WGM, gsz = (nM - fm) < WGM ? (nM - fm) : WGM;
    pm = fm + ((wgid % nig) % gsz); pn = (wgid % nig) / gsz;
}
struct StaticOrder {
    int nM, nN, nwg, G, c; const char* A; const char* B; size_t at, bt;
    __device__ void init(int M, int N, int G_, int c_, const void* A_, int lda, const void* B_, int ldb) { nM = M / BM; nN = N / BM; nwg = nM * nN; G = G_; c = c_; A = (const char*)A_; B = (const char*)B_; at = (size_t)BM * lda; bt = (size_t)BM * ldb; }
    __device__ __forceinline__ bool next(int i, Unit& u) const {
        const long Lx = (long)i * G + c; if (Lx >= nwg) return false;
        int pm, pn; tile_of((int)Lx, nM, nN, pm, pn); u.pm = pm; u.pn = pn; u.z = 0; u.A = A + (size_t)pm * at; u.B = B + (size_t)pn * bt; return true;
    }
};

__device__ __forceinline__ unsigned cvt_pk_bf16(float lo, float hi) { unsigned r; asm volatile("v_cvt_pk_bf16_f32 %0, %1, %2" : "=v"(r) : "v"(lo), "v"(hi)); return r; }

template <class Epi, class Sched, bool ALIGN_EPI = false, bool SP2 = false, bool FP8 = false  ,
          bool GATHER = false  >
__device__ __forceinline__ void gemm_phase(LAS unsigned char* lds, const Dims g, const Sched& S, const Epi& E, int tid_in) {
    int tid = tid_in; asm volatile("" : "+v"(tid));
    const int wid = __builtin_amdgcn_readfirstlane(tid >> 6), lane = tid & 63, wr = wid >> 2, wc = wid & 3, fr = lane & 15, fq = lane >> 4;
    const int nt = g.K / (BK * 2);
    unsigned voffA[2], voffB[2];
#pragma unroll
    for (int i = 0; i < 2; ++i) { int R, C; stage_rc(tid * 16 + i * 8192, R, C); const int Rb = Epi::PERM ? ((R & ~31) + perm32(R & 31)) : R;
        voffA[i] = (unsigned)(R * g.lda + C * 2); voffB[i] = (unsigned)(Rb * g.ldb + C * 2); }
    static_assert(!GATHER || SP2, "gathered A rows: SP2 schedule only");
    unsigned vgc[2][2]; bool last_g = false; int nxp_ = 0, gR_ = 0; unsigned gC_ = 0u; (void)last_g; (void)nxp_;
    if constexpr (GATHER) { int R, C; stage_rc(tid * 16, R, C); gR_ = R; gC_ = (unsigned)(C * 2); }
    LAS int* const ntok_ = (LAS int*)(lds + GATHER_LIST_OFF);
#define PG8_GLIST(u, par) do { if (tid < 256) { const int* tb_; int s0_, ce_; S.rowinfo(u, tb_, s0_, ce_); const int s_ = s0_ + tid; ntok_[(par) * 256 + tid] = tb_[s_ < ce_ ? s_ : 0]; } } while (0)
#define PG8_GOFF(par, vg) do { _Pragma("unroll") for (int _h = 0; _h < 2; ++_h) _Pragma("unroll") for (int _i = 0; _i < 2; ++_i) vg[_h][_i] = (unsigned)ntok_[(par) * 256 + gR_ + 64 * _i + 128 * _h] * 1024u + gC_; } while (0)
#define PG8_STAGE_A(slot, ptr, half, SEL) do { if constexpr (GATHER) { if (SEL) { unsigned vt_[2] = {vgc[half][0], vgc[half][1]}; if (last_g) { _Pragma("unroll") for (int _i = 0; _i < 2; ++_i) vt_[_i] = (unsigned)ntok_[nxp_ * 256 + gR_ + 64 * _i + 128 * (half)] * 1024u + gC_; } PG8_STAGE(slot, ptr, vt_); } else PG8_STAGE(slot, ptr, vgc[half]); } else PG8_STAGE(slot, (ptr) + ((half) ? hstepA : (size_t)0), voffA); } while (0)
    const size_t kstep = (size_t)(BK * 2);
    const size_t hstepA = (size_t)HALF * g.lda, hstepB = (size_t)HALF * g.ldb;
    const unsigned ldsw = (unsigned)wid * 1024u;
    const int aoff0 = lds_byte(wr * 64 + fr, fq * 8), aoff1 = aoff0 + 1024;
    const int boff0 = lds_byte(wc * 32 + fr, fq * 8), boff1 = boff0 + 1024;
#define PG8_SA(b, h) (((b) * 2 + (h)) * HTB)
#define PG8_SB(b, h) ((4 + (b) * 2 + (h)) * HTB)
#define PG8_STAGE(bufoff, gbase, voff) do { _Pragma("unroll") for (int _i = 0; _i < 2; ++_i) \
        __builtin_amdgcn_global_load_lds((const unsigned*)((const char*)(gbase) + (voff)[_i]), (LAS unsigned*)(lds + (bufoff) + ldsw + _i * 8192), 16, 0, 0); } while (0)
#define PG8_LDA(dst, b, h) do { _Pragma("unroll") for (int m = 0; m < 4; ++m) _Pragma("unroll") for (int k = 0; k < 2; ++k) dst[m][k] = *(const LAS bf16x8*)(lds + PG8_SA(b, h) + (k ? aoff1 : aoff0) + m * 2048); } while (0)
#define PG8_LDB(dst, b, h) do { _Pragma("unroll") for (int n = 0; n < 2; ++n) _Pragma("unroll") for (int k = 0; k < 2; ++k) dst[n][k] = *(const LAS bf16x8*)(lds + PG8_SB(b, h) + (k ? boff1 : boff0) + n * 2048); } while (0)
#define PG8_MMA(ai, bj, At, Bt) do { __builtin_amdgcn_s_setprio(1); _Pragma("unroll") for (int m = 0; m < 4; ++m) _Pragma("unroll") for (int n = 0; n < 2; ++n) _Pragma("unroll") for (int k = 0; k < 2; ++k) { \
        if constexpr (FP8) acc[ai][bj][m][n] = __builtin_bit_cast(f32x4, __builtin_amdgcn_mfma_i32_16x16x64_i8(__builtin_bit_cast(v4i_t, Bt[n][k]), __builtin_bit_cast(v4i_t, At[m][k]), __builtin_bit_cast(v4i_t, acc[ai][bj][m][n]), 0, 0, 0)); \
        else acc[ai][bj][m][n] = __builtin_amdgcn_mfma_f32_16x16x32_bf16(Bt[n][k], At[m][k], acc[ai][bj][m][n], 0, 0, 0); } __builtin_amdgcn_s_setprio(0); } while (0)
#define PG8_WAIT_V(n) asm volatile("s_waitcnt vmcnt(" #n ")" ::: "memory")
#define PG8_WAIT_L(n) asm volatile("s_waitcnt lgkmcnt(" #n ")" ::: "memory")
#define PG8_BAR __builtin_amdgcn_s_barrier()
#define PG8_SCHED __builtin_amdgcn_sched_barrier(0)
    Unit cur, nxt; int ui = 0;
    if (!S.next(0, cur)) return;
    f32x4 acc[2][2][4][2];
    float zq = 0.f; asm volatile("" : "+v"(zq));
#pragma unroll
    for (int a = 0; a < 2; ++a)
#pragma unroll
        for (int b = 0; b < 2; ++b)
#pragma unroll
            for (int m = 0; m < 4; ++m)
#pragma unroll
                for (int n = 0; n < 2; ++n) acc[a][b][m][n] = (f32x4){zq, zq, zq, zq};
    bf16x8 At[4][2], B0[2][2], B1[2][2];
    const char* cA = cur.A; const char* cB = cur.B;
    if constexpr (SP2) {
        if constexpr (GATHER) { PG8_GLIST(cur, 0); PG8_WAIT_L(0); PG8_BAR; PG8_GOFF(0, vgc); }
        PG8_STAGE(PG8_SB(0, 0), cB, voffB); PG8_STAGE(PG8_SB(0, 1), cB + hstepB, voffB); PG8_STAGE_A(PG8_SA(0, 0), cA, 0, 0); PG8_STAGE_A(PG8_SA(0, 1), cA, 1, 0);
        if (wr == 1) PG8_BAR;
        PG8_WAIT_V(2); PG8_BAR;
        PG8_STAGE(PG8_SB(1, 0), cB + kstep, voffB); PG8_STAGE_A(PG8_SA(1, 0), cA + kstep, 0, 0); PG8_STAGE(PG8_SB(1, 1), cB + hstepB + kstep, voffB);
        PG8_WAIT_V(6); PG8_BAR;
    } else {
        PG8_STAGE(PG8_SB(0, 0), cB, voffB); PG8_STAGE(PG8_SA(0, 0), cA, voffA); PG8_STAGE(PG8_SB(0, 1), cB + hstepB, voffB); PG8_STAGE(PG8_SA(0, 1), cA + hstepA, voffA);
        if (wr == 1) PG8_BAR;
        PG8_WAIT_V(4); PG8_BAR;
        PG8_STAGE(PG8_SB(1, 0), cB + kstep, voffB); PG8_STAGE(PG8_SA(1, 0), cA + kstep, voffA); PG8_STAGE(PG8_SB(1, 1), cB + hstepB + kstep, voffB);
        PG8_WAIT_V(6); PG8_BAR;
    }
    for (;;) {
        const bool has_next = S.next(ui + 1, nxt);
        const char* nA = has_next ? nxt.A : cA; const char* nB = has_next ? nxt.B : cB;
        if constexpr (GATHER) { if (has_next) PG8_GLIST(nxt, (ui + 1) & 1); }
#pragma unroll 1
        for (int t = 0; t < nt; t += 2) {
            const bool last = (t == nt - 2);
            const char* a1 = cA + (size_t)(t + 1) * kstep;
            const char* a2 = last ? nA : cA + (size_t)(t + 2) * kstep; const char* b2 = last ? nB : cB + (size_t)(t + 2) * kstep;
            const char* a3 = a2 + kstep; const char* b3 = b2 + kstep;
            if constexpr (SP2) {
            if constexpr (GATHER) { last_g = last && has_next; nxp_ = (ui + 1) & 1; }
            PG8_LDB(B0, 0, 0); PG8_LDB(B1, 0, 1); PG8_SCHED; PG8_LDA(At, 0, 0); PG8_STAGE_A(PG8_SA(1, 1), a1, 1, 0);
            PG8_WAIT_V(8); PG8_WAIT_L(0); PG8_BAR; PG8_MMA(0, 0, At, B0); PG8_MMA(0, 1, At, B1); PG8_BAR; PG8_SCHED;
            PG8_LDA(At, 0, 1); PG8_STAGE(PG8_SB(0, 0), b2, voffB); PG8_STAGE(PG8_SB(0, 1), b2 + hstepB, voffB); PG8_STAGE_A(PG8_SA(0, 0), a2, 0, 1);
            PG8_WAIT_V(8); PG8_WAIT_L(0); PG8_BAR; PG8_MMA(1, 0, At, B0); PG8_MMA(1, 1, At, B1); PG8_BAR; PG8_SCHED;
            PG8_LDB(B0, 1, 0); PG8_LDB(B1, 1, 1); PG8_SCHED; PG8_LDA(At, 1, 0); PG8_STAGE_A(PG8_SA(0, 1), a2, 1, 1);
            PG8_WAIT_V(8); PG8_WAIT_L(0); PG8_BAR; PG8_MMA(0, 0, At, B0); PG8_MMA(0, 1, At, B1); PG8_BAR; PG8_SCHED;
            PG8_LDA(At, 1, 1); PG8_STAGE(PG8_SB(1, 0), b3, voffB); PG8_STAGE(PG8_SB(1, 1), b3 + hstepB, voffB); PG8_STAGE_A(PG8_SA(1, 0), a3, 0, 1);
            PG8_WAIT_V(8); PG8_WAIT_L(0); PG8_BAR; PG8_MMA(1, 0, At, B0); PG8_MMA(1, 1, At, B1); PG8_BAR; PG8_SCHED;
            } else {
            PG8_LDB(B0, 0, 0); PG8_SCHED; PG8_LDA(At, 0, 0); PG8_STAGE(PG8_SA(1, 1), a1 + hstepA, voffA);
            PG8_WAIT_L(8); PG8_BAR; PG8_WAIT_L(0); PG8_MMA(0, 0, At, B0); PG8_BAR; PG8_SCHED;
            PG8_LDB(B1, 0, 1); PG8_STAGE(PG8_SB(0, 0), b2, voffB);
            PG8_BAR; PG8_WAIT_L(0); PG8_MMA(0, 1, At, B1); PG8_BAR;
            PG8_LDA(At, 0, 1); PG8_STAGE(PG8_SA(0, 0), a2, voffA);
            PG8_BAR; PG8_WAIT_L(0); PG8_MMA(1, 0, At, B0); PG8_BAR; PG8_SCHED;
            PG8_STAGE(PG8_SB(0, 1), b2 + hstepB, voffB);
            PG8_WAIT_V(6); PG8_BAR; PG8_MMA(1, 1, At, B1); PG8_BAR;
            PG8_LDB(B0, 1, 0); PG8_SCHED; PG8_LDA(At, 1, 0); PG8_STAGE(PG8_SA(0, 1), a2 + hstepA, voffA);
            PG8_WAIT_L(8); PG8_BAR; PG8_WAIT_L(0); PG8_MMA(0, 0, At, B0); PG8_BAR; PG8_SCHED;
            PG8_LDB(B1, 1, 1); PG8_STAGE(PG8_SB(1, 0), b3, voffB);
            PG8_BAR; PG8_WAIT_L(0); PG8_MMA(0, 1, At, B1); PG8_BAR;
            PG8_LDA(At, 1, 1); PG8_STAGE(PG8_SA(1, 0), a3, voffA);
            PG8_BAR; PG8_WAIT_L(0); PG8_MMA(1, 0, At, B0); PG8_BAR; PG8_SCHED;
            PG8_STAGE(PG8_SB(1, 1), b3 + hstepB, voffB);
            PG8_WAIT_V(6); PG8_BAR; PG8_MMA(1, 1, At, B1); PG8_BAR;
            }
        }
        if constexpr (ALIGN_EPI) { if (wr == 0) PG8_BAR; }
        E(acc, cur, wr, wc, fr, fq);
        if (!has_next) break;
#pragma unroll
        for (int a = 0; a < 2; ++a)
#pragma unroll
            for (int b = 0; b < 2; ++b)
#pragma unroll
                for (int m = 0; m < 4; ++m)
#pragma unroll
                    for (int n = 0; n < 2; ++n) acc[a][b][m][n] = (f32x4){zq, zq, zq, zq};
        cur = nxt; cA = nA; cB = nB; ++ui;
        if constexpr (GATHER) PG8_GOFF(ui & 1, vgc);
        if constexpr (ALIGN_EPI) { if (wr == 1) PG8_BAR; }
    }
    PG8_WAIT_V(0);
    if constexpr (!ALIGN_EPI) { if (wr == 0) PG8_BAR; }
    PG8_BAR;
#undef PG8_GOFF
#undef PG8_GLIST
#undef PG8_STAGE_A
#undef PG8_SA
#undef PG8_SB
#undef PG8_STAGE
#undef PG8_LDA
#undef PG8_LDB
#undef PG8_MMA
#undef PG8_WAIT_V
#undef PG8_WAIT_L
#undef PG8_BAR
#undef PG8_SCHED
}
}

constexpr int NB = 2, T = 8192, D = 1024, M = NB * T, NL = 4;
constexpr int DIN = 7592, NP = 8192;
constexpr int PC_QLAT = 0, PC_CKV = 1024, PC_KIDX = 1152, PC_WIDX = 1184, PC_QIDX = 1280, PC_CU = 1536, PC_GB = 2048, PC_GC = 2560, PC_SU = 3072, PC_MQ = 3584, PC_GATE = 4096;
constexpr int SC_Q = 0, SC_CKV = 512, SC_QIDX = 640, SC_KIDX = 896, SC_WIDX = 928, SC_CU = 936, SC_GB = 1448, SC_GC = 1960, SC_SU = 2472, SC_MQ = 2984, SC_GATE = 3496;
constexpr float QS_H = 127.f / 5.f, QS_WUP = 127.f / (4.5f * 0.03125f), QS_ACT = 127.f / 12.f, QS_WDN = 127.f / (4.5f * 0.013139006f), QS_WIN = 127.f / (4.5f * 0.03125f), QS_WQL = 8.f * QS_WIN;
constexpr int NE = 32, FE = 1024, MAXBLK = 288, MOE_ROWS = MAXBLK * 256;
constexpr int SSM_LC = 32, SSM_NC = T / SSM_LC, SSM_K = SSM_LC * 16 + 128;
constexpr float LN_EPS = 1e-5f;
constexpr float DN_ALPHA = 1.681792830507429f;

constexpr size_t MiB = 1u << 20;
constexpr size_t WS_CTL = 0, CTL_ZERO_BYTES = 1 * MiB;
constexpr size_t WS_WIN = 1 * MiB;
constexpr size_t WS_WGLU = WS_WIN + (size_t)NL * NP * D * 2;
constexpr size_t WS_WMKV = WS_WGLU + (size_t)NL * 512 * 512 * 2;
constexpr size_t WS_WUV = WS_WMKV + (size_t)NL * 1024 * 1024 * 2;
constexpr size_t WS_WBR = WS_WUV + (size_t)NL * 512 * 1024 * 2;
constexpr size_t WS_WO = WS_WBR + (size_t)NL * 4 * 1024 * 512 * 2;
constexpr size_t WS_WUP = WS_WO + (size_t)NL * 1024 * 1024 * 2;
constexpr size_t WS_WDN = WS_WUP + (size_t)NL * NE * 2048 * 1024 * 2;
constexpr size_t WS_S5A = WS_WDN + (size_t)NL * NE * 1024 * 1024 * 2;
constexpr size_t WS_S5B = WS_S5A + 1 * MiB;
constexpr size_t WS_MEMB = WS_S5B + 1 * MiB;
constexpr size_t WS_MKV = WS_MEMB + 1 * MiB;
constexpr size_t WS_H = WS_MKV + 4 * MiB;
constexpr size_t WS_HB = WS_H + (size_t)M * D * 4;
constexpr size_t WS_PROJ = WS_HB + (size_t)M * D * 2;
constexpr size_t WS_KVN = WS_PROJ + (size_t)M * NP * 2;
constexpr size_t WS_OLAT = WS_KVN + (size_t)M * 128 * 2;
constexpr size_t WS_BR = WS_OLAT + (size_t)M * 1024 * 2;
constexpr size_t WS_Z = WS_BR + (size_t)M * 2048 * 2;
constexpr size_t WS_MRG = WS_Z + (size_t)M * 512 * 2;
constexpr size_t WS_MRGB = WS_MRG + (size_t)M * D * 4;
constexpr size_t WS_V = WS_MRGB + (size_t)M * D * 2;
constexpr size_t WS_H1 = WS_V + (size_t)M * D * 4;
constexpr size_t WS_H1B = WS_H1 + (size_t)M * D * 4;
constexpr size_t WS_SSE = WS_H1B + (size_t)M * D * 2;
constexpr size_t WS_SSC = WS_SSE + (size_t)NB * SSM_NC * 32 * 64 * 8;
constexpr size_t WS_TOK = WS_SSC + (size_t)NB * SSM_NC * 32 * 64 * 8;
constexpr size_t WS_GATE = WS_TOK + (size_t)NE * M * 4;
constexpr size_t WS_SLOT = WS_GATE + (size_t)NE * M * 4;
constexpr size_t WS_XS = WS_SLOT + (size_t)M * 4 * 4;
constexpr size_t WS_ACT = WS_XS + (size_t)MOE_ROWS * 1024 * 2;
constexpr size_t WS_SCR = WS_ACT + (size_t)MOE_ROWS * 1024 * 2;
constexpr size_t WS_KIDX = WS_SCR + (size_t)256 * 2 * 8 * 8192 * 4;
constexpr size_t WS_WSSM = WS_KIDX + (size_t)M * 32 * 2;
constexpr size_t WS_AEXT = WS_WSSM + (size_t)NL * 32 * 512 * SSM_K * 2;
constexpr size_t WS_WE = WS_AEXT + (size_t)32 * 512 * SSM_K * 2;
constexpr size_t WS_END = WS_WE + (size_t)NL * 32 * 256 * 512 * 2;
constexpr int CW_TMO = 0, CW_BAR = 4096, CW_CNT = 16384, CW_Q0 = 2048;

constexpr int RING_BYTES = 131072, LDSCTL_OFF = RING_BYTES, MISC_OFF = LDSCTL_OFF + 320, LDS_BYTES = 147456;
constexpr int NWAVES = 8;

#define RLX_AGENT __ATOMIC_RELAXED, __HIP_MEMORY_SCOPE_AGENT
#define LDS_WAIT() asm volatile("s_waitcnt lgkmcnt(0)" ::: "memory")
#define VM_WAIT() asm volatile("s_waitcnt vmcnt(0)" ::: "memory")
__device__ __forceinline__ unsigned f2bf(float f) { unsigned u = __builtin_bit_cast(unsigned, f); return (u + 0x7fffu + ((u >> 16) & 1u)) >> 16; }
__device__ __forceinline__ unsigned pk2(float lo, float hi) { return f2bf(lo) | (f2bf(hi) << 16); }
__device__ __forceinline__ float bflo(unsigned w) { return __builtin_bit_cast(float, w << 16); }
__device__ __forceinline__ float bfhi(unsigned w) { return __builtin_bit_cast(float, w & 0xffff0000u); }
__device__ __forceinline__ float bf1(bf16 v) { return __builtin_bit_cast(float, (unsigned)v << 16); }
__device__ __forceinline__ unsigned q8_(float x, float s) { return (unsigned)(int)__builtin_rintf(fminf(fmaxf(x * s, -127.f), 127.f)) & 255u; }
__device__ __forceinline__ unsigned q8x4(float a, float b, float c, float d, float s) { return q8_(a, s) | (q8_(b, s) << 8) | (q8_(c, s) << 16) | (q8_(d, s) << 24); }
__device__ __forceinline__ float sigmoidf_(float x) { return __builtin_amdgcn_rcpf(1.f + __expf(-x)); }
__device__ __forceinline__ int lane_op() { int l = (int)__builtin_amdgcn_mbcnt_hi(~0u, __builtin_amdgcn_mbcnt_lo(~0u, 0u)); asm volatile("" : "+v"(l)); return l; }
template <class Tv> __device__ __forceinline__ Tv bperm_(int srcLane, Tv v) { return __builtin_bit_cast(Tv, __builtin_amdgcn_ds_bpermute(srcLane << 2, __builtin_bit_cast(int, v))); }
#define SHX(v, m, l) bperm_((l) ^ (m), (v))
#define SHD(v, o, l) bperm_((l) + (o), (v))
#define SHI(v, s) bperm_((s), (v))
__device__ __forceinline__ float wave_sum(float v) { const int l = lane_op();
#pragma unroll
    for (int o = 1; o < 64; o <<= 1) v += SHX(v, o, l);
    return v;
}
__device__ __forceinline__ float wave_max(float v) { const int l = lane_op();
#pragma unroll
    for (int o = 1; o < 64; o <<= 1) v = fmaxf(v, SHX(v, o, l));
    return v;
}

#define DPP_STEP_(T, v, ctrl, rm, idbits, OP) { const T t_ = __builtin_bit_cast(T, __builtin_amdgcn_update_dpp((int)(idbits), __builtin_bit_cast(int, v), ctrl, rm, 0xf, false)); v = OP(v, t_); }
#define DPP_ADD_(a, b) ((a) + (b))
__device__ __forceinline__ unsigned dpp_scan_add_u32(unsigned v) {
    DPP_STEP_(unsigned, v, 0x111, 0xf, 0, DPP_ADD_) DPP_STEP_(unsigned, v, 0x112, 0xf, 0, DPP_ADD_) DPP_STEP_(unsigned, v, 0x114, 0xf, 0, DPP_ADD_) DPP_STEP_(unsigned, v, 0x118, 0xf, 0, DPP_ADD_)
    DPP_STEP_(unsigned, v, 0x142, 0xa, 0, DPP_ADD_) DPP_STEP_(unsigned, v, 0x143, 0xc, 0, DPP_ADD_) return v; }
__device__ __forceinline__ float wave_sum_dpp(float v) {
    DPP_STEP_(float, v, 0x111, 0xf, 0, DPP_ADD_) DPP_STEP_(float, v, 0x112, 0xf, 0, DPP_ADD_) DPP_STEP_(float, v, 0x114, 0xf, 0, DPP_ADD_) DPP_STEP_(float, v, 0x118, 0xf, 0, DPP_ADD_)
    DPP_STEP_(float, v, 0x142, 0xa, 0, DPP_ADD_) DPP_STEP_(float, v, 0x143, 0xc, 0, DPP_ADD_)
    return __builtin_bit_cast(float, __builtin_amdgcn_readlane(__builtin_bit_cast(int, v), 63)); }
__device__ __forceinline__ float wave_max_dpp(float v) {
    DPP_STEP_(float, v, 0x111, 0xf, 0xff800000u, fmaxf) DPP_STEP_(float, v, 0x112, 0xf, 0xff800000u, fmaxf) DPP_STEP_(float, v, 0x114, 0xf, 0xff800000u, fmaxf) DPP_STEP_(float, v, 0x118, 0xf, 0xff800000u, fmaxf)
    DPP_STEP_(float, v, 0x142, 0xa, 0xff800000u, fmaxf) DPP_STEP_(float, v, 0x143, 0xc, 0xff800000u, fmaxf)
    return __builtin_bit_cast(float, __builtin_amdgcn_readlane(__builtin_bit_cast(int, v), 63)); }

#define XB_TMO      128
#define XB_XCNT(j)  (256  + 64 * (j))
#define XB_XSUB(j)  (1280 + 64 * (j))
#define XB_XGEN(j)  (2304 + 64 * (j))
#define XB_TOP      3328
#define XB_TOPGEN   3392
#define XCD_BAR_WORDS 3456
#define XB_SPIN_CAP (1u << 18)
__device__ __forceinline__ unsigned xb_ld(unsigned* p)              { return __hip_atomic_load(p, __ATOMIC_RELAXED, __HIP_MEMORY_SCOPE_AGENT); }
__device__ __forceinline__ unsigned xb_add(unsigned* p, unsigned v) { return __hip_atomic_fetch_add(p, v, __ATOMIC_RELAXED, __HIP_MEMORY_SCOPE_AGENT); }
__device__ __forceinline__ unsigned xb_xcc_id() { return (unsigned)__builtin_amdgcn_s_getreg((3 << 11) | 20) & 0xFu; }
#define XB_SPIN(cond, bar) do { unsigned _sp = 0; while (cond) { __builtin_amdgcn_s_sleep(1); \
    if ((++_sp & 255u) == 0u) { if (xb_ld(&(bar)[XB_TMO])) break; if (_sp > XB_SPIN_CAP) { atomicAdd(&(bar)[XB_TMO], 1u); break; } } } } while (0)
struct XcdBarrier { unsigned* bar; unsigned x; volatile LAS unsigned* st; };
__device__ __forceinline__ XcdBarrier xcd_barrier_post(unsigned* bar, volatile LAS unsigned* st) {
    XcdBarrier b; b.bar = bar; b.x = xb_xcc_id(); b.st = st;
    if (threadIdx.x == 0) st[2] = xb_add(&bar[XB_XCNT(b.x)], 1u);
    return b;
}
__device__ __forceinline__ void xcd_barrier_complete(unsigned* bar, unsigned x, unsigned& nloc, unsigned& nx, unsigned& balanced) {
    const unsigned G = gridDim.x * gridDim.y * gridDim.z;
    unsigned sum, cnt, mine, sp = 0u, bal;
    for (;;) {
        sum = 0u; cnt = 0u; mine = 0u; bal = 1u;
#pragma unroll 1
        for (unsigned j = 0; j < 16; ++j) { const unsigned c = xb_ld(&bar[XB_XCNT(j)]); sum += c; cnt += (c > 0u) ? 1u : 0u; mine = (j == x) ? c : mine; bal = (c == (j < 8u ? (G >> 3) : 0u)) ? bal : 0u; }
        if (sum == G) break;
        __builtin_amdgcn_s_sleep(1);
        if ((++sp & 255u) == 0u) { if (xb_ld(&bar[XB_TMO])) break; if (sp > XB_SPIN_CAP) { atomicAdd(&bar[XB_TMO], 1u); break; } }
    }
    nloc = mine > 0u ? mine : 1u; nx = cnt > 0u ? cnt : 1u; balanced = ((G & 7u) == 0u && sum == G) ? bal : 0u;
}
__device__ __forceinline__ void xcd_barrier(const XcdBarrier& b, int tid_) {
    asm volatile("s_waitcnt vmcnt(0)" ::: "memory");
    __syncthreads();
    if (tid_ == 0) {
        unsigned* bar = b.bar;
        __builtin_amdgcn_s_waitcnt(0);
        unsigned nloc = b.st[0], nx = b.st[1];
        if (nloc == 0u) { unsigned bal_; xcd_barrier_complete(bar, b.x, nloc, nx, bal_); b.st[0] = nloc; b.st[1] = nx;
            b.st[3] = (bal_ ? b.st[2] * 8u + b.x : (unsigned)blockIdx.x) + 1u; }
        const unsigned old = xb_add(&bar[XB_XSUB(b.x)], 1u);
        const unsigned gen = old / nloc;
        if (old + 1u == (gen + 1u) * nloc) {
            __builtin_amdgcn_fence(__ATOMIC_RELEASE, "agent");
            asm volatile("s_waitcnt vmcnt(0)" ::: "memory");
            const unsigned og = xb_add(&bar[XB_TOP], 1u);
            const unsigned tg = og / nx;
            if (og + 1u == (tg + 1u) * nx) xb_add(&bar[XB_TOPGEN], 1u);
            else XB_SPIN(xb_ld(&bar[XB_TOPGEN]) == tg, bar);
            __builtin_amdgcn_fence(__ATOMIC_ACQUIRE, "agent");
            xb_add(&bar[XB_XGEN(b.x)], 1u);
            asm volatile("s_waitcnt vmcnt(0)" ::: "memory");
        } else {
            XB_SPIN(xb_ld(&bar[XB_XGEN(b.x)]) == gen, bar);
            __builtin_amdgcn_fence(__ATOMIC_ACQUIRE, "agent");
            asm volatile("s_waitcnt vmcnt(0)" ::: "memory");
        }
    }
    __syncthreads();
}

__device__ __forceinline__ unsigned long long ldp(volatile LAS unsigned long long* PT, int k) { const unsigned long long v = PT[k];
    const unsigned lo = __builtin_amdgcn_readfirstlane((unsigned)v), hi = __builtin_amdgcn_readfirstlane((unsigned)(v >> 32)); return ((unsigned long long)hi << 32) | lo; }
typedef __attribute__((address_space(1))) unsigned char gu8_t;
__device__ __forceinline__ unsigned char* gptr(unsigned long long v) { return (unsigned char*)(gu8_t*)v; }
struct Args { const float* in[33]; float* out; unsigned char* ws; int ph_lo, ph_hi; };

struct Frame {
    LAS unsigned char* lds;
    int tid, lane, wave, G, gw, NGW, bx;
};

using pg8::Unit; using pg8::cvt_pk_bf16; using pg8::v4i_t;
struct EpiBf16 {
    static constexpr bool PERM = true;
    bf16* O; int ldc;
    __device__ __forceinline__ void operator()(const f32x4 (&acc)[2][2][4][2], const Unit& u, int wr, int wc, int fr, int fq) const {
        const int row0 = u.pm * 256 + wr * 64 + fr, col0 = u.pn * 256 + wc * 32 + 8 * fq;
#pragma unroll
        for (int ai = 0; ai < 2; ++ai)
#pragma unroll
            for (int m = 0; m < 4; ++m) { bf16* rowp = O + (size_t)(row0 + ai * 128 + m * 16) * ldc + col0;
#pragma unroll
                for (int bj = 0; bj < 2; ++bj) { const f32x4 v0 = acc[ai][bj][m][0], v1 = acc[ai][bj][m][1];
                    v4u w; w.x = cvt_pk_bf16(v0[0], v0[1]); w.y = cvt_pk_bf16(v0[2], v0[3]); w.z = cvt_pk_bf16(v1[0], v1[1]); w.w = cvt_pk_bf16(v1[2], v1[3]);
                    *(v4u*)(rowp + bj * 128) = w; } }
    }
};
struct EpiProjQ {
    static constexpr bool PERM = true;
    bf16* O; int ldc; bf16* AX;
    __device__ __forceinline__ void operator()(const f32x4 (&acc)[2][2][4][2], const Unit& u, int wr, int wc, int fr, int fq) const {
        const int row0 = u.pm * 256 + wr * 64 + fr, col0 = u.pn * 256 + wc * 32 + 8 * fq; const float dq = 1.f / (QS_H * (u.pn < 4 ? QS_WQL : QS_WIN));
#pragma unroll
        for (int ai = 0; ai < 2; ++ai)
#pragma unroll
            for (int m = 0; m < 4; ++m) { bf16* rowp = O + (size_t)(row0 + ai * 128 + m * 16) * ldc + col0;
#pragma unroll
                for (int bj = 0; bj < 2; ++bj) { const v4i_t i0 = __builtin_bit_cast(v4i_t, acc[ai][bj][m][0]), i1 = __builtin_bit_cast(v4i_t, acc[ai][bj][m][1]);
                    v4u w; w.x = cvt_pk_bf16((float)i0[0] * dq, (float)i0[1] * dq); w.y = cvt_pk_bf16((float)i0[2] * dq, (float)i0[3] * dq); w.z = cvt_pk_bf16((float)i1[0] * dq, (float)i1[1] * dq); w.w = cvt_pk_bf16((float)i1[2] * dq, (float)i1[3] * dq);
                    if (u.pn == 12 || u.pn == 13) { const int m_ = row0 + ai * 128 + m * 16, ch = (u.pn - 12) * 256 + wc * 32 + 8 * fq + bj * 128, tl = m_ & (T - 1);
                        *(v4u*)(AX + ((size_t)((ch >> 4) * 512 + (m_ >> 13) * 256 + (tl >> 5))) * SSM_K + (tl & 31) * 16 + (ch & 15)) = w; }
                    else *(v4u*)(rowp + bj * 128) = w; } }
    }
};
struct EpiE {
    static constexpr bool PERM = true;
    float* E2;
    __device__ __forceinline__ void operator()(const f32x4 (&acc)[2][2][4][2], const Unit& u, int wr, int wc, int fr, int fq) const {
        const int row0 = u.pm * 256 + wr * 64 + fr, col0 = wc * 32 + 8 * fq;
#pragma unroll
        for (int ai = 0; ai < 2; ++ai)
#pragma unroll
            for (int m = 0; m < 4; ++m) { float* p = E2 + ((size_t)(row0 + ai * 128 + m * 16) * 32 + u.z) * 128 + col0; *(f32x4*)p = acc[ai][0][m][0]; *(f32x4*)(p + 4) = acc[ai][0][m][1]; }
    }
};
struct EOrder {
    int G, c; const char* A; const char* B;
    __device__ __forceinline__ bool next(int i, Unit& u) const {
        const int Lx = i * G + c; if (Lx >= 64) return false;
        const int g = Lx >> 1, pm = Lx & 1; u.pm = pm; u.pn = 0; u.z = g; u.A = A + ((size_t)g * 512 + pm * 256) * SSM_K * 2; u.B = B + (size_t)g * 256 * 512 * 2; return true;
    }
};
struct EpiMkv {
    static constexpr bool PERM = true;
    bf16* O;
    __device__ __forceinline__ void operator()(const f32x4 (&acc)[2][2][4][2], const Unit& u, int wr, int wc, int fr, int fq) const {
        EpiBf16 e{O + (size_t)u.z * 512 * 1024, 1024}; e(acc, u, wr, wc, fr, fq);
    }
};
struct EpiGlu {
    static constexpr bool PERM = true;
    const bf16* Z; int ldz; const float* bias; bf16* O; int ldo;
    __device__ __forceinline__ void operator()(const f32x4 (&acc)[2][2][4][2], const Unit& u, int wr, int wc, int fr, int fq) const {
        const int row0 = u.pm * 256 + wr * 64 + fr, col0 = u.pn * 256 + wc * 32 + 8 * fq;
        f32x4 bv[2][2];
#pragma unroll
        for (int bj = 0; bj < 2; ++bj)
#pragma unroll
            for (int n = 0; n < 2; ++n) bv[bj][n] = *(const f32x4*)(bias + col0 + bj * 128 + 4 * n);
#pragma unroll
        for (int ai = 0; ai < 2; ++ai) { v4u zq[4][2];
#pragma unroll
            for (int m = 0; m < 4; ++m)
#pragma unroll
                for (int bj = 0; bj < 2; ++bj) zq[m][bj] = *(const v4u*)(Z + (size_t)(row0 + ai * 128 + m * 16) * ldz + col0 + bj * 128);
#pragma unroll
            for (int m = 0; m < 4; ++m) { const size_t r = (size_t)(row0 + ai * 128 + m * 16);
#pragma unroll
                for (int bj = 0; bj < 2; ++bj) { const f32x4 v0 = acc[ai][bj][m][0] + bv[bj][0], v1 = acc[ai][bj][m][1] + bv[bj][1];
                    const v4u zz = zq[m][bj];
                    v4u w;
                    w.x = cvt_pk_bf16(bflo(zz.x) * sigmoidf_(v0[0]), bfhi(zz.x) * sigmoidf_(v0[1]));
                    w.y = cvt_pk_bf16(bflo(zz.y) * sigmoidf_(v0[2]), bfhi(zz.y) * sigmoidf_(v0[3]));
                    w.z = cvt_pk_bf16(bflo(zz.z) * sigmoidf_(v1[0]), bfhi(zz.z) * sigmoidf_(v1[1]));
                    w.w = cvt_pk_bf16(bflo(zz.w) * sigmoidf_(v1[2]), bfhi(zz.w) * sigmoidf_(v1[3]));
                    *(v4u*)(O + r * ldo + col0 + bj * 128) = w; } } }
    }
};
struct EpiMerge {
    static constexpr bool PERM = true;
    const bf16* G; int ldg; bf16* Mb;
    __device__ __forceinline__ void operator()(const f32x4 (&acc)[2][2][4][2], const Unit& u, int wr, int wc, int fr, int fq) const {
        const int row0 = u.pm * 256 + wr * 64 + fr, col0 = u.pn * 256 + wc * 32 + 8 * fq; const int r = u.z;
#pragma unroll
        for (int ai = 0; ai < 2; ++ai) { v4u gq[4][2], pq[4][2];
#pragma unroll
            for (int m = 0; m < 4; ++m) { const size_t rr = (size_t)(row0 + ai * 128 + m * 16);
#pragma unroll
                for (int bj = 0; bj < 2; ++bj) { const int c = col0 + bj * 128; gq[m][bj] = *(const v4u*)(G + rr * ldg + r * 1024 + c); pq[m][bj] = (v4u){0u, 0u, 0u, 0u}; if (r) pq[m][bj] = *(const v4u*)(Mb + rr * 1024 + c); } }
#pragma unroll
            for (int m = 0; m < 4; ++m) { const size_t rr = (size_t)(row0 + ai * 128 + m * 16);
#pragma unroll
                for (int bj = 0; bj < 2; ++bj) { const int c = col0 + bj * 128;
                    const v4u gg = gq[m][bj], pv = pq[m][bj]; bf16* mp = Mb + rr * 1024 + c;
                    f32x4 o0 = (f32x4){bflo(pv.x), bfhi(pv.x), bflo(pv.y), bfhi(pv.y)}, o1 = (f32x4){bflo(pv.z), bfhi(pv.z), bflo(pv.w), bfhi(pv.w)};
                    const f32x4 v0 = acc[ai][bj][m][0], v1 = acc[ai][bj][m][1];
                    o0[0] += sigmoidf_(bflo(gg.x)) * v0[0]; o0[1] += sigmoidf_(bfhi(gg.x)) * v0[1]; o0[2] += sigmoidf_(bflo(gg.y)) * v0[2]; o0[3] += sigmoidf_(bfhi(gg.y)) * v0[3];
                    o1[0] += sigmoidf_(bflo(gg.z)) * v1[0]; o1[1] += sigmoidf_(bfhi(gg.z)) * v1[1]; o1[2] += sigmoidf_(bflo(gg.w)) * v1[2]; o1[3] += sigmoidf_(bfhi(gg.w)) * v1[3];
                    v4u w; w.x = cvt_pk_bf16(o0[0], o0[1]); w.y = cvt_pk_bf16(o0[2], o0[3]); w.z = cvt_pk_bf16(o1[0], o1[1]); w.w = cvt_pk_bf16(o1[2], o1[3]); *(v4u*)mp = w; } } }
    }
};
struct EpiWo {
    static constexpr bool PERM = true;
    const bf16* H; bf16* V;
    __device__ __forceinline__ void operator()(const f32x4 (&acc)[2][2][4][2], const Unit& u, int wr, int wc, int fr, int fq) const {
        const int row0 = u.pm * 256 + wr * 64 + fr, col0 = u.pn * 256 + wc * 32 + 8 * fq;
#pragma unroll
        for (int ai = 0; ai < 2; ++ai) { v4u hq[4][2];
#pragma unroll
            for (int m = 0; m < 4; ++m)
#pragma unroll
                for (int bj = 0; bj < 2; ++bj) hq[m][bj] = *(const v4u*)(H + (size_t)(row0 + ai * 128 + m * 16) * 1024 + col0 + bj * 128);
#pragma unroll
            for (int m = 0; m < 4; ++m) { const size_t off = (size_t)(row0 + ai * 128 + m * 16) * 1024 + col0;
#pragma unroll
                for (int bj = 0; bj < 2; ++bj) { const v4u hh = hq[m][bj]; const f32x4 v0 = acc[ai][bj][m][0], v1 = acc[ai][bj][m][1];
                    v4u w; w.x = cvt_pk_bf16(bflo(hh.x) * DN_ALPHA + v0[0], bfhi(hh.x) * DN_ALPHA + v0[1]); w.y = cvt_pk_bf16(bflo(hh.y) * DN_ALPHA + v0[2], bfhi(hh.y) * DN_ALPHA + v0[3]);
                    w.z = cvt_pk_bf16(bflo(hh.z) * DN_ALPHA + v1[0], bfhi(hh.z) * DN_ALPHA + v1[1]); w.w = cvt_pk_bf16(bflo(hh.w) * DN_ALPHA + v1[2], bfhi(hh.w) * DN_ALPHA + v1[3]);
                    *(v4u*)(V + off + bj * 128) = w; } } }
    }
};
struct EpiUp {
    static constexpr bool PERM = true;
    const float* bup; unsigned char* ACT;
    __device__ __forceinline__ void operator()(const f32x4 (&acc)[2][2][4][2], const Unit& u, int wr, int wc, int fr, int fq) const {
        const int row0 = u.pm * 256 + wr * 64 + fr, col0 = u.pn * 256 + wc * 32 + 8 * fq; const float* bb = bup + (size_t)u.z * 2048; const float dq = 1.f / (QS_H * QS_WUP);
        f32x4 bv[2][2];
#pragma unroll
        for (int bj = 0; bj < 2; ++bj)
#pragma unroll
            for (int n = 0; n < 2; ++n) bv[bj][n] = *(const f32x4*)(bb + col0 + bj * 128 + 4 * n);
#pragma unroll
        for (int ai = 0; ai < 2; ++ai)
#pragma unroll
            for (int m = 0; m < 4; ++m) { const size_t r = (size_t)(row0 + ai * 128 + m * 16);
#pragma unroll
                for (int bj = 0; bj < 2; ++bj) { const v4i_t i0 = __builtin_bit_cast(v4i_t, acc[ai][bj][m][0]), i1 = __builtin_bit_cast(v4i_t, acc[ai][bj][m][1]);
                    const f32x4 v0 = (f32x4){(float)i0[0], (float)i0[1], (float)i0[2], (float)i0[3]} * dq + bv[bj][0], v1 = (f32x4){(float)i1[0], (float)i1[1], (float)i1[2], (float)i1[3]} * dq + bv[bj][1];
                    float a[4];
#pragma unroll
                    for (int j = 0; j < 4; ++j) { const float gx = j < 2 ? v0[2 * j] : v1[2 * j - 4], lx = j < 2 ? v0[2 * j + 1] : v1[2 * j - 3];
                        const float gl = fminf(gx, 7.0f), li = fminf(fmaxf(lx, -7.0f), 7.0f); a[j] = gl * sigmoidf_(1.702f * gl) * (li + 1.0f); }
                    *(unsigned*)(ACT + r * 1024 + ((col0 + bj * 128) >> 1)) = q8x4(a[0], a[1], a[2], a[3], QS_ACT); } }
    }
};
struct EpiDown {
    static constexpr bool PERM = true;
    const float* bdn; const float* grow; bf16* YS;
    __device__ __forceinline__ void operator()(const f32x4 (&acc)[2][2][4][2], const Unit& u, int wr, int wc, int fr, int fq) const {
        const int row0 = u.pm * 256 + wr * 64 + fr, col0 = u.pn * 256 + wc * 32 + 8 * fq; const float* bb = bdn + (size_t)u.z * 1024; const float dq = 1.f / (QS_ACT * QS_WDN);
        f32x4 bv[2][2];
#pragma unroll
        for (int bj = 0; bj < 2; ++bj)
#pragma unroll
            for (int n = 0; n < 2; ++n) bv[bj][n] = *(const f32x4*)(bb + col0 + bj * 128 + 4 * n);
        float gq[2][4];
#pragma unroll
        for (int ai = 0; ai < 2; ++ai)
#pragma unroll
            for (int m = 0; m < 4; ++m) gq[ai][m] = grow[(size_t)(row0 + ai * 128 + m * 16)];
#pragma unroll
        for (int ai = 0; ai < 2; ++ai)
#pragma unroll
            for (int m = 0; m < 4; ++m) { const size_t r = (size_t)(row0 + ai * 128 + m * 16); const float gt = gq[ai][m];
#pragma unroll
                for (int bj = 0; bj < 2; ++bj) { const v4i_t i0 = __builtin_bit_cast(v4i_t, acc[ai][bj][m][0]), i1 = __builtin_bit_cast(v4i_t, acc[ai][bj][m][1]);
                    const f32x4 v0 = ((f32x4){(float)i0[0], (float)i0[1], (float)i0[2], (float)i0[3]} * dq + bv[bj][0]) * gt, v1 = ((f32x4){(float)i1[0], (float)i1[1], (float)i1[2], (float)i1[3]} * dq + bv[bj][1]) * gt;
                    v4u w; w.x = cvt_pk_bf16(v0[0], v0[1]); w.y = cvt_pk_bf16(v0[2], v0[3]); w.z = cvt_pk_bf16(v1[0], v1[1]); w.w = cvt_pk_bf16(v1[2], v1[3]);
                    *(v4u*)(YS + r * 1024 + col0 + bj * 128) = w; } }
    }
};
struct EpiSsm {
    static constexpr bool PERM = true;
    bf16* Z;
    __device__ __forceinline__ void operator()(const f32x4 (&acc)[2][2][4][2], const Unit& u, int wr, int wc, int fr, int fq) const {
        const int row0 = u.pm * 256 + wr * 64 + fr, col0 = u.pn * 256 + wc * 32 + 8 * fq;
#pragma unroll
        for (int ai = 0; ai < 2; ++ai)
#pragma unroll
            for (int m = 0; m < 4; ++m) { const int row = row0 + ai * 128 + m * 16; const size_t tokb = (size_t)(row >> 8) * T + (size_t)(row & 255) * SSM_LC;
#pragma unroll
                for (int bj = 0; bj < 2; ++bj) { const int col = col0 + bj * 128; const f32x4 v0 = acc[ai][bj][m][0], v1 = acc[ai][bj][m][1]; float z[8];
#pragma unroll
                    for (int j = 0; j < 8; ++j) { const float y = j < 4 ? v0[j] : v1[j - 4]; const float x3 = 0.7978845608028654f * (y + 0.044715f * y * y * y); const float th = 1.f - 2.f * __builtin_amdgcn_rcpf(__expf(2.f * x3) + 1.f); z[j] = 0.5f * y * (1.f + th); }
                    v4u w; w.x = cvt_pk_bf16(z[0], z[1]); w.y = cvt_pk_bf16(z[2], z[3]); w.z = cvt_pk_bf16(z[4], z[5]); w.w = cvt_pk_bf16(z[6], z[7]);
                    *(v4u*)(Z + (tokb + (col >> 4)) * 512 + u.z * 16 + (col & 15)) = w; } }
    }
};
struct SsmOrder {
    int G, c; const char* A; const char* B;
    __device__ __forceinline__ bool next(int i, Unit& u) const {
        const int Lx = i * G + c; if (Lx >= 128) return false;
        const int g = Lx >> 2, pm = (Lx >> 1) & 1, pn = Lx & 1; u.pm = pm; u.pn = pn; u.z = g;
        u.A = A + ((size_t)g * 512 + pm * 256) * SSM_K * 2; u.B = B + ((size_t)g * 512 + pn * 256) * SSM_K * 2; return true;
    }
};
struct MkvOrder {
    int G, c; const char* A; const char* B;
    __device__ __forceinline__ bool next(int i, Unit& u) const {
        const int Lx = i * G + c; if (Lx >= NL * 8) return false;
        const int l = Lx >> 3, pm = (Lx >> 2) & 1, pn = Lx & 3; u.pm = pm; u.pn = pn; u.z = l;
        u.A = A + (size_t)pm * 256 * 1024 * 2; u.B = B + ((size_t)l * 1024 + pn * 256) * 1024 * 2; return true;
    }
};
struct MergeOrder {
    int G, c; const char* A; const char* B;
    __device__ __forceinline__ bool next(int i, Unit& u) const {
        const long Lx = (long)(i >> 2) * G + c; if (Lx >= 64 * 4) return false;
        int pm, pn; pg8::tile_of((int)Lx, 64, 4, pm, pn); const int r = i & 3; u.pm = pm; u.pn = pn; u.z = r;
        u.A = A + ((size_t)pm * 256 * 2048 + r * 512) * 2; u.B = B + ((size_t)r * 1024 + pn * 256) * 512 * 2; return true;
    }
};
struct MoeOrder {
    int G, c, nN, nunits; const LAS int* blk0; const char* A; const char* B; size_t atile, bexp, btile;
    const int* tok; const LAS int* cnt;
    __device__ __forceinline__ void rowinfo(const pg8::Unit& u, const int*& tb, int& s0, int& ce) const { const int e = u.z; tb = tok + (size_t)e * M; s0 = (u.pm - blk0[e]) * 256; ce = cnt[e]; }
    __device__ __forceinline__ bool next(int i, Unit& u) const {
        const int c2 = (G & 7) ? c : (c & 7) * (G >> 3) + (c >> 3);
        const long Lx = (long)i * G + c2; if (Lx >= nunits) return false;
        const int j = (int)(Lx / nN), pn = (int)(Lx % nN); int e = 0;
#pragma unroll
        for (int k = 1; k < 32; ++k) e += (j >= blk0[k]) ? 1 : 0;
        u.pm = j; u.pn = pn; u.z = e; u.A = A + (size_t)j * atile; u.B = B + (size_t)e * bexp + (size_t)pn * btile; return true;
    }
};

template <int QMODE = 0>
__device__ __forceinline__ void tr_item64(const float* W, int ldw, int c0, int nc, int K, bf16* WT, int r0, LAS unsigned char* scr, int item, int lane) {
    const int nblk = (nc + 63) >> 6, kb = item / nblk, nb = item % nblk, k0 = 64 * kb, n0 = 64 * nb;
    const int nn = 4 * (lane & 15), g = lane >> 4; const bool okn = (n0 + nn) < nc;
    const float* wp = W + (size_t)(k0 + g) * ldw + c0 + n0 + nn;
    f32x4 vv[16];
#pragma unroll
    for (int i = 0; i < 16; ++i) { vv[i] = (f32x4){0.f, 0.f, 0.f, 0.f}; if (okn) vv[i] = __builtin_nontemporal_load((const f32x4*)(wp + (size_t)(4 * i) * ldw)); }
#pragma unroll
    for (int i = 0; i < 16; ++i) { v2u w2; w2.x = pk2(vv[i][0], vv[i][1]); w2.y = pk2(vv[i][2], vv[i][3]); *(LAS v2u*)(scr + (4 * i + g) * 136 + nn * 2) = w2; }
    LDS_WAIT(); asm volatile("" ::: "memory");
    const int i16 = lane & 15, q = i16 >> 2, p = i16 & 3;
#pragma unroll
    for (int s = 0; s < 8; ++s) { const int nbk = s & 3, kbk = 4 * (s >> 2) + g;
        const v4i16_t lo = __builtin_amdgcn_ds_read_tr16_b64_v4i16((LAS v4i16_t*)(scr + (8 * kbk + q) * 136 + 32 * nbk + 8 * p));
        const v4i16_t hi = __builtin_amdgcn_ds_read_tr16_b64_v4i16((LAS v4i16_t*)(scr + (8 * kbk + 4 + q) * 136 + 32 * nbk + 8 * p));
        const bf16x8 o = __builtin_shufflevector(lo, hi, 0, 1, 2, 3, 4, 5, 6, 7); const int n = 16 * nbk + i16;
        if (n0 + n < nc) {
            if constexpr (QMODE == 0) *(bf16x8*)(WT + (size_t)(r0 + n0 + n) * K + k0 + 8 * kbk) = o;
            else { const v4u ou = __builtin_bit_cast(v4u, o); const float sc_ = QMODE == 1 ? QS_WUP : (QMODE == 2 ? QS_WDN : QS_WIN);
                *(v2u*)((unsigned char*)WT + (size_t)(r0 + n0 + n) * K + k0 + 8 * kbk) = (v2u){q8x4(bflo(ou.x), bfhi(ou.x), bflo(ou.y), bfhi(ou.y), sc_), q8x4(bflo(ou.z), bfhi(ou.z), bflo(ou.w), bfhi(ou.w), sc_)}; } } }
    LDS_WAIT(); asm volatile("" ::: "memory");
}
__device__ __forceinline__ void ln_rows(f32x4 (&v)[4], const float* g, const float* b, int lane) {
    float s = 0.f;
#pragma unroll
    for (int j = 0; j < 4; ++j) s += (v[j][0] + v[j][1]) + (v[j][2] + v[j][3]);
    const float mean = wave_sum(s) * (1.f / D); float s2 = 0.f;
#pragma unroll
    for (int j = 0; j < 4; ++j) { v[j] = v[j] - mean; s2 += (v[j][0] * v[j][0] + v[j][1] * v[j][1]) + (v[j][2] * v[j][2] + v[j][3] * v[j][3]); }
    const float rstd = 1.f / sqrtf(wave_sum(s2) * (1.f / D) + LN_EPS);
#pragma unroll
    for (int j = 0; j < 4; ++j) { const f32x4 gg = *(const f32x4*)(g + 4 * lane + 256 * j), bb = *(const f32x4*)(b + 4 * lane + 256 * j); v[j] = v[j] * rstd * gg + bb; }
}
struct LnAff { f32x4 g[4], b[4]; };
__device__ __forceinline__ LnAff ln_aff(const float* g, const float* b, int lane) { LnAff a;
#pragma unroll
    for (int j = 0; j < 4; ++j) { a.g[j] = *(const f32x4*)(g + 4 * lane + 256 * j); a.b[j] = *(const f32x4*)(b + 4 * lane + 256 * j); }
    return a; }
__device__ __forceinline__ void ln_rows_pre(f32x4 (&v)[4], const LnAff& a) {
    float s = 0.f;
#pragma unroll
    for (int j = 0; j < 4; ++j) s += (v[j][0] + v[j][1]) + (v[j][2] + v[j][3]);
    const float mean = wave_sum(s) * (1.f / D); float s2 = 0.f;
#pragma unroll
    for (int j = 0; j < 4; ++j) { v[j] = v[j] - mean; s2 += (v[j][0] * v[j][0] + v[j][1] * v[j][1]) + (v[j][2] * v[j][2] + v[j][3] * v[j][3]); }
    const float rstd = 1.f / sqrtf(wave_sum(s2) * (1.f / D) + LN_EPS);
#pragma unroll
    for (int j = 0; j < 4; ++j) v[j] = v[j] * rstd * a.g[j] + a.b[j];
}
__device__ __forceinline__ void store_row_f32_bf16(const f32x4 (&v)[4], float* of, bf16* ob, int lane) {
#pragma unroll
    for (int j = 0; j < 4; ++j) { if (of) *(f32x4*)(of + 4 * lane + 256 * j) = v[j];
        if (ob) { v2u w; w.x = pk2(v[j][0], v[j][1]); w.y = pk2(v[j][2], v[j][3]); *(v2u*)(ob + 4 * lane + 256 * j) = w; } }
}

typedef float f32x16 __attribute__((ext_vector_type(16)));
constexpr int DSA_LIST_OFF = LDSCTL_OFF + 2048, DSA_WCNT_OFF = DSA_LIST_OFF + 4096, DSA_SEL_OFF = DSA_WCNT_OFF + 256;
__device__ __forceinline__ unsigned mono_key(float x) { const unsigned u = __builtin_bit_cast(unsigned, x); return u ^ ((unsigned)((int)u >> 31) | 0x80000000u); }
__device__ __forceinline__ unsigned kv_off(unsigned row, unsigned ch) { return 256u * row + 16u * (ch ^ (((row & 3u) << 2) | ((row >> 2) & 3u))); }

#ifndef DUP_IDX
#define DUP_IDX 1
#endif
#ifndef DUP_SEL
#define DUP_SEL 1
#endif
#ifndef DUP_ATT
#define DUP_ATT 1
#endif
template <int LEVEL>
__device__ __forceinline__ void dsa2_level(LAS unsigned* hist, const unsigned (&kk)[128], int nreg, int lane, unsigned& prefix, unsigned& need) {
    constexpr int NBIN = LEVEL == 2 ? 1024 : 2048; constexpr int PB = NBIN / 64;
#pragma unroll
    for (int i = 0; i < PB / 4; ++i) *(LAS v4u*)(hist + lane * PB + 4 * i) = (v4u){0u, 0u, 0u, 0u};
    LDS_WAIT();
#pragma unroll
    for (int i = 0; i < 128; ++i) { if ((i & ~15) < nreg) { const unsigned k = kk[i]; bool part; unsigned bin;
            if (LEVEL == 0) { part = k != 0u; bin = k >> 21; }
            else if (LEVEL == 1) { part = (k != 0u) && ((k >> 21) == prefix); bin = (k >> 10) & 0x7FFu; }
            else { part = (k != 0u) && ((k >> 10) == prefix); bin = k & 0x3FFu; }
            if (part) (void)__hip_atomic_fetch_add(&hist[bin], 1u, __ATOMIC_RELAXED, __HIP_MEMORY_SCOPE_WORKGROUP); }
        if ((i & 7) == 7) __builtin_amdgcn_sched_barrier(0); }
    LDS_WAIT();
    unsigned hv[PB]; unsigned mine = 0u;
#pragma unroll
    for (int i = 0; i < PB / 4; ++i) { const v4u v = *(const LAS v4u*)(hist + lane * PB + 4 * i); hv[4 * i] = v.x; hv[4 * i + 1] = v.y; hv[4 * i + 2] = v.z; hv[4 * i + 3] = v.w; mine += (v.x + v.y) + (v.z + v.w); }
    const unsigned pre779_ = dpp_scan_add_u32(mine); const unsigned incl = (unsigned)__builtin_amdgcn_readlane((int)pre779_, 63) - pre779_ + mine;
    const unsigned above = incl - mine; const bool found = above < need && need <= above + mine;
    unsigned a = above; int bsel = 0; bool done = false;
#pragma unroll
    for (int i = PB - 1; i >= 0; --i) { const bool hit = !done && (need <= a + hv[i]); bsel = hit ? i : bsel; a = (done || hit) ? a : a + hv[i]; done = done || hit; }
    const int src = __builtin_ctzll(__ballot(found));
    const unsigned bfull = (unsigned)SHI(lane * PB + bsel, src); const unsigned aa = (unsigned)SHI((int)a, src);
    prefix = LEVEL == 0 ? bfull : (LEVEL == 1 ? ((prefix << 11) | bfull) : ((prefix << 10) | bfull)); need -= aa;
    LDS_WAIT();
}

__device__ __forceinline__ bool dsa2_sampled(LAS unsigned char* wl, const unsigned (&kk)[128], int nreg, int n, int lane) {
    LAS unsigned* hist = (LAS unsigned*)wl; LAS int* LIST = (LAS int*)(wl + 12288); LAS unsigned* h2 = (LAS unsigned*)(wl + 13312);
    LAS unsigned long long* PRIV = (LAS unsigned long long*)wl;
    const unsigned long long ltm = (1ull << lane) - 1ull;
#pragma unroll
    for (int i = 0; i < 8; ++i) *(LAS v4u*)(hist + lane * 32 + 4 * i) = (v4u){0u, 0u, 0u, 0u};
    LDS_WAIT();
#pragma unroll
    for (int i = 0; i < 128; i += 8) { if (i < nreg) { const unsigned k = kk[i]; if (k != 0u) (void)__hip_atomic_fetch_add(&hist[k >> 21], 1u, __ATOMIC_RELAXED, __HIP_MEMORY_SCOPE_WORKGROUP); } }
    LDS_WAIT();
    unsigned hv[32]; unsigned mine = 0u;
#pragma unroll
    for (int i = 0; i < 8; ++i) { const v4u v = *(const LAS v4u*)(hist + lane * 32 + 4 * i); hv[4 * i] = v.x; hv[4 * i + 1] = v.y; hv[4 * i + 2] = v.z; hv[4 * i + 3] = v.w; mine += (v.x + v.y) + (v.z + v.w); }
    const unsigned pre_ = dpp_scan_add_u32(mine); const unsigned incl = (unsigned)__builtin_amdgcn_readlane((int)pre_, 63) - pre_ + mine; const int lop_ = lane_op(); (void)lop_;
    const unsigned above = incl - mine; const unsigned ns = SHI(incl, 0);
    const float E = (float)ns * 256.f / (float)n, mg = 3.f * sqrtf(E) + 3.f;
    const int rhi = (int)fmaxf(E - mg, 0.f), rlo = (int)(E + mg) + 1;
    int bhl = -1, bll = -1; { unsigned s = above;
#pragma unroll
        for (int i = 31; i >= 0; --i) { if ((int)s <= rhi) bhl = i; s += hv[i]; if (bll < 0 && (int)s >= rlo) bll = i; } }
    const bool hasH = ((int)above <= rhi) && ((int)incl > rhi || lane == 0), hasL = ((int)incl >= rlo) && ((int)above < rlo);
    const unsigned long long mH = __ballot(hasH), mL = __ballot(hasL);
    if (mH == 0ull) return false;
    const int sH = 63 - __builtin_clzll(mH);
    const unsigned bh = (unsigned)SHI(lane * 32 + (bhl < 0 ? 0 : bhl), sH);
    unsigned bl = 1u; if (mL != 0ull) { const int sL = 63 - __builtin_clzll(mL); bl = (unsigned)SHI(lane * 32 + (bll < 0 ? 0 : bll), sL); }
    bl = bl < 1u ? 1u : bl; if (bl > bh) bl = bh;
    int cur = 0; LAS unsigned* pp = (LAS unsigned*)(PRIV + lane);
#pragma unroll
    for (int i = 0; i < 128; ++i) { if ((i & ~15) < nreg) { const unsigned k = kk[i];
            if ((k >> 21) >= bl) { if (cur < 24) { pp[0] = (unsigned)(lane + 64 * i); pp[1] = k; } pp += 128; ++cur; } }
        __builtin_amdgcn_sched_barrier(0); }
    LDS_WAIT();
    int mxc = cur; { const int lq_ = lane_op();
#pragma unroll
        for (int o = 1; o < 64; o <<= 1) { const int t2 = SHX(mxc, o, lq_); mxc = t2 > mxc ? t2 : mxc; } }
    mxc = __builtin_amdgcn_readfirstlane(mxc);
    if (mxc > 24) return false;
    int A = 0, C = 0;
#pragma unroll 1
    for (int s = 0; s < mxc; ++s) { const bool vld = s < cur; const unsigned long long e = vld ? PRIV[s * 64 + lane] : 0ull; const unsigned k = (unsigned)(e >> 32), ix = (unsigned)e;
        const bool sure = vld && (k >> 21) > bh, cand = vld && !sure;
        const unsigned long long ms = __ballot(sure), mc = __ballot(cand);
        const int ps = A + __builtin_popcountll(ms & ltm), pc = C + __builtin_popcountll(mc & ltm);
        if (sure && ps < 256) LIST[ps] = (int)ix;
        if (cand) PRIV[pc] = ((unsigned long long)k << 13) | (unsigned long long)(8191u - ix);
        A += __builtin_popcountll(ms); C += __builtin_popcountll(mc); }
    if (A > 256 || A + C < 256) return false;
    LDS_WAIT();
    unsigned need = 256u - (unsigned)A; const int nit = (C + 63) >> 6;
    if (need > 0u) { unsigned long long prefix = 0ull; int shf = 45;
#pragma unroll 1
        for (int lev = 0; lev < 6; ++lev) { const int w = lev < 5 ? 8 : 5; const int sh = shf - w;
            { unsigned zq_ = 0u; asm volatile("" : "+v"(zq_)); *(LAS v4u*)(h2 + 4 * lane) = (v4u){zq_, zq_, zq_, zq_}; }
            LDS_WAIT();
            for (int it = 0; it < nit; ++it) { const int i = it * 64 + lane; if (i < C) { const unsigned long long c2 = PRIV[i]; if (lev == 0 || (c2 >> shf) == prefix) (void)__hip_atomic_fetch_add(&h2[(unsigned)(c2 >> sh) & ((1u << w) - 1u)], 1u, __ATOMIC_RELAXED, __HIP_MEMORY_SCOPE_WORKGROUP); } }
            LDS_WAIT();
            const v4u v = *(const LAS v4u*)(h2 + 4 * lane); const unsigned m4 = (v.x + v.y) + (v.z + v.w); const unsigned pr2_ = dpp_scan_add_u32(m4); const unsigned in2 = (unsigned)__builtin_amdgcn_readlane((int)pr2_, 63) - pr2_ + m4;
            const unsigned ab = in2 - m4; const bool fnd = ab < need && need <= ab + m4;
            unsigned a = ab; int bs = 0; bool dn = false; const unsigned h4[4] = {v.x, v.y, v.z, v.w};
#pragma unroll
            for (int i = 3; i >= 0; --i) { const bool hit = !dn && (need <= a + h4[i]); bs = hit ? i : bs; a = (dn || hit) ? a : a + h4[i]; dn = dn || hit; }
            const int src = __builtin_ctzll(__ballot(fnd));
            const unsigned bf = (unsigned)SHI(lane * 4 + bs, src); const unsigned aa = (unsigned)SHI((int)a, src); const unsigned hb = (unsigned)SHI((int)(bs == 3 ? h4[3] : bs == 2 ? h4[2] : bs == 1 ? h4[1] : h4[0]), src);
            prefix = (prefix << w) | bf; need -= aa; shf = sh;
            LDS_WAIT();
            if (hb == need) break; }
        int pos = A;
        for (int it = 0; it < nit; ++it) { const int i = it * 64 + lane; unsigned long long c2 = 0ull; if (i < C) c2 = PRIV[i];
            const bool take = (i < C) && ((c2 >> shf) >= prefix);
            const unsigned long long mt = __ballot(take);
            if (take) LIST[pos + __builtin_popcountll(mt & ltm)] = (int)(8191u - (unsigned)(c2 & 8191ull));
            pos += __builtin_popcountll(mt); }
    }
    LDS_WAIT();
    return true;
}

__device__ __forceinline__ void dsa2_unit(LAS unsigned char* lds, const bf16* PROJ, const bf16* KIDX, const bf16* KVN, bf16* OLAT, float* sbuf, int b, int t0, int tid) {
    asm volatile("" : "+v"(tid));
    const int lane = tid & 63, wave = __builtin_amdgcn_readfirstlane(tid >> 6), r = lane & 31, h = lane >> 5;
    const size_t rowb = (size_t)b * T;
    LAS unsigned char* wl = lds + wave * 16384; LAS unsigned* hist = (LAS unsigned*)wl; LAS int* LIST = (LAS int*)(wl + 12288);
    const int t = t0 + wave; int cnt;
    if (t0 >= 256) {
        { const int ntiles = (t0 >> 5) + 1, tpw = (ntiles + 7) >> 3, tile0 = wave * tpw; int tile1 = tile0 + tpw; tile1 = tile1 < ntiles ? tile1 : ntiles;
          const int ahead = (r & 3) + 4 * ((r >> 3) & 1), atok = ((r >> 2) & 1) + 2 * (r >> 4);
          const bf16* qpa = PROJ + (rowb + t0 + atok) * NP + PC_QIDX + ahead * 32 + 8 * h; const bf16* qpb = qpa + (size_t)4 * NP;
          const bf16x8 A0a = *(const bf16x8*)qpa, A1a = *(const bf16x8*)(qpa + 16), A0b = *(const bf16x8*)qpb, A1b = *(const bf16x8*)(qpb + 16);
          float wq[32];
#pragma unroll
          for (int gq = 0; gq < 4; ++gq) { const v4u w0 = *(const v4u*)(PROJ + (rowb + t0 + h + 2 * gq) * NP + PC_WIDX);
              wq[8 * gq] = 0.5f * bflo(w0.x); wq[8 * gq + 1] = 0.5f * bfhi(w0.x); wq[8 * gq + 2] = 0.5f * bflo(w0.y); wq[8 * gq + 3] = 0.5f * bfhi(w0.y); wq[8 * gq + 4] = 0.5f * bflo(w0.z); wq[8 * gq + 5] = 0.5f * bfhi(w0.z); wq[8 * gq + 6] = 0.5f * bflo(w0.w); wq[8 * gq + 7] = 0.5f * bfhi(w0.w); }
          v4u A0c = {0u, 0u, 0u, 0u}, A1c = {0u, 0u, 0u, 0u};
          if (r < 8) { const bf16* qrow = PROJ + (rowb + t0 + (r >> 2) + 2 * (r & 3)) * NP; const v4u wv = *(const v4u*)(qrow + PC_WIDX);
              const float wl_[8] = {bflo(wv.x), bfhi(wv.x), bflo(wv.y), bfhi(wv.y), bflo(wv.z), bfhi(wv.z), bflo(wv.w), bfhi(wv.w)};
              float a0[8], a1[8];
#pragma unroll
              for (int j = 0; j < 8; ++j) { a0[j] = 0.f; a1[j] = 0.f; }
#pragma unroll
              for (int hd = 0; hd < 8; ++hd) { const v4u q0 = *(const v4u*)(qrow + PC_QIDX + hd * 32 + 8 * h), q1 = *(const v4u*)(qrow + PC_QIDX + hd * 32 + 16 + 8 * h); const float hw = 0.5f * wl_[hd];
                  a0[0] += hw * bflo(q0.x); a0[1] += hw * bfhi(q0.x); a0[2] += hw * bflo(q0.y); a0[3] += hw * bfhi(q0.y); a0[4] += hw * bflo(q0.z); a0[5] += hw * bfhi(q0.z); a0[6] += hw * bflo(q0.w); a0[7] += hw * bfhi(q0.w);
                  a1[0] += hw * bflo(q1.x); a1[1] += hw * bfhi(q1.x); a1[2] += hw * bflo(q1.y); a1[3] += hw * bfhi(q1.y); a1[4] += hw * bflo(q1.z); a1[5] += hw * bfhi(q1.z); a1[6] += hw * bflo(q1.w); a1[7] += hw * bfhi(q1.w); }
              A0c = (v4u){pk2(a0[0], a0[1]), pk2(a0[2], a0[3]), pk2(a0[4], a0[5]), pk2(a0[6], a0[7])}; A1c = (v4u){pk2(a1[0], a1[1]), pk2(a1[2], a1[3]), pk2(a1[4], a1[5]), pk2(a1[6], a1[7])}; }
          const bf16x8 A0cb = __builtin_bit_cast(bf16x8, A0c), A1cb = __builtin_bit_cast(bf16x8, A1c);
          const bf16* kp = KIDX + (rowb + (size_t)tile0 * 32 + r) * 32 + 8 * h;
          bf16x8 Bq[4][2];
#pragma unroll
          for (int u = 0; u < 3; ++u) if (tile0 + u < tile1) { Bq[u][0] = *(const bf16x8*)(kp + (size_t)u * 1024); Bq[u][1] = *(const bf16x8*)(kp + (size_t)u * 1024 + 16); }
          for (int tileb = tile0; tileb < tile1; tileb += 4) {
#pragma unroll
          for (int u = 0; u < 4; ++u) { const int tile = tileb + u; if (tile < tile1) { const bf16x8 b0 = Bq[u][0], b1 = Bq[u][1];
              if (tile + 3 < tile1) { const bf16* kn = kp + (size_t)(tile + 3 - tile0) * 1024; Bq[(u + 3) & 3][0] = *(const bf16x8*)kn; Bq[(u + 3) & 3][1] = *(const bf16x8*)(kn + 16); }
              f32x16 da, db, dc;
#pragma unroll
              for (int i = 0; i < 16; ++i) { da[i] = 0.f; db[i] = 0.f; dc[i] = 0.f; }
              da = __builtin_amdgcn_mfma_f32_32x32x16_bf16(A0a, b0, da, 0, 0, 0); db = __builtin_amdgcn_mfma_f32_32x32x16_bf16(A0b, b0, db, 0, 0, 0); dc = __builtin_amdgcn_mfma_f32_32x32x16_bf16(A0cb, b0, dc, 0, 0, 0);
              da = __builtin_amdgcn_mfma_f32_32x32x16_bf16(A1a, b1, da, 0, 0, 0); db = __builtin_amdgcn_mfma_f32_32x32x16_bf16(A1b, b1, db, 0, 0, 0); dc = __builtin_amdgcn_mfma_f32_32x32x16_bf16(A1cb, b1, dc, 0, 0, 0);
              float s0 = dc[0], s1 = dc[1], s2 = dc[2], s3 = dc[3];
#pragma unroll
              for (int i = 0; i < 8; ++i) { s0 += wq[i] * __builtin_fabsf(da[i]); s1 += wq[8 + i] * __builtin_fabsf(da[8 + i]); s2 += wq[16 + i] * __builtin_fabsf(db[i]); s3 += wq[24 + i] * __builtin_fabsf(db[8 + i]); }
              float* sp = sbuf + (size_t)h * 8192 + tile * 32 + r;
              sp[0] = __builtin_bit_cast(float, mono_key(s0)); sp[2 * 8192] = __builtin_bit_cast(float, mono_key(s1)); sp[4 * 8192] = __builtin_bit_cast(float, mono_key(s2)); sp[6 * 8192] = __builtin_bit_cast(float, mono_key(s3)); } } } }
        asm volatile("s_waitcnt vmcnt(0)" ::: "memory");
        __syncthreads();
        const int n = t + 1, nreg = (n + 63) >> 6; const float* sr = sbuf + (size_t)wave * 8192;
        unsigned kk[128];
#ifndef DUP_KK
#define DUP_KK 1
#endif
        for (int repk = 0; repk < DUP_KK; ++repk)
#pragma unroll
        for (int gI = 0; gI < 4; ++gI) {
            if (gI * 32 < nreg) {
                float fv[32];
#pragma unroll
                for (int i = 0; i < 32; ++i) { const int key = lane + 64 * (gI * 32 + i); fv[i] = __hip_atomic_load(sr + (key < n ? key : n - 1), __ATOMIC_RELAXED, __HIP_MEMORY_SCOPE_AGENT); }
#pragma unroll
                for (int i = 0; i < 32; ++i) { const int key = lane + 64 * (gI * 32 + i); kk[gI * 32 + i] = key < n ? __builtin_bit_cast(unsigned, fv[i]) : 0u; }
            } else {
#pragma unroll
                for (int i = 0; i < 32; ++i) kk[gI * 32 + i] = 0u;
            }
        }
        unsigned prefix = 0u, need = 256u; int pos = 0, eqs = 0; const unsigned long long ltm = (1ull << lane) - 1ull;
        bool seldone = false; if (nreg > 16) seldone = dsa2_sampled(wl, kk, nreg, n, lane);
        if (!seldone)
        for (int reps = 0; reps < DUP_SEL; ++reps) { prefix = 0u; need = 256u; pos = 0; eqs = 0;
        dsa2_level<0>(hist, kk, nreg, lane, prefix, need);
        dsa2_level<1>(hist, kk, nreg, lane, prefix, need);
        dsa2_level<2>(hist, kk, nreg, lane, prefix, need);
        const unsigned tau = prefix;
#pragma unroll
        for (int i = 0; i < 128; ++i) { if ((i & ~15) < nreg) { const unsigned k = kk[i]; const bool gt = k > tau, eq = k == tau;
                const unsigned long long me = __ballot(eq);
                const bool take = gt || (eq && (eqs + __builtin_popcountll(me & ltm) < (int)need));
                const unsigned long long mt = __ballot(take);
                if (take) LIST[pos + __builtin_popcountll(mt & ltm)] = lane + 64 * i;
                pos += __builtin_popcountll(mt); eqs += __builtin_popcountll(me); }
            if ((i & 3) == 3) __builtin_amdgcn_sched_barrier(0); } }
        cnt = 256;
    } else {
#pragma unroll
        for (int j = 0; j < 4; ++j) LIST[lane + 64 * j] = lane + 64 * j;
        cnt = t + 1;
    }
    LDS_WAIT();
    int tid2 = tid; asm volatile("" : "+v"(tid2)); const int lane2 = tid2 & 63; const int nn = lane2 & 15, g = lane2 >> 4;
    bf16x8 qf[4];
#pragma unroll
    for (int s = 0; s < 4; ++s) { if (nn < 8) qf[s] = *(const bf16x8*)(PROJ + (rowb + t) * NP + PC_QLAT + nn * 128 + 32 * s + 8 * g); else qf[s] = (bf16x8){0, 0, 0, 0, 0, 0, 0, 0}; }
    f32x4 O[8]; float mrun, lrun;
    LAS unsigned char* buf = wl; const unsigned q4 = (unsigned)(nn >> 2), p = (unsigned)(lane2 & 3); const int nch = (cnt + 31) >> 5;
    for (int repa = 0; repa < DUP_ATT; ++repa) {
#pragma unroll
    for (int c = 0; c < 8; ++c) O[c] = (f32x4){0.f, 0.f, 0.f, 0.f};
    mrun = -INFINITY; lrun = 0.f;
    v4u pre[8];
#pragma unroll
    for (int it = 0; it < 8; ++it) { const int row = it * 4 + g; pre[it] = (v4u){0u, 0u, 0u, 0u}; if (row < cnt) { const int idx = LIST[row]; pre[it] = *(const v4u*)(KVN + (rowb + idx) * 128 + nn * 8); } }
#pragma unroll 1
    for (int ch = 0; ch < nch; ++ch) {
#pragma unroll
        for (int it = 0; it < 8; ++it) *(LAS v4u*)(buf + kv_off(it * 4 + g, nn)) = pre[it];
        if (ch + 1 < nch) {
#pragma unroll
            for (int it = 0; it < 8; ++it) { const int row = (ch + 1) * 32 + it * 4 + g; pre[it] = (v4u){0u, 0u, 0u, 0u}; if (row < cnt) { const int idx = LIST[row]; pre[it] = *(const v4u*)(KVN + (rowb + idx) * 128 + nn * 8); } } }
        LDS_WAIT();
        f32x4 S0 = {0.f, 0.f, 0.f, 0.f}, S1 = {0.f, 0.f, 0.f, 0.f};
        { const unsigned slot0 = 8u * (nn >> 2) + (nn & 3), slot1 = slot0 + 4u;
#pragma unroll
          for (int s = 0; s < 4; ++s) { const bf16x8 a0 = *(const LAS bf16x8*)(buf + kv_off(slot0, 4 * s + g)), a1 = *(const LAS bf16x8*)(buf + kv_off(slot1, 4 * s + g));
              S0 = __builtin_amdgcn_mfma_f32_16x16x32_bf16(a0, qf[s], S0, 0, 0, 0); S1 = __builtin_amdgcn_mfma_f32_16x16x32_bf16(a1, qf[s], S1, 0, 0, 0); } }
        if (ch * 32 + 32 > cnt) {
#pragma unroll
            for (int j = 0; j < 4; ++j) { if (ch * 32 + 8 * g + j >= cnt) S0[j] = -INFINITY; if (ch * 32 + 8 * g + 4 + j >= cnt) S1[j] = -INFINITY; } }
        float mc = fmaxf(fmaxf(fmaxf(S0[0], S0[1]), fmaxf(S0[2], S0[3])), fmaxf(fmaxf(S1[0], S1[1]), fmaxf(S1[2], S1[3])));
        const int lop891_ = lane_op(); mc = fmaxf(mc, SHX(mc, 16, lop891_)); mc = fmaxf(mc, SHX(mc, 32, lop891_));
        const float mnew = fmaxf(mrun, mc); const float alpha = __expf(mrun - mnew); mrun = mnew;
        float ps = 0.f;
#pragma unroll
        for (int j = 0; j < 4; ++j) { S0[j] = __expf(S0[j] - mnew); S1[j] = __expf(S1[j] - mnew); ps += S0[j] + S1[j]; }
        lrun = lrun * alpha + ps;
        v4u w; w.x = pk2(S0[0], S0[1]); w.y = pk2(S0[2], S0[3]); w.z = pk2(S1[0], S1[1]); w.w = pk2(S1[2], S1[3]); const bf16x8 Bp = __builtin_bit_cast(bf16x8, w);
#pragma unroll
        for (int c = 0; c < 8; ++c) { O[c] = O[c] * alpha;
            const v4i16_t lo = __builtin_amdgcn_ds_read_tr16_b64_v4i16((LAS v4i16_t*)(buf + kv_off(8u * g + q4, 2u * c + (p >> 1)) + 8u * (p & 1u)));
            const v4i16_t hi = __builtin_amdgcn_ds_read_tr16_b64_v4i16((LAS v4i16_t*)(buf + kv_off(8u * g + 4u + q4, 2u * c + (p >> 1)) + 8u * (p & 1u)));
            const bf16x8 a = __builtin_shufflevector(lo, hi, 0, 1, 2, 3, 4, 5, 6, 7);
            O[c] = __builtin_amdgcn_mfma_f32_16x16x32_bf16(a, Bp, O[c], 0, 0, 0); }
        LDS_WAIT();
    } }
    const int lop906_ = lane_op(); lrun += SHX(lrun, 16, lop906_); lrun += SHX(lrun, 32, lop906_);
    const float inv = 1.f / lrun;
    if (nn < 8) {
#pragma unroll
        for (int c = 0; c < 8; ++c) { v2u w; w.x = pk2(O[c][0] * inv, O[c][1] * inv); w.y = pk2(O[c][2] * inv, O[c][3] * inv); *(v2u*)(OLAT + (rowb + t) * 1024 + nn * 128 + 16 * c + 4 * g) = w; } }
}

__device__ __forceinline__ unsigned swap23(unsigned r) { return (r & ~12u) | ((r & 4u) << 1) | ((r & 8u) >> 1); }
__device__ __forceinline__ void memattn_unit(LAS unsigned char* lds, const bf16* PROJ, const bf16* MKVl, bf16* BR, int b, int hd, int qblk, int tid) {
    asm volatile("" : "+v"(tid));
    const int lane = tid & 63, wave = __builtin_amdgcn_readfirstlane(tid >> 6), r = lane & 31, hh = lane >> 5;
    LAS unsigned char* kimg = lds; LAS unsigned char* vimg = lds + 65536;
    { const bf16* kb = MKVl + (size_t)b * 256 * 1024 + hd * 128;
#pragma unroll 4
      for (int it = 0; it < 8; ++it) { const int row = it * 32 + (tid >> 4), ch = tid & 15;
          const v4u kv = *(const v4u*)(kb + (size_t)row * 1024 + ch * 8), vv = *(const v4u*)(kb + (size_t)row * 1024 + 512 + ch * 8);
          *(LAS v4u*)(kimg + kv_off(row, ch)) = kv; *(LAS v4u*)(vimg + kv_off(row, ch)) = vv; } }
    const size_t tok = (size_t)b * T + qblk * 256 + wave * 32 + r;
    bf16x8 qf[8];
#pragma unroll
    for (int s = 0; s < 8; ++s) qf[s] = *(const bf16x8*)(PROJ + tok * NP + PC_MQ + hd * 128 + 16 * s + 8 * hh);
    __syncthreads();
    f32x16 S[8];
#pragma unroll
    for (int kap = 0; kap < 8; ++kap) { f32x16 acc;
#pragma unroll
        for (int i = 0; i < 16; ++i) acc[i] = 0.f;
        const unsigned slot = 32u * kap + swap23((unsigned)r);
#pragma unroll
        for (int s = 0; s < 8; ++s) { const bf16x8 a = *(const LAS bf16x8*)(kimg + kv_off(slot, 2 * s + hh)); acc = __builtin_amdgcn_mfma_f32_32x32x16_bf16(a, qf[s], acc, 0, 0, 0); }
        S[kap] = acc; if (kap & 1) __builtin_amdgcn_sched_barrier(0); }
    float mx = -INFINITY;
#pragma unroll
    for (int kap = 0; kap < 8; ++kap)
#pragma unroll
        for (int i = 0; i < 16; ++i) mx = fmaxf(mx, S[kap][i]);
    const int lop945_ = lane_op(); mx = fmaxf(mx, SHX(mx, 32, lop945_));
    const float sc_ = 0.08838834764831845f * 1.4426950408889634f; float sum = 0.f;
#pragma unroll
    for (int kap = 0; kap < 8; ++kap)
#pragma unroll
        for (int i = 0; i < 16; ++i) { const float e = __builtin_amdgcn_exp2f((S[kap][i] - mx) * sc_); S[kap][i] = e; sum += e; }
    const int lop951_ = lane_op(); sum += SHX(sum, 32, lop951_);
    const float inv = 1.f / sum;
    bf16x8 Bp[16];
#pragma unroll
    for (int kap = 0; kap < 8; ++kap)
#pragma unroll
        for (int s = 0; s < 2; ++s) { v4u w; w.x = pk2(S[kap][8 * s], S[kap][8 * s + 1]); w.y = pk2(S[kap][8 * s + 2], S[kap][8 * s + 3]); w.z = pk2(S[kap][8 * s + 4], S[kap][8 * s + 5]); w.w = pk2(S[kap][8 * s + 6], S[kap][8 * s + 7]);
            Bp[2 * kap + s] = __builtin_bit_cast(bf16x8, w); }
    const unsigned blk = (lane >> 4) & 1, q4 = (lane & 15) >> 2, p = lane & 3;
    bf16* orow = BR + tok * 2048 + 1536 + hd * 128;
#pragma unroll
    for (int c = 0; c < 4; ++c) { f32x16 o;
#pragma unroll
        for (int i = 0; i < 16; ++i) o[i] = 0.f;
#pragma unroll
        for (int ks = 0; ks < 16; ++ks) {
            const v4i16_t lo = __builtin_amdgcn_ds_read_tr16_b64_v4i16((LAS v4i16_t*)(vimg + kv_off(16u * ks + 8u * hh + q4, 4u * c + 2u * blk + (p >> 1)) + 8u * (p & 1u)));
            const v4i16_t hi = __builtin_amdgcn_ds_read_tr16_b64_v4i16((LAS v4i16_t*)(vimg + kv_off(16u * ks + 8u * hh + 4u + q4, 4u * c + 2u * blk + (p >> 1)) + 8u * (p & 1u)));
            const bf16x8 a = __builtin_shufflevector(lo, hi, 0, 1, 2, 3, 4, 5, 6, 7);
            o = __builtin_amdgcn_mfma_f32_32x32x16_bf16(a, Bp[ks], o, 0, 0, 0); if ((ks & 3) == 3) __builtin_amdgcn_sched_barrier(0); }
#pragma unroll
        for (int i4 = 0; i4 < 4; ++i4) { v2u w; w.x = pk2(o[4 * i4] * inv, o[4 * i4 + 1] * inv); w.y = pk2(o[4 * i4 + 2] * inv, o[4 * i4 + 3] * inv);
            *(v2u*)(orow + 32 * c + 8 * i4 + 4 * hh) = w; } }
    __syncthreads();
}

__device__ __forceinline__ f32x4 ld4bf(const bf16* p) { const v2u w = *(const v2u*)p; return (f32x4){bflo(w.x), bfhi(w.x), bflo(w.y), bfhi(w.y)}; }
__device__ __forceinline__ void store_row_fp8(const f32x4 (&v)[4], unsigned char* o8, int lane) {
#pragma unroll
    for (int j = 0; j < 4; ++j) *(unsigned*)(o8 + 4 * lane + 256 * j) = q8x4(v[j][0], v[j][1], v[j][2], v[j][3], QS_H);
}
constexpr int PH_PER_LAYER = 11, NPHASE = 2 + NL * PH_PER_LAYER;

__global__ void __launch_bounds__(NWAVES * 64, 2) fwd(Args args) {
    extern __shared__ __attribute__((aligned(16))) unsigned char lds_raw[];
    Frame F;
    F.lds = (LAS unsigned char*)lds_raw;
    F.tid = threadIdx.x; F.lane = F.tid & 63; F.wave = __builtin_amdgcn_readfirstlane(F.tid >> 6);
    const int wave_s = F.wave;
    F.G = gridDim.x; F.gw = blockIdx.x * NWAVES + F.wave; F.NGW = F.G * NWAVES;
    volatile LAS unsigned* MISC = (volatile LAS unsigned*)(F.lds + MISC_OFF);
    for (int u = F.tid; u < (LDS_BYTES - LDSCTL_OFF) / 4; u += NWAVES * 64) ((LAS unsigned*)(F.lds + LDSCTL_OFF))[u] = 0u;
    __syncthreads();
#if ONE_LAUNCH
    XcdBarrier bar = xcd_barrier_post((unsigned*)(args.ws + WS_CTL) + CW_BAR, MISC + 8);
#define GRID_BAR() xcd_barrier(bar, tidq)
#else
#define GRID_BAR() do {} while (0)
#endif
    { volatile LAS unsigned long long* PT = (volatile LAS unsigned long long*)(F.lds + MISC_OFF + 512);
    if (F.tid == 0) {
#pragma unroll
        for (int i = 0; i < 33; ++i) PT[i] = (unsigned long long)args.in[i];
        PT[33] = (unsigned long long)args.out; PT[34] = (unsigned long long)args.ws;
    } }
    const int lo = args.ph_lo, hi = args.ph_hi;
    __syncthreads();
    int ph = 0;
#define IN(k) ((const float*)gptr(ldp(PT, k)))
#ifndef DUP_PHASE
#define DUP_PHASE (-1)
#endif
#ifndef PHMASK
#define PHMASK 0xFFFFull
#endif
#define PHASE_BEGIN(id) if (((PHMASK >> (id)) & 1ull) && lo <= ph && ph < hi) { unsigned ldsb_ = 0u; asm volatile("" : "+s"(ldsb_)); LAS unsigned char* ldsq = (LAS unsigned char*)lds_raw + ldsb_; \
    volatile LAS unsigned long long* PT = (volatile LAS unsigned long long*)(ldsq + MISC_OFF + 512); LAS int* BLK0 = (LAS int*)(ldsq + MISC_OFF + 128); (void)BLK0; unsigned char* ws = gptr(ldp(PT, 34)); int tidq = wave_s * 64 + lane_op(); asm volatile("" : "+v"(tidq)); const int lane = tidq & 63, wave = __builtin_amdgcn_readfirstlane(tidq >> 6); \
    Frame F; F.lds = ldsq; F.tid = tidq; F.lane = lane; F.wave = wave; { const unsigned vb1_ = ((volatile LAS unsigned*)(ldsq + MISC_OFF))[11]; int Gq_ = gridDim.x, bxq_ = __builtin_amdgcn_readfirstlane(vb1_ ? (int)vb1_ - 1 : (int)blockIdx.x); asm volatile("" : "+s"(Gq_), "+s"(bxq_)); F.G = Gq_; F.bx = bxq_; } F.gw = F.bx * NWAVES + wave; F.NGW = F.G * NWAVES; \
    bf16* WinT = (bf16*)(ws + WS_WIN); bf16* WgluT = (bf16*)(ws + WS_WGLU); bf16* WmkvT = (bf16*)(ws + WS_WMKV); bf16* WuvT = (bf16*)(ws + WS_WUV); \
    bf16* WbrT = (bf16*)(ws + WS_WBR); bf16* WoT = (bf16*)(ws + WS_WO); bf16* WupT = (bf16*)(ws + WS_WUP); bf16* WdnT = (bf16*)(ws + WS_WDN); \
    f32x2* S5A = (f32x2*)(ws + WS_S5A); f32x2* S5B = (f32x2*)(ws + WS_S5B); \
    bf16* MEMB = (bf16*)(ws + WS_MEMB); bf16* MKV = (bf16*)(ws + WS_MKV); \
    bf16* Hf = (bf16*)(ws + WS_H); bf16* Hb = (bf16*)(ws + WS_HB); bf16* PROJ = (bf16*)(ws + WS_PROJ); bf16* KVN = (bf16*)(ws + WS_KVN); \
    bf16* OLAT = (bf16*)(ws + WS_OLAT); bf16* BR = (bf16*)(ws + WS_BR); bf16* Zb = (bf16*)(ws + WS_Z); float* MRG = (float*)(ws + WS_MRG); bf16* MRGB = (bf16*)(ws + WS_MRGB); \
    bf16* Vf = (bf16*)(ws + WS_V); bf16* H1 = (bf16*)(ws + WS_H1); bf16* H1B = (bf16*)(ws + WS_H1B); \
    f32x2* SSE = (f32x2*)(ws + WS_SSE); f32x2* SSC = (f32x2*)(ws + WS_SSC); \
    int* TOK = (int*)(ws + WS_TOK); float* GATE = (float*)(ws + WS_GATE); int* SLOT = (int*)(ws + WS_SLOT); \
    bf16* XS = (bf16*)(ws + WS_XS); bf16* ACT = (bf16*)(ws + WS_ACT); bf16* YS = XS; float* SCR = (float*)(ws + WS_SCR); float* GROW = (float*)(ws + WS_SCR); bf16* KIDX = (bf16*)(ws + WS_KIDX); (void)KIDX; bf16* WSSM = (bf16*)(ws + WS_WSSM); bf16* AEXT = (bf16*)(ws + WS_AEXT); bf16* WEW = (bf16*)(ws + WS_WE); (void)WSSM; (void)AEXT; (void)WEW; \
    unsigned* CTLP = (unsigned*)(ws + WS_CTL); float* OUTP = (float*)gptr(ldp(PT, 33)); \
    (void)WinT; (void)WgluT; (void)WmkvT; (void)WuvT; (void)WbrT; (void)WoT; (void)WupT; (void)WdnT; (void)S5A; (void)S5B; (void)MEMB; (void)MKV; (void)Hf; (void)Hb; (void)PROJ; (void)KVN; (void)OLAT; (void)BR; (void)Zb; (void)MRG; (void)MRGB; \
    (void)Vf; (void)H1; (void)H1B; (void)SSE; (void)SSC; (void)TOK; (void)GATE; (void)SLOT; (void)XS; (void)ACT; (void)YS; (void)SCR; (void)GROW; (void)CTLP; (void)OUTP; \
    for (int rep_ = 0; rep_ < (((id) == DUP_PHASE) ? 2 : 1); ++rep_)
#define PHASE_END   if (ph + 1 < hi) GRID_BAR(); } ++ph;

    PHASE_BEGIN(0)
    {
        LAS unsigned char* scr = F.lds + wave * 16384;
        constexpr int I_CKV = 16 * 2, I_QIDX = 16 * 4, I_KIDX = 16, I_WIDX = 16, I_512 = 16 * 8, I_GATE = 16 * 64;
        constexpr int I_WIN = I_CKV + I_QIDX + I_KIDX + I_WIDX + 5 * I_512 + I_GATE;
        constexpr int I_GLU = 8 * 8, I_MKV = 16 * 16, I_BR = 8 * 16, I_WO = 16 * 16, I_UP = 16 * 32, I_DN = 16 * 16;
        constexpr int I_LAYER = I_WIN + I_GLU + I_MKV + 4 * I_BR + I_WO + NE * I_UP + NE * I_DN;
        const float* w_in = IN(4);
        { LAS float* wt = (LAS float*)F.lds; LAS float* uk = wt + 64 * 65;
          for (int it = F.bx; it < NL * 8 * 16; it += F.G) { const int l = it >> 7, h = (it >> 4) & 7, kb = it & 15;
            const float* Wl = w_in + (size_t)l * D * DIN + (size_t)(kb * 64) * DIN + h * 64; const float* wuk = IN(6) + (size_t)l * 128 * 512 + h * 64;
            { float t8[8], u16[16];
#pragma unroll
              for (int j = 0; j < 8; ++j) { const int i = F.tid + 512 * j; t8[j] = Wl[(size_t)(i >> 6) * DIN + (i & 63)]; }
#pragma unroll
              for (int j = 0; j < 16; ++j) { const int i = F.tid + 512 * j; u16[j] = wuk[(size_t)(i >> 6) * 512 + (i & 63)]; }
#pragma unroll
              for (int j = 0; j < 8; ++j) { const int i = F.tid + 512 * j; wt[(i >> 6) * 65 + (i & 63)] = t8[j]; }
#pragma unroll
              for (int j = 0; j < 16; ++j) { const int i = F.tid + 512 * j; uk[(i >> 6) * 65 + (i & 63)] = u16[j]; } }
            __syncthreads();
            const int c = F.tid >> 2, kq = F.tid & 3; float a[16];
#pragma unroll
            for (int j = 0; j < 16; ++j) a[j] = 0.f;
            for (int d = 0; d < 64; ++d) { const float wv = uk[c * 65 + d];
#pragma unroll
                for (int j = 0; j < 16; ++j) a[j] += wv * wt[(kq * 16 + j) * 65 + d]; }
            unsigned char* p = (unsigned char*)WinT + ((size_t)l * NP + PC_QLAT + h * 128 + c) * D + kb * 64 + kq * 16; const float sq = 0.125f * QS_WQL;
            *(v4u*)p = (v4u){q8x4(a[0], a[1], a[2], a[3], sq), q8x4(a[4], a[5], a[6], a[7], sq), q8x4(a[8], a[9], a[10], a[11], sq), q8x4(a[12], a[13], a[14], a[15], sq)};
            __syncthreads(); } }
        { LAS float* APr = (LAS float*)F.lds; LAS float* APi = APr + 33 * 64; LAS float* Br = APi + 33 * 64; LAS float* Bi = Br + 1024; LAS float* Cr = Bi + 1024; LAS float* Ci = Cr + 1024; LAS float* KD = Ci + 1024;
          for (int it = F.bx; it < NL * 32; it += F.G) { const int l = it >> 5, g = it & 31; const int lg = l * 32 + g;
            if (F.tid < 64) { const int p = F.tid; const int idx = lg * 64 + p; const float lr = IN(10)[idx], li = IN(11)[idx], dt = expf(IN(17)[lg]);
                const float er = expf(lr * dt); float sn, cs; sincosf(li * dt, &sn, &cs); const float ar = er * cs, ai = er * sn;
                float xr = 1.f, xi = 0.f;
                for (int d = 0; d <= 32; ++d) { APr[d * 64 + p] = xr; APi[d * 64 + p] = xi; const float nr = xr * ar - xi * ai, ni = xr * ai + xi * ar; xr = nr; xi = ni; }
                const float nr_ = ar - 1.f, ni_ = ai, den = lr * lr + li * li; const float fr_ = (nr_ * lr + ni_ * li) / den, fi_ = (ni_ * lr - nr_ * li) / den;
                { f32x4 br4[4], bi4[4];
#pragma unroll
                  for (int q = 0; q < 4; ++q) { br4[q] = *(const f32x4*)(IN(12) + (size_t)idx * 16 + 4 * q); bi4[q] = *(const f32x4*)(IN(13) + (size_t)idx * 16 + 4 * q); }
#pragma unroll
                  for (int n = 0; n < 16; ++n) { const float br = br4[n >> 2][n & 3], bi = bi4[n >> 2][n & 3]; Br[p * 16 + n] = fr_ * br - fi_ * bi; Bi[p * 16 + n] = fr_ * bi + fi_ * br; } } }
            for (int i = F.tid; i < 1024; i += 512) { Cr[i] = IN(14)[(size_t)lg * 1024 + i]; Ci[i] = IN(15)[(size_t)lg * 1024 + i]; }
            __syncthreads();
            { const int d = F.tid >> 4, n = F.tid & 15; float a[16];
#pragma unroll
              for (int m = 0; m < 16; ++m) a[m] = 0.f;
              for (int p = 0; p < 64; ++p) { const float cr = Cr[n * 64 + p], ci = Ci[n * 64 + p], xr = APr[d * 64 + p], xi = APi[d * 64 + p]; const float gr = cr * xr - ci * xi, gi = cr * xi + ci * xr;
#pragma unroll
                  for (int m = 0; m < 16; ++m) a[m] += gr * Br[p * 16 + m] - gi * Bi[p * 16 + m]; }
              if (d == 0) { const float dn = IN(16)[lg * 16 + n];
#pragma unroll
                  for (int m = 0; m < 16; ++m) if (m == n) a[m] += dn; }
#pragma unroll
              for (int m = 0; m < 16; ++m) KD[(d * 16 + n) * 16 + m] = a[m]; }
            __syncthreads();
            bf16* wb = WSSM + (size_t)lg * 512 * SSM_K;
            for (int q = F.tid; q < 512 * (SSM_K / 8); q += 512) { const int row = q / (SSM_K / 8), ch = q % (SSM_K / 8); const int t = row >> 4, n = row & 15; float v[8];
                if (ch < 64) { const int j = ch >> 1, m0 = (ch & 1) * 8;
#pragma unroll
                    for (int e = 0; e < 8; ++e) v[e] = (j <= t) ? KD[((t - j) * 16 + n) * 16 + m0 + e] : 0.f; }
                else { const int p2 = (ch - 64) * 8, part = p2 >> 6, p0 = p2 & 63;
#pragma unroll
                    for (int e = 0; e < 8; ++e) { const float cr = Cr[n * 64 + p0 + e], ci = Ci[n * 64 + p0 + e], ar = APr[(t + 1) * 64 + p0 + e], ai = APi[(t + 1) * 64 + p0 + e]; v[e] = part ? -(cr * ai + ci * ar) : (cr * ar - ci * ai); } }
                v4u o; o.x = pk2(v[0], v[1]); o.y = pk2(v[2], v[3]); o.z = pk2(v[4], v[5]); o.w = pk2(v[6], v[7]);
                *(v4u*)(wb + (size_t)row * SSM_K + ch * 8) = o; }
            { bf16* we = WEW + (size_t)lg * 256 * 512;
              for (int q = F.tid; q < 256 * 64; q += 512) { const int row = q >> 6, ch = q & 63; v4u o = {0u, 0u, 0u, 0u};
                  if (row < 128) { const int p = row & 63, part = row >> 6, j = ch >> 1, n0 = (ch & 1) * 8; const float ar = APr[(31 - j) * 64 + p], ai = APi[(31 - j) * 64 + p]; float v[8];
#pragma unroll
                      for (int e = 0; e < 8; ++e) { const float br = Br[p * 16 + n0 + e], bi = Bi[p * 16 + n0 + e]; v[e] = part ? (ar * bi + ai * br) : (ar * br - ai * bi); }
                      o.x = pk2(v[0], v[1]); o.y = pk2(v[2], v[3]); o.z = pk2(v[4], v[5]); o.w = pk2(v[6], v[7]); }
                  *(v4u*)(we + (size_t)row * 512 + ch * 8) = o; } }
            __syncthreads(); } }
        for (;;) { int base_ = 0; if (lane == 0) base_ = (int)__hip_atomic_fetch_add(CTLP + CW_Q0, 8u, RLX_AGENT); base_ = __builtin_amdgcn_readfirstlane(base_); if (base_ >= NL * I_LAYER) break;
        for (int it = base_; it < base_ + 8 && it < NL * I_LAYER; ++it) {
            const int l = it / I_LAYER; int r = it % I_LAYER;
            const float* Wl = w_in + (size_t)l * D * DIN; bf16* Wt = (bf16*)((unsigned char*)WinT + (size_t)l * NP * D);
            if (r < I_WIN) {
                if (r < I_CKV) { tr_item64<3>(Wl, DIN, SC_CKV, 128, D, Wt, PC_CKV, scr, r, lane); continue; } r -= I_CKV;
                if (r < I_QIDX) { tr_item64<3>(Wl, DIN, SC_QIDX, 256, D, Wt, PC_QIDX, scr, r, lane); continue; } r -= I_QIDX;
                if (r < I_KIDX) { tr_item64<3>(Wl, DIN, SC_KIDX, 32, D, Wt, PC_KIDX, scr, r, lane); continue; } r -= I_KIDX;
                if (r < I_WIDX) { tr_item64<3>(Wl, DIN, SC_WIDX, 8, D, Wt, PC_WIDX, scr, r, lane); continue; } r -= I_WIDX;
                if (r < 5 * I_512) { const int s = r / I_512; tr_item64<3>(Wl, DIN, SC_CU + 512 * s, 512, D, Wt, PC_CU + 512 * s, scr, r % I_512, lane); continue; } r -= 5 * I_512;
                tr_item64<3>(Wl, DIN, SC_GATE, 4096, D, Wt, PC_GATE, scr, r, lane); continue;
            }
            r -= I_WIN;
            if (r < I_GLU) { tr_item64(IN(18) + (size_t)l * 512 * 512, 512, 0, 512, 512, WgluT + (size_t)l * 512 * 512, 0, scr, r, lane); continue; } r -= I_GLU;
            if (r < I_MKV) { tr_item64(IN(20) + (size_t)l * 1024 * 1024, 1024, 0, 1024, 1024, WmkvT + (size_t)l * 1024 * 1024, 0, scr, r, lane); continue; } r -= I_MKV;
            if (r < 4 * I_BR) { const int b = r / I_BR; tr_item64(IN(21) + ((size_t)l * 4 + b) * 512 * 1024, 1024, 0, 1024, 512, WbrT + ((size_t)l * 4 + b) * 1024 * 512, 0, scr, r % I_BR, lane); continue; } r -= 4 * I_BR;
            if (r < I_WO) { tr_item64(IN(22) + (size_t)l * 1024 * 1024, 1024, 0, 1024, 1024, WoT + (size_t)l * 1024 * 1024, 0, scr, r, lane); continue; } r -= I_WO;
            if (r < NE * I_UP) { const int e = r / I_UP; tr_item64<1>(IN(27) + ((size_t)l * NE + e) * 1024 * 2048, 2048, 0, 2048, 1024, (bf16*)((unsigned char*)WupT + ((size_t)l * NE + e) * 2048 * 1024), 0, scr, r % I_UP, lane); continue; } r -= NE * I_UP;
            { const int e = r / I_DN; tr_item64<2>(IN(29) + ((size_t)l * NE + e) * 1024 * 1024, 1024, 0, 1024, 1024, (bf16*)((unsigned char*)WdnT + ((size_t)l * NE + e) * 1024 * 1024), 0, scr, r % I_DN, lane); }
        } }
        for (int it = F.gw; it < NL * (PC_QIDX - PC_WIDX - 8); it += F.NGW) { const int l = it / (PC_QIDX - PC_WIDX - 8), rr = PC_WIDX + 8 + it % (PC_QIDX - PC_WIDX - 8);
            *((v4u*)((unsigned char*)WinT + ((size_t)l * NP + rr) * D) + lane) = (v4u){0u, 0u, 0u, 0u}; }
        for (int it = F.gw; it < NL * 512; it += F.NGW) { const int l = it / 512, n = it % 512, h = n >> 6, d = n & 63; const float* wuv = IN(7) + (size_t)l * 128 * 512;
            bf16* p = WuvT + ((size_t)l * 512 + n) * 1024;
#pragma unroll
            for (int j = 0; j < 2; ++j) { const int k0 = 8 * lane + 512 * j; float v[8];
#pragma unroll
                for (int q = 0; q < 8; ++q) { const int k = k0 + q; const float x_ = wuv[(size_t)(k & 127) * 512 + h * 64 + d]; v[q] = ((k >> 7) == h) ? x_ : 0.f; }
                v4u o; o.x = pk2(v[0], v[1]); o.y = pk2(v[2], v[3]); o.z = pk2(v[4], v[5]); o.w = pk2(v[6], v[7]); *(v4u*)(p + k0) = o; } }
        for (int it = F.gw; it < NL * 32; it += F.NGW) { const int l = it >> 5, g = it & 31; const int idx = (l * 32 + g) * 64 + lane;
            const float lr = IN(10)[idx], li = IN(11)[idx], dt = expf(IN(17)[l * 32 + g]);
            const float er = expf(lr * dt); float sn, cs; sincosf(li * dt, &sn, &cs); const float ar = er * cs, ai = er * sn;
            S5A[idx] = (f32x2){ar, ai};
            float pr = ar, pi = ai;
#pragma unroll
            for (int q = 0; q < 5; ++q) { const float nr = pr * pr - pi * pi, ni = 2.f * pr * pi; pr = nr; pi = ni; }
            S5A[NL * 32 * 64 + idx] = (f32x2){pr, pi};
            const float nr_ = ar - 1.f, ni_ = ai, den = lr * lr + li * li; const float fr_ = (nr_ * lr + ni_ * li) / den, fi_ = (ni_ * lr - nr_ * li) / den;
            { f32x4 br4[4], bi4[4];
#pragma unroll
              for (int q = 0; q < 4; ++q) { br4[q] = *(const f32x4*)(IN(12) + (size_t)idx * 16 + 4 * q); bi4[q] = *(const f32x4*)(IN(13) + (size_t)idx * 16 + 4 * q); }
#pragma unroll
              for (int n = 0; n < 16; ++n) { const float br = br4[n >> 2][n & 3], bi = bi4[n >> 2][n & 3];
                  S5B[(size_t)idx * 16 + n] = (f32x2){fr_ * br - fi_ * bi, fr_ * bi + fi_ * br}; } } }
        for (int it = F.gw; it < 512; it += F.NGW) { const float* mp = IN(1) + (size_t)it * 1024; f32x4 v[4];
#pragma unroll
            for (int j = 0; j < 4; ++j) v[j] = *(const f32x4*)(mp + 4 * lane + 256 * j);
            store_row_f32_bf16(v, nullptr, MEMB + (size_t)it * 1024, lane); }
        const LnAff aff0 = ln_aff(IN(2), IN(3), lane);
        for (int m = F.gw; m < M; m += F.NGW) { const float* xp = IN(0) + (size_t)m * D; f32x4 v[4];
#pragma unroll
            for (int j = 0; j < 4; ++j) v[j] = *(const f32x4*)(xp + 4 * lane + 256 * j);
            ln_rows_pre(v, aff0); store_row_f32_bf16(v, nullptr, Hf + (size_t)m * D, lane); store_row_fp8(v, (unsigned char*)Hb + (size_t)m * D, lane); }
    }
    PHASE_END

    PHASE_BEGIN(1)
    {
        pg8::Dims g{2048, 2048, 2048}; MkvOrder S{F.G, F.bx, (const char*)MEMB, (const char*)WmkvT}; EpiMkv E{MKV};
        pg8::gemm_phase<EpiMkv, MkvOrder, true, true>(F.lds, g, S, E, F.tid);
    }
    PHASE_END

#define MOE_BLK0() do { if (F.tid < 32) CNTL[F.tid] = (int)__hip_atomic_load(CTLP + CW_CNT + l * 2048 + F.tid * 64, RLX_AGENT); __syncthreads(); \
        if (F.tid < 33) { int acc_ = 0; for (int k_ = 0; k_ < 32; ++k_) acc_ += (k_ < F.tid) ? ((CNTL[k_] + 255) >> 8) : 0; BLK0[F.tid] = acc_; } __syncthreads(); } while (0)
    for (int l = 0; l < NL; ++l) {
        PHASE_BEGIN(2)
        {
            pg8::Dims g{1024, 1024, 1024}; pg8::StaticOrder S; S.init(M, NP, F.G, F.bx, Hb, 1024, (const unsigned char*)WinT + (size_t)l * NP * D, 1024); EpiProjQ E{PROJ, NP, AEXT};
            pg8::gemm_phase<EpiProjQ, pg8::StaticOrder, true, true, true>(F.lds, g, S, E, F.tid);
        }
        PHASE_END

        PHASE_BEGIN(3)
        {
            { const float* kg = IN(5) + (size_t)l * 128; const float* cw = IN(8) + (size_t)l * 3 * 512; const float* cb = IN(9) + (size_t)l * 512;
              const float kg0 = kg[2 * lane], kg1 = kg[2 * lane + 1];
              const int eg_ = (F.G >= 128) ? 64 : 0; const int gw2_ = (F.bx - eg_) * NWAVES + wave, ngw2_ = (F.G - eg_) * NWAVES;
              if (F.bx >= eg_)
#pragma unroll 1
              for (int mb = gw2_; mb < M; mb += 4 * ngw2_) {
                unsigned cw2[4], kx[4]; v4u uu[4][3], gc[4][3], gb[4];
#pragma unroll
                for (int q = 0; q < 4; ++q) { int m = mb + q * ngw2_; m = m < M ? m : mb; const bf16* pr = PROJ + (size_t)m * NP; const int tl = m & (T - 1);
                    cw2[q] = *(const unsigned*)(pr + PC_CKV + 2 * lane); kx[q] = *(const unsigned*)(pr + PC_KIDX + 2 * (lane & 15)); gb[q] = *(const v4u*)(pr + PC_GB + 8 * lane);
#pragma unroll
                    for (int k = 0; k < 3; ++k) { const int back = 2 - k; const bf16* pp = pr - (size_t)(tl >= back ? back : 0) * NP;
                        uu[q][k] = *(const v4u*)(pp + PC_CU + 8 * lane); gc[q][k] = *(const v4u*)(pp + PC_GC + 8 * lane); } }
#pragma unroll
                for (int q = 0; q < 4; ++q) { const int m = mb + q * ngw2_; if (m < M) { const int tl = m & (T - 1);
                    const float c0 = bflo(cw2[q]), c1 = bfhi(cw2[q]);
                    const float rs = 1.f / sqrtf(wave_sum(c0 * c0 + c1 * c1) * (1.f / 128.f) + LN_EPS);
                    *(unsigned*)(KVN + (size_t)m * 128 + 2 * lane) = pk2(c0 * rs * kg0, c1 * rs * kg1);
                    if (lane < 16) *(unsigned*)(KIDX + (size_t)m * 32 + 2 * lane) = kx[q];
                    float y[8];
#pragma unroll
                    for (int i = 0; i < 8; ++i) y[i] = cb[8 * lane + i];
#pragma unroll
                    for (int k = 0; k < 3; ++k) { const int back = 2 - k; if (tl >= back) { const v4u u4 = uu[q][k], g4 = gc[q][k]; const float* wk = cw + k * 512 + 8 * lane;
                            y[0] += wk[0] * bflo(u4.x) * bflo(g4.x); y[1] += wk[1] * bfhi(u4.x) * bfhi(g4.x); y[2] += wk[2] * bflo(u4.y) * bflo(g4.y); y[3] += wk[3] * bfhi(u4.y) * bfhi(g4.y);
                            y[4] += wk[4] * bflo(u4.z) * bflo(g4.z); y[5] += wk[5] * bfhi(u4.z) * bfhi(g4.z); y[6] += wk[6] * bflo(u4.w) * bflo(g4.w); y[7] += wk[7] * bfhi(u4.w) * bfhi(g4.w); } }
                    const v4u b4 = gb[q];
                    v4u o; o.x = pk2(y[0] * bflo(b4.x), y[1] * bfhi(b4.x)); o.y = pk2(y[2] * bflo(b4.y), y[3] * bfhi(b4.y)); o.z = pk2(y[4] * bflo(b4.z), y[5] * bfhi(b4.z)); o.w = pk2(y[6] * bflo(b4.w), y[7] * bfhi(b4.w));
                    *(v4u*)(BR + (size_t)m * 2048 + 512 + 8 * lane) = o; } } } }
            __syncthreads();
            { pg8::Dims g{SSM_K * 2, 1024, 1024}; EOrder S{F.G, F.bx, (const char*)AEXT, (const char*)(WEW + (size_t)l * 32 * 256 * 512)}; EpiE E{(float*)SSE};
              pg8::gemm_phase<EpiE, EOrder, true, true>(F.lds, g, S, E, F.tid); }
            __syncthreads();
            __syncthreads();
            for (int u = F.bx; u < NB * 4 * (T / 256); u += F.G) { const int qblk = u % (T / 256), hd = (u / (T / 256)) & 3, b = u / (4 * (T / 256));
                memattn_unit(F.lds, PROJ, MKV + (size_t)l * 512 * 1024, BR, b, hd, qblk, F.tid); }
        }
        PHASE_END

        PHASE_BEGIN(4)
        {
            { int par = 0; float* sb0 = SCR + (size_t)F.bx * 2 * 8 * 8192;
              for (int i = 0; ; ++i) { const int rk = (i & 1) ? (i * F.G + (F.G - 1 - F.bx)) : (i * F.G + F.bx); if (rk >= M / 8) break;
                const int u = M / 8 - 1 - rk; const int b = u & 1, t0 = (u >> 1) * 8;
                dsa2_unit(F.lds, PROJ, KIDX, KVN, OLAT, sb0 + (size_t)par * 8 * 8192, b, t0, F.tid); if (t0 >= 256) par ^= 1; }
              __syncthreads(); }
#ifndef DUP_CARRY
#define DUP_CARRY 1
#endif
            for (int repc = 0; repc < DUP_CARRY; ++repc)
            for (int it = F.gw; it < NB * 32; it += F.NGW) { const int b = it >> 5, g = it & 31; const f32x2 aL = S5A[NL * 32 * 64 + (l * 32 + g) * 64 + lane];
                float hr = 0.f, hi_ = 0.f; bf16* ap = AEXT + ((size_t)(g * 512 + b * 256)) * SSM_K + 512 + lane;
                for (int c0 = 0; c0 < SSM_NC; c0 += 8) { f32x2 e[8];
#pragma unroll
                    for (int k = 0; k < 8; ++k) { const float* ep_ = (const float*)SSE + ((size_t)(b * SSM_NC + c0 + k) * 32 + g) * 128 + lane; e[k] = (f32x2){ep_[0], ep_[64]}; }
#pragma unroll
                    for (int k = 0; k < 8; ++k) { ap[(size_t)(c0 + k) * SSM_K] = (bf16)f2bf(hr); ap[(size_t)(c0 + k) * SSM_K + 64] = (bf16)f2bf(hi_);
                        const float nr = aL[0] * hr - aL[1] * hi_ + e[k][0], ni = aL[0] * hi_ + aL[1] * hr + e[k][1]; hr = nr; hi_ = ni; } } }
        }
        PHASE_END

        PHASE_BEGIN(5)
        {
            const int half = F.G >> 1;
            if (F.bx < half) {
                pg8::Dims g{SSM_K * 2, SSM_K * 2, SSM_K * 2}; SsmOrder S{half, F.bx, (const char*)AEXT, (const char*)(WSSM + (size_t)l * 32 * 512 * SSM_K)}; EpiSsm E{Zb};
                pg8::gemm_phase<EpiSsm, SsmOrder, true, true>(F.lds, g, S, E, F.tid);
            } else {
                pg8::Dims g{2048, 2048, 2048}; pg8::StaticOrder S; S.init(M, 512, F.G - half, F.bx - half, OLAT, 2048, WuvT + (size_t)l * 512 * 1024, 2048);
                EpiBf16 E{BR, 2048};
                pg8::gemm_phase<EpiBf16, pg8::StaticOrder, true, true>(F.lds, g, S, E, F.tid);
            }
        }
        PHASE_END

        PHASE_BEGIN(6)
        {
            pg8::Dims g{1024, 1024, 1024}; pg8::StaticOrder S; S.init(M, 512, F.G, F.bx, Zb, 1024, WgluT + (size_t)l * 512 * 512, 1024);
            EpiGlu E{Zb, 512, IN(19) + (size_t)l * 512, BR + 1024, 2048};
            pg8::gemm_phase<EpiGlu, pg8::StaticOrder, true, true>(F.lds, g, S, E, F.tid);
        }
        PHASE_END

        PHASE_BEGIN(7)
        {
            pg8::Dims g{4096, 1024, 1024}; MergeOrder S{F.G, F.bx, (const char*)BR, (const char*)(WbrT + (size_t)l * 4 * 1024 * 512)};
            EpiMerge E{PROJ + PC_GATE, NP, MRGB};
            pg8::gemm_phase<EpiMerge, MergeOrder, true, true>(F.lds, g, S, E, F.tid);
        }
        PHASE_END

        PHASE_BEGIN(8)
        {
            pg8::Dims g{2048, 2048, 2048}; pg8::StaticOrder S; S.init(M, 1024, F.G, F.bx, MRGB, 2048, WoT + (size_t)l * 1024 * 1024, 2048); EpiWo E{Hf, Vf};
            pg8::gemm_phase<EpiWo, pg8::StaticOrder, true, true>(F.lds, g, S, E, F.tid);
        }
        PHASE_END

        PHASE_BEGIN(9)
        {
            constexpr int HP = 2064, HLO_OFF = 16 * HP, PART_OFF = 66560;
            LAS unsigned char* hhi = F.lds; LAS unsigned char* hlo = F.lds + HLO_OFF; LAS float* part = (LAS float*)(F.lds + PART_OFF);
            LAS unsigned* wcnt = (LAS unsigned*)(F.lds + LDSCTL_OFF + 2048); LAS unsigned* wbase = wcnt + 32; LAS unsigned* asg = wcnt + 64; LAS float* asgg = (LAS float*)(asg + 256);
            const float* wr_ = IN(25) + (size_t)l * 1024 * 32; const float* brt = IN(26) + (size_t)l * 32;
            unsigned* cnt = CTLP + CW_CNT + l * 2048;
            const float* g1 = IN(23) + (size_t)l * D; const float* b1 = IN(24) + (size_t)l * D;
            const int fn = lane & 15, fkq = lane >> 4;
            v4u whi[4][2], wlo[4][2];
#pragma unroll
            for (int ks = 0; ks < 4; ++ks)
#pragma unroll
                for (int mt = 0; mt < 2; ++mt) { unsigned hh[8], ll[8];
#pragma unroll
                    for (int i = 0; i < 8; ++i) { const float f = wr_[(size_t)(128 * wave + 32 * ks + 8 * fkq + i) * 32 + 16 * mt + fn]; hh[i] = f2bf(f); ll[i] = f2bf(f - __builtin_bit_cast(float, hh[i] << 16)); }
                    whi[ks][mt] = (v4u){hh[0] | (hh[1] << 16), hh[2] | (hh[3] << 16), hh[4] | (hh[5] << 16), hh[6] | (hh[7] << 16)};
                    wlo[ks][mt] = (v4u){ll[0] | (ll[1] << 16), ll[2] | (ll[3] << 16), ll[4] | (ll[5] << 16), ll[6] | (ll[7] << 16)}; }
            const LnAff aff1 = ln_aff(g1, b1, lane);
            for (int blk = F.bx; blk < M / 64; blk += F.G) {
                if (F.tid < 32) wcnt[F.tid] = 0u;
                __syncthreads();
                v2u raw[2][4];
#pragma unroll
                for (int tk = 0; tk < 2; ++tk)
#pragma unroll
                    for (int j = 0; j < 4; ++j) raw[tk][j] = *(const v2u*)(Vf + (size_t)(blk * 64 + 2 * wave + tk) * D + 4 * lane + 256 * j);
#pragma unroll 1
                for (int rd = 0; rd < 4; ++rd) { const int m0 = blk * 64 + rd * 16 + 2 * wave;
#pragma unroll
                    for (int tk = 0; tk < 2; ++tk) { f32x4 v[4];
#pragma unroll
                        for (int j = 0; j < 4; ++j) v[j] = (f32x4){bflo(raw[tk][j].x), bfhi(raw[tk][j].x), bflo(raw[tk][j].y), bfhi(raw[tk][j].y)};
                        ln_rows_pre(v, aff1); store_row_f32_bf16(v, nullptr, H1 + (size_t)(m0 + tk) * D, lane); store_row_fp8(v, (unsigned char*)H1B + (size_t)(m0 + tk) * D, lane);
#pragma unroll
                        for (int j = 0; j < 4; ++j) { unsigned hh[4]; float rr[4];
#pragma unroll
                            for (int q = 0; q < 4; ++q) { hh[q] = f2bf(v[j][q]); rr[q] = v[j][q] - __builtin_bit_cast(float, hh[q] << 16); }
                            const int o_ = (2 * wave + tk) * HP + (4 * lane + 256 * j) * 2;
                            *(LAS v2u*)(hhi + o_) = (v2u){hh[0] | (hh[1] << 16), hh[2] | (hh[3] << 16)}; *(LAS v2u*)(hlo + o_) = (v2u){pk2(rr[0], rr[1]), pk2(rr[2], rr[3])}; } }
                    if (rd + 1 < 4) {
#pragma unroll
                        for (int tk = 0; tk < 2; ++tk)
#pragma unroll
                            for (int j = 0; j < 4; ++j) raw[tk][j] = *(const v2u*)(Vf + (size_t)(m0 + 16 + tk) * D + 4 * lane + 256 * j); }
                    __syncthreads();
                    { f32x4 acc[2] = {{0.f, 0.f, 0.f, 0.f}, {0.f, 0.f, 0.f, 0.f}};
#pragma unroll
                      for (int ks = 0; ks < 4; ++ks) { const int ko = fn * HP + (128 * wave + 32 * ks + 8 * fkq) * 2;
                          const bf16x8 bh = *(const LAS bf16x8*)(hhi + ko), bl = *(const LAS bf16x8*)(hlo + ko);
#pragma unroll
                          for (int mt = 0; mt < 2; ++mt) { const bf16x8 ah = __builtin_bit_cast(bf16x8, whi[ks][mt]), al = __builtin_bit_cast(bf16x8, wlo[ks][mt]);
                              acc[mt] = __builtin_amdgcn_mfma_f32_16x16x32_bf16(ah, bh, acc[mt], 0, 0, 0); acc[mt] = __builtin_amdgcn_mfma_f32_16x16x32_bf16(al, bh, acc[mt], 0, 0, 0);
                              acc[mt] = __builtin_amdgcn_mfma_f32_16x16x32_bf16(ah, bl, acc[mt], 0, 0, 0); } }
#pragma unroll
                      for (int mt = 0; mt < 2; ++mt) *(LAS f32x4*)(part + (wave * 16 + fn) * 32 + 16 * mt + 4 * fkq) = acc[mt]; }
                    __syncthreads();
                    const int eq = lane & 7; const int lopr_ = lane_op(); const f32x4 be4 = *(const f32x4*)(brt + 4 * eq);
#pragma unroll 1
                    for (int tk = 0; tk < 2; ++tk) { float cur[4] = {be4[0], be4[1], be4[2], be4[3]};
#pragma unroll
                        for (int w = 0; w < 8; ++w) { const f32x4 p = *(const LAS f32x4*)(part + (w * 16 + 2 * wave + tk) * 32 + 4 * eq);
#pragma unroll
                            for (int j = 0; j < 4; ++j) cur[j] += p[j]; }
                        float val[4]; int idx[4];
#pragma unroll
                        for (int k = 0; k < 4; ++k) { float bv = cur[0]; int bi = 4 * eq;
#pragma unroll
                            for (int j = 1; j < 4; ++j) if (cur[j] > bv) { bv = cur[j]; bi = 4 * eq + j; }
#pragma unroll
                            for (int o = 1; o < 8; o <<= 1) { const float ov = SHX(bv, o, lopr_); const int oi = SHX(bi, o, lopr_); if (ov > bv || (ov == bv && oi < bi)) { bv = ov; bi = oi; } }
                            val[k] = bv; idx[k] = bi;
#pragma unroll
                            for (int j = 0; j < 4; ++j) if (bi == 4 * eq + j) cur[j] = -INFINITY; }
                        const float e1 = __expf(val[1] - val[0]), e2 = __expf(val[2] - val[0]), e3 = __expf(val[3] - val[0]); const float inv = 1.f / (1.f + e1 + e2 + e3);
                        const float gt[4] = {inv, e1 * inv, e2 * inv, e3 * inv};
                        if (lane < 4) { int ee = idx[0]; float gg = gt[0];
#pragma unroll
                            for (int k = 1; k < 4; ++k) if (lane == k) { ee = idx[k]; gg = gt[k]; }
                            const unsigned rank = __hip_atomic_fetch_add(&wcnt[ee], 1u, __ATOMIC_RELAXED, __HIP_MEMORY_SCOPE_WORKGROUP);
                            const int tl_ = rd * 16 + 2 * wave + tk; asg[tl_ * 4 + lane] = (unsigned)ee | (rank << 8); asgg[tl_ * 4 + lane] = gg; } }
                    LDS_WAIT();
                }
                __syncthreads();
                if (F.tid < 32) { const unsigned c = wcnt[F.tid]; wbase[F.tid] = c ? __hip_atomic_fetch_add(cnt + F.tid * 64, c, RLX_AGENT) : 0u; }
                __syncthreads();
                if (F.tid < 256) { const unsigned a_ = asg[F.tid]; const int ee = (int)(a_ & 255u); const unsigned slot = wbase[ee] + (a_ >> 8); const int m = blk * 64 + (F.tid >> 2);
                    TOK[(size_t)ee * M + slot] = m; GATE[(size_t)ee * M + slot] = asgg[F.tid]; SLOT[(size_t)m * 4 + (F.tid & 3)] = ee * M + (int)slot; }
                __syncthreads();
            }
        }
        PHASE_END

        PHASE_BEGIN(11)
        {
            LAS int* CNTL = (LAS int*)(ldsq + MISC_OFF + 272);
            MOE_BLK0();
            for (int mb = F.gw; mb < M; mb += 16 * F.NGW) { const int m = mb + (lane >> 2) * F.NGW;
                if (m < M) { const int sl = SLOT[(size_t)m * 4 + (lane & 3)]; const int e = sl >> 14, s = sl & (M - 1); GROW[(size_t)BLK0[e] * 256 + s] = GATE[(size_t)e * M + s]; } }
            pg8::Dims g{1024, 1024, 1024}; MoeOrder S{F.G, F.bx, 8, BLK0[32] * 8, BLK0, (const char*)H1B, (const char*)WupT + (size_t)l * NE * 2048 * 1024, (size_t)0, (size_t)2048 * 1024, (size_t)256 * 1024, TOK, CNTL};
            EpiUp E{IN(28) + (size_t)l * NE * 2048, (unsigned char*)ACT};
            pg8::gemm_phase<EpiUp, MoeOrder, true, true, true, true>(F.lds, g, S, E, F.tid);
        }
        PHASE_END

        PHASE_BEGIN(12)
        {
            { LAS int* CNTL = (LAS int*)(ldsq + MISC_OFF + 272); MOE_BLK0(); }
            pg8::Dims g{1024, 1024, 1024}; MoeOrder S{F.G, F.bx, 4, BLK0[32] * 4, BLK0, (const char*)ACT, (const char*)WdnT + (size_t)l * NE * 1024 * 1024, (size_t)256 * 1024, (size_t)1024 * 1024, (size_t)256 * 1024, nullptr, nullptr};
            EpiDown E{IN(30) + (size_t)l * NE * 1024, GROW, YS};
            pg8::gemm_phase<EpiDown, MoeOrder, true, true, true>(F.lds, g, S, E, F.tid);
        }
        PHASE_END

        PHASE_BEGIN(13)
        {
            { LAS int* CNTL = (LAS int*)(ldsq + MISC_OFF + 272); MOE_BLK0(); }
#define LL_ISSUE(mm, s4, hh, yy) do { const unsigned ho_ = (unsigned)(mm) * 2048u + 8u * (unsigned)lane; \
                _Pragma("unroll") for (int j = 0; j < 4; ++j) hh[j] = *(const v2u*)((const char*)H1 + ho_ + 512 * j); \
                _Pragma("unroll") for (int k = 0; k < 4; ++k) { const unsigned sl = s4[k]; const unsigned ro_ = ((unsigned)BLK0[sl >> 14] * 256u + (sl & (unsigned)(M - 1))) * 2048u + 8u * (unsigned)lane; \
                    _Pragma("unroll") for (int j = 0; j < 4; ++j) yy[k][j] = *(const v2u*)((const char*)YS + ro_ + 512 * j); } } while (0)
#define LL_FIN(mm, hC, yC) { f32x4 v[4]; \
                  _Pragma("unroll") for (int j = 0; j < 4; ++j) { v[j] = (f32x4){bflo(hC[j].x), bfhi(hC[j].x), bflo(hC[j].y), bfhi(hC[j].y)} * DN_ALPHA; \
                      _Pragma("unroll") for (int k = 0; k < 4; ++k) { const v2u y2 = yC[k][j]; v[j][0] += bflo(y2.x); v[j][1] += bfhi(y2.x); v[j][2] += bflo(y2.y); v[j][3] += bfhi(y2.y); } } \
                  ln_rows_pre(v, aff2); \
                  if (l == NL - 1) store_row_f32_bf16(v, OUTP + (size_t)(mm) * D, nullptr, lane); \
                  else { store_row_f32_bf16(v, nullptr, Hf + (size_t)(mm) * D, lane); store_row_fp8(v, (unsigned char*)Hb + (size_t)(mm) * D, lane); } }
            const LnAff aff2 = ln_aff(IN(31) + (size_t)l * D, IN(32) + (size_t)l * D, lane);
            { int m = F.gw; const int st = F.NGW; v4u sa = *(const v4u*)(SLOT + (size_t)m * 4), sb = *(const v4u*)(SLOT + (size_t)(m + st < M ? m + st : m) * 4);
#pragma unroll 1
              for (; m < M; m += 2 * st) { const bool two = m + st < M; const int m1 = two ? m + st : m; v2u hA[4], yA[4][4], hB[4], yB[4][4];
                  LL_ISSUE(m, sa, hA, yA); LL_ISSUE(m1, sb, hB, yB);
                  { const int n0 = m + 2 * st; if (n0 < M) { sa = *(const v4u*)(SLOT + (size_t)n0 * 4); sb = *(const v4u*)(SLOT + (size_t)(n0 + st < M ? n0 + st : n0) * 4); } }
                  LL_FIN(m, hA, yA)
                  if (two) LL_FIN(m1, hB, yB) } }
#undef LL_FIN
#undef LL_ISSUE
        }
        PHASE_END
    }
#undef PHASE_BEGIN
#undef PHASE_END
}

extern "C" void kernel_launch(void* const* d_in, const int* in_sizes, int n_in, void* d_out, int out_size, void* d_ws, size_t ws_size, hipStream_t stream) {
    static int grid = 0;
    if (grid == 0) {
        if (n_in != 33 || out_size != M * D || ws_size < WS_END) { fprintf(stderr, "kernel_launch: unexpected shapes (n_in %d out %d ws %zu need %zu)\n", n_in, out_size, ws_size, (size_t)WS_END); grid = -1; return; }
        int dev = 0, cus = 0, per_cu = 0;
        if (hipGetDevice(&dev) != hipSuccess || hipDeviceGetAttribute(&cus, hipDeviceAttributeMultiprocessorCount, dev) != hipSuccess) { grid = -1; return; }
        if (hipFuncSetAttribute((const void*)fwd, hipFuncAttributeMaxDynamicSharedMemorySize, LDS_BYTES) != hipSuccess) { fprintf(stderr, "kernel_launch: hipFuncSetAttribute failed\n"); grid = -1; return; }
        if (hipOccupancyMaxActiveBlocksPerMultiprocessor(&per_cu, (const void*)fwd, NWAVES * 64, LDS_BYTES) != hipSuccess || per_cu < 1) fprintf(stderr, "kernel_launch: occupancy query says %d\n", per_cu);
        (void)hipGetLastError();
        grid = cus;
    }
    if (grid < 0) return;
    (void)hipMemsetAsync((char*)d_ws + WS_CTL, 0, CTL_ZERO_BYTES, stream);
    Args a{};
    for (int i = 0; i < 33; ++i) a.in[i] = (const float*)d_in[i];
    a.out = (float*)d_out; a.ws = (unsigned char*)d_ws;
#if ONE_LAUNCH
    a.ph_lo = 0; a.ph_hi = NPHASE;
    hipLaunchKernelGGL(fwd, dim3(grid), dim3(NWAVES * 64), LDS_BYTES, stream, a);
#else
    for (int p = 0; p < NPHASE; ++p) { a.ph_lo = p; a.ph_hi = p + 1; hipLaunchKernelGGL(fwd, dim3(grid), dim3(NWAVES * 64), LDS_BYTES, stream, a); }
#endif
}
```

```cpp
#include <hip/hip_runtime.h>
#include <cstdio>
#include <cstdint>

#ifndef ONE_LAUNCH
#define ONE_LAUNCH 1
#endif

#define LAS __attribute__((address_space(3)))
#define GAS __attribute__((address_space(1)))
typedef unsigned short bf16;
typedef unsigned v4u __attribute__((ext_vector_type(4)));
typedef unsigned v2u __attribute__((ext_vector_type(2)));
typedef float f32x4 __attribute__((ext_vector_type(4)));
typedef float f32x2 __attribute__((ext_vector_type(2)));
typedef short bf16x8 __attribute__((ext_vector_type(8)));
typedef short v4i16_t __attribute__((ext_vector_type(4)));

namespace pg8 {
constexpr int BM = 256, BK = 64, HALF = 128, HTB = HALF * BK * 2, STAGE_BYTES = 8 * HTB, NXCD = 8, WGM = 8;
__host__ __device__ __forceinline__ int lds_byte(int r, int c) { const int st = (r >> 4) * 2 + (c >> 5), rr = r & 15, cc = c & 31, ob = rr * 64 + cc * 2; return st * 1024 + (ob ^ (((ob >> 9) & 1) << 5)); }
__host__ __device__ __forceinline__ void stage_rc(int b, int& R, int& C) { const int st = b / 1024, sb = b % 1024, swz = sb ^ (((sb >> 9) & 1) << 5); R = (st >> 1) * 16 + swz / 64; C = (st & 1) * 32 + (swz % 64) / 2; }
__host__ __device__ __forceinline__ int perm32(int rho) { const int n = rho >> 4, i = rho & 15; return 8 * (i >> 2) + 4 * n + (i & 3); }

constexpr int GATHER_LIST_OFF = 131072 + 2048;
struct Unit { int pm, pn, z; const char* A; const char* B; };
struct Dims { int lda, ldb, K; };
typedef int v8i_t __attribute__((ext_vector_type(8)));
typedef int v4i_t __attribute__((ext_vector_type(4)));

__device__ __forceinline__ void tile_of(int wgid, int nM, int nN, int& pm, int& pn) {
    const int nwg = nM * nN;
    { const int q = nwg / NXCD, r = nwg % NXCD, xcd = wgid % NXCD, off = wgid / NXCD; wgid = (xcd < r ? xcd * (q + 1) : r * (q + 1) + (xcd - r) * q) + off; }
    const int nig = WGM * nN, gid = wgid / nig, fm = gid * WGM, gsz = (nM - fm) < WGM ? (nM - fm) : WGM;
    pm = fm + ((wgid % nig) % gsz); pn = (wgid % nig) / gsz;
}
struct StaticOrder {
    int nM, nN, nwg, G, c; const char* A; const char* B; size_t at, bt;
    __device__ void init(int M, int N, int G_, int c_, const void* A_, int lda, const void* B_, int ldb) { nM = M / BM; nN = N / BM; nwg = nM * nN; G = G_; c = c_; A = (const char*)A_; B = (const char*)B_; at = (size_t)BM * lda; bt = (size_t)BM * ldb; }
    __device__ __forceinline__ bool next(int i, Unit& u) const {
        const long Lx = (long)i * G + c; if (Lx >= nwg) return false;
        int pm, pn; tile_of((int)Lx, nM, nN, pm, pn); u.pm = pm; u.pn = pn; u.z = 0; u.A = A + (size_t)pm * at; u.B = B + (size_t)pn * bt; return true;
    }
};

__device__ __forceinline__ unsigned cvt_pk_bf16(float lo, float hi) { unsigned r; asm volatile("v_cvt_pk_bf16_f32 %0, %1, %2" : "=v"(r) : "v"(lo), "v"(hi)); return r; }

template <class Epi, class Sched, bool ALIGN_EPI = false, bool SP2 = false, bool FP8 = false  ,
          bool GATHER = false  >
__device__ __forceinline__ void gemm_phase(LAS unsigned char* lds, const Dims g, const Sched& S, const Epi& E, int tid_in) {
    int tid = tid_in; asm volatile("" : "+v"(tid));
    const int wid = __builtin_amdgcn_readfirstlane(tid >> 6), lane = tid & 63, wr = wid >> 2, wc = wid & 3, fr = lane & 15, fq = lane >> 4;
    const int nt = g.K / (BK * 2);
    unsigned voffA[2], voffB[2];
#pragma unroll
    for (int i = 0; i < 2; ++i) { int R, C; stage_rc(tid * 16 + i * 8192, R, C); const int Rb = Epi::PERM ? ((R & ~31) + perm32(R & 31)) : R;
        voffA[i] = (unsigned)(R * g.lda + C * 2); voffB[i] = (unsigned)(Rb * g.ldb + C * 2); }
    static_assert(!GATHER || SP2, "gathered A rows: SP2 schedule only");
    unsigned vgc[2][2]; bool last_g = false; int nxp_ = 0, gR_ = 0; unsigned gC_ = 0u; (void)last_g; (void)nxp_;
    if constexpr (GATHER) { int R, C; stage_rc(tid * 16, R, C); gR_ = R; gC_ = (unsigned)(C * 2); }
    LAS int* const ntok_ = (LAS int*)(lds + GATHER_LIST_OFF);
#define PG8_GLIST(u, par) do { if (tid < 256) { const int* tb_; int s0_, ce_; S.rowinfo(u, tb_, s0_, ce_); const int s_ = s0_ + tid; ntok_[(par) * 256 + tid] = tb_[s_ < ce_ ? s_ : 0]; } } while (0)
#define PG8_GOFF(par, vg) do { _Pragma("unroll") for (int _h = 0; _h < 2; ++_h) _Pragma("unroll") for (int _i = 0; _i < 2; ++_i) vg[_h][_i] = (unsigned)ntok_[(par) * 256 + gR_ + 64 * _i + 128 * _h] * 1024u + gC_; } while (0)
#define PG8_STAGE_A(slot, ptr, half, SEL) do { if constexpr (GATHER) { if (SEL) { unsigned vt_[2] = {vgc[half][0], vgc[half][1]}; if (last_g) { _Pragma("unroll") for (int _i = 0; _i < 2; ++_i) vt_[_i] = (unsigned)ntok_[nxp_ * 256 + gR_ + 64 * _i + 128 * (half)] * 1024u + gC_; } PG8_STAGE(slot, ptr, vt_); } else PG8_STAGE(slot, ptr, vgc[half]); } else PG8_STAGE(slot, (ptr) + ((half) ? hstepA : (size_t)0), voffA); } while (0)
    const size_t kstep = (size_t)(BK * 2);
    const size_t hstepA = (size_t)HALF * g.lda, hstepB = (size_t)HALF * g.ldb;
    const unsigned ldsw = (unsigned)wid * 1024u;
    const int aoff0 = lds_byte(wr * 64 + fr, fq * 8), aoff1 = aoff0 + 1024;
    const int boff0 = lds_byte(wc * 32 + fr, fq * 8), boff1 = boff0 + 1024;
#define PG8_SA(b, h) (((b) * 2 + (h)) * HTB)
#define PG8_SB(b, h) ((4 + (b) * 2 + (h)) * HTB)
#define PG8_STAGE(bufoff, gbase, voff) do { _Pragma("unroll") for (int _i = 0; _i < 2; ++_i) \
        __builtin_amdgcn_global_load_lds((const unsigned*)((const char*)(gbase) + (voff)[_i]), (LAS unsigned*)(lds + (bufoff) + ldsw + _i * 8192), 16, 0, 0); } while (0)
#define PG8_LDA(dst, b, h) do { _Pragma("unroll") for (int m = 0; m < 4; ++m) _Pragma("unroll") for (int k = 0; k < 2; ++k) dst[m][k] = *(const LAS bf16x8*)(lds + PG8_SA(b, h) + (k ? aoff1 : aoff0) + m * 2048); } while (0)
#define PG8_LDB(dst, b, h) do { _Pragma("unroll") for (int n = 0; n < 2; ++n) _Pragma("unroll") for (int k = 0; k < 2; ++k) dst[n][k] = *(const LAS bf16x8*)(lds + PG8_SB(b, h) + (k ? boff1 : boff0) + n * 2048); } while (0)
#define PG8_MMA(ai, bj, At, Bt) do { __builtin_amdgcn_s_setprio(1); _Pragma("unroll") for (int m = 0; m < 4; ++m) _Pragma("unroll") for (int n = 0; n < 2; ++n) _Pragma("unroll") for (int k = 0; k < 2; ++k) { \
        if constexpr (FP8) acc[ai][bj][m][n] = __builtin_bit_cast(f32x4, __builtin_amdgcn_mfma_i32_16x16x64_i8(__builtin_bit_cast(v4i_t, Bt[n][k]), __builtin_bit_cast(v4i_t, At[m][k]), __builtin_bit_cast(v4i_t, acc[ai][bj][m][n]), 0, 0, 0)); \
        else acc[ai][bj][m][n] = __builtin_amdgcn_mfma_f32_16x16x32_bf16(Bt[n][k], At[m][k], acc[ai][bj][m][n], 0, 0, 0); } __builtin_amdgcn_s_setprio(0); } while (0)
#define PG8_WAIT_V(n) asm volatile("s_waitcnt vmcnt(" #n ")" ::: "memory")
#define PG8_WAIT_L(n) asm volatile("s_waitcnt lgkmcnt(" #n ")" ::: "memory")
#define PG8_BAR __builtin_amdgcn_s_barrier()
#define PG8_SCHED __builtin_amdgcn_sched_barrier(0)
    Unit cur, nxt; int ui = 0;
    if (!S.next(0, cur)) return;
    f32x4 acc[2][2][4][2];
    float zq = 0.f; asm volatile("" : "+v"(zq));
#pragma unroll
    for (int a = 0; a < 2; ++a)
#pragma unroll
        for (int b = 0; b < 2; ++b)
#pragma unroll
            for (int m = 0; m < 4; ++m)
#pragma unroll
                for (int n = 0; n < 2; ++n) acc[a][b][m][n] = (f32x4){zq, zq, zq, zq};
    bf16x8 At[4][2], B0[2][2], B1[2][2];
    const char* cA = cur.A; const char* cB = cur.B;
    if constexpr (SP2) {
        if constexpr (GATHER) { PG8_GLIST(cur, 0); PG8_WAIT_L(0); PG8_BAR; PG8_GOFF(0, vgc); }
        PG8_STAGE(PG8_SB(0, 0), cB, voffB); PG8_STAGE(PG8_SB(0, 1), cB + hstepB, voffB); PG8_STAGE_A(PG8_SA(0, 0), cA, 0, 0); PG8_STAGE_A(PG8_SA(0, 1), cA, 1, 0);
        if (wr == 1) PG8_BAR;
        PG8_WAIT_V(2); PG8_BAR;
        PG8_STAGE(PG8_SB(1, 0), cB + kstep, voffB); PG8_STAGE_A(PG8_SA(1, 0), cA + kstep, 0, 0); PG8_STAGE(PG8_SB(1, 1), cB + hstepB + kstep, voffB);
        PG8_WAIT_V(6); PG8_BAR;
    } else {
        PG8_STAGE(PG8_SB(0, 0), cB, voffB); PG8_STAGE(PG8_SA(0, 0), cA, voffA); PG8_STAGE(PG8_SB(0, 1), cB + hstepB, voffB); PG8_STAGE(PG8_SA(0, 1), cA + hstepA, voffA);
        if (wr == 1) PG8_BAR;
        PG8_WAIT_V(4); PG8_BAR;
        PG8_STAGE(PG8_SB(1, 0), cB + kstep, voffB); PG8_STAGE(PG8_SA(1, 0), cA + kstep, voffA); PG8_STAGE(PG8_SB(1, 1), cB + hstepB + kstep, voffB);
        PG8_WAIT_V(6); PG8_BAR;
    }
    for (;;) {
        const bool has_next = S.next(ui + 1, nxt);
        const char* nA = has_next ? nxt.A : cA; const char* nB = has_next ? nxt.B : cB;
        if constexpr (GATHER) { if (has_next) PG8_GLIST(nxt, (ui + 1) & 1); }
#pragma unroll 1
        for (int t = 0; t < nt; t += 2) {
            const bool last = (t == nt - 2);
            const char* a1 = cA + (size_t)(t + 1) * kstep;
            const char* a2 = last ? nA : cA + (size_t)(t + 2) * kstep; const char* b2 = last ? nB : cB + (size_t)(t + 2) * kstep;
            const char* a3 = a2 + kstep; const char* b3 = b2 + kstep;
            if constexpr (SP2) {
            if constexpr (GATHER) { last_g = last && has_next; nxp_ = (ui + 1) & 1; }
            PG8_LDB(B0, 0, 0); PG8_LDB(B1, 0, 1); PG8_SCHED; PG8_LDA(At, 0, 0); PG8_STAGE_A(PG8_SA(1, 1), a1, 1, 0);
            PG8_WAIT_V(8); PG8_WAIT_L(0); PG8_BAR; PG8_MMA(0, 0, At, B0); PG8_MMA(0, 1, At, B1); PG8_BAR; PG8_SCHED;
            PG8_LDA(At, 0, 1); PG8_STAGE(PG8_SB(0, 0), b2, voffB); PG8_STAGE(PG8_SB(0, 1), b2 + hstepB, voffB); PG8_STAGE_A(PG8_SA(0, 0), a2, 0, 1);
            PG8_WAIT_V(8); PG8_WAIT_L(0); PG8_BAR; PG8_MMA(1, 0, At, B0); PG8_MMA(1, 1, At, B1); PG8_BAR; PG8_SCHED;
            PG8_LDB(B0, 1, 0); PG8_LDB(B1, 1, 1); PG8_SCHED; PG8_LDA(At, 1, 0); PG8_STAGE_A(PG8_SA(0, 1), a2, 1, 1);
            PG8_WAIT_V(8); PG8_WAIT_L(0); PG8_BAR; PG8_MMA(0, 0, At, B0); PG8_MMA(0, 1, At, B1); PG8_BAR; PG8_SCHED;
            PG8_LDA(At, 1, 1); PG8_STAGE(PG8_SB(1, 0), b3, voffB); PG8_STAGE(PG8_SB(1, 1), b3 + hstepB, voffB); PG8_STAGE_A(PG8_SA(1, 0), a3, 0, 1);
            PG8_WAIT_V(8); PG8_WAIT_L(0); PG8_BAR; PG8_MMA(1, 0, At, B0); PG8_MMA(1, 1, At, B1); PG8_BAR; PG8_SCHED;
            } else {
            PG8_LDB(B0, 0, 0); PG8_SCHED; PG8_LDA(At, 0, 0); PG8_STAGE(PG8_SA(1, 1), a1 + hstepA, voffA);
            PG8_WAIT_L(8); PG8_BAR; PG8_WAIT_L(0); PG8_MMA(0, 0, At, B0); PG8_BAR; PG8_SCHED;
            PG8_LDB(B1, 0, 1); PG8_STAGE(PG8_SB(0, 0), b2, voffB);
            PG8_BAR; PG8_WAIT_L(0); PG8_MMA(0, 1, At, B1); PG8_BAR;
            PG8_LDA(At, 0, 1); PG8_STAGE(PG8_SA(0, 0), a2, voffA);
            PG8_BAR; PG8_WAIT_L(0); PG8_MMA(1, 0, At, B0); PG8_BAR; PG8_SCHED;
            PG8_STAGE(PG8_SB(0, 1), b2 + hstepB, voffB);
            PG8_WAIT_V(6); PG8_BAR; PG8_MMA(1, 1, At, B1); PG8_BAR;
            PG8_LDB(B0, 1, 0); PG8_SCHED; PG8_LDA(At, 1, 0); PG8_STAGE(PG8_SA(0, 1), a2 + hstepA, voffA);
            PG8_WAIT_L(8); PG8_BAR; PG8_WAIT_L(0); PG8_MMA(0, 0, At, B0); PG8_BAR; PG8_SCHED;
            PG8_LDB(B1, 1, 1); PG8_STAGE(PG8_SB(1, 0), b3, voffB);
            PG8_BAR; PG8_WAIT_L(0); PG8_MMA(0, 1, At, B1); PG8_BAR;
            PG8_LDA(At, 1, 1); PG8_STAGE(PG8_SA(1, 0), a3, voffA);
            PG8_BAR; PG8_WAIT_L(0); PG8_MMA(1, 0, At, B0); PG8_BAR; PG8_SCHED;
            PG8_STAGE(PG8_SB(1, 1), b3 + hstepB, voffB);
            PG8_WAIT_V(6); PG8_BAR; PG8_MMA(1, 1, At, B1); PG8_BAR;
            }
        }
        if constexpr (ALIGN_EPI) { if (wr == 0) PG8_BAR; }
        E(acc, cur, wr, wc, fr, fq);
        if (!has_next) break;
#pragma unroll
        for (int a = 0; a < 2; ++a)
#pragma unroll
            for (int b = 0; b < 2; ++b)
#pragma unroll
                for (int m = 0; m < 4; ++m)
#pragma unroll
                    for (int n = 0; n < 2; ++n) acc[a][b][m][n] = (f32x4){zq, zq, zq, zq};
        cur = nxt; cA = nA; cB = nB; ++ui;
        if constexpr (GATHER) PG8_GOFF(ui & 1, vgc);
        if constexpr (ALIGN_EPI) { if (wr == 1) PG8_BAR; }
    }
    PG8_WAIT_V(0);
    if constexpr (!ALIGN_EPI) { if (wr == 0) PG8_BAR; }
    PG8_BAR;
#undef PG8_GOFF
#undef PG8_GLIST
#undef PG8_STAGE_A
#undef PG8_SA
#undef PG8_SB
#undef PG8_STAGE
#undef PG8_LDA
#undef PG8_LDB
#undef PG8_MMA
#undef PG8_WAIT_V
#undef PG8_WAIT_L
#undef PG8_BAR
#undef PG8_SCHED
}
}

constexpr int NB = 2, T = 8192, D = 1024, M = NB * T, NL = 4;
constexpr int DIN = 7592, NP = 8192;
constexpr int PC_QLAT = 0, PC_CKV = 1024, PC_KIDX = 1152, PC_WIDX = 1184, PC_QIDX = 1280, PC_CU = 1536, PC_GB = 2048, PC_GC = 2560, PC_SU = 3072, PC_MQ = 3584, PC_GATE = 4096;
constexpr int SC_Q = 0, SC_CKV = 512, SC_QIDX = 640, SC_KIDX = 896, SC_WIDX = 928, SC_CU = 936, SC_GB = 1448, SC_GC = 1960, SC_SU = 2472, SC_MQ = 2984, SC_GATE = 3496;
constexpr float QS_H = 127.f / 5.f, QS_WUP = 127.f / (4.5f * 0.03125f), QS_ACT = 127.f / 12.f, QS_WDN = 127.f / (4.5f * 0.013139006f), QS_WIN = 127.f / (4.5f * 0.03125f), QS_WQL = 8.f * QS_WIN;
constexpr int NE = 32, FE = 1024, MAXBLK = 288, MOE_ROWS = MAXBLK * 256;
constexpr int SSM_LC = 32, SSM_NC = T / SSM_LC, SSM_K = SSM_LC * 16 + 128;
constexpr float LN_EPS = 1e-5f;
constexpr float DN_ALPHA = 1.681792830507429f;

constexpr size_t MiB = 1u << 20;
constexpr size_t WS_CTL = 0, CTL_ZERO_BYTES = 1 * MiB;
constexpr size_t WS_WIN = 1 * MiB;
constexpr size_t WS_WGLU = WS_WIN + (size_t)NL * NP * D * 2;
constexpr size_t WS_WMKV = WS_WGLU + (size_t)NL * 512 * 512 * 2;
constexpr size_t WS_WUV = WS_WMKV + (size_t)NL * 1024 * 1024 * 2;
constexpr size_t WS_WBR = WS_WUV + (size_t)NL * 512 * 1024 * 2;
constexpr size_t WS_WO = WS_WBR + (size_t)NL * 4 * 1024 * 512 * 2;
constexpr size_t WS_WUP = WS_WO + (size_t)NL * 1024 * 1024 * 2;
constexpr size_t WS_WDN = WS_WUP + (size_t)NL * NE * 2048 * 1024 * 2;
constexpr size_t WS_S5A = WS_WDN + (size_t)NL * NE * 1024 * 1024 * 2;
constexpr size_t WS_S5B = WS_S5A + 1 * MiB;
constexpr size_t WS_MEMB = WS_S5B + 1 * MiB;
constexpr size_t WS_MKV = WS_MEMB + 1 * MiB;
constexpr size_t WS_H = WS_MKV + 4 * MiB;
constexpr size_t WS_HB = WS_H + (size_t)M * D * 4;
constexpr size_t WS_PROJ = WS_HB + (size_t)M * D * 2;
constexpr size_t WS_KVN = WS_PROJ + (size_t)M * NP * 2;
constexpr size_t WS_OLAT = WS_KVN + (size_t)M * 128 * 2;
constexpr size_t WS_BR = WS_OLAT + (size_t)M * 1024 * 2;
constexpr size_t WS_Z = WS_BR + (size_t)M * 2048 * 2;
constexpr size_t WS_MRG = WS_Z + (size_t)M * 512 * 2;
constexpr size_t WS_MRGB = WS_MRG + (size_t)M * D * 4;
constexpr size_t WS_V = WS_MRGB + (size_t)M * D * 2;
constexpr size_t WS_H1 = WS_V + (size_t)M * D * 4;
constexpr size_t WS_H1B = WS_H1 + (size_t)M * D * 4;
constexpr size_t WS_SSE = WS_H1B + (size_t)M * D * 2;
constexpr size_t WS_SSC = WS_SSE + (size_t)NB * SSM_NC * 32 * 64 * 8;
constexpr size_t WS_TOK = WS_SSC + (size_t)NB * SSM_NC * 32 * 64 * 8;
constexpr size_t WS_GATE = WS_TOK + (size_t)NE * M * 4;
constexpr size_t WS_SLOT = WS_GATE + (size_t)NE * M * 4;
constexpr size_t WS_XS = WS_SLOT + (size_t)M * 4 * 4;
constexpr size_t WS_ACT = WS_XS + (size_t)MOE_ROWS * 1024 * 2;
constexpr size_t WS_SCR = WS_ACT + (size_t)MOE_ROWS * 1024 * 2;
constexpr size_t WS_KIDX = WS_SCR + (size_t)256 * 2 * 8 * 8192 * 4;
constexpr size_t WS_WSSM = WS_KIDX + (size_t)M * 32 * 2;
constexpr size_t WS_AEXT = WS_WSSM + (size_t)NL * 32 * 512 * SSM_K * 2;
constexpr size_t WS_WE = WS_AEXT + (size_t)32 * 512 * SSM_K * 2;
constexpr size_t WS_END = WS_WE + (size_t)NL * 32 * 256 * 512 * 2;
constexpr int CW_TMO = 0, CW_BAR = 4096, CW_CNT = 16384, CW_Q0 = 2048;

constexpr int RING_BYTES = 131072, LDSCTL_OFF = RING_BYTES, MISC_OFF = LDSCTL_OFF + 320, LDS_BYTES = 147456;
constexpr int NWAVES = 8;

#define RLX_AGENT __ATOMIC_RELAXED, __HIP_MEMORY_SCOPE_AGENT
#define LDS_WAIT() asm volatile("s_waitcnt lgkmcnt(0)" ::: "memory")
#define VM_WAIT() asm volatile("s_waitcnt vmcnt(0)" ::: "memory")
__device__ __forceinline__ unsigned f2bf(float f) { unsigned u = __builtin_bit_cast(unsigned, f); return (u + 0x7fffu + ((u >> 16) & 1u)) >> 16; }
__device__ __forceinline__ unsigned pk2(float lo, float hi) { return f2bf(lo) | (f2bf(hi) << 16); }
__device__ __forceinline__ float bflo(unsigned w) { return __builtin_bit_cast(float, w << 16); }
__device__ __forceinline__ float bfhi(unsigned w) { return __builtin_bit_cast(float, w & 0xffff0000u); }
__device__ __forceinline__ float bf1(bf16 v) { return __builtin_bit_cast(float, (unsigned)v << 16); }
__device__ __forceinline__ unsigned q8_(float x, float s) { return (unsigned)(int)__builtin_rintf(fminf(fmaxf(x * s, -127.f), 127.f)) & 255u; }
__device__ __forceinline__ unsigned q8x4(float a, float b, float c, float d, float s) { return q8_(a, s) | (q8_(b, s) << 8) | (q8_(c, s) << 16) | (q8_(d, s) << 24); }
__device__ __forceinline__ float sigmoidf_(float x) { return __builtin_amdgcn_rcpf(1.f + __expf(-x)); }
__device__ __forceinline__ int lane_op() { int l = (int)__builtin_amdgcn_mbcnt_hi(~0u, __builtin_amdgcn_mbcnt_lo(~0u, 0u)); asm volatile("" : "+v"(l)); return l; }
template <class Tv> __device__ __forceinline__ Tv bperm_(int srcLane, Tv v) { return __builtin_bit_cast(Tv, __builtin_amdgcn_ds_bpermute(srcLane << 2, __builtin_bit_cast(int, v))); }
#define SHX(v, m, l) bperm_((l) ^ (m), (v))
#define SHD(v, o, l) bperm_((l) + (o), (v))
#define SHI(v, s) bperm_((s), (v))
__device__ __forceinline__ float wave_sum(float v) { const int l = lane_op();
#pragma unroll
    for (int o = 1; o < 64; o <<= 1) v += SHX(v, o, l);
    return v;
}
__device__ __forceinline__ float wave_max(float v) { const int l = lane_op();
#pragma unroll
    for (int o = 1; o < 64; o <<= 1) v = fmaxf(v, SHX(v, o, l));
    return v;
}

#define DPP_STEP_(T, v, ctrl, rm, idbits, OP) { const T t_ = __builtin_bit_cast(T, __builtin_amdgcn_update_dpp((int)(idbits), __builtin_bit_cast(int, v), ctrl, rm, 0xf, false)); v = OP(v, t_); }
#define DPP_ADD_(a, b) ((a) + (b))
__device__ __forceinline__ unsigned dpp_scan_add_u32(unsigned v) {
    DPP_STEP_(unsigned, v, 0x111, 0xf, 0, DPP_ADD_) DPP_STEP_(unsigned, v, 0x112, 0xf, 0, DPP_ADD_) DPP_STEP_(unsigned, v, 0x114, 0xf, 0, DPP_ADD_) DPP_STEP_(unsigned, v, 0x118, 0xf, 0, DPP_ADD_)
    DPP_STEP_(unsigned, v, 0x142, 0xa, 0, DPP_ADD_) DPP_STEP_(unsigned, v, 0x143, 0xc, 0, DPP_ADD_) return v; }
__device__ __forceinline__ float wave_sum_dpp(float v) {
    DPP_STEP_(float, v, 0x111, 0xf, 0, DPP_ADD_) DPP_STEP_(float, v, 0x112, 0xf, 0, DPP_ADD_) DPP_STEP_(float, v, 0x114, 0xf, 0, DPP_ADD_) DPP_STEP_(float, v, 0x118, 0xf, 0, DPP_ADD_)
    DPP_STEP_(float, v, 0x142, 0xa, 0, DPP_ADD_) DPP_STEP_(float, v, 0x143, 0xc, 0, DPP_ADD_)
    return __builtin_bit_cast(float, __builtin_amdgcn_readlane(__builtin_bit_cast(int, v), 63)); }
__device__ __forceinline__ float wave_max_dpp(float v) {
    DPP_STEP_(float, v, 0x111, 0xf, 0xff800000u, fmaxf) DPP_STEP_(float, v, 0x112, 0xf, 0xff800000u, fmaxf) DPP_STEP_(float, v, 0x114, 0xf, 0xff800000u, fmaxf) DPP_STEP_(float, v, 0x118, 0xf, 0xff800000u, fmaxf)
    DPP_STEP_(float, v, 0x142, 0xa, 0xff800000u, fmaxf) DPP_STEP_(float, v, 0x143, 0xc, 0xff800000u, fmaxf)
    return __builtin_bit_cast(float, __builtin_amdgcn_readlane(__builtin_bit_cast(int, v), 63)); }

#define XB_TMO      128
#define XB_XCNT(j)  (256  + 64 * (j))
#define XB_XSUB(j)  (1280 + 64 * (j))
#define XB_XGEN(j)  (2304 + 64 * (j))
#define XB_TOP      3328
#define XB_TOPGEN   3392
#define XCD_BAR_WORDS 3456
#define XB_SPIN_CAP (1u << 18)
__device__ __forceinline__ unsigned xb_ld(unsigned* p)              { return __hip_atomic_load(p, __ATOMIC_RELAXED, __HIP_MEMORY_SCOPE_AGENT); }
__device__ __forceinline__ unsigned xb_add(unsigned* p, unsigned v) { return __hip_atomic_fetch_add(p, v, __ATOMIC_RELAXED, __HIP_MEMORY_SCOPE_AGENT); }
__device__ __forceinline__ unsigned xb_xcc_id() { return (unsigned)__builtin_amdgcn_s_getreg((3 << 11) | 20) & 0xFu; }
#define XB_SPIN(cond, bar) do { unsigned _sp = 0; while (cond) { __builtin_amdgcn_s_sleep(1); \
    if ((++_sp & 255u) == 0u) { if (xb_ld(&(bar)[XB_TMO])) break; if (_sp > XB_SPIN_CAP) { atomicAdd(&(bar)[XB_TMO], 1u); break; } } } } while (0)
struct XcdBarrier { unsigned* bar; unsigned x; volatile LAS unsigned* st; };
__device__ __forceinline__ XcdBarrier xcd_barrier_post(unsigned* bar, volatile LAS unsigned* st) {
    XcdBarrier b; b.bar = bar; b.x = xb_xcc_id(); b.st = st;
    if (threadIdx.x == 0) st[2] = xb_add(&bar[XB_XCNT(b.x)], 1u);
    return b;
}
__device__ __forceinline__ void xcd_barrier_complete(unsigned* bar, unsigned x, unsigned& nloc, unsigned& nx, unsigned& balanced) {
    const unsigned G = gridDim.x * gridDim.y * gridDim.z;
    unsigned sum, cnt, mine, sp = 0u, bal;
    for (;;) {
        sum = 0u; cnt = 0u; mine = 0u; bal = 1u;
#pragma unroll 1
        for (unsigned j = 0; j < 16; ++j) { const unsigned c = xb_ld(&bar[XB_XCNT(j)]); sum += c; cnt += (c > 0u) ? 1u : 0u; mine = (j == x) ? c : mine; bal = (c == (j < 8u ? (G >> 3) : 0u)) ? bal : 0u; }
        if (sum == G) break;
        __builtin_amdgcn_s_sleep(1);
        if ((++sp & 255u) == 0u) { if (xb_ld(&bar[XB_TMO])) break; if (sp > XB_SPIN_CAP) { atomicAdd(&bar[XB_TMO], 1u); break; } }
    }
    nloc = mine > 0u ? mine : 1u; nx = cnt > 0u ? cnt : 1u; balanced = ((G & 7u) == 0u && sum == G) ? bal : 0u;
}
__device__ __forceinline__ void xcd_barrier(const XcdBarrier& b, int tid_) {
    asm volatile("s_waitcnt vmcnt(0)" ::: "memory");
    __syncthreads();
    if (tid_ == 0) {
        unsigned* bar = b.bar;
        __builtin_amdgcn_s_waitcnt(0);
        unsigned nloc = b.st[0], nx = b.st[1];
        if (nloc == 0u) { unsigned bal_; xcd_barrier_complete(bar, b.x, nloc, nx, bal_); b.st[0] = nloc; b.st[1] = nx;
            b.st[3] = (bal_ ? b.st[2] * 8u + b.x : (unsigned)blockIdx.x) + 1u; }
        const unsigned old = xb_add(&bar[XB_XSUB(b.x)], 1u);
        const unsigned gen = old / nloc;
        if (old + 1u == (gen + 1u) * nloc) {
            __builtin_amdgcn_fence(__ATOMIC_RELEASE, "agent");
            asm volatile("s_waitcnt vmcnt(0)" ::: "memory");
            const unsigned og = xb_add(&bar[XB_TOP], 1u);
            const unsigned tg = og / nx;
            if (og + 1u == (tg + 1u) * nx) xb_add(&bar[XB_TOPGEN], 1u);
            else XB_SPIN(xb_ld(&bar[XB_TOPGEN]) == tg, bar);
            __builtin_amdgcn_fence(__ATOMIC_ACQUIRE, "agent");
            xb_add(&bar[XB_XGEN(b.x)], 1u);
            asm volatile("s_waitcnt vmcnt(0)" ::: "memory");
        } else {
            XB_SPIN(xb_ld(&bar[XB_XGEN(b.x)]) == gen, bar);
            __builtin_amdgcn_fence(__ATOMIC_ACQUIRE, "agent");
            asm volatile("s_waitcnt vmcnt(0)" ::: "memory");
        }
    }
    __syncthreads();
}

__device__ __forceinline__ unsigned long long ldp(volatile LAS unsigned long long* PT, int k) { const unsigned long long v = PT[k];
    const unsigned lo = __builtin_amdgcn_readfirstlane((unsigned)v), hi = __builtin_amdgcn_readfirstlane((unsigned)(v >> 32)); return ((unsigned long long)hi << 32) | lo; }
typedef __attribute__((address_space(1))) unsigned char gu8_t;
__device__ __forceinline__ unsigned char* gptr(unsigned long long v) { return (unsigned char*)(gu8_t*)v; }
struct Args { const float* in[33]; float* out; unsigned char* ws; int ph_lo, ph_hi; };

struct Frame {
    LAS unsigned char* lds;
    int tid, lane, wave, G, gw, NGW, bx;
};

using pg8::Unit; using pg8::cvt_pk_bf16; using pg8::v4i_t;
struct EpiBf16 {
    static constexpr bool PERM = true;
    bf16* O; int ldc;
    __device__ __forceinline__ void operator()(const f32x4 (&acc)[2][2][4][2], const Unit& u, int wr, int wc, int fr, int fq) const {
        const int row0 = u.pm * 256 + wr * 64 + fr, col0 = u.pn * 256 + wc * 32 + 8 * fq;
#pragma unroll
        for (int ai = 0; ai < 2; ++ai)
#pragma unroll
            for (int m = 0; m < 4; ++m) { bf16* rowp = O + (size_t)(row0 + ai * 128 + m * 16) * ldc + col0;
#pragma unroll
                for (int bj = 0; bj < 2; ++bj) { const f32x4 v0 = acc[ai][bj][m][0], v1 = acc[ai][bj][m][1];
                    v4u w; w.x = cvt_pk_bf16(v0[0], v0[1]); w.y = cvt_pk_bf16(v0[2], v0[3]); w.z = cvt_pk_bf16(v1[0], v1[1]); w.w = cvt_pk_bf16(v1[2], v1[3]);
                    *(v4u*)(rowp + bj * 128) = w; } }
    }
};
struct EpiProjQ {
    static constexpr bool PERM = true;
    bf16* O; int ldc; bf16* AX;
    __device__ __forceinline__ void operator()(const f32x4 (&acc)[2][2][4][2], const Unit& u, int wr, int wc, int fr, int fq) const {
        const int row0 = u.pm * 256 + wr * 64 + fr, col0 = u.pn * 256 + wc * 32 + 8 * fq; const float dq = 1.f / (QS_H * (u.pn < 4 ? QS_WQL : QS_WIN));
#pragma unroll
        for (int ai = 0; ai < 2; ++ai)
#pragma unroll
            for (int m = 0; m < 4; ++m) { bf16* rowp = O + (size_t)(row0 + ai * 128 + m * 16) * ldc + col0;
#pragma unroll
                for (int bj = 0; bj < 2; ++bj) { const v4i_t i0 = __builtin_bit_cast(v4i_t, acc[ai][bj][m][0]), i1 = __builtin_bit_cast(v4i_t, acc[ai][bj][m][1]);
                    v4u w; w.x = cvt_pk_bf16((float)i0[0] * dq, (float)i0[1] * dq); w.y = cvt_pk_bf16((float)i0[2] * dq, (float)i0[3] * dq); w.z = cvt_pk_bf16((float)i1[0] * dq, (float)i1[1] * dq); w.w = cvt_pk_bf16((float)i1[2] * dq, (float)i1[3] * dq);
                    if (u.pn == 12 || u.pn == 13) { const int m_ = row0 + ai * 128 + m * 16, ch = (u.pn - 12) * 256 + wc * 32 + 8 * fq + bj * 128, tl = m_ & (T - 1);
                        *(v4u*)(AX + ((size_t)((ch >> 4) * 512 + (m_ >> 13) * 256 + (tl >> 5))) * SSM_K + (tl & 31) * 16 + (ch & 15)) = w; }
                    else *(v4u*)(rowp + bj * 128) = w; } }
    }
};
struct EpiE {
    static constexpr bool PERM = true;
    float* E2;
    __device__ __forceinline__ void operator()(const f32x4 (&acc)[2][2][4][2], const Unit& u, int wr, int wc, int fr, int fq) const {
        const int row0 = u.pm * 256 + wr * 64 + fr, col0 = wc * 32 + 8 * fq;
#pragma unroll
        for (int ai = 0; ai < 2; ++ai)
#pragma unroll
            for (int m = 0; m < 4; ++m) { float* p = E2 + ((size_t)(row0 + ai * 128 + m * 16) * 32 + u.z) * 128 + col0; *(f32x4*)p = acc[ai][0][m][0]; *(f32x4*)(p + 4) = acc[ai][0][m][1]; }
    }
};
struct EOrder {
    int G, c; const char* A; const char* B;
    __device__ __forceinline__ bool next(int i, Unit& u) const {
        const int Lx = i * G + c; if (Lx >= 64) return false;
        const int g = Lx >> 1, pm = Lx & 1; u.pm = pm; u.pn = 0; u.z = g; u.A = A + ((size_t)g * 512 + pm * 256) * SSM_K * 2; u.B = B + (size_t)g * 256 * 512 * 2; return true;
    }
};
struct EpiMkv {
    static constexpr bool PERM = true;
    bf16* O;
    __device__ __forceinline__ void operator()(const f32x4 (&acc)[2][2][4][2], const Unit& u, int wr, int wc, int fr, int fq) const {
        EpiBf16 e{O + (size_t)u.z * 512 * 1024, 1024}; e(acc, u, wr, wc, fr, fq);
    }
};
struct EpiGlu {
    static constexpr bool PERM = true;
    const bf16* Z; int ldz; const float* bias; bf16* O; int ldo;
    __device__ __forceinline__ void operator()(const f32x4 (&acc)[2][2][4][2], const Unit& u, int wr, int wc, int fr, int fq) const {
        const int row0 = u.pm * 256 + wr * 64 + fr, col0 = u.pn * 256 + wc * 32 + 8 * fq;
        f32x4 bv[2][2];
#pragma unroll
        for (int bj = 0; bj < 2; ++bj)
#pragma unroll
            for (int n = 0; n < 2; ++n) bv[bj][n] = *(const f32x4*)(bias + col0 + bj * 128 + 4 * n);
#pragma unroll
        for (int ai = 0; ai < 2; ++ai) { v4u zq[4][2];
#pragma unroll
            for (int m = 0; m < 4; ++m)
#pragma unroll
                for (int bj = 0; bj < 2; ++bj) zq[m][bj] = *(const v4u*)(Z + (size_t)(row0 + ai * 128 + m * 16) * ldz + col0 + bj * 128);
#pragma unroll
            for (int m = 0; m < 4; ++m) { const size_t r = (size_t)(row0 + ai * 128 + m * 16);
#pragma unroll
                for (int bj = 0; bj < 2; ++bj) { const f32x4 v0 = acc[ai][bj][m][0] + bv[bj][0], v1 = acc[ai][bj][m][1] + bv[bj][1];
                    const v4u zz = zq[m][bj];
                    v4u w;
                    w.x = cvt_pk_bf16(bflo(zz.x) * sigmoidf_(v0[0]), bfhi(zz.x) * sigmoidf_(v0[1]));
                    w.y = cvt_pk_bf16(bflo(zz.y) * sigmoidf_(v0[2]), bfhi(zz.y) * sigmoidf_(v0[3]));
                    w.z = cvt_pk_bf16(bflo(zz.z) * sigmoidf_(v1[0]), bfhi(zz.z) * sigmoidf_(v1[1]));
                    w.w = cvt_pk_bf16(bflo(zz.w) * sigmoidf_(v1[2]), bfhi(zz.w) * sigmoidf_(v1[3]));
                    *(v4u*)(O + r * ldo + col0 + bj * 128) = w; } } }
    }
};
struct EpiMerge {
    static constexpr bool PERM = true;
    const bf16* G; int ldg; bf16* Mb;
    __device__ __forceinline__ void operator()(const f32x4 (&acc)[2][2][4][2], const Unit& u, int wr, int wc, int fr, int fq) const {
        const int row0 = u.pm * 256 + wr * 64 + fr, col0 = u.pn * 256 + wc * 32 + 8 * fq; const int r = u.z;
#pragma unroll
        for (int ai = 0; ai < 2; ++ai) { v4u gq[4][2], pq[4][2];
#pragma unroll
            for (int m = 0; m < 4; ++m) { const size_t rr = (size_t)(row0 + ai * 128 + m * 16);
#pragma unroll
                for (int bj = 0; bj < 2; ++bj) { const int c = col0 + bj * 128; gq[m][bj] = *(const v4u*)(G + rr * ldg + r * 1024 + c); pq[m][bj] = (v4u){0u, 0u, 0u, 0u}; if (r) pq[m][bj] = *(const v4u*)(Mb + rr * 1024 + c); } }
#pragma unroll
            for (int m = 0; m < 4; ++m) { const size_t rr = (size_t)(row0 + ai * 128 + m * 16);
#pragma unroll
                for (int bj = 0; bj < 2; ++bj) { const int c = col0 + bj * 128;
                    const v4u gg = gq[m][bj], pv = pq[m][bj]; bf16* mp = Mb + rr * 1024 + c;
                    f32x4 o0 = (f32x4){bflo(pv.x), bfhi(pv.x), bflo(pv.y), bfhi(pv.y)}, o1 = (f32x4){bflo(pv.z), bfhi(pv.z), bflo(pv.w), bfhi(pv.w)};
                    const f32x4 v0 = acc[ai][bj][m][0], v1 = acc[ai][bj][m][1];
                    o0[0] += sigmoidf_(bflo(gg.x)) * v0[0]; o0[1] += sigmoidf_(bfhi(gg.x)) * v0[1]; o0[2] += sigmoidf_(bflo(gg.y)) * v0[2]; o0[3] += sigmoidf_(bfhi(gg.y)) * v0[3];
                    o1[0] += sigmoidf_(bflo(gg.z)) * v1[0]; o1[1] += sigmoidf_(bfhi(gg.z)) * v1[1]; o1[2] += sigmoidf_(bflo(gg.w)) * v1[2]; o1[3] += sigmoidf_(bfhi(gg.w)) * v1[3];
                    v4u w; w.x = cvt_pk_bf16(o0[0], o0[1]); w.y = cvt_pk_bf16(o0[2], o0[3]); w.z = cvt_pk_bf16(o1[0], o1[1]); w.w = cvt_pk_bf16(o1[2], o1[3]); *(v4u*)mp = w; } } }
    }
};
struct EpiWo {
    static constexpr bool PERM = true;
    const bf16* H; bf16* V;
    __device__ __forceinline__ void operator()(const f32x4 (&acc)[2][2][4][2], const Unit& u, int wr, int wc, int fr, int fq) const {
        const int row0 = u.pm * 256 + wr * 64 + fr, col0 = u.pn * 256 + wc * 32 + 8 * fq;
#pragma unroll
        for (int ai = 0; ai < 2; ++ai) { v4u hq[4][2];
#pragma unroll
            for (int m = 0; m < 4; ++m)
#pragma unroll
                for (int bj = 0; bj < 2; ++bj) hq[m][bj] = *(const v4u*)(H + (size_t)(row0 + ai * 128 + m * 16) * 1024 + col0 + bj * 128);
#pragma unroll
            for (int m = 0; m < 4; ++m) { const size_t off = (size_t)(row0 + ai * 128 + m * 16) * 1024 + col0;
#pragma unroll
                for (int bj = 0; bj < 2; ++bj) { const v4u hh = hq[m][bj]; const f32x4 v0 = acc[ai][bj][m][0], v1 = acc[ai][bj][m][1];
                    v4u w; w.x = cvt_pk_bf16(bflo(hh.x) * DN_ALPHA + v0[0], bfhi(hh.x) * DN_ALPHA + v0[1]); w.y = cvt_pk_bf16(bflo(hh.y) * DN_ALPHA + v0[2], bfhi(hh.y) * DN_ALPHA + v0[3]);
                    w.z = cvt_pk_bf16(bflo(hh.z) * DN_ALPHA + v1[0], bfhi(hh.z) * DN_ALPHA + v1[1]); w.w = cvt_pk_bf16(bflo(hh.w) * DN_ALPHA + v1[2], bfhi(hh.w) * DN_ALPHA + v1[3]);
                    *(v4u*)(V + off + bj * 128) = w; } } }
    }
};
struct EpiUp {
    static constexpr bool PERM = true;
    const float* bup; unsigned char* ACT;
    __device__ __forceinline__ void operator()(const f32x4 (&acc)[2][2][4][2], const Unit& u, int wr, int wc, int fr, int fq) const {
        const int row0 = u.pm * 256 + wr * 64 + fr, col0 = u.pn * 256 + wc * 32 + 8 * fq; const float* bb = bup + (size_t)u.z * 2048; const float dq = 1.f / (QS_H * QS_WUP);
        f32x4 bv[2][2];
#pragma unroll
        for (int bj = 0; bj < 2; ++bj)
#pragma unroll
            for (int n = 0; n < 2; ++n) bv[bj][n] = *(const f32x4*)(bb + col0 + bj * 128 + 4 * n);
#pragma unroll
        for (int ai = 0; ai < 2; ++ai)
#pragma unroll
            for (int m = 0; m < 4; ++m) { const size_t r = (size_t)(row0 + ai * 128 + m * 16);
#pragma unroll
                for (int bj = 0; bj < 2; ++bj) { const v4i_t i0 = __builtin_bit_cast(v4i_t, acc[ai][bj][m][0]), i1 = __builtin_bit_cast(v4i_t, acc[ai][bj][m][1]);
                    const f32x4 v0 = (f32x4){(float)i0[0], (float)i0[1], (float)i0[2], (float)i0[3]} * dq + bv[bj][0], v1 = (f32x4){(float)i1[0], (float)i1[1], (float)i1[2], (float)i1[3]} * dq + bv[bj][1];
                    float a[4];
#pragma unroll
                    for (int j = 0; j < 4; ++j) { const float gx = j < 2 ? v0[2 * j] : v1[2 * j - 4], lx = j < 2 ? v0[2 * j + 1] : v1[2 * j - 3];
                        const float gl = fminf(gx, 7.0f), li = fminf(fmaxf(lx, -7.0f), 7.0f); a[j] = gl * sigmoidf_(1.702f * gl) * (li + 1.0f); }
                    *(unsigned*)(ACT + r * 1024 + ((col0 + bj * 128) >> 1)) = q8x4(a[0], a[1], a[2], a[3], QS_ACT); } }
    }
};
struct EpiDown {
    static constexpr bool PERM = true;
    const float* bdn; const float* grow; bf16* YS;
    __device__ __forceinline__ void operator()(const f32x4 (&acc)[2][2][4][2], const Unit& u, int wr, int wc, int fr, int fq) const {
        const int row0 = u.pm * 256 + wr * 64 + fr, col0 = u.pn * 256 + wc * 32 + 8 * fq; const float* bb = bdn + (size_t)u.z * 1024; const float dq = 1.f / (QS_ACT * QS_WDN);
        f32x4 bv[2][2];
#pragma unroll
        for (int bj = 0; bj < 2; ++bj)
#pragma unroll
            for (int n = 0; n < 2; ++n) bv[bj][n] = *(const f32x4*)(bb + col0 + bj * 128 + 4 * n);
        float gq[2][4];
#pragma unroll
        for (int ai = 0; ai < 2; ++ai)
#pragma unroll
            for (int m = 0; m < 4; ++m) gq[ai][m] = grow[(size_t)(row0 + ai * 128 + m * 16)];
#pragma unroll
        for (int ai = 0; ai < 2; ++ai)
#pragma unroll
            for (int m = 0; m < 4; ++m) { const size_t r = (size_t)(row0 + ai * 128 + m * 16); const float gt = gq[ai][m];
#pragma unroll
                for (int bj = 0; bj < 2; ++bj) { const v4i_t i0 = __builtin_bit_cast(v4i_t, acc[ai][bj][m][0]), i1 = __builtin_bit_cast(v4i_t, acc[ai][bj][m][1]);
                    const f32x4 v0 = ((f32x4){(float)i0[0], (float)i0[1], (float)i0[2], (float)i0[3]} * dq + bv[bj][0]) * gt, v1 = ((f32x4){(float)i1[0], (float)i1[1], (float)i1[2], (float)i1[3]} * dq + bv[bj][1]) * gt;
                    v4u w; w.x = cvt_pk_bf16(v0[0], v0[1]); w.y = cvt_pk_bf16(v0[2], v0[3]); w.z = cvt_pk_bf16(v1[0], v1[1]); w.w = cvt_pk_bf16(v1[2], v1[3]);
                    *(v4u*)(YS + r * 1024 + col0 + bj * 128) = w; } }
    }
};
struct EpiSsm {
    static constexpr bool PERM = true;
    bf16* Z;
    __device__ __forceinline__ void operator()(const f32x4 (&acc)[2][2][4][2], const Unit& u, int wr, int wc, int fr, int fq) const {
        const int row0 = u.pm * 256 + wr * 64 + fr, col0 = u.pn * 256 + wc * 32 + 8 * fq;
#pragma unroll
        for (int ai = 0; ai < 2; ++ai)
#pragma unroll
            for (int m = 0; m < 4; ++m) { const int row = row0 + ai * 128 + m * 16; const size_t tokb = (size_t)(row >> 8) * T + (size_t)(row & 255) * SSM_LC;
#pragma unroll
                for (int bj = 0; bj < 2; ++bj) { const int col = col0 + bj * 128; const f32x4 v0 = acc[ai][bj][m][0], v1 = acc[ai][bj][m][1]; float z[8];
#pragma unroll
                    for (int j = 0; j < 8; ++j) { const float y = j < 4 ? v0[j] : v1[j - 4]; const float x3 = 0.7978845608028654f * (y + 0.044715f * y * y * y); const float th = 1.f - 2.f * __builtin_amdgcn_rcpf(__expf(2.f * x3) + 1.f); z[j] = 0.5f * y * (1.f + th); }
                    v4u w; w.x = cvt_pk_bf16(z[0], z[1]); w.y = cvt_pk_bf16(z[2], z[3]); w.z = cvt_pk_bf16(z[4], z[5]); w.w = cvt_pk_bf16(z[6], z[7]);
                    *(v4u*)(Z + (tokb + (col >> 4)) * 512 + u.z * 16 + (col & 15)) = w; } }
    }
};
struct SsmOrder {
    int G, c; const char* A; const char* B;
    __device__ __forceinline__ bool next(int i, Unit& u) const {
        const int Lx = i * G + c; if (Lx >= 128) return false;
        const int g = Lx >> 2, pm = (Lx >> 1) & 1, pn = Lx & 1; u.pm = pm; u.pn = pn; u.z = g;
        u.A = A + ((size_t)g * 512 + pm * 256) * SSM_K * 2; u.B = B + ((size_t)g * 512 + pn * 256) * SSM_K * 2; return true;
    }
};
struct MkvOrder {
    int G, c; const char* A; const char* B;
    __device__ __forceinline__ bool next(int i, Unit& u) const {
        const int Lx = i * G + c; if (Lx >= NL * 8) return false;
        const int l = Lx >> 3, pm = (Lx >> 2) & 1, pn = Lx & 3; u.pm = pm; u.pn = pn; u.z = l;
        u.A = A + (size_t)pm * 256 * 1024 * 2; u.B = B + ((size_t)l * 1024 + pn * 256) * 1024 * 2; return true;
    }
};
struct MergeOrder {
    int G, c; const char* A; const char* B;
    __device__ __forceinline__ bool next(int i, Unit& u) const {
        const long Lx = (long)(i >> 2) * G + c; if (Lx >= 64 * 4) return false;
        int pm, pn; pg8::tile_of((int)Lx, 64, 4, pm, pn); const int r = i & 3; u.pm = pm; u.pn = pn; u.z = r;
        u.A = A + ((size_t)pm * 256 * 2048 + r * 512) * 2; u.B = B + ((size_t)r * 1024 + pn * 256) * 512 * 2; return true;
    }
};
struct MoeOrder {
    int G, c, nN, nunits; const LAS int* blk0; const char* A; const char* B; size_t atile, bexp, btile;
    const int* tok; const LAS int* cnt;
    __device__ __forceinline__ void rowinfo(const pg8::Unit& u, const int*& tb, int& s0, int& ce) const { const int e = u.z; tb = tok + (size_t)e * M; s0 = (u.pm - blk0[e]) * 256; ce = cnt[e]; }
    __device__ __forceinline__ bool next(int i, Unit& u) const {
        const int c2 = (G & 7) ? c : (c & 7) * (G >> 3) + (c >> 3);
        const long Lx = (long)i * G + c2; if (Lx >= nunits) return false;
        const int j = (int)(Lx / nN), pn = (int)(Lx % nN); int e = 0;
#pragma unroll
        for (int k = 1; k < 32; ++k) e += (j >= blk0[k]) ? 1 : 0;
        u.pm = j; u.pn = pn; u.z = e; u.A = A + (size_t)j * atile; u.B = B + (size_t)e * bexp + (size_t)pn * btile; return true;
    }
};

template <int QMODE = 0>
__device__ __forceinline__ void tr_item64(const float* W, int ldw, int c0, int nc, int K, bf16* WT, int r0, LAS unsigned char* scr, int item, int lane) {
    const int nblk = (nc + 63) >> 6, kb = item / nblk, nb = item % nblk, k0 = 64 * kb, n0 = 64 * nb;
    const int nn = 4 * (lane & 15), g = lane >> 4; const bool okn = (n0 + nn) < nc;
    const float* wp = W + (size_t)(k0 + g) * ldw + c0 + n0 + nn;
    f32x4 vv[16];
#pragma unroll
    for (int i = 0; i < 16; ++i) { vv[i] = (f32x4){0.f, 0.f, 0.f, 0.f}; if (okn) vv[i] = __builtin_nontemporal_load((const f32x4*)(wp + (size_t)(4 * i) * ldw)); }
#pragma unroll
    for (int i = 0; i < 16; ++i) { v2u w2; w2.x = pk2(vv[i][0], vv[i][1]); w2.y = pk2(vv[i][2], vv[i][3]); *(LAS v2u*)(scr + (4 * i + g) * 136 + nn * 2) = w2; }
    LDS_WAIT(); asm volatile("" ::: "memory");
    const int i16 = lane & 15, q = i16 >> 2, p = i16 & 3;
#pragma unroll
    for (int s = 0; s < 8; ++s) { const int nbk = s & 3, kbk = 4 * (s >> 2) + g;
        const v4i16_t lo = __builtin_amdgcn_ds_read_tr16_b64_v4i16((LAS v4i16_t*)(scr + (8 * kbk + q) * 136 + 32 * nbk + 8 * p));
        const v4i16_t hi = __builtin_amdgcn_ds_read_tr16_b64_v4i16((LAS v4i16_t*)(scr + (8 * kbk + 4 + q) * 136 + 32 * nbk + 8 * p));
        const bf16x8 o = __builtin_shufflevector(lo, hi, 0, 1, 2, 3, 4, 5, 6, 7); const int n = 16 * nbk + i16;
        if (n0 + n < nc) {
            if constexpr (QMODE == 0) *(bf16x8*)(WT + (size_t)(r0 + n0 + n) * K + k0 + 8 * kbk) = o;
            else { const v4u ou = __builtin_bit_cast(v4u, o); const float sc_ = QMODE == 1 ? QS_WUP : (QMODE == 2 ? QS_WDN : QS_WIN);
                *(v2u*)((unsigned char*)WT + (size_t)(r0 + n0 + n) * K + k0 + 8 * kbk) = (v2u){q8x4(bflo(ou.x), bfhi(ou.x), bflo(ou.y), bfhi(ou.y), sc_), q8x4(bflo(ou.z), bfhi(ou.z), bflo(ou.w), bfhi(ou.w), sc_)}; } } }
    LDS_WAIT(); asm volatile("" ::: "memory");
}
__device__ __forceinline__ void ln_rows(f32x4 (&v)[4], const float* g, const float* b, int lane) {
    float s = 0.f;
#pragma unroll
    for (int j = 0; j < 4; ++j) s += (v[j][0] + v[j][1]) + (v[j][2] + v[j][3]);
    const float mean = wave_sum(s) * (1.f / D); float s2 = 0.f;
#pragma unroll
    for (int j = 0; j < 4; ++j) { v[j] = v[j] - mean; s2 += (v[j][0] * v[j][0] + v[j][1] * v[j][1]) + (v[j][2] * v[j][2] + v[j][3] * v[j][3]); }
    const float rstd = 1.f / sqrtf(wave_sum(s2) * (1.f / D) + LN_EPS);
#pragma unroll
    for (int j = 0; j < 4; ++j) { const f32x4 gg = *(const f32x4*)(g + 4 * lane + 256 * j), bb = *(const f32x4*)(b + 4 * lane + 256 * j); v[j] = v[j] * rstd * gg + bb; }
}
struct LnAff { f32x4 g[4], b[4]; };
__device__ __forceinline__ LnAff ln_aff(const float* g, const float* b, int lane) { LnAff a;
#pragma unroll
    for (int j = 0; j < 4; ++j) { a.g[j] = *(const f32x4*)(g + 4 * lane + 256 * j); a.b[j] = *(const f32x4*)(b + 4 * lane + 256 * j); }
    return a; }
__device__ __forceinline__ void ln_rows_pre(f32x4 (&v)[4], const LnAff& a) {
    float s = 0.f;
#pragma unroll
    for (int j = 0; j < 4; ++j) s += (v[j][0] + v[j][1]) + (v[j][2] + v[j][3]);
    const float mean = wave_sum(s) * (1.f / D); float s2 = 0.f;
#pragma unroll
    for (int j = 0; j < 4; ++j) { v[j] = v[j] - mean; s2 += (v[j][0] * v[j][0] + v[j][1] * v[j][1]) + (v[j][2] * v[j][2] + v[j][3] * v[j][3]); }
    const float rstd = 1.f / sqrtf(wave_sum(s2) * (1.f / D) + LN_EPS);
#pragma unroll
    for (int j = 0; j < 4; ++j) v[j] = v[j] * rstd * a.g[j] + a.b[j];
}
__device__ __forceinline__ void store_row_f32_bf16(const f32x4 (&v)[4], float* of, bf16* ob, int lane) {
#pragma unroll
    for (int j = 0; j < 4; ++j) { if (of) *(f32x4*)(of + 4 * lane + 256 * j) = v[j];
        if (ob) { v2u w; w.x = pk2(v[j][0], v[j][1]); w.y = pk2(v[j][2], v[j][3]); *(v2u*)(ob + 4 * lane + 256 * j) = w; } }
}

typedef float f32x16 __attribute__((ext_vector_type(16)));
constexpr int DSA_LIST_OFF = LDSCTL_OFF + 2048, DSA_WCNT_OFF = DSA_LIST_OFF + 4096, DSA_SEL_OFF = DSA_WCNT_OFF + 256;
__device__ __forceinline__ unsigned mono_key(float x) { const unsigned u = __builtin_bit_cast(unsigned, x); return u ^ ((unsigned)((int)u >> 31) | 0x80000000u); }
__device__ __forceinline__ unsigned kv_off(unsigned row, unsigned ch) { return 256u * row + 16u * (ch ^ (((row & 3u) << 2) | ((row >> 2) & 3u))); }

#ifndef DUP_IDX
#define DUP_IDX 1
#endif
#ifndef DUP_SEL
#define DUP_SEL 1
#endif
#ifndef DUP_ATT
#define DUP_ATT 1
#endif
template <int LEVEL>
__device__ __forceinline__ void dsa2_level(LAS unsigned* hist, const unsigned (&kk)[128], int nreg, int lane, unsigned& prefix, unsigned& need) {
    constexpr int NBIN = LEVEL == 2 ? 1024 : 2048; constexpr int PB = NBIN / 64;
#pragma unroll
    for (int i = 0; i < PB / 4; ++i) *(LAS v4u*)(hist + lane * PB + 4 * i) = (v4u){0u, 0u, 0u, 0u};
    LDS_WAIT();
#pragma unroll
    for (int i = 0; i < 128; ++i) { if ((i & ~15) < nreg) { const unsigned k = kk[i]; bool part; unsigned bin;
            if (LEVEL == 0) { part = k != 0u; bin = k >> 21; }
            else if (LEVEL == 1) { part = (k != 0u) && ((k >> 21) == prefix); bin = (k >> 10) & 0x7FFu; }
            else { part = (k != 0u) && ((k >> 10) == prefix); bin = k & 0x3FFu; }
            if (part) (void)__hip_atomic_fetch_add(&hist[bin], 1u, __ATOMIC_RELAXED, __HIP_MEMORY_SCOPE_WORKGROUP); }
        if ((i & 7) == 7) __builtin_amdgcn_sched_barrier(0); }
    LDS_WAIT();
    unsigned hv[PB]; unsigned mine = 0u;
#pragma unroll
    for (int i = 0; i < PB / 4; ++i) { const v4u v = *(const LAS v4u*)(hist + lane * PB + 4 * i); hv[4 * i] = v.x; hv[4 * i + 1] = v.y; hv[4 * i + 2] = v.z; hv[4 * i + 3] = v.w; mine += (v.x + v.y) + (v.z + v.w); }
    const unsigned pre779_ = dpp_scan_add_u32(mine); const unsigned incl = (unsigned)__builtin_amdgcn_readlane((int)pre779_, 63) - pre779_ + mine;
    const unsigned above = incl - mine; const bool found = above < need && need <= above + mine;
    unsigned a = above; int bsel = 0; bool done = false;
#pragma unroll
    for (int i = PB - 1; i >= 0; --i) { const bool hit = !done && (need <= a + hv[i]); bsel = hit ? i : bsel; a = (done || hit) ? a : a + hv[i]; done = done || hit; }
    const int src = __builtin_ctzll(__ballot(found));
    const unsigned bfull = (unsigned)SHI(lane * PB + bsel, src); const unsigned aa = (unsigned)SHI((int)a, src);
    prefix = LEVEL == 0 ? bfull : (LEVEL == 1 ? ((prefix << 11) | bfull) : ((prefix << 10) | bfull)); need -= aa;
    LDS_WAIT();
}

__device__ __forceinline__ bool dsa2_sampled(LAS unsigned char* wl, const unsigned (&kk)[128], int nreg, int n, int lane) {
    LAS unsigned* hist = (LAS unsigned*)wl; LAS int* LIST = (LAS int*)(wl + 12288); LAS unsigned* h2 = (LAS unsigned*)(wl + 13312);
    LAS unsigned long long* PRIV = (LAS unsigned long long*)wl;
    const unsigned long long ltm = (1ull << lane) - 1ull;
#pragma unroll
    for (int i = 0; i < 8; ++i) *(LAS v4u*)(hist + lane * 32 + 4 * i) = (v4u){0u, 0u, 0u, 0u};
    LDS_WAIT();
#pragma unroll
    for (int i = 0; i < 128; i += 8) { if (i < nreg) { const unsigned k = kk[i]; if (k != 0u) (void)__hip_atomic_fetch_add(&hist[k >> 21], 1u, __ATOMIC_RELAXED, __HIP_MEMORY_SCOPE_WORKGROUP); } }
    LDS_WAIT();
    unsigned hv[32]; unsigned mine = 0u;
#pragma unroll
    for (int i = 0; i < 8; ++i) { const v4u v = *(const LAS v4u*)(hist + lane * 32 + 4 * i); hv[4 * i] = v.x; hv[4 * i + 1] = v.y; hv[4 * i + 2] = v.z; hv[4 * i + 3] = v.w; mine += (v.x + v.y) + (v.z + v.w); }
    const unsigned pre_ = dpp_scan_add_u32(mine); const unsigned incl = (unsigned)__builtin_amdgcn_readlane((int)pre_, 63) - pre_ + mine; const int lop_ = lane_op(); (void)lop_;
    const unsigned above = incl - mine; const unsigned ns = SHI(incl, 0);
    const float E = (float)ns * 256.f / (float)n, mg = 3.f * sqrtf(E) + 3.f;
    const int rhi = (int)fmaxf(E - mg, 0.f), rlo = (int)(E + mg) + 1;
    int bhl = -1, bll = -1; { unsigned s = above;
#pragma unroll
        for (int i = 31; i >= 0; --i) { if ((int)s <= rhi) bhl = i; s += hv[i]; if (bll < 0 && (int)s >= rlo) bll = i; } }
    const bool hasH = ((int)above <= rhi) && ((int)incl > rhi || lane == 0), hasL = ((int)incl >= rlo) && ((int)above < rlo);
    const unsigned long long mH = __ballot(hasH), mL = __ballot(hasL);
    if (mH == 0ull) return false;
    const int sH = 63 - __builtin_clzll(mH);
    const unsigned bh = (unsigned)SHI(lane * 32 + (bhl < 0 ? 0 : bhl), sH);
    unsigned bl = 1u; if (mL != 0ull) { const int sL = 63 - __builtin_clzll(mL); bl = (unsigned)SHI(lane * 32 + (bll < 0 ? 0 : bll), sL); }
    bl = bl < 1u ? 1u : bl; if (bl > bh) bl = bh;
    int cur = 0; LAS unsigned* pp = (LAS unsigned*)(PRIV + lane);
#pragma unroll
    for (int i = 0; i < 128; ++i) { if ((i & ~15) < nreg) { const unsigned k = kk[i];
            if ((k >> 21) >= bl) { if (cur < 24) { pp[0] = (unsigned)(lane + 64 * i); pp[1] = k; } pp += 128; ++cur; } }
        __builtin_amdgcn_sched_barrier(0); }
    LDS_WAIT();
    int mxc = cur; { const int lq_ = lane_op();
#pragma unroll
        for (int o = 1; o < 64; o <<= 1) { const int t2 = SHX(mxc, o, lq_); mxc = t2 > mxc ? t2 : mxc; } }
    mxc = __builtin_amdgcn_readfirstlane(mxc);
    if (mxc > 24) return false;
    int A = 0, C = 0;
#pragma unroll 1
    for (int s = 0; s < mxc; ++s) { const bool vld = s < cur; const unsigned long long e = vld ? PRIV[s * 64 + lane] : 0ull; const unsigned k = (unsigned)(e >> 32), ix = (unsigned)e;
        const bool sure = vld && (k >> 21) > bh, cand = vld && !sure;
        const unsigned long long ms = __ballot(sure), mc = __ballot(cand);
        const int ps = A + __builtin_popcountll(ms & ltm), pc = C + __builtin_popcountll(mc & ltm);
        if (sure && ps < 256) LIST[ps] = (int)ix;
        if (cand) PRIV[pc] = ((unsigned long long)k << 13) | (unsigned long long)(8191u - ix);
        A += __builtin_popcountll(ms); C += __builtin_popcountll(mc); }
    if (A > 256 || A + C < 256) return false;
    LDS_WAIT();
    unsigned need = 256u - (unsigned)A; const int nit = (C + 63) >> 6;
    if (need > 0u) { unsigned long long prefix = 0ull; int shf = 45;
#pragma unroll 1
        for (int lev = 0; lev < 6; ++lev) { const int w = lev < 5 ? 8 : 5; const int sh = shf - w;
            { unsigned zq_ = 0u; asm volatile("" : "+v"(zq_)); *(LAS v4u*)(h2 + 4 * lane) = (v4u){zq_, zq_, zq_, zq_}; }
            LDS_WAIT();
            for (int it = 0; it < nit; ++it) { const int i = it * 64 + lane; if (i < C) { const unsigned long long c2 = PRIV[i]; if (lev == 0 || (c2 >> shf) == prefix) (void)__hip_atomic_fetch_add(&h2[(unsigned)(c2 >> sh) & ((1u << w) - 1u)], 1u, __ATOMIC_RELAXED, __HIP_MEMORY_SCOPE_WORKGROUP); } }
            LDS_WAIT();
            const v4u v = *(const LAS v4u*)(h2 + 4 * lane); const unsigned m4 = (v.x + v.y) + (v.z + v.w); const unsigned pr2_ = dpp_scan_add_u32(m4); const unsigned in2 = (unsigned)__builtin_amdgcn_readlane((int)pr2_, 63) - pr2_ + m4;
            const unsigned ab = in2 - m4; const bool fnd = ab < need && need <= ab + m4;
            unsigned a = ab; int bs = 0; bool dn = false; const unsigned h4[4] = {v.x, v.y, v.z, v.w};
#pragma unroll
            for (int i = 3; i >= 0; --i) { const bool hit = !dn && (need <= a + h4[i]); bs = hit ? i : bs; a = (dn || hit) ? a : a + h4[i]; dn = dn || hit; }
            const int src = __builtin_ctzll(__ballot(fnd));
            const unsigned bf = (unsigned)SHI(lane * 4 + bs, src); const unsigned aa = (unsigned)SHI((int)a, src); const unsigned hb = (unsigned)SHI((int)(bs == 3 ? h4[3] : bs == 2 ? h4[2] : bs == 1 ? h4[1] : h4[0]), src);
            prefix = (prefix << w) | bf; need -= aa; shf = sh;
            LDS_WAIT();
            if (hb == need) break; }
        int pos = A;
        for (int it = 0; it < nit; ++it) { const int i = it * 64 + lane; unsigned long long c2 = 0ull; if (i < C) c2 = PRIV[i];
            const bool take = (i < C) && ((c2 >> shf) >= prefix);
            const unsigned long long mt = __ballot(take);
            if (take) LIST[pos + __builtin_popcountll(mt & ltm)] = (int)(8191u - (unsigned)(c2 & 8191ull));
            pos += __builtin_popcountll(mt); }
    }
    LDS_WAIT();
    return true;
}

__device__ __forceinline__ void dsa2_unit(LAS unsigned char* lds, const bf16* PROJ, const bf16* KIDX, const bf16* KVN, bf16* OLAT, float* sbuf, int b, int t0, int tid) {
    asm volatile("" : "+v"(tid));
    const int lane = tid & 63, wave = __builtin_amdgcn_readfirstlane(tid >> 6), r = lane & 31, h = lane >> 5;
    const size_t rowb = (size_t)b * T;
    LAS unsigned char* wl = lds + wave * 16384; LAS unsigned* hist = (LAS unsigned*)wl; LAS int* LIST = (LAS int*)(wl + 12288);
    const int t = t0 + wave; int cnt;
    if (t0 >= 256) {
        { const int ntiles = (t0 >> 5) + 1, tpw = (ntiles + 7) >> 3, tile0 = wave * tpw; int tile1 = tile0 + tpw; tile1 = tile1 < ntiles ? tile1 : ntiles;
          const int ahead = (r & 3) + 4 * ((r >> 3) & 1), atok = ((r >> 2) & 1) + 2 * (r >> 4);
          const bf16* qpa = PROJ + (rowb + t0 + atok) * NP + PC_QIDX + ahead * 32 + 8 * h; const bf16* qpb = qpa + (size_t)4 * NP;
          const bf16x8 A0a = *(const bf16x8*)qpa, A1a = *(const bf16x8*)(qpa + 16), A0b = *(const bf16x8*)qpb, A1b = *(const bf16x8*)(qpb + 16);
          float wq[32];
#pragma unroll
          for (int gq = 0; gq < 4; ++gq) { const v4u w0 = *(const v4u*)(PROJ + (rowb + t0 + h + 2 * gq) * NP + PC_WIDX);
              wq[8 * gq] = 0.5f * bflo(w0.x); wq[8 * gq + 1] = 0.5f * bfhi(w0.x); wq[8 * gq + 2] = 0.5f * bflo(w0.y); wq[8 * gq + 3] = 0.5f * bfhi(w0.y); wq[8 * gq + 4] = 0.5f * bflo(w0.z); wq[8 * gq + 5] = 0.5f * bfhi(w0.z); wq[8 * gq + 6] = 0.5f * bflo(w0.w); wq[8 * gq + 7] = 0.5f * bfhi(w0.w); }
          v4u A0c = {0u, 0u, 0u, 0u}, A1c = {0u, 0u, 0u, 0u};
          if (r < 8) { const bf16* qrow = PROJ + (rowb + t0 + (r >> 2) + 2 * (r & 3)) * NP; const v4u wv = *(const v4u*)(qrow + PC_WIDX);
              const float wl_[8] = {bflo(wv.x), bfhi(wv.x), bflo(wv.y), bfhi(wv.y), bflo(wv.z), bfhi(wv.z), bflo(wv.w), bfhi(wv.w)};
              float a0[8], a1[8];
#pragma unroll
              for (int j = 0; j < 8; ++j) { a0[j] = 0.f; a1[j] = 0.f; }
#pragma unroll
              for (int hd = 0; hd < 8; ++hd) { const v4u q0 = *(const v4u*)(qrow + PC_QIDX + hd * 32 + 8 * h), q1 = *(const v4u*)(qrow + PC_QIDX + hd * 32 + 16 + 8 * h); const float hw = 0.5f * wl_[hd];
                  a0[0] += hw * bflo(q0.x); a0[1] += hw * bfhi(q0.x); a0[2] += hw * bflo(q0.y); a0[3] += hw * bfhi(q0.y); a0[4] += hw * bflo(q0.z); a0[5] += hw * bfhi(q0.z); a0[6] += hw * bflo(q0.w); a0[7] += hw * bfhi(q0.w);
                  a1[0] += hw * bflo(q1.x); a1[1] += hw * bfhi(q1.x); a1[2] += hw * bflo(q1.y); a1[3] += hw * bfhi(q1.y); a1[4] += hw * bflo(q1.z); a1[5] += hw * bfhi(q1.z); a1[6] += hw * bflo(q1.w); a1[7] += hw * bfhi(q1.w); }
              A0c = (v4u){pk2(a0[0], a0[1]), pk2(a0[2], a0[3]), pk2(a0[4], a0[5]), pk2(a0[6], a0[7])}; A1c = (v4u){pk2(a1[0], a1[1]), pk2(a1[2], a1[3]), pk2(a1[4], a1[5]), pk2(a1[6], a1[7])}; }
          const bf16x8 A0cb = __builtin_bit_cast(bf16x8, A0c), A1cb = __builtin_bit_cast(bf16x8, A1c);
          const bf16* kp = KIDX + (rowb + (size_t)tile0 * 32 + r) * 32 + 8 * h;
#define IDX_LOADG(BG, tb) do { _Pragma("unroll") for (int u = 0; u < 4; ++u) { int tt_ = (tb) + u; tt_ = tt_ < tile1 ? tt_ : tile1 - 1;        \
              const bf16* kn = kp + (size_t)(tt_ - tile0) * 1024; BG[u][0] = *(const bf16x8*)kn; BG[u][1] = *(const bf16x8*)(kn + 16); } } while (0)
#define IDX_ONE(BG, u, tile) { const bf16x8 b0 = BG[u][0], b1 = BG[u][1]; \
              f32x16 da, db, dc; \
              _Pragma("unroll") for (int i = 0; i < 16; ++i) { da[i] = 0.f; db[i] = 0.f; dc[i] = 0.f; } \
              da = __builtin_amdgcn_mfma_f32_32x32x16_bf16(A0a, b0, da, 0, 0, 0); db = __builtin_amdgcn_mfma_f32_32x32x16_bf16(A0b, b0, db, 0, 0, 0); dc = __builtin_amdgcn_mfma_f32_32x32x16_bf16(A0cb, b0, dc, 0, 0, 0); \
              da = __builtin_amdgcn_mfma_f32_32x32x16_bf16(A1a, b1, da, 0, 0, 0); db = __builtin_amdgcn_mfma_f32_32x32x16_bf16(A1b, b1, db, 0, 0, 0); dc = __builtin_amdgcn_mfma_f32_32x32x16_bf16(A1cb, b1, dc, 0, 0, 0); \
              float s0 = dc[0], s1 = dc[1], s2 = dc[2], s3 = dc[3]; \
              _Pragma("unroll") for (int i = 0; i < 8; ++i) { s0 += wq[i] * __builtin_fabsf(da[i]); s1 += wq[8 + i] * __builtin_fabsf(da[8 + i]); s2 += wq[16 + i] * __builtin_fabsf(db[i]); s3 += wq[24 + i] * __builtin_fabsf(db[8 + i]); } \
              float* sp = sbuf + (size_t)h * 8192 + (tile) * 32 + r; \
              sp[0] = __builtin_bit_cast(float, mono_key(s0)); sp[2 * 8192] = __builtin_bit_cast(float, mono_key(s1)); sp[4 * 8192] = __builtin_bit_cast(float, mono_key(s2)); sp[6 * 8192] = __builtin_bit_cast(float, mono_key(s3)); }
#define IDX_TILES_NG(BG, tb) do { _Pragma("unroll") for (int u = 0; u < 4; ++u) IDX_ONE(BG, u, (tb) + u) } while (0)
#define IDX_TILES(BG, tb) do { _Pragma("unroll") for (int u = 0; u < 4; ++u) { if ((tb) + u < tile1) IDX_ONE(BG, u, (tb) + u) } } while (0)
          if (tile0 < tile1) { bf16x8 BA[4][2], BB[4][2];
              IDX_LOADG(BA, tile0);
              int tileb = tile0;
              for (; tileb + 8 <= tile1; tileb += 8) {
                  IDX_LOADG(BB, tileb + 4);
                  IDX_TILES_NG(BA, tileb);
                  IDX_LOADG(BA, tileb + 8);
                  IDX_TILES_NG(BB, tileb + 4); }
              if (tileb < tile1) { IDX_LOADG(BB, tileb + 4); IDX_TILES(BA, tileb); IDX_TILES(BB, tileb + 4); } }
#undef IDX_ONE
#undef IDX_TILES_NG
#undef IDX_LOADG
#undef IDX_TILES
        }
        asm volatile("s_waitcnt vmcnt(0)" ::: "memory");
        __syncthreads();
        const int n = t + 1, nreg = (n + 63) >> 6; const float* sr = sbuf + (size_t)wave * 8192;
        unsigned kk[128];
#ifndef DUP_KK
#define DUP_KK 1
#endif
        for (int repk = 0; repk < DUP_KK; ++repk)
#pragma unroll
        for (int gI = 0; gI < 4; ++gI) {
            if (gI * 32 < nreg) {
                float fv[32];
#pragma unroll
                for (int i = 0; i < 32; ++i) { const int key = lane + 64 * (gI * 32 + i); fv[i] = __hip_atomic_load(sr + (key < n ? key : n - 1), __ATOMIC_RELAXED, __HIP_MEMORY_SCOPE_AGENT); }
#pragma unroll
                for (int i = 0; i < 32; ++i) { const int key = lane + 64 * (gI * 32 + i); kk[gI * 32 + i] = key < n ? __builtin_bit_cast(unsigned, fv[i]) : 0u; }
            } else {
#pragma unroll
                for (int i = 0; i < 32; ++i) kk[gI * 32 + i] = 0u;
            }
        }
        unsigned prefix = 0u, need = 256u; int pos = 0, eqs = 0; const unsigned long long ltm = (1ull << lane) - 1ull;
        bool seldone = false; if (nreg > 16) seldone = dsa2_sampled(wl, kk, nreg, n, lane);
        if (!seldone)
        for (int reps = 0; reps < DUP_SEL; ++reps) { prefix = 0u; need = 256u; pos = 0; eqs = 0;
        dsa2_level<0>(hist, kk, nreg, lane, prefix, need);
        dsa2_level<1>(hist, kk, nreg, lane, prefix, need);
        dsa2_level<2>(hist, kk, nreg, lane, prefix, need);
        const unsigned tau = prefix;
#pragma unroll
        for (int i = 0; i < 128; ++i) { if ((i & ~15) < nreg) { const unsigned k = kk[i]; const bool gt = k > tau, eq = k == tau;
                const unsigned long long me = __ballot(eq);
                const bool take = gt || (eq && (eqs + __builtin_popcountll(me & ltm) < (int)need));
                const unsigned long long mt = __ballot(take);
                if (take) LIST[pos + __builtin_popcountll(mt & ltm)] = lane + 64 * i;
                pos += __builtin_popcountll(mt); eqs += __builtin_popcountll(me); }
            if ((i & 3) == 3) __builtin_amdgcn_sched_barrier(0); } }
        cnt = 256;
    } else {
#pragma unroll
        for (int j = 0; j < 4; ++j) LIST[lane + 64 * j] = lane + 64 * j;
        cnt = t + 1;
    }
    LDS_WAIT();
    int tid2 = tid; asm volatile("" : "+v"(tid2)); const int lane2 = tid2 & 63; const int nn = lane2 & 15, g = lane2 >> 4;
    bf16x8 qf[4];
#pragma unroll
    for (int s = 0; s < 4; ++s) { if (nn < 8) qf[s] = *(const bf16x8*)(PROJ + (rowb + t) * NP + PC_QLAT + nn * 128 + 32 * s + 8 * g); else qf[s] = (bf16x8){0, 0, 0, 0, 0, 0, 0, 0}; }
    f32x4 O[8]; float mrun, lrun;
    LAS unsigned char* buf = wl; const unsigned q4 = (unsigned)(nn >> 2), p = (unsigned)(lane2 & 3); const int nch = (cnt + 31) >> 5;
    for (int repa = 0; repa < DUP_ATT; ++repa) {
#pragma unroll
    for (int c = 0; c < 8; ++c) O[c] = (f32x4){0.f, 0.f, 0.f, 0.f};
    mrun = -INFINITY; lrun = 0.f;
    v4u pre[8];
#pragma unroll
    for (int it = 0; it < 8; ++it) { const int row = it * 4 + g; pre[it] = (v4u){0u, 0u, 0u, 0u}; if (row < cnt) { const int idx = LIST[row]; pre[it] = *(const v4u*)(KVN + (rowb + idx) * 128 + nn * 8); } }
#pragma unroll 1
    for (int ch = 0; ch < nch; ++ch) {
#pragma unroll
        for (int it = 0; it < 8; ++it) *(LAS v4u*)(buf + kv_off(it * 4 + g, nn)) = pre[it];
        if (ch + 1 < nch) {
#pragma unroll
            for (int it = 0; it < 8; ++it) { const int row = (ch + 1) * 32 + it * 4 + g; pre[it] = (v4u){0u, 0u, 0u, 0u}; if (row < cnt) { const int idx = LIST[row]; pre[it] = *(const v4u*)(KVN + (rowb + idx) * 128 + nn * 8); } } }
        LDS_WAIT();
        f32x4 S0 = {0.f, 0.f, 0.f, 0.f}, S1 = {0.f, 0.f, 0.f, 0.f};
        { const unsigned slot0 = 8u * (nn >> 2) + (nn & 3), slot1 = slot0 + 4u;
#pragma unroll
          for (int s = 0; s < 4; ++s) { const bf16x8 a0 = *(const LAS bf16x8*)(buf + kv_off(slot0, 4 * s + g)), a1 = *(const LAS bf16x8*)(buf + kv_off(slot1, 4 * s + g));
              S0 = __builtin_amdgcn_mfma_f32_16x16x32_bf16(a0, qf[s], S0, 0, 0, 0); S1 = __builtin_amdgcn_mfma_f32_16x16x32_bf16(a1, qf[s], S1, 0, 0, 0); } }
        if (ch * 32 + 32 > cnt) {
#pragma unroll
            for (int j = 0; j < 4; ++j) { if (ch * 32 + 8 * g + j >= cnt) S0[j] = -INFINITY; if (ch * 32 + 8 * g + 4 + j >= cnt) S1[j] = -INFINITY; } }
        float mc = fmaxf(fmaxf(fmaxf(S0[0], S0[1]), fmaxf(S0[2], S0[3])), fmaxf(fmaxf(S1[0], S1[1]), fmaxf(S1[2], S1[3])));
        const int lop891_ = lane_op(); mc = fmaxf(mc, SHX(mc, 16, lop891_)); mc = fmaxf(mc, SHX(mc, 32, lop891_));
        const float mnew = fmaxf(mrun, mc); const float alpha = __expf(mrun - mnew); mrun = mnew;
        float ps = 0.f;
#pragma unroll
        for (int j = 0; j < 4; ++j) { S0[j] = __expf(S0[j] - mnew); S1[j] = __expf(S1[j] - mnew); ps += S0[j] + S1[j]; }
        lrun = lrun * alpha + ps;
        v4u w; w.x = pk2(S0[0], S0[1]); w.y = pk2(S0[2], S0[3]); w.z = pk2(S1[0], S1[1]); w.w = pk2(S1[2], S1[3]); const bf16x8 Bp = __builtin_bit_cast(bf16x8, w);
#pragma unroll
        for (int c = 0; c < 8; ++c) { O[c] = O[c] * alpha;
            const v4i16_t lo = __builtin_amdgcn_ds_read_tr16_b64_v4i16((LAS v4i16_t*)(buf + kv_off(8u * g + q4, 2u * c + (p >> 1)) + 8u * (p & 1u)));
            const v4i16_t hi = __builtin_amdgcn_ds_read_tr16_b64_v4i16((LAS v4i16_t*)(buf + kv_off(8u * g + 4u + q4, 2u * c + (p >> 1)) + 8u * (p & 1u)));
            const bf16x8 a = __builtin_shufflevector(lo, hi, 0, 1, 2, 3, 4, 5, 6, 7);
            O[c] = __builtin_amdgcn_mfma_f32_16x16x32_bf16(a, Bp, O[c], 0, 0, 0); }
        LDS_WAIT();
    } }
    const int lop906_ = lane_op(); lrun += SHX(lrun, 16, lop906_); lrun += SHX(lrun, 32, lop906_);
    const float inv = 1.f / lrun;
    if (nn < 8) {
#pragma unroll
        for (int c = 0; c < 8; ++c) { v2u w; w.x = pk2(O[c][0] * inv, O[c][1] * inv); w.y = pk2(O[c][2] * inv, O[c][3] * inv); *(v2u*)(OLAT + (rowb + t) * 1024 + nn * 128 + 16 * c + 4 * g) = w; } }
}

__device__ __forceinline__ unsigned swap23(unsigned r) { return (r & ~12u) | ((r & 4u) << 1) | ((r & 8u) >> 1); }
__device__ __forceinline__ void memattn_unit(LAS unsigned char* lds, const bf16* PROJ, const bf16* MKVl, bf16* BR, int b, int hd, int qblk, int tid) {
    asm volatile("" : "+v"(tid));
    const int lane = tid & 63, wave = __builtin_amdgcn_readfirstlane(tid >> 6), r = lane & 31, hh = lane >> 5;
    LAS unsigned char* kimg = lds; LAS unsigned char* vimg = lds + 65536;
    { const bf16* kb = MKVl + (size_t)b * 256 * 1024 + hd * 128;
#pragma unroll 4
      for (int it = 0; it < 8; ++it) { const int row = it * 32 + (tid >> 4), ch = tid & 15;
          const v4u kv = *(const v4u*)(kb + (size_t)row * 1024 + ch * 8), vv = *(const v4u*)(kb + (size_t)row * 1024 + 512 + ch * 8);
          *(LAS v4u*)(kimg + kv_off(row, ch)) = kv; *(LAS v4u*)(vimg + kv_off(row, ch)) = vv; } }
    const size_t tok = (size_t)b * T + qblk * 256 + wave * 32 + r;
    bf16x8 qf[8];
#pragma unroll
    for (int s = 0; s < 8; ++s) qf[s] = *(const bf16x8*)(PROJ + tok * NP + PC_MQ + hd * 128 + 16 * s + 8 * hh);
    __syncthreads();
    f32x16 S[8];
#pragma unroll
    for (int kap = 0; kap < 8; ++kap) { f32x16 acc;
#pragma unroll
        for (int i = 0; i < 16; ++i) acc[i] = 0.f;
        const unsigned slot = 32u * kap + swap23((unsigned)r);
#pragma unroll
        for (int s = 0; s < 8; ++s) { const bf16x8 a = *(const LAS bf16x8*)(kimg + kv_off(slot, 2 * s + hh)); acc = __builtin_amdgcn_mfma_f32_32x32x16_bf16(a, qf[s], acc, 0, 0, 0); }
        S[kap] = acc; if (kap & 1) __builtin_amdgcn_sched_barrier(0); }
    float mx = -INFINITY;
#pragma unroll
    for (int kap = 0; kap < 8; ++kap)
#pragma unroll
        for (int i = 0; i < 16; ++i) mx = fmaxf(mx, S[kap][i]);
    const int lop945_ = lane_op(); mx = fmaxf(mx, SHX(mx, 32, lop945_));
    const float sc_ = 0.08838834764831845f * 1.4426950408889634f; float sum = 0.f;
#pragma unroll
    for (int kap = 0; kap < 8; ++kap)
#pragma unroll
        for (int i = 0; i < 16; ++i) { const float e = __builtin_amdgcn_exp2f((S[kap][i] - mx) * sc_); S[kap][i] = e; sum += e; }
    const int lop951_ = lane_op(); sum += SHX(sum, 32, lop951_);
    const float inv = 1.f / sum;
    bf16x8 Bp[16];
#pragma unroll
    for (int kap = 0; kap < 8; ++kap)
#pragma unroll
        for (int s = 0; s < 2; ++s) { v4u w; w.x = pk2(S[kap][8 * s], S[kap][8 * s + 1]); w.y = pk2(S[kap][8 * s + 2], S[kap][8 * s + 3]); w.z = pk2(S[kap][8 * s + 4], S[kap][8 * s + 5]); w.w = pk2(S[kap][8 * s + 6], S[kap][8 * s + 7]);
            Bp[2 * kap + s] = __builtin_bit_cast(bf16x8, w); }
    const unsigned blk = (lane >> 4) & 1, q4 = (lane & 15) >> 2, p = lane & 3;
    bf16* orow = BR + tok * 2048 + 1536 + hd * 128;
#pragma unroll
    for (int c = 0; c < 4; ++c) { f32x16 o;
#pragma unroll
        for (int i = 0; i < 16; ++i) o[i] = 0.f;
#pragma unroll
        for (int ks = 0; ks < 16; ++ks) {
            const v4i16_t lo = __builtin_amdgcn_ds_read_tr16_b64_v4i16((LAS v4i16_t*)(vimg + kv_off(16u * ks + 8u * hh + q4, 4u * c + 2u * blk + (p >> 1)) + 8u * (p & 1u)));
            const v4i16_t hi = __builtin_amdgcn_ds_read_tr16_b64_v4i16((LAS v4i16_t*)(vimg + kv_off(16u * ks + 8u * hh + 4u + q4, 4u * c + 2u * blk + (p >> 1)) + 8u * (p & 1u)));
            const bf16x8 a = __builtin_shufflevector(lo, hi, 0, 1, 2, 3, 4, 5, 6, 7);
            o = __builtin_amdgcn_mfma_f32_32x32x16_bf16(a, Bp[ks], o, 0, 0, 0); if ((ks & 3) == 3) __builtin_amdgcn_sched_barrier(0); }
#pragma unroll
        for (int i4 = 0; i4 < 4; ++i4) { v2u w; w.x = pk2(o[4 * i4] * inv, o[4 * i4 + 1] * inv); w.y = pk2(o[4 * i4 + 2] * inv, o[4 * i4 + 3] * inv);
            *(v2u*)(orow + 32 * c + 8 * i4 + 4 * hh) = w; } }
    __syncthreads();
}

__device__ __forceinline__ f32x4 ld4bf(const bf16* p) { const v2u w = *(const v2u*)p; return (f32x4){bflo(w.x), bfhi(w.x), bflo(w.y), bfhi(w.y)}; }
__device__ __forceinline__ void store_row_fp8(const f32x4 (&v)[4], unsigned char* o8, int lane) {
#pragma unroll
    for (int j = 0; j < 4; ++j) *(unsigned*)(o8 + 4 * lane + 256 * j) = q8x4(v[j][0], v[j][1], v[j][2], v[j][3], QS_H);
}
constexpr int PH_PER_LAYER = 11, NPHASE = 2 + NL * PH_PER_LAYER;

__global__ void __launch_bounds__(NWAVES * 64, 2) fwd(Args args) {
    extern __shared__ __attribute__((aligned(16))) unsigned char lds_raw[];
    Frame F;
    F.lds = (LAS unsigned char*)lds_raw;
    F.tid = threadIdx.x; F.lane = F.tid & 63; F.wave = __builtin_amdgcn_readfirstlane(F.tid >> 6);
    const int wave_s = F.wave;
    F.G = gridDim.x; F.gw = blockIdx.x * NWAVES + F.wave; F.NGW = F.G * NWAVES;
    volatile LAS unsigned* MISC = (volatile LAS unsigned*)(F.lds + MISC_OFF);
    for (int u = F.tid; u < (LDS_BYTES - LDSCTL_OFF) / 4; u += NWAVES * 64) ((LAS unsigned*)(F.lds + LDSCTL_OFF))[u] = 0u;
    __syncthreads();
#if ONE_LAUNCH
    XcdBarrier bar = xcd_barrier_post((unsigned*)(args.ws + WS_CTL) + CW_BAR, MISC + 8);
#define GRID_BAR() xcd_barrier(bar, tidq)
#else
#define GRID_BAR() do {} while (0)
#endif
    { volatile LAS unsigned long long* PT = (volatile LAS unsigned long long*)(F.lds + MISC_OFF + 512);
    if (F.tid == 0) {
#pragma unroll
        for (int i = 0; i < 33; ++i) PT[i] = (unsigned long long)args.in[i];
        PT[33] = (unsigned long long)args.out; PT[34] = (unsigned long long)args.ws;
    } }
    const int lo = args.ph_lo, hi = args.ph_hi;
    __syncthreads();
    int ph = 0;
#define IN(k) ((const float*)gptr(ldp(PT, k)))
#ifndef DUP_PHASE
#define DUP_PHASE (-1)
#endif
#ifndef PHMASK
#define PHMASK 0xFFFFull
#endif
#define PHASE_BEGIN(id) if (((PHMASK >> (id)) & 1ull) && lo <= ph && ph < hi) { unsigned ldsb_ = 0u; asm volatile("" : "+s"(ldsb_)); LAS unsigned char* ldsq = (LAS unsigned char*)lds_raw + ldsb_; \
    volatile LAS unsigned long long* PT = (volatile LAS unsigned long long*)(ldsq + MISC_OFF + 512); LAS int* BLK0 = (LAS int*)(ldsq + MISC_OFF + 128); (void)BLK0; unsigned char* ws = gptr(ldp(PT, 34)); int tidq = wave_s * 64 + lane_op(); asm volatile("" : "+v"(tidq)); const int lane = tidq & 63, wave = __builtin_amdgcn_readfirstlane(tidq >> 6); \
    Frame F; F.lds = ldsq; F.tid = tidq; F.lane = lane; F.wave = wave; { const unsigned vb1_ = ((volatile LAS unsigned*)(ldsq + MISC_OFF))[11]; int Gq_ = gridDim.x, bxq_ = __builtin_amdgcn_readfirstlane(vb1_ ? (int)vb1_ - 1 : (int)blockIdx.x); asm volatile("" : "+s"(Gq_), "+s"(bxq_)); F.G = Gq_; F.bx = bxq_; } F.gw = F.bx * NWAVES + wave; F.NGW = F.G * NWAVES; \
    bf16* WinT = (bf16*)(ws + WS_WIN); bf16* WgluT = (bf16*)(ws + WS_WGLU); bf16* WmkvT = (bf16*)(ws + WS_WMKV); bf16* WuvT = (bf16*)(ws + WS_WUV); \
    bf16* WbrT = (bf16*)(ws + WS_WBR); bf16* WoT = (bf16*)(ws + WS_WO); bf16* WupT = (bf16*)(ws + WS_WUP); bf16* WdnT = (bf16*)(ws + WS_WDN); \
    f32x2* S5A = (f32x2*)(ws + WS_S5A); f32x2* S5B = (f32x2*)(ws + WS_S5B); \
    bf16* MEMB = (bf16*)(ws + WS_MEMB); bf16* MKV = (bf16*)(ws + WS_MKV); \
    bf16* Hf = (bf16*)(ws + WS_H); bf16* Hb = (bf16*)(ws + WS_HB); bf16* PROJ = (bf16*)(ws + WS_PROJ); bf16* KVN = (bf16*)(ws + WS_KVN); \
    bf16* OLAT = (bf16*)(ws + WS_OLAT); bf16* BR = (bf16*)(ws + WS_BR); bf16* Zb = (bf16*)(ws + WS_Z); float* MRG = (float*)(ws + WS_MRG); bf16* MRGB = (bf16*)(ws + WS_MRGB); \
    bf16* Vf = (bf16*)(ws + WS_V); bf16* H1 = (bf16*)(ws + WS_H1); bf16* H1B = (bf16*)(ws + WS_H1B); \
    f32x2* SSE = (f32x2*)(ws + WS_SSE); f32x2* SSC = (f32x2*)(ws + WS_SSC); \
    int* TOK = (int*)(ws + WS_TOK); float* GATE = (float*)(ws + WS_GATE); int* SLOT = (int*)(ws + WS_SLOT); \
    bf16* XS = (bf16*)(ws + WS_XS); bf16* ACT = (bf16*)(ws + WS_ACT); bf16* YS = XS; float* SCR = (float*)(ws + WS_SCR); float* GROW = (float*)(ws + WS_SCR); bf16* KIDX = (bf16*)(ws + WS_KIDX); (void)KIDX; bf16* WSSM = (bf16*)(ws + WS_WSSM); bf16* AEXT = (bf16*)(ws + WS_AEXT); bf16* WEW = (bf16*)(ws + WS_WE); (void)WSSM; (void)AEXT; (void)WEW; \
    unsigned* CTLP = (unsigned*)(ws + WS_CTL); float* OUTP = (float*)gptr(ldp(PT, 33)); \
    (void)WinT; (void)WgluT; (void)WmkvT; (void)WuvT; (void)WbrT; (void)WoT; (void)WupT; (void)WdnT; (void)S5A; (void)S5B; (void)MEMB; (void)MKV; (void)Hf; (void)Hb; (void)PROJ; (void)KVN; (void)OLAT; (void)BR; (void)Zb; (void)MRG; (void)MRGB; \
    (void)Vf; (void)H1; (void)H1B; (void)SSE; (void)SSC; (void)TOK; (void)GATE; (void)SLOT; (void)XS; (void)ACT; (void)YS; (void)SCR; (void)GROW; (void)CTLP; (void)OUTP; \
    for (int rep_ = 0; rep_ < (((id) == DUP_PHASE) ? 2 : 1); ++rep_)
#define PHASE_END   if (ph + 1 < hi) GRID_BAR(); } ++ph;

    PHASE_BEGIN(0)
    {
        LAS unsigned char* scr = F.lds + wave * 16384;
        constexpr int I_CKV = 16 * 2, I_QIDX = 16 * 4, I_KIDX = 16, I_WIDX = 16, I_512 = 16 * 8, I_GATE = 16 * 64;
        constexpr int I_WIN = I_CKV + I_QIDX + I_KIDX + I_WIDX + 5 * I_512 + I_GATE;
        constexpr int I_GLU = 8 * 8, I_MKV = 16 * 16, I_BR = 8 * 16, I_WO = 16 * 16, I_UP = 16 * 32, I_DN = 16 * 16;
        constexpr int I_LAYER = I_WIN + I_GLU + I_MKV + 4 * I_BR + I_WO + NE * I_UP + NE * I_DN;
        const float* w_in = IN(4);
        { LAS float* wt = (LAS float*)F.lds; LAS float* uk = wt + 64 * 65;
          for (int it = F.bx; it < NL * 8 * 16; it += F.G) { const int l = it >> 7, h = (it >> 4) & 7, kb = it & 15;
            const float* Wl = w_in + (size_t)l * D * DIN + (size_t)(kb * 64) * DIN + h * 64; const float* wuk = IN(6) + (size_t)l * 128 * 512 + h * 64;
            { float t8[8], u16[16];
#pragma unroll
              for (int j = 0; j < 8; ++j) { const int i = F.tid + 512 * j; t8[j] = Wl[(size_t)(i >> 6) * DIN + (i & 63)]; }
#pragma unroll
              for (int j = 0; j < 16; ++j) { const int i = F.tid + 512 * j; u16[j] = wuk[(size_t)(i >> 6) * 512 + (i & 63)]; }
#pragma unroll
              for (int j = 0; j < 8; ++j) { const int i = F.tid + 512 * j; wt[(i >> 6) * 65 + (i & 63)] = t8[j]; }
#pragma unroll
              for (int j = 0; j < 16; ++j) { const int i = F.tid + 512 * j; uk[(i >> 6) * 65 + (i & 63)] = u16[j]; } }
            __syncthreads();
            const int c = F.tid >> 2, kq = F.tid & 3; float a[16];
#pragma unroll
            for (int j = 0; j < 16; ++j) a[j] = 0.f;
            for (int d = 0; d < 64; ++d) { const float wv = uk[c * 65 + d];
#pragma unroll
                for (int j = 0; j < 16; ++j) a[j] += wv * wt[(kq * 16 + j) * 65 + d]; }
            unsigned char* p = (unsigned char*)WinT + ((size_t)l * NP + PC_QLAT + h * 128 + c) * D + kb * 64 + kq * 16; const float sq = 0.125f * QS_WQL;
            *(v4u*)p = (v4u){q8x4(a[0], a[1], a[2], a[3], sq), q8x4(a[4], a[5], a[6], a[7], sq), q8x4(a[8], a[9], a[10], a[11], sq), q8x4(a[12], a[13], a[14], a[15], sq)};
            __syncthreads(); } }
        { LAS float* APr = (LAS float*)F.lds; LAS float* APi = APr + 33 * 64; LAS float* Br = APi + 33 * 64; LAS float* Bi = Br + 1024; LAS float* Cr = Bi + 1024; LAS float* Ci = Cr + 1024; LAS float* KD = Ci + 1024;
          for (int it = F.bx; it < NL * 32; it += F.G) { const int l = it >> 5, g = it & 31; const int lg = l * 32 + g;
            if (F.tid < 64) { const int p = F.tid; const int idx = lg * 64 + p; const float lr = IN(10)[idx], li = IN(11)[idx], dt = expf(IN(17)[lg]);
                const float er = expf(lr * dt); float sn, cs; sincosf(li * dt, &sn, &cs); const float ar = er * cs, ai = er * sn;
                float xr = 1.f, xi = 0.f;
                for (int d = 0; d <= 32; ++d) { APr[d * 64 + p] = xr; APi[d * 64 + p] = xi; const float nr = xr * ar - xi * ai, ni = xr * ai + xi * ar; xr = nr; xi = ni; }
                const float nr_ = ar - 1.f, ni_ = ai, den = lr * lr + li * li; const float fr_ = (nr_ * lr + ni_ * li) / den, fi_ = (ni_ * lr - nr_ * li) / den;
                { f32x4 br4[4], bi4[4];
#pragma unroll
                  for (int q = 0; q < 4; ++q) { br4[q] = *(const f32x4*)(IN(12) + (size_t)idx * 16 + 4 * q); bi4[q] = *(const f32x4*)(IN(13) + (size_t)idx * 16 + 4 * q); }
#pragma unroll
                  for (int n = 0; n < 16; ++n) { const float br = br4[n >> 2][n & 3], bi = bi4[n >> 2][n & 3]; Br[p * 16 + n] = fr_ * br - fi_ * bi; Bi[p * 16 + n] = fr_ * bi + fi_ * br; } } }
            for (int i = F.tid; i < 1024; i += 512) { Cr[i] = IN(14)[(size_t)lg * 1024 + i]; Ci[i] = IN(15)[(size_t)lg * 1024 + i]; }
            __syncthreads();
            { const int d = F.tid >> 4, n = F.tid & 15; float a[16];
#pragma unroll
              for (int m = 0; m < 16; ++m) a[m] = 0.f;
              for (int p = 0; p < 64; ++p) { const float cr = Cr[n * 64 + p], ci = Ci[n * 64 + p], xr = APr[d * 64 + p], xi = APi[d * 64 + p]; const float gr = cr * xr - ci * xi, gi = cr * xi + ci * xr;
#pragma unroll
                  for (int m = 0; m < 16; ++m) a[m] += gr * Br[p * 16 + m] - gi * Bi[p * 16 + m]; }
              if (d == 0) { const float dn = IN(16)[lg * 16 + n];
#pragma unroll
                  for (int m = 0; m < 16; ++m) if (m == n) a[m] += dn; }
#pragma unroll
              for (int m = 0; m < 16; ++m) KD[(d * 16 + n) * 16 + m] = a[m]; }
            __syncthreads();
            bf16* wb = WSSM + (size_t)lg * 512 * SSM_K;
            for (int q = F.tid; q < 512 * (SSM_K / 8); q += 512) { const int row = q / (SSM_K / 8), ch = q % (SSM_K / 8); const int t = row >> 4, n = row & 15; float v[8];
                if (ch < 64) { const int j = ch >> 1, m0 = (ch & 1) * 8;
#pragma unroll
                    for (int e = 0; e < 8; ++e) v[e] = (j <= t) ? KD[((t - j) * 16 + n) * 16 + m0 + e] : 0.f; }
                else { const int p2 = (ch - 64) * 8, part = p2 >> 6, p0 = p2 & 63;
#pragma unroll
                    for (int e = 0; e < 8; ++e) { const float cr = Cr[n * 64 + p0 + e], ci = Ci[n * 64 + p0 + e], ar = APr[(t + 1) * 64 + p0 + e], ai = APi[(t + 1) * 64 + p0 + e]; v[e] = part ? -(cr * ai + ci * ar) : (cr * ar - ci * ai); } }
                v4u o; o.x = pk2(v[0], v[1]); o.y = pk2(v[2], v[3]); o.z = pk2(v[4], v[5]); o.w = pk2(v[6], v[7]);
                *(v4u*)(wb + (size_t)row * SSM_K + ch * 8) = o; }
            { bf16* we = WEW + (size_t)lg * 256 * 512;
              for (int q = F.tid; q < 256 * 64; q += 512) { const int row = q >> 6, ch = q & 63; v4u o = {0u, 0u, 0u, 0u};
                  if (row < 128) { const int p = row & 63, part = row >> 6, j = ch >> 1, n0 = (ch & 1) * 8; const float ar = APr[(31 - j) * 64 + p], ai = APi[(31 - j) * 64 + p]; float v[8];
#pragma unroll
                      for (int e = 0; e < 8; ++e) { const float br = Br[p * 16 + n0 + e], bi = Bi[p * 16 + n0 + e]; v[e] = part ? (ar * bi + ai * br) : (ar * br - ai * bi); }
                      o.x = pk2(v[0], v[1]); o.y = pk2(v[2], v[3]); o.z = pk2(v[4], v[5]); o.w = pk2(v[6], v[7]); }
                  *(v4u*)(we + (size_t)row * 512 + ch * 8) = o; } }
            __syncthreads(); } }
        for (;;) { int base_ = 0; if (lane == 0) base_ = (int)__hip_atomic_fetch_add(CTLP + CW_Q0, 8u, RLX_AGENT); base_ = __builtin_amdgcn_readfirstlane(base_); if (base_ >= NL * I_LAYER) break;
        for (int it = base_; it < base_ + 8 && it < NL * I_LAYER; ++it) {
            const int l = it / I_LAYER; int r = it % I_LAYER;
            const float* Wl = w_in + (size_t)l * D * DIN; bf16* Wt = (bf16*)((unsigned char*)WinT + (size_t)l * NP * D);
            if (r < I_WIN) {
                if (r < I_CKV) { tr_item64<3>(Wl, DIN, SC_CKV, 128, D, Wt, PC_CKV, scr, r, lane); continue; } r -= I_CKV;
                if (r < I_QIDX) { tr_item64<3>(Wl, DIN, SC_QIDX, 256, D, Wt, PC_QIDX, scr, r, lane); continue; } r -= I_QIDX;
                if (r < I_KIDX) { tr_item64<3>(Wl, DIN, SC_KIDX, 32, D, Wt, PC_KIDX, scr, r, lane); continue; } r -= I_KIDX;
                if (r < I_WIDX) { tr_item64<3>(Wl, DIN, SC_WIDX, 8, D, Wt, PC_WIDX, scr, r, lane); continue; } r -= I_WIDX;
                if (r < 5 * I_512) { const int s = r / I_512; tr_item64<3>(Wl, DIN, SC_CU + 512 * s, 512, D, Wt, PC_CU + 512 * s, scr, r % I_512, lane); continue; } r -= 5 * I_512;
                tr_item64<3>(Wl, DIN, SC_GATE, 4096, D, Wt, PC_GATE, scr, r, lane); continue;
            }
            r -= I_WIN;
            if (r < I_GLU) { tr_item64(IN(18) + (size_t)l * 512 * 512, 512, 0, 512, 512, WgluT + (size_t)l * 512 * 512, 0, scr, r, lane); continue; } r -= I_GLU;
            if (r < I_MKV) { tr_item64(IN(20) + (size_t)l * 1024 * 1024, 1024, 0, 1024, 1024, WmkvT + (size_t)l * 1024 * 1024, 0, scr, r, lane); continue; } r -= I_MKV;
            if (r < 4 * I_BR) { const int b = r / I_BR; tr_item64(IN(21) + ((size_t)l * 4 + b) * 512 * 1024, 1024, 0, 1024, 512, WbrT + ((size_t)l * 4 + b) * 1024 * 512, 0, scr, r % I_BR, lane); continue; } r -= 4 * I_BR;
            if (r < I_WO) { tr_item64(IN(22) + (size_t)l * 1024 * 1024, 1024, 0, 1024, 1024, WoT + (size_t)l * 1024 * 1024, 0, scr, r, lane); continue; } r -= I_WO;
            if (r < NE * I_UP) { const int e = r / I_UP; tr_item64<1>(IN(27) + ((size_t)l * NE + e) * 1024 * 2048, 2048, 0, 2048, 1024, (bf16*)((unsigned char*)WupT + ((size_t)l * NE + e) * 2048 * 1024), 0, scr, r % I_UP, lane); continue; } r -= NE * I_UP;
            { const int e = r / I_DN; tr_item64<2>(IN(29) + ((size_t)l * NE + e) * 1024 * 1024, 1024, 0, 1024, 1024, (bf16*)((unsigned char*)WdnT + ((size_t)l * NE + e) * 1024 * 1024), 0, scr, r % I_DN, lane); }
        } }
        for (int it = F.gw; it < NL * (PC_QIDX - PC_WIDX - 8); it += F.NGW) { const int l = it / (PC_QIDX - PC_WIDX - 8), rr = PC_WIDX + 8 + it % (PC_QIDX - PC_WIDX - 8);
            *((v4u*)((unsigned char*)WinT + ((size_t)l * NP + rr) * D) + lane) = (v4u){0u, 0u, 0u, 0u}; }
        for (int it = F.gw; it < NL * 512; it += F.NGW) { const int l = it / 512, n = it % 512, h = n >> 6, d = n & 63; const float* wuv = IN(7) + (size_t)l * 128 * 512;
            bf16* p = WuvT + ((size_t)l * 512 + n) * 1024;
#pragma unroll
            for (int j = 0; j < 2; ++j) { const int k0 = 8 * lane + 512 * j; float v[8];
#pragma unroll
                for (int q = 0; q < 8; ++q) { const int k = k0 + q; const float x_ = wuv[(size_t)(k & 127) * 512 + h * 64 + d]; v[q] = ((k >> 7) == h) ? x_ : 0.f; }
                v4u o; o.x = pk2(v[0], v[1]); o.y = pk2(v[2], v[3]); o.z = pk2(v[4], v[5]); o.w = pk2(v[6], v[7]); *(v4u*)(p + k0) = o; } }
        for (int it = F.gw; it < NL * 32; it += F.NGW) { const int l = it >> 5, g = it & 31; const int idx = (l * 32 + g) * 64 + lane;
            const float lr = IN(10)[idx], li = IN(11)[idx], dt = expf(IN(17)[l * 32 + g]);
            const float er = expf(lr * dt); float sn, cs; sincosf(li * dt, &sn, &cs); const float ar = er * cs, ai = er * sn;
            S5A[idx] = (f32x2){ar, ai};
            float pr = ar, pi = ai;
#pragma unroll
            for (int q = 0; q < 5; ++q) { const float nr = pr * pr - pi * pi, ni = 2.f * pr * pi; pr = nr; pi = ni; }
            S5A[NL * 32 * 64 + idx] = (f32x2){pr, pi};
            const float nr_ = ar - 1.f, ni_ = ai, den = lr * lr + li * li; const float fr_ = (nr_ * lr + ni_ * li) / den, fi_ = (ni_ * lr - nr_ * li) / den;
            { f32x4 br4[4], bi4[4];
#pragma unroll
              for (int q = 0; q < 4; ++q) { br4[q] = *(const f32x4*)(IN(12) + (size_t)idx * 16 + 4 * q); bi4[q] = *(const f32x4*)(IN(13) + (size_t)idx * 16 + 4 * q); }
#pragma unroll
              for (int n = 0; n < 16; ++n) { const float br = br4[n >> 2][n & 3], bi = bi4[n >> 2][n & 3];
                  S5B[(size_t)idx * 16 + n] = (f32x2){fr_ * br - fi_ * bi, fr_ * bi + fi_ * br}; } } }
        for (int it = F.gw; it < 512; it += F.NGW) { const float* mp = IN(1) + (size_t)it * 1024; f32x4 v[4];
#pragma unroll
            for (int j = 0; j < 4; ++j) v[j] = *(const f32x4*)(mp + 4 * lane + 256 * j);
            store_row_f32_bf16(v, nullptr, MEMB + (size_t)it * 1024, lane); }
        const LnAff aff0 = ln_aff(IN(2), IN(3), lane);
        for (int m = F.gw; m < M; m += F.NGW) { const float* xp = IN(0) + (size_t)m * D; f32x4 v[4];
#pragma unroll
            for (int j = 0; j < 4; ++j) v[j] = *(const f32x4*)(xp + 4 * lane + 256 * j);
            ln_rows_pre(v, aff0); store_row_f32_bf16(v, nullptr, Hf + (size_t)m * D, lane); store_row_fp8(v, (unsigned char*)Hb + (size_t)m * D, lane); }
    }
    PHASE_END

    PHASE_BEGIN(1)
    {
        pg8::Dims g{2048, 2048, 2048}; MkvOrder S{F.G, F.bx, (const char*)MEMB, (const char*)WmkvT}; EpiMkv E{MKV};
        pg8::gemm_phase<EpiMkv, MkvOrder, true, true>(F.lds, g, S, E, F.tid);
    }
    PHASE_END

#define MOE_BLK0() do { if (F.tid < 32) CNTL[F.tid] = (int)__hip_atomic_load(CTLP + CW_CNT + l * 2048 + F.tid * 64, RLX_AGENT); __syncthreads(); \
        if (F.tid < 33) { int acc_ = 0; for (int k_ = 0; k_ < 32; ++k_) acc_ += (k_ < F.tid) ? ((CNTL[k_] + 255) >> 8) : 0; BLK0[F.tid] = acc_; } __syncthreads(); } while (0)
    for (int l = 0; l < NL; ++l) {
        PHASE_BEGIN(2)
        {
            pg8::Dims g{1024, 1024, 1024}; pg8::StaticOrder S; S.init(M, NP, F.G, F.bx, Hb, 1024, (const unsigned char*)WinT + (size_t)l * NP * D, 1024); EpiProjQ E{PROJ, NP, AEXT};
            pg8::gemm_phase<EpiProjQ, pg8::StaticOrder, true, true, true>(F.lds, g, S, E, F.tid);
        }
        PHASE_END

        PHASE_BEGIN(3)
        {
            { const float* kg = IN(5) + (size_t)l * 128; const float* cw = IN(8) + (size_t)l * 3 * 512; const float* cb = IN(9) + (size_t)l * 512;
              const float kg0 = kg[2 * lane], kg1 = kg[2 * lane + 1];
              const int eg_ = (F.G >= 128) ? 64 : 0; const int gw2_ = (F.bx - eg_) * NWAVES + wave, ngw2_ = (F.G - eg_) * NWAVES;
              if (F.bx >= eg_)
#pragma unroll 1
              for (int mb = gw2_; mb < M; mb += 4 * ngw2_) {
                unsigned cw2[4], kx[4]; v4u uu[4][3], gc[4][3], gb[4];
#pragma unroll
                for (int q = 0; q < 4; ++q) { int m = mb + q * ngw2_; m = m < M ? m : mb; const bf16* pr = PROJ + (size_t)m * NP; const int tl = m & (T - 1);
                    cw2[q] = *(const unsigned*)(pr + PC_CKV + 2 * lane); kx[q] = *(const unsigned*)(pr + PC_KIDX + 2 * (lane & 15)); gb[q] = *(const v4u*)(pr + PC_GB + 8 * lane);
#pragma unroll
                    for (int k = 0; k < 3; ++k) { const int back = 2 - k; const bf16* pp = pr - (size_t)(tl >= back ? back : 0) * NP;
                        uu[q][k] = *(const v4u*)(pp + PC_CU + 8 * lane); gc[q][k] = *(const v4u*)(pp + PC_GC + 8 * lane); } }
#pragma unroll
                for (int q = 0; q < 4; ++q) { const int m = mb + q * ngw2_; if (m < M) { const int tl = m & (T - 1);
                    const float c0 = bflo(cw2[q]), c1 = bfhi(cw2[q]);
                    const float rs = 1.f / sqrtf(wave_sum(c0 * c0 + c1 * c1) * (1.f / 128.f) + LN_EPS);
                    *(unsigned*)(KVN + (size_t)m * 128 + 2 * lane) = pk2(c0 * rs * kg0, c1 * rs * kg1);
                    if (lane < 16) *(unsigned*)(KIDX + (size_t)m * 32 + 2 * lane) = kx[q];
                    float y[8];
#pragma unroll
                    for (int i = 0; i < 8; ++i) y[i] = cb[8 * lane + i];
#pragma unroll
                    for (int k = 0; k < 3; ++k) { const int back = 2 - k; if (tl >= back) { const v4u u4 = uu[q][k], g4 = gc[q][k]; const float* wk = cw + k * 512 + 8 * lane;
                            y[0] += wk[0] * bflo(u4.x) * bflo(g4.x); y[1] += wk[1] * bfhi(u4.x) * bfhi(g4.x); y[2] += wk[2] * bflo(u4.y) * bflo(g4.y); y[3] += wk[3] * bfhi(u4.y) * bfhi(g4.y);
                            y[4] += wk[4] * bflo(u4.z) * bflo(g4.z); y[5] += wk[5] * bfhi(u4.z) * bfhi(g4.z); y[6] += wk[6] * bflo(u4.w) * bflo(g4.w); y[7] += wk[7] * bfhi(u4.w) * bfhi(g4.w); } }
                    const v4u b4 = gb[q];
                    v4u o; o.x = pk2(y[0] * bflo(b4.x), y[1] * bfhi(b4.x)); o.y = pk2(y[2] * bflo(b4.y), y[3] * bfhi(b4.y)); o.z = pk2(y[4] * bflo(b4.z), y[5] * bfhi(b4.z)); o.w = pk2(y[6] * bflo(b4.w), y[7] * bfhi(b4.w));
                    *(v4u*)(BR + (size_t)m * 2048 + 512 + 8 * lane) = o; } } } }
            __syncthreads();
            { pg8::Dims g{SSM_K * 2, 1024, 1024}; EOrder S{F.G, F.bx, (const char*)AEXT, (const char*)(WEW + (size_t)l * 32 * 256 * 512)}; EpiE E{(float*)SSE};
              pg8::gemm_phase<EpiE, EOrder, true, true>(F.lds, g, S, E, F.tid); }
            __syncthreads();
            __syncthreads();
            for (int u = F.bx; u < NB * 4 * (T / 256); u += F.G) { const int qblk = u % (T / 256), hd = (u / (T / 256)) & 3, b = u / (4 * (T / 256));
                memattn_unit(F.lds, PROJ, MKV + (size_t)l * 512 * 1024, BR, b, hd, qblk, F.tid); }
        }
        PHASE_END

        PHASE_BEGIN(4)
        {
            { int par = 0; float* sb0 = SCR + (size_t)F.bx * 2 * 8 * 8192;
              for (int i = 0; ; ++i) { const int rk = (i & 1) ? (i * F.G + (F.G - 1 - F.bx)) : (i * F.G + F.bx); if (rk >= M / 8) break;
                const int u = M / 8 - 1 - rk; const int b = u & 1, t0 = (u >> 1) * 8;
                dsa2_unit(F.lds, PROJ, KIDX, KVN, OLAT, sb0 + (size_t)par * 8 * 8192, b, t0, F.tid); if (t0 >= 256) par ^= 1; }
              __syncthreads(); }
#ifndef DUP_CARRY
#define DUP_CARRY 1
#endif
            for (int repc = 0; repc < DUP_CARRY; ++repc)
            for (int it = F.gw; it < NB * 32; it += F.NGW) { const int b = it >> 5, g = it & 31; const f32x2 aL = S5A[NL * 32 * 64 + (l * 32 + g) * 64 + lane];
                float hr = 0.f, hi_ = 0.f; bf16* ap = AEXT + ((size_t)(g * 512 + b * 256)) * SSM_K + 512 + lane;
                for (int c0 = 0; c0 < SSM_NC; c0 += 8) { f32x2 e[8];
#pragma unroll
                    for (int k = 0; k < 8; ++k) { const float* ep_ = (const float*)SSE + ((size_t)(b * SSM_NC + c0 + k) * 32 + g) * 128 + lane; e[k] = (f32x2){ep_[0], ep_[64]}; }
#pragma unroll
                    for (int k = 0; k < 8; ++k) { ap[(size_t)(c0 + k) * SSM_K] = (bf16)f2bf(hr); ap[(size_t)(c0 + k) * SSM_K + 64] = (bf16)f2bf(hi_);
                        const float nr = aL[0] * hr - aL[1] * hi_ + e[k][0], ni = aL[0] * hi_ + aL[1] * hr + e[k][1]; hr = nr; hi_ = ni; } } }
        }
        PHASE_END

        PHASE_BEGIN(5)
        {
            const int half = F.G >> 1;
            if (F.bx < half) {
                pg8::Dims g{SSM_K * 2, SSM_K * 2, SSM_K * 2}; SsmOrder S{half, F.bx, (const char*)AEXT, (const char*)(WSSM + (size_t)l * 32 * 512 * SSM_K)}; EpiSsm E{Zb};
                pg8::gemm_phase<EpiSsm, SsmOrder, true, true>(F.lds, g, S, E, F.tid);
            } else {
                pg8::Dims g{2048, 2048, 2048}; pg8::StaticOrder S; S.init(M, 512, F.G - half, F.bx - half, OLAT, 2048, WuvT + (size_t)l * 512 * 1024, 2048);
                EpiBf16 E{BR, 2048};
                pg8::gemm_phase<EpiBf16, pg8::StaticOrder, true, true>(F.lds, g, S, E, F.tid);
            }
        }
        PHASE_END

        PHASE_BEGIN(6)
        {
            pg8::Dims g{1024, 1024, 1024}; pg8::StaticOrder S; S.init(M, 512, F.G, F.bx, Zb, 1024, WgluT + (size_t)l * 512 * 512, 1024);
            EpiGlu E{Zb, 512, IN(19) + (size_t)l * 512, BR + 1024, 2048};
            pg8::gemm_phase<EpiGlu, pg8::StaticOrder, true, true>(F.lds, g, S, E, F.tid);
        }
        PHASE_END

        PHASE_BEGIN(7)
        {
            pg8::Dims g{4096, 1024, 1024}; MergeOrder S{F.G, F.bx, (const char*)BR, (const char*)(WbrT + (size_t)l * 4 * 1024 * 512)};
            EpiMerge E{PROJ + PC_GATE, NP, MRGB};
            pg8::gemm_phase<EpiMerge, MergeOrder, true, true>(F.lds, g, S, E, F.tid);
        }
        PHASE_END

        PHASE_BEGIN(8)
        {
            pg8::Dims g{2048, 2048, 2048}; pg8::StaticOrder S; S.init(M, 1024, F.G, F.bx, MRGB, 2048, WoT + (size_t)l * 1024 * 1024, 2048); EpiWo E{Hf, Vf};
            pg8::gemm_phase<EpiWo, pg8::StaticOrder, true, true>(F.lds, g, S, E, F.tid);
        }
        PHASE_END

        PHASE_BEGIN(9)
        {
            constexpr int HP = 2064, HLO_OFF = 16 * HP, PART_OFF = 66560;
            LAS unsigned char* hhi = F.lds; LAS unsigned char* hlo = F.lds + HLO_OFF; LAS float* part = (LAS float*)(F.lds + PART_OFF);
            LAS unsigned* wcnt = (LAS unsigned*)(F.lds + LDSCTL_OFF + 2048); LAS unsigned* wbase = wcnt + 32; LAS unsigned* asg = wcnt + 64; LAS float* asgg = (LAS float*)(asg + 256);
            const float* wr_ = IN(25) + (size_t)l * 1024 * 32; const float* brt = IN(26) + (size_t)l * 32;
            unsigned* cnt = CTLP + CW_CNT + l * 2048;
            const float* g1 = IN(23) + (size_t)l * D; const float* b1 = IN(24) + (size_t)l * D;
            const int fn = lane & 15, fkq = lane >> 4;
            v4u whi[4][2], wlo[4][2];
#pragma unroll
            for (int ks = 0; ks < 4; ++ks)
#pragma unroll
                for (int mt = 0; mt < 2; ++mt) { unsigned hh[8], ll[8];
#pragma unroll
                    for (int i = 0; i < 8; ++i) { const float f = wr_[(size_t)(128 * wave + 32 * ks + 8 * fkq + i) * 32 + 16 * mt + fn]; hh[i] = f2bf(f); ll[i] = f2bf(f - __builtin_bit_cast(float, hh[i] << 16)); }
                    whi[ks][mt] = (v4u){hh[0] | (hh[1] << 16), hh[2] | (hh[3] << 16), hh[4] | (hh[5] << 16), hh[6] | (hh[7] << 16)};
                    wlo[ks][mt] = (v4u){ll[0] | (ll[1] << 16), ll[2] | (ll[3] << 16), ll[4] | (ll[5] << 16), ll[6] | (ll[7] << 16)}; }
            const LnAff aff1 = ln_aff(g1, b1, lane);
            for (int blk = F.bx; blk < M / 64; blk += F.G) {
                if (F.tid < 32) wcnt[F.tid] = 0u;
                __syncthreads();
                v2u raw[2][4];
#pragma unroll
                for (int tk = 0; tk < 2; ++tk)
#pragma unroll
                    for (int j = 0; j < 4; ++j) raw[tk][j] = *(const v2u*)(Vf + (size_t)(blk * 64 + 2 * wave + tk) * D + 4 * lane + 256 * j);
#pragma unroll 1
                for (int rd = 0; rd < 4; ++rd) { const int m0 = blk * 64 + rd * 16 + 2 * wave;
#pragma unroll
                    for (int tk = 0; tk < 2; ++tk) { f32x4 v[4];
#pragma unroll
                        for (int j = 0; j < 4; ++j) v[j] = (f32x4){bflo(raw[tk][j].x), bfhi(raw[tk][j].x), bflo(raw[tk][j].y), bfhi(raw[tk][j].y)};
                        ln_rows_pre(v, aff1); store_row_f32_bf16(v, nullptr, H1 + (size_t)(m0 + tk) * D, lane); store_row_fp8(v, (unsigned char*)H1B + (size_t)(m0 + tk) * D, lane);
#pragma unroll
                        for (int j = 0; j < 4; ++j) { unsigned hh[4]; float rr[4];
#pragma unroll
                            for (int q = 0; q < 4; ++q) { hh[q] = f2bf(v[j][q]); rr[q] = v[j][q] - __builtin_bit_cast(float, hh[q] << 16); }
                            const int o_ = (2 * wave + tk) * HP + (4 * lane + 256 * j) * 2;
                            *(LAS v2u*)(hhi + o_) = (v2u){hh[0] | (hh[1] << 16), hh[2] | (hh[3] << 16)}; *(LAS v2u*)(hlo + o_) = (v2u){pk2(rr[0], rr[1]), pk2(rr[2], rr[3])}; } }
                    if (rd + 1 < 4) {
#pragma unroll
                        for (int tk = 0; tk < 2; ++tk)
#pragma unroll
                            for (int j = 0; j < 4; ++j) raw[tk][j] = *(const v2u*)(Vf + (size_t)(m0 + 16 + tk) * D + 4 * lane + 256 * j); }
                    __syncthreads();
                    { f32x4 acc[2] = {{0.f, 0.f, 0.f, 0.f}, {0.f, 0.f, 0.f, 0.f}};
#pragma unroll
                      for (int ks = 0; ks < 4; ++ks) { const int ko = fn * HP + (128 * wave + 32 * ks + 8 * fkq) * 2;
                          const bf16x8 bh = *(const LAS bf16x8*)(hhi + ko), bl = *(const LAS bf16x8*)(hlo + ko);
#pragma unroll
                          for (int mt = 0; mt < 2; ++mt) { const bf16x8 ah = __builtin_bit_cast(bf16x8, whi[ks][mt]), al = __builtin_bit_cast(bf16x8, wlo[ks][mt]);
                              acc[mt] = __builtin_amdgcn_mfma_f32_16x16x32_bf16(ah, bh, acc[mt], 0, 0, 0); acc[mt] = __builtin_amdgcn_mfma_f32_16x16x32_bf16(al, bh, acc[mt], 0, 0, 0);
                              acc[mt] = __builtin_amdgcn_mfma_f32_16x16x32_bf16(ah, bl, acc[mt], 0, 0, 0); } }
#pragma unroll
                      for (int mt = 0; mt < 2; ++mt) *(LAS f32x4*)(part + (wave * 16 + fn) * 32 + 16 * mt + 4 * fkq) = acc[mt]; }
                    __syncthreads();
                    const int eq = lane & 7; const int lopr_ = lane_op(); const f32x4 be4 = *(const f32x4*)(brt + 4 * eq);
#pragma unroll 1
                    for (int tk = 0; tk < 2; ++tk) { float cur[4] = {be4[0], be4[1], be4[2], be4[3]};
#pragma unroll
                        for (int w = 0; w < 8; ++w) { const f32x4 p = *(const LAS f32x4*)(part + (w * 16 + 2 * wave + tk) * 32 + 4 * eq);
#pragma unroll
                            for (int j = 0; j < 4; ++j) cur[j] += p[j]; }
                        float val[4]; int idx[4];
#pragma unroll
                        for (int k = 0; k < 4; ++k) { float bv = cur[0]; int bi = 4 * eq;
#pragma unroll
                            for (int j = 1; j < 4; ++j) if (cur[j] > bv) { bv = cur[j]; bi = 4 * eq + j; }
#pragma unroll
                            for (int o = 1; o < 8; o <<= 1) { const float ov = SHX(bv, o, lopr_); const int oi = SHX(bi, o, lopr_); if (ov > bv || (ov == bv && oi < bi)) { bv = ov; bi = oi; } }
                            val[k] = bv; idx[k] = bi;
#pragma unroll
                            for (int j = 0; j < 4; ++j) if (bi == 4 * eq + j) cur[j] = -INFINITY; }
                        const float e1 = __expf(val[1] - val[0]), e2 = __expf(val[2] - val[0]), e3 = __expf(val[3] - val[0]); const float inv = 1.f / (1.f + e1 + e2 + e3);
                        const float gt[4] = {inv, e1 * inv, e2 * inv, e3 * inv};
                        if (lane < 4) { int ee = idx[0]; float gg = gt[0];
#pragma unroll
                            for (int k = 1; k < 4; ++k) if (lane == k) { ee = idx[k]; gg = gt[k]; }
                            const unsigned rank = __hip_atomic_fetch_add(&wcnt[ee], 1u, __ATOMIC_RELAXED, __HIP_MEMORY_SCOPE_WORKGROUP);
                            const int tl_ = rd * 16 + 2 * wave + tk; asg[tl_ * 4 + lane] = (unsigned)ee | (rank << 8); asgg[tl_ * 4 + lane] = gg; } }
                    LDS_WAIT();
                }
                __syncthreads();
                if (F.tid < 32) { const unsigned c = wcnt[F.tid]; wbase[F.tid] = c ? __hip_atomic_fetch_add(cnt + F.tid * 64, c, RLX_AGENT) : 0u; }
                __syncthreads();
                if (F.tid < 256) { const unsigned a_ = asg[F.tid]; const int ee = (int)(a_ & 255u); const unsigned slot = wbase[ee] + (a_ >> 8); const int m = blk * 64 + (F.tid >> 2);
                    TOK[(size_t)ee * M + slot] = m; GATE[(size_t)ee * M + slot] = asgg[F.tid]; SLOT[(size_t)m * 4 + (F.tid & 3)] = ee * M + (int)slot; }
                __syncthreads();
            }
        }
        PHASE_END

        PHASE_BEGIN(11)
        {
            LAS int* CNTL = (LAS int*)(ldsq + MISC_OFF + 272);
            MOE_BLK0();
            for (int mb = F.gw; mb < M; mb += 16 * F.NGW) { const int m = mb + (lane >> 2) * F.NGW;
                if (m < M) { const int sl = SLOT[(size_t)m * 4 + (lane & 3)]; const int e = sl >> 14, s = sl & (M - 1); GROW[(size_t)BLK0[e] * 256 + s] = GATE[(size_t)e * M + s]; } }
            pg8::Dims g{1024, 1024, 1024}; MoeOrder S{F.G, F.bx, 8, BLK0[32] * 8, BLK0, (const char*)H1B, (const char*)WupT + (size_t)l * NE * 2048 * 1024, (size_t)0, (size_t)2048 * 1024, (size_t)256 * 1024, TOK, CNTL};
            EpiUp E{IN(28) + (size_t)l * NE * 2048, (unsigned char*)ACT};
            pg8::gemm_phase<EpiUp, MoeOrder, true, true, true, true>(F.lds, g, S, E, F.tid);
        }
        PHASE_END

        PHASE_BEGIN(12)
        {
            { LAS int* CNTL = (LAS int*)(ldsq + MISC_OFF + 272); MOE_BLK0(); }
            pg8::Dims g{1024, 1024, 1024}; MoeOrder S{F.G, F.bx, 4, BLK0[32] * 4, BLK0, (const char*)ACT, (const char*)WdnT + (size_t)l * NE * 1024 * 1024, (size_t)256 * 1024, (size_t)1024 * 1024, (size_t)256 * 1024, nullptr, nullptr};
            EpiDown E{IN(30) + (size_t)l * NE * 1024, GROW, YS};
            pg8::gemm_phase<EpiDown, MoeOrder, true, true, true>(F.lds, g, S, E, F.tid);
        }
        PHASE_END

        PHASE_BEGIN(13)
        {
            { LAS int* CNTL = (LAS int*)(ldsq + MISC_OFF + 272); MOE_BLK0(); }
#define LL_ISSUE(mm, s4, hh, yy) do { const unsigned ho_ = (unsigned)(mm) * 2048u + 8u * (unsigned)lane; \
                _Pragma("unroll") for (int j = 0; j < 4; ++j) hh[j] = *(const v2u*)((const char*)H1 + ho_ + 512 * j); \
                _Pragma("unroll") for (int k = 0; k < 4; ++k) { const unsigned sl = s4[k]; const unsigned ro_ = ((unsigned)BLK0[sl >> 14] * 256u + (sl & (unsigned)(M - 1))) * 2048u + 8u * (unsigned)lane; \
                    _Pragma("unroll") for (int j = 0; j < 4; ++j) yy[k][j] = *(const v2u*)((const char*)YS + ro_ + 512 * j); } } while (0)
#define LL_FIN(mm, hC, yC) { f32x4 v[4]; \
                  _Pragma("unroll") for (int j = 0; j < 4; ++j) { v[j] = (f32x4){bflo(hC[j].x), bfhi(hC[j].x), bflo(hC[j].y), bfhi(hC[j].y)} * DN_ALPHA; \
                      _Pragma("unroll") for (int k = 0; k < 4; ++k) { const v2u y2 = yC[k][j]; v[j][0] += bflo(y2.x); v[j][1] += bfhi(y2.x); v[j][2] += bflo(y2.y); v[j][3] += bfhi(y2.y); } } \
                  ln_rows_pre(v, aff2); \
                  if (l == NL - 1) store_row_f32_bf16(v, OUTP + (size_t)(mm) * D, nullptr, lane); \
                  else { store_row_f32_bf16(v, nullptr, Hf + (size_t)(mm) * D, lane); store_row_fp8(v, (unsigned char*)Hb + (size_t)(mm) * D, lane); } }
            const LnAff aff2 = ln_aff(IN(31) + (size_t)l * D, IN(32) + (size_t)l * D, lane);
            { int m = F.gw; const int st = F.NGW; v4u sa = *(const v4u*)(SLOT + (size_t)m * 4), sb = *(const v4u*)(SLOT + (size_t)(m + st < M ? m + st : m) * 4);
#pragma unroll 1
              for (; m < M; m += 2 * st) { const bool two = m + st < M; const int m1 = two ? m + st : m; v2u hA[4], yA[4][4], hB[4], yB[4][4];
                  LL_ISSUE(m, sa, hA, yA); LL_ISSUE(m1, sb, hB, yB);
                  { const int n0 = m + 2 * st; if (n0 < M) { sa = *(const v4u*)(SLOT + (size_t)n0 * 4); sb = *(const v4u*)(SLOT + (size_t)(n0 + st < M ? n0 + st : n0) * 4); } }
                  LL_FIN(m, hA, yA)
                  if (two) LL_FIN(m1, hB, yB) } }
#undef LL_FIN
#undef LL_ISSUE
        }
        PHASE_END
    }
#undef PHASE_BEGIN
#undef PHASE_END
}

extern "C" void kernel_launch(void* const* d_in, const int* in_sizes, int n_in, void* d_out, int out_size, void* d_ws, size_t ws_size, hipStream_t stream) {
    static int grid = 0;
    if (grid == 0) {
        if (n_in != 33 || out_size != M * D || ws_size < WS_END) { fprintf(stderr, "kernel_launch: unexpected shapes (n_in %d out %d ws %zu need %zu)\n", n_in, out_size, ws_size, (size_t)WS_END); grid = -1; return; }
        int dev = 0, cus = 0, per_cu = 0;
        if (hipGetDevice(&dev) != hipSuccess || hipDeviceGetAttribute(&cus, hipDeviceAttributeMultiprocessorCount, dev) != hipSuccess) { grid = -1; return; }
        if (hipFuncSetAttribute((const void*)fwd, hipFuncAttributeMaxDynamicSharedMemorySize, LDS_BYTES) != hipSuccess) { fprintf(stderr, "kernel_launch: hipFuncSetAttribute failed\n"); grid = -1; return; }
        if (hipOccupancyMaxActiveBlocksPerMultiprocessor(&per_cu, (const void*)fwd, NWAVES * 64, LDS_BYTES) != hipSuccess || per_cu < 1) fprintf(stderr, "kernel_launch: occupancy query says %d\n", per_cu);
        (void)hipGetLastError();
        grid = cus;
    }
    if (grid < 0) return;
    (void)hipMemsetAsync((char*)d_ws + WS_CTL, 0, CTL_ZERO_BYTES, stream);
    Args a{};
    for (int i = 0; i < 33; ++i) a.in[i] = (const float*)d_in[i];
    a.out = (float*)d_out; a.ws = (unsigned char*)d_ws;
#if ONE_LAUNCH
    a.ph_lo = 0; a.ph_hi = NPHASE;
    hipLaunchKernelGGL(fwd, dim3(grid), dim3(NWAVES * 64), LDS_BYTES, stream, a);
#else
    for (int p = 0; p < NPHASE; ++p) { a.ph_lo = p; a.ph_hi = p + 1; hipLaunchKernelGGL(fwd, dim3(grid), dim3(NWAVES * 64), LDS_BYTES, stream, a); }
#endif
}
```

```cpp
#include <hip/hip_runtime.h>
#include <cstdio>
#include <cstdint>

#ifndef ONE_LAUNCH
#define ONE_LAUNCH 1
#endif

#define LAS __attribute__((address_space(3)))
#define GAS __attribute__((address_space(1)))
typedef unsigned short bf16;
typedef unsigned v4u __attribute__((ext_vector_type(4)));
typedef unsigned v2u __attribute__((ext_vector_type(2)));
typedef float f32x4 __attribute__((ext_vector_type(4)));
typedef float f32x2 __attribute__((ext_vector_type(2)));
typedef short bf16x8 __attribute__((ext_vector_type(8)));
typedef short v4i16_t __attribute__((ext_vector_type(4)));

namespace pg8 {
constexpr int BM = 256, BK = 64, HALF = 128, HTB = HALF * BK * 2, STAGE_BYTES = 8 * HTB, NXCD = 8, WGM = 8;
__host__ __device__ __forceinline__ int lds_byte(int r, int c) { const int st = (r >> 4) * 2 + (c >> 5), rr = r & 15, cc = c & 31, ob = rr * 64 + cc * 2; return st * 1024 + (ob ^ (((ob >> 9) & 1) << 5)); }
__host__ __device__ __forceinline__ void stage_rc(int b, int& R, int& C) { const int st = b / 1024, sb = b % 1024, swz = sb ^ (((sb >> 9) & 1) << 5); R = (st >> 1) * 16 + swz / 64; C = (st & 1) * 32 + (swz % 64) / 2; }
__host__ __device__ __forceinline__ int perm32(int rho) { const int n = rho >> 4, i = rho & 15; return 8 * (i >> 2) + 4 * n + (i & 3); }

constexpr int GATHER_LIST_OFF = 131072 + 2048;
struct Unit { int pm, pn, z; const char* A; const char* B; };
struct Dims { int lda, ldb, K; };
typedef int v8i_t __attribute__((ext_vector_type(8)));
typedef int v4i_t __attribute__((ext_vector_type(4)));

__device__ __forceinline__ void tile_of(int wgid, int nM, int nN, int& pm, int& pn) {
    const int nwg = nM * nN;
    { const int q = nwg / NXCD, r = nwg % NXCD, xcd = wgid % NXCD, off = wgid / NXCD; wgid = (xcd < r ? xcd * (q + 1) : r * (q + 1) + (xcd - r) * q) + off; }
    const int nig = WGM * nN, gid = wgid / nig, fm = gid * WGM, gsz = (nM - fm) < WGM ? (nM - fm) : WGM;
    pm = fm + ((wgid % nig) % gsz); pn = (wgid % nig) / gsz;
}
struct StaticOrder {
    int nM, nN, nwg, G, c; const char* A; const char* B; size_t at, bt;
    __device__ void init(int M, int N, int G_, int c_, const void* A_, int lda, const void* B_, int ldb) { nM = M / BM; nN = N / BM; nwg = nM * nN; G = G_; c = c_; A = (const char*)A_; B = (const char*)B_; at = (size_t)BM * lda; bt = (size_t)BM * ldb; }
    __device__ __forceinline__ bool next(int i, Unit& u) const {
        const long Lx = (long)i * G + c; if (Lx >= nwg) return false;
        int pm, pn; tile_of((int)Lx, nM, nN, pm, pn); u.pm = pm; u.pn = pn; u.z = 0; u.A = A + (size_t)pm * at; u.B = B + (size_t)pn * bt; return true;
    }
};

__device__ __forceinline__ unsigned cvt_pk_bf16(float lo, float hi) { unsigned r; asm volatile("v_cvt_pk_bf16_f32 %0, %1, %2" : "=v"(r) : "v"(lo), "v"(hi)); return r; }

template <class Epi, class Sched, bool ALIGN_EPI = false, bool SP2 = false, bool FP8 = false  ,
          bool GATHER = false  >
__device__ __forceinline__ void gemm_phase(LAS unsigned char* lds, const Dims g, const Sched& S, const Epi& E, int tid_in) {
    int tid = tid_in; asm volatile("" : "+v"(tid));
    const int wid = __builtin_amdgcn_readfirstlane(tid >> 6), lane = tid & 63, wr = wid >> 2, wc = wid & 3, fr = lane & 15, fq = lane >> 4;
    const int nt = g.K / (BK * 2);
    unsigned voffA[2], voffB[2];
#pragma unroll
    for (int i = 0; i < 2; ++i) { int R, C; stage_rc(tid * 16 + i * 8192, R, C); const int Rb = Epi::PERM ? ((R & ~31) + perm32(R & 31)) : R;
        voffA[i] = (unsigned)(R * g.lda + C * 2); voffB[i] = (unsigned)(Rb * g.ldb + C * 2); }
    static_assert(!GATHER || SP2, "gathered A rows: SP2 schedule only");
    unsigned vgc[2][2]; bool last_g = false; int nxp_ = 0, gR_ = 0; unsigned gC_ = 0u; (void)last_g; (void)nxp_;
    if constexpr (GATHER) { int R, C; stage_rc(tid * 16, R, C); gR_ = R; gC_ = (unsigned)(C * 2); }
    LAS int* const ntok_ = (LAS int*)(lds + GATHER_LIST_OFF);
#define PG8_GLIST(u, par) do { if (tid < 256) { const int* tb_; int s0_, ce_; S.rowinfo(u, tb_, s0_, ce_); const int s_ = s0_ + tid; ntok_[(par) * 256 + tid] = tb_[s_ < ce_ ? s_ : 0]; } } while (0)
#define PG8_GOFF(par, vg) do { _Pragma("unroll") for (int _h = 0; _h < 2; ++_h) _Pragma("unroll") for (int _i = 0; _i < 2; ++_i) vg[_h][_i] = (unsigned)ntok_[(par) * 256 + gR_ + 64 * _i + 128 * _h] * 1024u + gC_; } while (0)
#define PG8_STAGE_A(slot, ptr, half, SEL) do { if constexpr (GATHER) { if (SEL) { unsigned vt_[2] = {vgc[half][0], vgc[half][1]}; if (last_g) { _Pragma("unroll") for (int _i = 0; _i < 2; ++_i) vt_[_i] = (unsigned)ntok_[nxp_ * 256 + gR_ + 64 * _i + 128 * (half)] * 1024u + gC_; } PG8_STAGE(slot, ptr, vt_); } else PG8_STAGE(slot, ptr, vgc[half]); } else PG8_STAGE(slot, (ptr) + ((half) ? hstepA : (size_t)0), voffA); } while (0)
    const size_t kstep = (size_t)(BK * 2);
    const size_t hstepA = (size_t)HALF * g.lda, hstepB = (size_t)HALF * g.ldb;
    const unsigned ldsw = (unsigned)wid * 1024u;
    const int aoff0 = lds_byte(wr * 64 + fr, fq * 8), aoff1 = aoff0 + 1024;
    const int boff0 = lds_byte(wc * 32 + fr, fq * 8), boff1 = boff0 + 1024;
#define PG8_SA(b, h) (((b) * 2 + (h)) * HTB)
#define PG8_SB(b, h) ((4 + (b) * 2 + (h)) * HTB)
#define PG8_STAGE(bufoff, gbase, voff) do { _Pragma("unroll") for (int _i = 0; _i < 2; ++_i) \
        __builtin_amdgcn_global_load_lds((const unsigned*)((const char*)(gbase) + (voff)[_i]), (LAS unsigned*)(lds + (bufoff) + ldsw + _i * 8192), 16, 0, 0); } while (0)
#define PG8_LDA(dst, b, h) do { _Pragma("unroll") for (int m = 0; m < 4; ++m) _Pragma("unroll") for (int k = 0; k < 2; ++k) dst[m][k] = *(const LAS bf16x8*)(lds + PG8_SA(b, h) + (k ? aoff1 : aoff0) + m * 2048); } while (0)
#define PG8_LDB(dst, b, h) do { _Pragma("unroll") for (int n = 0; n < 2; ++n) _Pragma("unroll") for (int k = 0; k < 2; ++k) dst[n][k] = *(const LAS bf16x8*)(lds + PG8_SB(b, h) + (k ? boff1 : boff0) + n * 2048); } while (0)
#define PG8_MMA(ai, bj, At, Bt) do { __builtin_amdgcn_s_setprio(1); _Pragma("unroll") for (int m = 0; m < 4; ++m) _Pragma("unroll") for (int n = 0; n < 2; ++n) _Pragma("unroll") for (int k = 0; k < 2; ++k) { \
        if constexpr (FP8) acc[ai][bj][m][n] = __builtin_bit_cast(f32x4, __builtin_amdgcn_mfma_i32_16x16x64_i8(__builtin_bit_cast(v4i_t, Bt[n][k]), __builtin_bit_cast(v4i_t, At[m][k]), __builtin_bit_cast(v4i_t, acc[ai][bj][m][n]), 0, 0, 0)); \
        else acc[ai][bj][m][n] = __builtin_amdgcn_mfma_f32_16x16x32_bf16(Bt[n][k], At[m][k], acc[ai][bj][m][n], 0, 0, 0); } __builtin_amdgcn_s_setprio(0); } while (0)
#define PG8_WAIT_V(n) asm volatile("s_waitcnt vmcnt(" #n ")" ::: "memory")
#define PG8_WAIT_L(n) asm volatile("s_waitcnt lgkmcnt(" #n ")" ::: "memory")
#define PG8_BAR __builtin_amdgcn_s_barrier()
#define PG8_SCHED __builtin_amdgcn_sched_barrier(0)
    Unit cur, nxt; int ui = 0;
    if (!S.next(0, cur)) return;
    f32x4 acc[2][2][4][2];
    float zq = 0.f; asm volatile("" : "+v"(zq));
#pragma unroll
    for (int a = 0; a < 2; ++a)
#pragma unroll
        for (int b = 0; b < 2; ++b)
#pragma unroll
            for (int m = 0; m < 4; ++m)
#pragma unroll
                for (int n = 0; n < 2; ++n) acc[a][b][m][n] = (f32x4){zq, zq, zq, zq};
    bf16x8 At[4][2], B0[2][2], B1[2][2];
    const char* cA = cur.A; const char* cB = cur.B;
    if constexpr (SP2) {
        if constexpr (GATHER) { PG8_GLIST(cur, 0); PG8_WAIT_L(0); PG8_BAR; PG8_GOFF(0, vgc); }
        PG8_STAGE(PG8_SB(0, 0), cB, voffB); PG8_STAGE(PG8_SB(0, 1), cB + hstepB, voffB); PG8_STAGE_A(PG8_SA(0, 0), cA, 0, 0); PG8_STAGE_A(PG8_SA(0, 1), cA, 1, 0);
        if (wr == 1) PG8_BAR;
        PG8_WAIT_V(2); PG8_BAR;
        PG8_STAGE(PG8_SB(1, 0), cB + kstep, voffB); PG8_STAGE_A(PG8_SA(1, 0), cA + kstep, 0, 0); PG8_STAGE(PG8_SB(1, 1), cB + hstepB + kstep, voffB);
        PG8_WAIT_V(6); PG8_BAR;
    } else {
        PG8_STAGE(PG8_SB(0, 0), cB, voffB); PG8_STAGE(PG8_SA(0, 0), cA, voffA); PG8_STAGE(PG8_SB(0, 1), cB + hstepB, voffB); PG8_STAGE(PG8_SA(0, 1), cA + hstepA, voffA);
        if (wr == 1) PG8_BAR;
        PG8_WAIT_V(4); PG8_BAR;
        PG8_STAGE(PG8_SB(1, 0), cB + kstep, voffB); PG8_STAGE(PG8_SA(1, 0), cA + kstep, voffA); PG8_STAGE(PG8_SB(1, 1), cB + hstepB + kstep, voffB);
        PG8_WAIT_V(6); PG8_BAR;
    }
    for (;;) {
        const bool has_next = S.next(ui + 1, nxt);
        const char* nA = has_next ? nxt.A : cA; const char* nB = has_next ? nxt.B : cB;
        if constexpr (GATHER) { if (has_next) PG8_GLIST(nxt, (ui + 1) & 1); }
#pragma unroll 1
        for (int t = 0; t < nt; t += 2) {
            const bool last = (t == nt - 2);
            const char* a1 = cA + (size_t)(t + 1) * kstep;
            const char* a2 = last ? nA : cA + (size_t)(t + 2) * kstep; const char* b2 = last ? nB : cB + (size_t)(t + 2) * kstep;
            const char* a3 = a2 + kstep; const char* b3 = b2 + kstep;
            if constexpr (SP2) {
            if constexpr (GATHER) { last_g = last && has_next; nxp_ = (ui + 1) & 1; }
            PG8_LDB(B0, 0, 0); PG8_LDB(B1, 0, 1); PG8_SCHED; PG8_LDA(At, 0, 0); PG8_STAGE_A(PG8_SA(1, 1), a1, 1, 0);
            PG8_WAIT_V(8); PG8_WAIT_L(0); PG8_BAR; PG8_MMA(0, 0, At, B0); PG8_MMA(0, 1, At, B1); PG8_BAR; PG8_SCHED;
            PG8_LDA(At, 0, 1); PG8_STAGE(PG8_SB(0, 0), b2, voffB); PG8_STAGE(PG8_SB(0, 1), b2 + hstepB, voffB); PG8_STAGE_A(PG8_SA(0, 0), a2, 0, 1);
            PG8_WAIT_V(8); PG8_WAIT_L(0); PG8_BAR; PG8_MMA(1, 0, At, B0); PG8_MMA(1, 1, At, B1); PG8_BAR; PG8_SCHED;
            PG8_LDB(B0, 1, 0); PG8_LDB(B1, 1, 1); PG8_SCHED; PG8_LDA(At, 1, 0); PG8_STAGE_A(PG8_SA(0, 1), a2, 1, 1);
            PG8_WAIT_V(8); PG8_WAIT_L(0); PG8_BAR; PG8_MMA(0, 0, At, B0); PG8_MMA(0, 1, At, B1); PG8_BAR; PG8_SCHED;
            PG8_LDA(At, 1, 1); PG8_STAGE(PG8_SB(1, 0), b3, voffB); PG8_STAGE(PG8_SB(1, 1), b3 + hstepB, voffB); PG8_STAGE_A(PG8_SA(1, 0), a3, 0, 1);
            PG8_WAIT_V(8); PG8_WAIT_L(0); PG8_BAR; PG8_MMA(1, 0, At, B0); PG8_MMA(1, 1, At, B1); PG8_BAR; PG8_SCHED;
            } else {
            PG8_LDB(B0, 0, 0); PG8_SCHED; PG8_LDA(At, 0, 0); PG8_STAGE(PG8_SA(1, 1), a1 + hstepA, voffA);
            PG8_WAIT_L(8); PG8_BAR; PG8_WAIT_L(0); PG8_MMA(0, 0, At, B0); PG8_BAR; PG8_SCHED;
            PG8_LDB(B1, 0, 1); PG8_STAGE(PG8_SB(0, 0), b2, voffB);
            PG8_BAR; PG8_WAIT_L(0); PG8_MMA(0, 1, At, B1); PG8_BAR;
            PG8_LDA(At, 0, 1); PG8_STAGE(PG8_SA(0, 0), a2, voffA);
            PG8_BAR; PG8_WAIT_L(0); PG8_MMA(1, 0, At, B0); PG8_BAR; PG8_SCHED;
            PG8_STAGE(PG8_SB(0, 1), b2 + hstepB, voffB);
            PG8_WAIT_V(6); PG8_BAR; PG8_MMA(1, 1, At, B1); PG8_BAR;
            PG8_LDB(B0, 1, 0); PG8_SCHED; PG8_LDA(At, 1, 0); PG8_STAGE(PG8_SA(0, 1), a2 + hstepA, voffA);
            PG8_WAIT_L(8); PG8_BAR; PG8_WAIT_L(0); PG8_MMA(0, 0, At, B0); PG8_BAR; PG8_SCHED;
            PG8_LDB(B1, 1, 1); PG8_STAGE(PG8_SB(1, 0), b3, voffB);
            PG8_BAR; PG8_WAIT_L(0); PG8_MMA(0, 1, At, B1); PG8_BAR;
            PG8_LDA(At, 1, 1); PG8_STAGE(PG8_SA(1, 0), a3, voffA);
            PG8_BAR; PG8_WAIT_L(0); PG8_MMA(1, 0, At, B0); PG8_BAR; PG8_SCHED;
            PG8_STAGE(PG8_SB(1, 1), b3 + hstepB, voffB);
            PG8_WAIT_V(6); PG8_BAR; PG8_MMA(1, 1, At, B1); PG8_BAR;
            }
        }
        if constexpr (ALIGN_EPI) { if (wr == 0) PG8_BAR; }
        E(acc, cur, wr, wc, fr, fq);
        if (!has_next) break;
#pragma unroll
        for (int a = 0; a < 2; ++a)
#pragma unroll
            for (int b = 0; b < 2; ++b)
#pragma unroll
                for (int m = 0; m < 4; ++m)
#pragma unroll
                    for (int n = 0; n < 2; ++n) acc[a][b][m][n] = (f32x4){zq, zq, zq, zq};
        cur = nxt; cA = nA; cB = nB; ++ui;
        if constexpr (GATHER) PG8_GOFF(ui & 1, vgc);
        if constexpr (ALIGN_EPI) { if (wr == 1) PG8_BAR; }
    }
    PG8_WAIT_V(0);
    if constexpr (!ALIGN_EPI) { if (wr == 0) PG8_BAR; }
    PG8_BAR;
#undef PG8_GOFF
#undef PG8_GLIST
#undef PG8_STAGE_A
#undef PG8_SA
#undef PG8_SB
#undef PG8_STAGE
#undef PG8_LDA
#undef PG8_LDB
#undef PG8_MMA
#undef PG8_WAIT_V
#undef PG8_WAIT_L
#undef PG8_BAR
#undef PG8_SCHED
}
}

constexpr int NB = 2, T = 8192, D = 1024, M = NB * T, NL = 4;
constexpr int DIN = 7592, NP = 8192;
constexpr int PC_QLAT = 0, PC_CKV = 1024, PC_KIDX = 1152, PC_WIDX = 1184, PC_QIDX = 1280, PC_CU = 1536, PC_GB = 2048, PC_GC = 2560, PC_SU = 3072, PC_MQ = 3584, PC_GATE = 4096;
constexpr int SC_Q = 0, SC_CKV = 512, SC_QIDX = 640, SC_KIDX = 896, SC_WIDX = 928, SC_CU = 936, SC_GB = 1448, SC_GC = 1960, SC_SU = 2472, SC_MQ = 2984, SC_GATE = 3496;
constexpr float QS_H = 127.f / 5.f, QS_WUP = 127.f / (4.5f * 0.03125f), QS_ACT = 127.f / 12.f, QS_WDN = 127.f / (4.5f * 0.013139006f), QS_WIN = 127.f / (4.5f * 0.03125f), QS_WQL = 8.f * QS_WIN;
constexpr int NE = 32, FE = 1024, MAXBLK = 288, MOE_ROWS = MAXBLK * 256;
constexpr int SSM_LC = 32, SSM_NC = T / SSM_LC, SSM_K = SSM_LC * 16 + 128;
constexpr float LN_EPS = 1e-5f;
constexpr float DN_ALPHA = 1.681792830507429f;

constexpr size_t MiB = 1u << 20;
constexpr size_t WS_CTL = 0, CTL_ZERO_BYTES = 1 * MiB;
constexpr size_t WS_WIN = 1 * MiB;
constexpr size_t WS_WGLU = WS_WIN + (size_t)NL * NP * D * 2;
constexpr size_t WS_WMKV = WS_WGLU + (size_t)NL * 512 * 512 * 2;
constexpr size_t WS_WUV = WS_WMKV + (size_t)NL * 1024 * 1024 * 2;
constexpr size_t WS_WBR = WS_WUV + (size_t)NL * 512 * 1024 * 2;
constexpr size_t WS_WO = WS_WBR + (size_t)NL * 4 * 1024 * 512 * 2;
constexpr size_t WS_WUP = WS_WO + (size_t)NL * 1024 * 1024 * 2;
constexpr size_t WS_WDN = WS_WUP + (size_t)NL * NE * 2048 * 1024 * 2;
constexpr size_t WS_S5A = WS_WDN + (size_t)NL * NE * 1024 * 1024 * 2;
constexpr size_t WS_S5B = WS_S5A + 1 * MiB;
constexpr size_t WS_MEMB = WS_S5B + 1 * MiB;
constexpr size_t WS_MKV = WS_MEMB + 1 * MiB;
constexpr size_t WS_H = WS_MKV + 4 * MiB;
constexpr size_t WS_HB = WS_H + (size_t)M * D * 4;
constexpr size_t WS_PROJ = WS_HB + (size_t)M * D * 2;
constexpr size_t WS_KVN = WS_PROJ + (size_t)M * NP * 2;
constexpr size_t WS_OLAT = WS_KVN + (size_t)M * 128 * 2;
constexpr size_t WS_BR = WS_OLAT + (size_t)M * 1024 * 2;
constexpr size_t WS_Z = WS_BR + (size_t)M * 2048 * 2;
constexpr size_t WS_MRG = WS_Z + (size_t)M * 512 * 2;
constexpr size_t WS_MRGB = WS_MRG + (size_t)M * D * 4;
constexpr size_t WS_V = WS_MRGB + (size_t)M * D * 2;
constexpr size_t WS_H1 = WS_V + (size_t)M * D * 4;
constexpr size_t WS_H1B = WS_H1 + (size_t)M * D * 4;
constexpr size_t WS_SSE = WS_H1B + (size_t)M * D * 2;
constexpr size_t WS_SSC = WS_SSE + (size_t)NB * SSM_NC * 32 * 64 * 8;
constexpr size_t WS_TOK = WS_SSC + (size_t)NB * SSM_NC * 32 * 64 * 8;
constexpr size_t WS_GATE = WS_TOK + (size_t)NE * M * 4;
constexpr size_t WS_SLOT = WS_GATE + (size_t)NE * M * 4;
constexpr size_t WS_XS = WS_SLOT + (size_t)M * 4 * 4;
constexpr size_t WS_ACT = WS_XS + (size_t)MOE_ROWS * 1024 * 2;
constexpr size_t WS_SCR = WS_ACT + (size_t)MOE_ROWS * 1024 * 2;
constexpr size_t WS_KIDX = WS_SCR + (size_t)256 * 2 * 8 * 8192 * 4;
constexpr size_t WS_WSSM = WS_KIDX + (size_t)M * 32 * 2;
constexpr size_t WS_AEXT = WS_WSSM + (size_t)NL * 32 * 512 * SSM_K * 2;
constexpr size_t WS_WE = WS_AEXT + (size_t)32 * 512 * SSM_K * 2;
constexpr size_t WS_END = WS_WE + (size_t)NL * 32 * 256 * 512 * 2;
constexpr int CW_TMO = 0, CW_BAR = 4096, CW_CNT = 16384, CW_Q0 = 2048;

constexpr int RING_BYTES = 131072, LDSCTL_OFF = RING_BYTES, MISC_OFF = LDSCTL_OFF + 320, LDS_BYTES = 147456;
constexpr int NWAVES = 8;

#define RLX_AGENT __ATOMIC_RELAXED, __HIP_MEMORY_SCOPE_AGENT
#define LDS_WAIT() asm volatile("s_waitcnt lgkmcnt(0)" ::: "memory")
#define VM_WAIT() asm volatile("s_waitcnt vmcnt(0)" ::: "memory")
__device__ __forceinline__ unsigned f2bf(float f) { unsigned u = __builtin_bit_cast(unsigned, f); return (u + 0x7fffu + ((u >> 16) & 1u)) >> 16; }
__device__ __forceinline__ unsigned pk2(float lo, float hi) { return f2bf(lo) | (f2bf(hi) << 16); }
__device__ __forceinline__ float bflo(unsigned w) { return __builtin_bit_cast(float, w << 16); }
__device__ __forceinline__ float bfhi(unsigned w) { return __builtin_bit_cast(float, w & 0xffff0000u); }
__device__ __forceinline__ float bf1(bf16 v) { return __builtin_bit_cast(float, (unsigned)v << 16); }
__device__ __forceinline__ unsigned q8_(float x, float s) { return (unsigned)(int)__builtin_rintf(fminf(fmaxf(x * s, -127.f), 127.f)) & 255u; }
__device__ __forceinline__ unsigned q8x4(float a, float b, float c, float d, float s) { return q8_(a, s) | (q8_(b, s) << 8) | (q8_(c, s) << 16) | (q8_(d, s) << 24); }
__device__ __forceinline__ float sigmoidf_(float x) { return __builtin_amdgcn_rcpf(1.f + __expf(-x)); }
__device__ __forceinline__ int lane_op() { int l = (int)__builtin_amdgcn_mbcnt_hi(~0u, __builtin_amdgcn_mbcnt_lo(~0u, 0u)); asm volatile("" : "+v"(l)); return l; }
template <class Tv> __device__ __forceinline__ Tv bperm_(int srcLane, Tv v) { return __builtin_bit_cast(Tv, __builtin_amdgcn_ds_bpermute(srcLane << 2, __builtin_bit_cast(int, v))); }
#define SHX(v, m, l) bperm_((l) ^ (m), (v))
#define SHD(v, o, l) bperm_((l) + (o), (v))
#define SHI(v, s) bperm_((s), (v))
__device__ __forceinline__ float wave_sum(float v) { const int l = lane_op();
#pragma unroll
    for (int o = 1; o < 64; o <<= 1) v += SHX(v, o, l);
    return v;
}
__device__ __forceinline__ float wave_max(float v) { const int l = lane_op();
#pragma unroll
    for (int o = 1; o < 64; o <<= 1) v = fmaxf(v, SHX(v, o, l));
    return v;
}

#define DPP_STEP_(T, v, ctrl, rm, idbits, OP) { const T t_ = __builtin_bit_cast(T, __builtin_amdgcn_update_dpp((int)(idbits), __builtin_bit_cast(int, v), ctrl, rm, 0xf, false)); v = OP(v, t_); }
#define DPP_ADD_(a, b) ((a) + (b))
__device__ __forceinline__ unsigned dpp_scan_add_u32(unsigned v) {
    DPP_STEP_(unsigned, v, 0x111, 0xf, 0, DPP_ADD_) DPP_STEP_(unsigned, v, 0x112, 0xf, 0, DPP_ADD_) DPP_STEP_(unsigned, v, 0x114, 0xf, 0, DPP_ADD_) DPP_STEP_(unsigned, v, 0x118, 0xf, 0, DPP_ADD_)
    DPP_STEP_(unsigned, v, 0x142, 0xa, 0, DPP_ADD_) DPP_STEP_(unsigned, v, 0x143, 0xc, 0, DPP_ADD_) return v; }
__device__ __forceinline__ float wave_sum_dpp(float v) {
    DPP_STEP_(float, v, 0x111, 0xf, 0, DPP_ADD_) DPP_STEP_(float, v, 0x112, 0xf, 0, DPP_ADD_) DPP_STEP_(float, v, 0x114, 0xf, 0, DPP_ADD_) DPP_STEP_(float, v, 0x118, 0xf, 0, DPP_ADD_)
    DPP_STEP_(float, v, 0x142, 0xa, 0, DPP_ADD_) DPP_STEP_(float, v, 0x143, 0xc, 0, DPP_ADD_)
    return __builtin_bit_cast(float, __builtin_amdgcn_readlane(__builtin_bit_cast(int, v), 63)); }
__device__ __forceinline__ float wave_max_dpp(float v) {
    DPP_STEP_(float, v, 0x111, 0xf, 0xff800000u, fmaxf) DPP_STEP_(float, v, 0x112, 0xf, 0xff800000u, fmaxf) DPP_STEP_(float, v, 0x114, 0xf, 0xff800000u, fmaxf) DPP_STEP_(float, v, 0x118, 0xf, 0xff800000u, fmaxf)
    DPP_STEP_(float, v, 0x142, 0xa, 0xff800000u, fmaxf) DPP_STEP_(float, v, 0x143, 0xc, 0xff800000u, fmaxf)
    return __builtin_bit_cast(float, __builtin_amdgcn_readlane(__builtin_bit_cast(int, v), 63)); }

#define XB_TMO      128
#define XB_XCNT(j)  (256  + 64 * (j))
#define XB_XSUB(j)  (1280 + 64 * (j))
#define XB_XGEN(j)  (2304 + 64 * (j))
#define XB_TOP      3328
#define XB_TOPGEN   3392
#define XCD_BAR_WORDS 3456
#define XB_SPIN_CAP (1u << 18)
__device__ __forceinline__ unsigned xb_ld(unsigned* p)              { return __hip_atomic_load(p, __ATOMIC_RELAXED, __HIP_MEMORY_SCOPE_AGENT); }
__device__ __forceinline__ unsigned xb_add(unsigned* p, unsigned v) { return __hip_atomic_fetch_add(p, v, __ATOMIC_RELAXED, __HIP_MEMORY_SCOPE_AGENT); }
__device__ __forceinline__ unsigned xb_xcc_id() { return (unsigned)__builtin_amdgcn_s_getreg((3 << 11) | 20) & 0xFu; }
#define XB_SPIN(cond, bar) do { unsigned _sp = 0; while (cond) { __builtin_amdgcn_s_sleep(1); \
    if ((++_sp & 255u) == 0u) { if (xb_ld(&(bar)[XB_TMO])) break; if (_sp > XB_SPIN_CAP) { atomicAdd(&(bar)[XB_TMO], 1u); break; } } } } while (0)
struct XcdBarrier { unsigned* bar; unsigned x; volatile LAS unsigned* st; };
__device__ __forceinline__ XcdBarrier xcd_barrier_post(unsigned* bar, volatile LAS unsigned* st) {
    XcdBarrier b; b.bar = bar; b.x = xb_xcc_id(); b.st = st;
    if (threadIdx.x == 0) st[2] = xb_add(&bar[XB_XCNT(b.x)], 1u);
    return b;
}
__device__ __forceinline__ void xcd_barrier_complete(unsigned* bar, unsigned x, unsigned& nloc, unsigned& nx, unsigned& balanced) {
    const unsigned G = gridDim.x * gridDim.y * gridDim.z;
    unsigned sum, cnt, mine, sp = 0u, bal;
    for (;;) {
        sum = 0u; cnt = 0u; mine = 0u; bal = 1u;
#pragma unroll 1
        for (unsigned j = 0; j < 16; ++j) { const unsigned c = xb_ld(&bar[XB_XCNT(j)]); sum += c; cnt += (c > 0u) ? 1u : 0u; mine = (j == x) ? c : mine; bal = (c == (j < 8u ? (G >> 3) : 0u)) ? bal : 0u; }
        if (sum == G) break;
        __builtin_amdgcn_s_sleep(1);
        if ((++sp & 255u) == 0u) { if (xb_ld(&bar[XB_TMO])) break; if (sp > XB_SPIN_CAP) { atomicAdd(&bar[XB_TMO], 1u); break; } }
    }
    nloc = mine > 0u ? mine : 1u; nx = cnt > 0u ? cnt : 1u; balanced = ((G & 7u) == 0u && sum == G) ? bal : 0u;
}
__device__ __forceinline__ void xcd_barrier(const XcdBarrier& b, int tid_) {
    asm volatile("s_waitcnt vmcnt(0)" ::: "memory");
    __syncthreads();
    if (tid_ == 0) {
        unsigned* bar = b.bar;
        __builtin_amdgcn_s_waitcnt(0);
        unsigned nloc = b.st[0], nx = b.st[1];
        if (nloc == 0u) { unsigned bal_; xcd_barrier_complete(bar, b.x, nloc, nx, bal_); b.st[0] = nloc; b.st[1] = nx;
            b.st[3] = (bal_ ? b.st[2] * 8u + b.x : (unsigned)blockIdx.x) + 1u; }
        const unsigned old = xb_add(&bar[XB_XSUB(b.x)], 1u);
        const unsigned gen = old / nloc;
        if (old + 1u == (gen + 1u) * nloc) {
            __builtin_amdgcn_fence(__ATOMIC_RELEASE, "agent");
            asm volatile("s_waitcnt vmcnt(0)" ::: "memory");
            const unsigned og = xb_add(&bar[XB_TOP], 1u);
            const unsigned tg = og / nx;
            if (og + 1u == (tg + 1u) * nx) xb_add(&bar[XB_TOPGEN], 1u);
            else XB_SPIN(xb_ld(&bar[XB_TOPGEN]) == tg, bar);
            __builtin_amdgcn_fence(__ATOMIC_ACQUIRE, "agent");
            xb_add(&bar[XB_XGEN(b.x)], 1u);
            asm volatile("s_waitcnt vmcnt(0)" ::: "memory");
        } else {
            XB_SPIN(xb_ld(&bar[XB_XGEN(b.x)]) == gen, bar);
            __builtin_amdgcn_fence(__ATOMIC_ACQUIRE, "agent");
            asm volatile("s_waitcnt vmcnt(0)" ::: "memory");
        }
    }
    __syncthreads();
}

__device__ __forceinline__ unsigned long long ldp(volatile LAS unsigned long long* PT, int k) { const unsigned long long v = PT[k];
    const unsigned lo = __builtin_amdgcn_readfirstlane((unsigned)v), hi = __builtin_amdgcn_readfirstlane((unsigned)(v >> 32)); return ((unsigned long long)hi << 32) | lo; }
typedef __attribute__((address_space(1))) unsigned char gu8_t;
__device__ __forceinline__ unsigned char* gptr(unsigned long long v) { return (unsigned char*)(gu8_t*)v; }
struct Args { const float* in[33]; float* out; unsigned char* ws; int ph_lo, ph_hi; };

struct Frame {
    LAS unsigned char* lds;
    int tid, lane, wave, G, gw, NGW, bx;
};

using pg8::Unit; using pg8::cvt_pk_bf16; using pg8::v4i_t;
struct EpiBf16 {
    static constexpr bool PERM = true;
    bf16* O; int ldc;
    __device__ __forceinline__ void operator()(const f32x4 (&acc)[2][2][4][2], const Unit& u, int wr, int wc, int fr, int fq) const {
        const int row0 = u.pm * 256 + wr * 64 + fr, col0 = u.pn * 256 + wc * 32 + 8 * fq;
#pragma unroll
        for (int ai = 0; ai < 2; ++ai)
#pragma unroll
            for (int m = 0; m < 4; ++m) { bf16* rowp = O + (size_t)(row0 + ai * 128 + m * 16) * ldc + col0;
#pragma unroll
                for (int bj = 0; bj < 2; ++bj) { const f32x4 v0 = acc[ai][bj][m][0], v1 = acc[ai][bj][m][1];
                    v4u w; w.x = cvt_pk_bf16(v0[0], v0[1]); w.y = cvt_pk_bf16(v0[2], v0[3]); w.z = cvt_pk_bf16(v1[0], v1[1]); w.w = cvt_pk_bf16(v1[2], v1[3]);
                    *(v4u*)(rowp + bj * 128) = w; } }
    }
};
struct EpiProjQ {
    static constexpr bool PERM = true;
    bf16* O; int ldc; bf16* AX;
    __device__ __forceinline__ void operator()(const f32x4 (&acc)[2][2][4][2], const Unit& u, int wr, int wc, int fr, int fq) const {
        const int row0 = u.pm * 256 + wr * 64 + fr, col0 = u.pn * 256 + wc * 32 + 8 * fq; const float dq = 1.f / (QS_H * (u.pn < 4 ? QS_WQL : QS_WIN));
#pragma unroll
        for (int ai = 0; ai < 2; ++ai)
#pragma unroll
            for (int m = 0; m < 4; ++m) { bf16* rowp = O + (size_t)(row0 + ai * 128 + m * 16) * ldc + col0;
#pragma unroll
                for (int bj = 0; bj < 2; ++bj) { const v4i_t i0 = __builtin_bit_cast(v4i_t, acc[ai][bj][m][0]), i1 = __builtin_bit_cast(v4i_t, acc[ai][bj][m][1]);
                    v4u w; w.x = cvt_pk_bf16((float)i0[0] * dq, (float)i0[1] * dq); w.y = cvt_pk_bf16((float)i0[2] * dq, (float)i0[3] * dq); w.z = cvt_pk_bf16((float)i1[0] * dq, (float)i1[1] * dq); w.w = cvt_pk_bf16((float)i1[2] * dq, (float)i1[3] * dq);
                    if (u.pn == 12 || u.pn == 13) { const int m_ = row0 + ai * 128 + m * 16, ch = (u.pn - 12) * 256 + wc * 32 + 8 * fq + bj * 128, tl = m_ & (T - 1);
                        *(v4u*)(AX + ((size_t)((ch >> 4) * 512 + (m_ >> 13) * 256 + (tl >> 5))) * SSM_K + (tl & 31) * 16 + (ch & 15)) = w; }
                    else *(v4u*)(rowp + bj * 128) = w; } }
    }
};
struct EpiE {
    static constexpr bool PERM = true;
    float* E2;
    __device__ __forceinline__ void operator()(const f32x4 (&acc)[2][2][4][2], const Unit& u, int wr, int wc, int fr, int fq) const {
        const int row0 = u.pm * 256 + wr * 64 + fr, col0 = wc * 32 + 8 * fq;
#pragma unroll
        for (int ai = 0; ai < 2; ++ai)
#pragma unroll
            for (int m = 0; m < 4; ++m) { float* p = E2 + ((size_t)(row0 + ai * 128 + m * 16) * 32 + u.z) * 128 + col0; *(f32x4*)p = acc[ai][0][m][0]; *(f32x4*)(p + 4) = acc[ai][0][m][1]; }
    }
};
struct EOrder {
    int G, c; const char* A; const char* B;
    __device__ __forceinline__ bool next(int i, Unit& u) const {
        const int Lx = i * G + c; if (Lx >= 64) return false;
        const int g = Lx >> 1, pm = Lx & 1; u.pm = pm; u.pn = 0; u.z = g; u.A = A + ((size_t)g * 512 + pm * 256) * SSM_K * 2; u.B = B + (size_t)g * 256 * 512 * 2; return true;
    }
};
struct EpiMkv {
    static constexpr bool PERM = true;
    bf16* O;
    __device__ __forceinline__ void operator()(const f32x4 (&acc)[2][2][4][2], const Unit& u, int wr, int wc, int fr, int fq) const {
        EpiBf16 e{O + (size_t)u.z * 512 * 1024, 1024}; e(acc, u, wr, wc, fr, fq);
    }
};
struct EpiGlu {
    static constexpr bool PERM = true;
    const bf16* Z; int ldz; const float* bias; bf16* O; int ldo;
    __device__ __forceinline__ void operator()(const f32x4 (&acc)[2][2][4][2], const Unit& u, int wr, int wc, int fr, int fq) const {
        const int row0 = u.pm * 256 + wr * 64 + fr, col0 = u.pn * 256 + wc * 32 + 8 * fq;
        f32x4 bv[2][2];
#pragma unroll
        for (int bj = 0; bj < 2; ++bj)
#pragma unroll
            for (int n = 0; n < 2; ++n) bv[bj][n] = *(const f32x4*)(bias + col0 + bj * 128 + 4 * n);
#pragma unroll
        for (int ai = 0; ai < 2; ++ai) { v4u zq[4][2];
#pragma unroll
            for (int m = 0; m < 4; ++m)
#pragma unroll
                for (int bj = 0; bj < 2; ++bj) zq[m][bj] = *(const v4u*)(Z + (size_t)(row0 + ai * 128 + m * 16) * ldz + col0 + bj * 128);
#pragma unroll
            for (int m = 0; m < 4; ++m) { const size_t r = (size_t)(row0 + ai * 128 + m * 16);
#pragma unroll
                for (int bj = 0; bj < 2; ++bj) { const f32x4 v0 = acc[ai][bj][m][0] + bv[bj][0], v1 = acc[ai][bj][m][1] + bv[bj][1];
                    const v4u zz = zq[m][bj];
                    v4u w;
                    w.x = cvt_pk_bf16(bflo(zz.x) * sigmoidf_(v0[0]), bfhi(zz.x) * sigmoidf_(v0[1]));
                    w.y = cvt_pk_bf16(bflo(zz.y) * sigmoidf_(v0[2]), bfhi(zz.y) * sigmoidf_(v0[3]));
                    w.z = cvt_pk_bf16(bflo(zz.z) * sigmoidf_(v1[0]), bfhi(zz.z) * sigmoidf_(v1[1]));
                    w.w = cvt_pk_bf16(bflo(zz.w) * sigmoidf_(v1[2]), bfhi(zz.w) * sigmoidf_(v1[3]));
                    *(v4u*)(O + r * ldo + col0 + bj * 128) = w; } } }
    }
};
struct EpiMerge {
    static constexpr bool PERM = true;
    const bf16* G; int ldg; bf16* Mb;
    __device__ __forceinline__ void operator()(const f32x4 (&acc)[2][2][4][2], const Unit& u, int wr, int wc, int fr, int fq) const {
        const int row0 = u.pm * 256 + wr * 64 + fr, col0 = u.pn * 256 + wc * 32 + 8 * fq; const int r = u.z;
#pragma unroll
        for (int ai = 0; ai < 2; ++ai) { v4u gq[4][2], pq[4][2];
#pragma unroll
            for (int m = 0; m < 4; ++m) { const size_t rr = (size_t)(row0 + ai * 128 + m * 16);
#pragma unroll
                for (int bj = 0; bj < 2; ++bj) { const int c = col0 + bj * 128; gq[m][bj] = *(const v4u*)(G + rr * ldg + r * 1024 + c); pq[m][bj] = (v4u){0u, 0u, 0u, 0u}; if (r) pq[m][bj] = *(const v4u*)(Mb + rr * 1024 + c); } }
#pragma unroll
            for (int m = 0; m < 4; ++m) { const size_t rr = (size_t)(row0 + ai * 128 + m * 16);
#pragma unroll
                for (int bj = 0; bj < 2; ++bj) { const int c = col0 + bj * 128;
                    const v4u gg = gq[m][bj], pv = pq[m][bj]; bf16* mp = Mb + rr * 1024 + c;
                    f32x4 o0 = (f32x4){bflo(pv.x), bfhi(pv.x), bflo(pv.y), bfhi(pv.y)}, o1 = (f32x4){bflo(pv.z), bfhi(pv.z), bflo(pv.w), bfhi(pv.w)};
                    const f32x4 v0 = acc[ai][bj][m][0], v1 = acc[ai][bj][m][1];
                    o0[0] += sigmoidf_(bflo(gg.x)) * v0[0]; o0[1] += sigmoidf_(bfhi(gg.x)) * v0[1]; o0[2] += sigmoidf_(bflo(gg.y)) * v0[2]; o0[3] += sigmoidf_(bfhi(gg.y)) * v0[3];
                    o1[0] += sigmoidf_(bflo(gg.z)) * v1[0]; o1[1] += sigmoidf_(bfhi(gg.z)) * v1[1]; o1[2] += sigmoidf_(bflo(gg.w)) * v1[2]; o1[3] += sigmoidf_(bfhi(gg.w)) * v1[3];
                    v4u w; w.x = cvt_pk_bf16(o0[0], o0[1]); w.y = cvt_pk_bf16(o0[2], o0[3]); w.z = cvt_pk_bf16(o1[0], o1[1]); w.w = cvt_pk_bf16(o1[2], o1[3]); *(v4u*)mp = w; } } }
    }
};
struct EpiWo {
    static constexpr bool PERM = true;
    const bf16* H; bf16* V;
    __device__ __forceinline__ void operator()(const f32x4 (&acc)[2][2][4][2], const Unit& u, int wr, int wc, int fr, int fq) const {
        const int row0 = u.pm * 256 + wr * 64 + fr, col0 = u.pn * 256 + wc * 32 + 8 * fq;
#pragma unroll
        for (int ai = 0; ai < 2; ++ai) { v4u hq[4][2];
#pragma unroll
            for (int m = 0; m < 4; ++m)
#pragma unroll
                for (int bj = 0; bj < 2; ++bj) hq[m][bj] = *(const v4u*)(H + (size_t)(row0 + ai * 128 + m * 16) * 1024 + col0 + bj * 128);
#pragma unroll
            for (int m = 0; m < 4; ++m) { const size_t off = (size_t)(row0 + ai * 128 + m * 16) * 1024 + col0;
#pragma unroll
                for (int bj = 0; bj < 2; ++bj) { const v4u hh = hq[m][bj]; const f32x4 v0 = acc[ai][bj][m][0], v1 = acc[ai][bj][m][1];
                    v4u w; w.x = cvt_pk_bf16(bflo(hh.x) * DN_ALPHA + v0[0], bfhi(hh.x) * DN_ALPHA + v0[1]); w.y = cvt_pk_bf16(bflo(hh.y) * DN_ALPHA + v0[2], bfhi(hh.y) * DN_ALPHA + v0[3]);
                    w.z = cvt_pk_bf16(bflo(hh.z) * DN_ALPHA + v1[0], bfhi(hh.z) * DN_ALPHA + v1[1]); w.w = cvt_pk_bf16(bflo(hh.w) * DN_ALPHA + v1[2], bfhi(hh.w) * DN_ALPHA + v1[3]);
                    *(v4u*)(V + off + bj * 128) = w; } } }
    }
};
struct EpiUp {
    static constexpr bool PERM = true;
    const float* bup; unsigned char* ACT;
    __device__ __forceinline__ void operator()(const f32x4 (&acc)[2][2][4][2], const Unit& u, int wr, int wc, int fr, int fq) const {
        const int row0 = u.pm * 256 + wr * 64 + fr, col0 = u.pn * 256 + wc * 32 + 8 * fq; const float* bb = bup + (size_t)u.z * 2048; const float dq = 1.f / (QS_H * QS_WUP);
        f32x4 bv[2][2];
#pragma unroll
        for (int bj = 0; bj < 2; ++bj)
#pragma unroll
            for (int n = 0; n < 2; ++n) bv[bj][n] = *(const f32x4*)(bb + col0 + bj * 128 + 4 * n);
#pragma unroll
        for (int ai = 0; ai < 2; ++ai)
#pragma unroll
            for (int m = 0; m < 4; ++m) { const size_t r = (size_t)(row0 + ai * 128 + m * 16);
#pragma unroll
                for (int bj = 0; bj < 2; ++bj) { const v4i_t i0 = __builtin_bit_cast(v4i_t, acc[ai][bj][m][0]), i1 = __builtin_bit_cast(v4i_t, acc[ai][bj][m][1]);
                    const f32x4 v0 = (f32x4){(float)i0[0], (float)i0[1], (float)i0[2], (float)i0[3]} * dq + bv[bj][0], v1 = (f32x4){(float)i1[0], (float)i1[1], (float)i1[2], (float)i1[3]} * dq + bv[bj][1];
                    float a[4];
#pragma unroll
                    for (int j = 0; j < 4; ++j) { const float gx = j < 2 ? v0[2 * j] : v1[2 * j - 4], lx = j < 2 ? v0[2 * j + 1] : v1[2 * j - 3];
                        const float gl = fminf(gx, 7.0f), li = fminf(fmaxf(lx, -7.0f), 7.0f); a[j] = gl * sigmoidf_(1.702f * gl) * (li + 1.0f); }
                    *(unsigned*)(ACT + r * 1024 + ((col0 + bj * 128) >> 1)) = q8x4(a[0], a[1], a[2], a[3], QS_ACT); } }
    }
};
struct EpiDown {
    static constexpr bool PERM = true;
    const float* bdn; const float* grow; bf16* YS;
    __device__ __forceinline__ void operator()(const f32x4 (&acc)[2][2][4][2], const Unit& u, int wr, int wc, int fr, int fq) const {
        const int row0 = u.pm * 256 + wr * 64 + fr, col0 = u.pn * 256 + wc * 32 + 8 * fq; const float* bb = bdn + (size_t)u.z * 1024; const float dq = 1.f / (QS_ACT * QS_WDN);
        f32x4 bv[2][2];
#pragma unroll
        for (int bj = 0; bj < 2; ++bj)
#pragma unroll
            for (int n = 0; n < 2; ++n) bv[bj][n] = *(const f32x4*)(bb + col0 + bj * 128 + 4 * n);
        float gq[2][4];
#pragma unroll
        for (int ai = 0; ai < 2; ++ai)
#pragma unroll
            for (int m = 0; m < 4; ++m) gq[ai][m] = grow[(size_t)(row0 + ai * 128 + m * 16)];
#pragma unroll
        for (int ai = 0; ai < 2; ++ai)
#pragma unroll
            for (int m = 0; m < 4; ++m) { const size_t r = (size_t)(row0 + ai * 128 + m * 16); const float gt = gq[ai][m];
#pragma unroll
                for (int bj = 0; bj < 2; ++bj) { const v4i_t i0 = __builtin_bit_cast(v4i_t, acc[ai][bj][m][0]), i1 = __builtin_bit_cast(v4i_t, acc[ai][bj][m][1]);
                    const f32x4 v0 = ((f32x4){(float)i0[0], (float)i0[1], (float)i0[2], (float)i0[3]} * dq + bv[bj][0]) * gt, v1 = ((f32x4){(float)i1[0], (float)i1[1], (float)i1[2], (float)i1[3]} * dq + bv[bj][1]) * gt;
                    v4u w; w.x = cvt_pk_bf16(v0[0], v0[1]); w.y = cvt_pk_bf16(v0[2], v0[3]); w.z = cvt_pk_bf16(v1[0], v1[1]); w.w = cvt_pk_bf16(v1[2], v1[3]);
                    *(v4u*)(YS + r * 1024 + col0 + bj * 128) = w; } }
    }
};
struct EpiSsm {
    static constexpr bool PERM = true;
    bf16* Z;
    __device__ __forceinline__ void operator()(const f32x4 (&acc)[2][2][4][2], const Unit& u, int wr, int wc, int fr, int fq) const {
        const int row0 = u.pm * 256 + wr * 64 + fr, col0 = u.pn * 256 + wc * 32 + 8 * fq;
#pragma unroll
        for (int ai = 0; ai < 2; ++ai)
#pragma unroll
            for (int m = 0; m < 4; ++m) { const int row = row0 + ai * 128 + m * 16; const size_t tokb = (size_t)(row >> 8) * T + (size_t)(row & 255) * SSM_LC;
#pragma unroll
                for (int bj = 0; bj < 2; ++bj) { const int col = col0 + bj * 128; const f32x4 v0 = acc[ai][bj][m][0], v1 = acc[ai][bj][m][1]; float z[8];
#pragma unroll
                    for (int j = 0; j < 8; ++j) { const float y = j < 4 ? v0[j] : v1[j - 4]; const float x3 = 0.7978845608028654f * (y + 0.044715f * y * y * y); const float th = 1.f - 2.f * __builtin_amdgcn_rcpf(__expf(2.f * x3) + 1.f); z[j] = 0.5f * y * (1.f + th); }
                    v4u w; w.x = cvt_pk_bf16(z[0], z[1]); w.y = cvt_pk_bf16(z[2], z[3]); w.z = cvt_pk_bf16(z[4], z[5]); w.w = cvt_pk_bf16(z[6], z[7]);
                    *(v4u*)(Z + (tokb + (col >> 4)) * 512 + u.z * 16 + (col & 15)) = w; } }
    }
};
struct SsmOrder {
    int G, c; const char* A; const char* B;
    __device__ __forceinline__ bool next(int i, Unit& u) const {
        const int Lx = i * G + c; if (Lx >= 128) return false;
        const int g = Lx >> 2, pm = (Lx >> 1) & 1, pn = Lx & 1; u.pm = pm; u.pn = pn; u.z = g;
        u.A = A + ((size_t)g * 512 + pm * 256) * SSM_K * 2; u.B = B + ((size_t)g * 512 + pn * 256) * SSM_K * 2; return true;
    }
};
struct UvOrder {
    int G, c; const char* A; const char* B;
    __device__ __forceinline__ bool next(int i, Unit& u) const {
        const int Lx = i * G + c; if (Lx >= 128) return false;
        int pm, pn; pg8::tile_of(Lx, 64, 2, pm, pn); u.pm = pm; u.pn = pn; u.z = 0;
        u.A = A + (size_t)pm * 256 * 2048 + (size_t)pn * 1024; u.B = B + (size_t)pn * 256 * 2048 + (size_t)pn * 1024; return true;
    }
};
struct MkvOrder {
    int G, c; const char* A; const char* B;
    __device__ __forceinline__ bool next(int i, Unit& u) const {
        const int Lx = i * G + c; if (Lx >= NL * 8) return false;
        const int l = Lx >> 3, pm = (Lx >> 2) & 1, pn = Lx & 3; u.pm = pm; u.pn = pn; u.z = l;
        u.A = A + (size_t)pm * 256 * 1024 * 2; u.B = B + ((size_t)l * 1024 + pn * 256) * 1024 * 2; return true;
    }
};
struct MergeOrder {
    int G, c; const char* A; const char* B;
    __device__ __forceinline__ bool next(int i, Unit& u) const {
        const long Lx = (long)(i >> 2) * G + c; if (Lx >= 64 * 4) return false;
        int pm, pn; pg8::tile_of((int)Lx, 64, 4, pm, pn); const int r = i & 3; u.pm = pm; u.pn = pn; u.z = r;
        u.A = A + ((size_t)pm * 256 * 2048 + r * 512) * 2; u.B = B + ((size_t)r * 1024 + pn * 256) * 512 * 2; return true;
    }
};
struct MoeOrder {
    int G, c, nN, nunits; const LAS int* blk0; const char* A; const char* B; size_t atile, bexp, btile;
    const int* tok; const LAS int* cnt;
    __device__ __forceinline__ void rowinfo(const pg8::Unit& u, const int*& tb, int& s0, int& ce) const { const int e = u.z; tb = tok + (size_t)e * M; s0 = (u.pm - blk0[e]) * 256; ce = cnt[e]; }
    __device__ __forceinline__ bool next(int i, Unit& u) const {
        const int c2 = (G & 7) ? c : (c & 7) * (G >> 3) + (c >> 3);
        const long Lx = (long)i * G + c2; if (Lx >= nunits) return false;
        const int j = (int)(Lx / nN), pn = (int)(Lx % nN); int e = 0;
#pragma unroll
        for (int k = 1; k < 32; ++k) e += (j >= blk0[k]) ? 1 : 0;
        u.pm = j; u.pn = pn; u.z = e; u.A = A + (size_t)j * atile; u.B = B + (size_t)e * bexp + (size_t)pn * btile; return true;
    }
};

template <int QMODE = 0>
__device__ __forceinline__ void tr_item64(const float* W, int ldw, int c0, int nc, int K, bf16* WT, int r0, LAS unsigned char* scr, int item, int lane) {
    const int nblk = (nc + 63) >> 6, kb = item / nblk, nb = item % nblk, k0 = 64 * kb, n0 = 64 * nb;
    const int nn = 4 * (lane & 15), g = lane >> 4; const bool okn = (n0 + nn) < nc;
    const float* wp = W + (size_t)(k0 + g) * ldw + c0 + n0 + nn;
    f32x4 vv[16];
#pragma unroll
    for (int i = 0; i < 16; ++i) { vv[i] = (f32x4){0.f, 0.f, 0.f, 0.f}; if (okn) vv[i] = __builtin_nontemporal_load((const f32x4*)(wp + (size_t)(4 * i) * ldw)); }
#pragma unroll
    for (int i = 0; i < 16; ++i) { v2u w2; w2.x = pk2(vv[i][0], vv[i][1]); w2.y = pk2(vv[i][2], vv[i][3]); *(LAS v2u*)(scr + (4 * i + g) * 136 + nn * 2) = w2; }
    LDS_WAIT(); asm volatile("" ::: "memory");
    const int i16 = lane & 15, q = i16 >> 2, p = i16 & 3;
#pragma unroll
    for (int s = 0; s < 8; ++s) { const int nbk = s & 3, kbk = 4 * (s >> 2) + g;
        const v4i16_t lo = __builtin_amdgcn_ds_read_tr16_b64_v4i16((LAS v4i16_t*)(scr + (8 * kbk + q) * 136 + 32 * nbk + 8 * p));
        const v4i16_t hi = __builtin_amdgcn_ds_read_tr16_b64_v4i16((LAS v4i16_t*)(scr + (8 * kbk + 4 + q) * 136 + 32 * nbk + 8 * p));
        const bf16x8 o = __builtin_shufflevector(lo, hi, 0, 1, 2, 3, 4, 5, 6, 7); const int n = 16 * nbk + i16;
        if (n0 + n < nc) {
            if constexpr (QMODE == 0) *(bf16x8*)(WT + (size_t)(r0 + n0 + n) * K + k0 + 8 * kbk) = o;
            else { const v4u ou = __builtin_bit_cast(v4u, o); const float sc_ = QMODE == 1 ? QS_WUP : (QMODE == 2 ? QS_WDN : QS_WIN);
                *(v2u*)((unsigned char*)WT + (size_t)(r0 + n0 + n) * K + k0 + 8 * kbk) = (v2u){q8x4(bflo(ou.x), bfhi(ou.x), bflo(ou.y), bfhi(ou.y), sc_), q8x4(bflo(ou.z), bfhi(ou.z), bflo(ou.w), bfhi(ou.w), sc_)}; } } }
    LDS_WAIT(); asm volatile("" ::: "memory");
}
__device__ __forceinline__ void ln_rows(f32x4 (&v)[4], const float* g, const float* b, int lane) {
    float s = 0.f;
#pragma unroll
    for (int j = 0; j < 4; ++j) s += (v[j][0] + v[j][1]) + (v[j][2] + v[j][3]);
    const float mean = wave_sum(s) * (1.f / D); float s2 = 0.f;
#pragma unroll
    for (int j = 0; j < 4; ++j) { v[j] = v[j] - mean; s2 += (v[j][0] * v[j][0] + v[j][1] * v[j][1]) + (v[j][2] * v[j][2] + v[j][3] * v[j][3]); }
    const float rstd = 1.f / sqrtf(wave_sum(s2) * (1.f / D) + LN_EPS);
#pragma unroll
    for (int j = 0; j < 4; ++j) { const f32x4 gg = *(const f32x4*)(g + 4 * lane + 256 * j), bb = *(const f32x4*)(b + 4 * lane + 256 * j); v[j] = v[j] * rstd * gg + bb; }
}
struct LnAff { f32x4 g[4], b[4]; };
__device__ __forceinline__ LnAff ln_aff(const float* g, const float* b, int lane) { LnAff a;
#pragma unroll
    for (int j = 0; j < 4; ++j) { a.g[j] = *(const f32x4*)(g + 4 * lane + 256 * j); a.b[j] = *(const f32x4*)(b + 4 * lane + 256 * j); }
    return a; }
__device__ __forceinline__ void ln_rows_pre(f32x4 (&v)[4], const LnAff& a) {
    float s = 0.f;
#pragma unroll
    for (int j = 0; j < 4; ++j) s += (v[j][0] + v[j][1]) + (v[j][2] + v[j][3]);
    const float mean = wave_sum(s) * (1.f / D); float s2 = 0.f;
#pragma unroll
    for (int j = 0; j < 4; ++j) { v[j] = v[j] - mean; s2 += (v[j][0] * v[j][0] + v[j][1] * v[j][1]) + (v[j][2] * v[j][2] + v[j][3] * v[j][3]); }
    const float rstd = 1.f / sqrtf(wave_sum(s2) * (1.f / D) + LN_EPS);
#pragma unroll
    for (int j = 0; j < 4; ++j) v[j] = v[j] * rstd * a.g[j] + a.b[j];
}
__device__ __forceinline__ void store_row_f32_bf16(const f32x4 (&v)[4], float* of, bf16* ob, int lane) {
#pragma unroll
    for (int j = 0; j < 4; ++j) { if (of) *(f32x4*)(of + 4 * lane + 256 * j) = v[j];
        if (ob) { v2u w; w.x = pk2(v[j][0], v[j][1]); w.y = pk2(v[j][2], v[j][3]); *(v2u*)(ob + 4 * lane + 256 * j) = w; } }
}

typedef float f32x16 __attribute__((ext_vector_type(16)));
constexpr int DSA_LIST_OFF = LDSCTL_OFF + 2048, DSA_WCNT_OFF = DSA_LIST_OFF + 4096, DSA_SEL_OFF = DSA_WCNT_OFF + 256;
__device__ __forceinline__ unsigned mono_key(float x) { const unsigned u = __builtin_bit_cast(unsigned, x); return u ^ ((unsigned)((int)u >> 31) | 0x80000000u); }
__device__ __forceinline__ unsigned kv_off(unsigned row, unsigned ch) { return 256u * row + 16u * (ch ^ (((row & 3u) << 2) | ((row >> 2) & 3u))); }

#ifndef DUP_IDX
#define DUP_IDX 1
#endif
#ifndef DUP_SEL
#define DUP_SEL 1
#endif
#ifndef DUP_ATT
#define DUP_ATT 1
#endif
template <int LEVEL>
__device__ __forceinline__ void dsa2_level(LAS unsigned* hist, const unsigned (&kk)[128], int nreg, int lane, unsigned& prefix, unsigned& need) {
    constexpr int NBIN = LEVEL == 2 ? 1024 : 2048; constexpr int PB = NBIN / 64;
#pragma unroll
    for (int i = 0; i < PB / 4; ++i) *(LAS v4u*)(hist + lane * PB + 4 * i) = (v4u){0u, 0u, 0u, 0u};
    LDS_WAIT();
#pragma unroll
    for (int i = 0; i < 128; ++i) { if ((i & ~15) < nreg) { const unsigned k = kk[i]; bool part; unsigned bin;
            if (LEVEL == 0) { part = k != 0u; bin = k >> 21; }
            else if (LEVEL == 1) { part = (k != 0u) && ((k >> 21) == prefix); bin = (k >> 10) & 0x7FFu; }
            else { part = (k != 0u) && ((k >> 10) == prefix); bin = k & 0x3FFu; }
            if (part) (void)__hip_atomic_fetch_add(&hist[bin], 1u, __ATOMIC_RELAXED, __HIP_MEMORY_SCOPE_WORKGROUP); }
        if ((i & 7) == 7) __builtin_amdgcn_sched_barrier(0); }
    LDS_WAIT();
    unsigned hv[PB]; unsigned mine = 0u;
#pragma unroll
    for (int i = 0; i < PB / 4; ++i) { const v4u v = *(const LAS v4u*)(hist + lane * PB + 4 * i); hv[4 * i] = v.x; hv[4 * i + 1] = v.y; hv[4 * i + 2] = v.z; hv[4 * i + 3] = v.w; mine += (v.x + v.y) + (v.z + v.w); }
    const unsigned pre779_ = dpp_scan_add_u32(mine); const unsigned incl = (unsigned)__builtin_amdgcn_readlane((int)pre779_, 63) - pre779_ + mine;
    const unsigned above = incl - mine; const bool found = above < need && need <= above + mine;
    unsigned a = above; int bsel = 0; bool done = false;
#pragma unroll
    for (int i = PB - 1; i >= 0; --i) { const bool hit = !done && (need <= a + hv[i]); bsel = hit ? i : bsel; a = (done || hit) ? a : a + hv[i]; done = done || hit; }
    const int src = __builtin_ctzll(__ballot(found));
    const unsigned bfull = (unsigned)SHI(lane * PB + bsel, src); const unsigned aa = (unsigned)SHI((int)a, src);
    prefix = LEVEL == 0 ? bfull : (LEVEL == 1 ? ((prefix << 11) | bfull) : ((prefix << 10) | bfull)); need -= aa;
    LDS_WAIT();
}

__device__ __forceinline__ bool dsa2_sampled(LAS unsigned char* wl, const unsigned (&kk)[128], int nreg, int n, int lane) {
    LAS unsigned* hist = (LAS unsigned*)wl; LAS int* LIST = (LAS int*)(wl + 12288); LAS unsigned* h2 = (LAS unsigned*)(wl + 13312);
    LAS unsigned long long* PRIV = (LAS unsigned long long*)wl;
    const unsigned long long ltm = (1ull << lane) - 1ull;
#pragma unroll
    for (int i = 0; i < 8; ++i) *(LAS v4u*)(hist + lane * 32 + 4 * i) = (v4u){0u, 0u, 0u, 0u};
    LDS_WAIT();
#pragma unroll
    for (int i = 0; i < 128; i += 8) { if (i < nreg) { const unsigned k = kk[i]; if (k != 0u) (void)__hip_atomic_fetch_add(&hist[k >> 21], 1u, __ATOMIC_RELAXED, __HIP_MEMORY_SCOPE_WORKGROUP); } }
    LDS_WAIT();
    unsigned hv[32]; unsigned mine = 0u;
#pragma unroll
    for (int i = 0; i < 8; ++i) { const v4u v = *(const LAS v4u*)(hist + lane * 32 + 4 * i); hv[4 * i] = v.x; hv[4 * i + 1] = v.y; hv[4 * i + 2] = v.z; hv[4 * i + 3] = v.w; mine += (v.x + v.y) + (v.z + v.w); }
    const unsigned pre_ = dpp_scan_add_u32(mine); const unsigned incl = (unsigned)__builtin_amdgcn_readlane((int)pre_, 63) - pre_ + mine; const int lop_ = lane_op(); (void)lop_;
    const unsigned above = incl - mine; const unsigned ns = SHI(incl, 0);
    const float E = (float)ns * 256.f / (float)n, mg = 3.f * sqrtf(E) + 3.f;
    const int rhi = (int)fmaxf(E - mg, 0.f), rlo = (int)(E + mg) + 1;
    int bhl = -1, bll = -1; { unsigned s = above;
#pragma unroll
        for (int i = 31; i >= 0; --i) { if ((int)s <= rhi) bhl = i; s += hv[i]; if (bll < 0 && (int)s >= rlo) bll = i; } }
    const bool hasH = ((int)above <= rhi) && ((int)incl > rhi || lane == 0), hasL = ((int)incl >= rlo) && ((int)above < rlo);
    const unsigned long long mH = __ballot(hasH), mL = __ballot(hasL);
    if (mH == 0ull) return false;
    const int sH = 63 - __builtin_clzll(mH);
    const unsigned bh = (unsigned)SHI(lane * 32 + (bhl < 0 ? 0 : bhl), sH);
    unsigned bl = 1u; if (mL != 0ull) { const int sL = 63 - __builtin_clzll(mL); bl = (unsigned)SHI(lane * 32 + (bll < 0 ? 0 : bll), sL); }
    bl = bl < 1u ? 1u : bl; if (bl > bh) bl = bh;
    int cur = 0; LAS unsigned* pp = (LAS unsigned*)(PRIV + lane);
#pragma unroll
    for (int i = 0; i < 128; ++i) { if ((i & ~15) < nreg) { const unsigned k = kk[i];
            if ((k >> 21) >= bl) { if (cur < 24) { pp[0] = (unsigned)(lane + 64 * i); pp[1] = k; } pp += 128; ++cur; } }
        __builtin_amdgcn_sched_barrier(0); }
    LDS_WAIT();
    int mxc = cur; { const int lq_ = lane_op();
#pragma unroll
        for (int o = 1; o < 64; o <<= 1) { const int t2 = SHX(mxc, o, lq_); mxc = t2 > mxc ? t2 : mxc; } }
    mxc = __builtin_amdgcn_readfirstlane(mxc);
    if (mxc > 24) return false;
    int A = 0, C = 0;
#pragma unroll 1
    for (int s = 0; s < mxc; ++s) { const bool vld = s < cur; const unsigned long long e = vld ? PRIV[s * 64 + lane] : 0ull; const unsigned k = (unsigned)(e >> 32), ix = (unsigned)e;
        const bool sure = vld && (k >> 21) > bh, cand = vld && !sure;
        const unsigned long long ms = __ballot(sure), mc = __ballot(cand);
        const int ps = A + __builtin_popcountll(ms & ltm), pc = C + __builtin_popcountll(mc & ltm);
        if (sure && ps < 256) LIST[ps] = (int)ix;
        if (cand) PRIV[pc] = ((unsigned long long)k << 13) | (unsigned long long)(8191u - ix);
        A += __builtin_popcountll(ms); C += __builtin_popcountll(mc); }
    if (A > 256 || A + C < 256) return false;
    LDS_WAIT();
    unsigned need = 256u - (unsigned)A; const int nit = (C + 63) >> 6;
    if (need > 0u) { unsigned long long prefix = 0ull; int shf = 45;
#pragma unroll 1
        for (int lev = 0; lev < 6; ++lev) { const int w = lev < 5 ? 8 : 5; const int sh = shf - w;
            { unsigned zq_ = 0u; asm volatile("" : "+v"(zq_)); *(LAS v4u*)(h2 + 4 * lane) = (v4u){zq_, zq_, zq_, zq_}; }
            LDS_WAIT();
            for (int it = 0; it < nit; ++it) { const int i = it * 64 + lane; if (i < C) { const unsigned long long c2 = PRIV[i]; if (lev == 0 || (c2 >> shf) == prefix) (void)__hip_atomic_fetch_add(&h2[(unsigned)(c2 >> sh) & ((1u << w) - 1u)], 1u, __ATOMIC_RELAXED, __HIP_MEMORY_SCOPE_WORKGROUP); } }
            LDS_WAIT();
            const v4u v = *(const LAS v4u*)(h2 + 4 * lane); const unsigned m4 = (v.x + v.y) + (v.z + v.w); const unsigned pr2_ = dpp_scan_add_u32(m4); const unsigned in2 = (unsigned)__builtin_amdgcn_readlane((int)pr2_, 63) - pr2_ + m4;
            const unsigned ab = in2 - m4; const bool fnd = ab < need && need <= ab + m4;
            unsigned a = ab; int bs = 0; bool dn = false; const unsigned h4[4] = {v.x, v.y, v.z, v.w};
#pragma unroll
            for (int i = 3; i >= 0; --i) { const bool hit = !dn && (need <= a + h4[i]); bs = hit ? i : bs; a = (dn || hit) ? a : a + h4[i]; dn = dn || hit; }
            const int src = __builtin_ctzll(__ballot(fnd));
            const unsigned bf = (unsigned)SHI(lane * 4 + bs, src); const unsigned aa = (unsigned)SHI((int)a, src); const unsigned hb = (unsigned)SHI((int)(bs == 3 ? h4[3] : bs == 2 ? h4[2] : bs == 1 ? h4[1] : h4[0]), src);
            prefix = (prefix << w) | bf; need -= aa; shf = sh;
            LDS_WAIT();
            if (hb == need) break; }
        int pos = A;
        for (int it = 0; it < nit; ++it) { const int i = it * 64 + lane; unsigned long long c2 = 0ull; if (i < C) c2 = PRIV[i];
            const bool take = (i < C) && ((c2 >> shf) >= prefix);
            const unsigned long long mt = __ballot(take);
            if (take) LIST[pos + __builtin_popcountll(mt & ltm)] = (int)(8191u - (unsigned)(c2 & 8191ull));
            pos += __builtin_popcountll(mt); }
    }
    LDS_WAIT();
    return true;
}

__device__ __forceinline__ void dsa2_unit(LAS unsigned char* lds, const bf16* PROJ, const bf16* KIDX, const bf16* KVN, bf16* OLAT, float* sbuf, int b, int t0, int tid) {
    asm volatile("" : "+v"(tid));
    const int lane = tid & 63, wave = __builtin_amdgcn_readfirstlane(tid >> 6), r = lane & 31, h = lane >> 5;
    const size_t rowb = (size_t)b * T;
    LAS unsigned char* wl = lds + wave * 16384; LAS unsigned* hist = (LAS unsigned*)wl; LAS int* LIST = (LAS int*)(wl + 12288);
    const int t = t0 + wave; int cnt;
    if (t0 >= 256) {
        { const int ntiles = (t0 >> 5) + 1, tpw = (ntiles + 7) >> 3, tile0 = wave * tpw; int tile1 = tile0 + tpw; tile1 = tile1 < ntiles ? tile1 : ntiles;
          const int ahead = (r & 3) + 4 * ((r >> 3) & 1), atok = ((r >> 2) & 1) + 2 * (r >> 4);
          const bf16* qpa = PROJ + (rowb + t0 + atok) * NP + PC_QIDX + ahead * 32 + 8 * h; const bf16* qpb = qpa + (size_t)4 * NP;
          const bf16x8 A0a = *(const bf16x8*)qpa, A1a = *(const bf16x8*)(qpa + 16), A0b = *(const bf16x8*)qpb, A1b = *(const bf16x8*)(qpb + 16);
          float wq[32];
#pragma unroll
          for (int gq = 0; gq < 4; ++gq) { const v4u w0 = *(const v4u*)(PROJ + (rowb + t0 + h + 2 * gq) * NP + PC_WIDX);
              wq[8 * gq] = 0.5f * bflo(w0.x); wq[8 * gq + 1] = 0.5f * bfhi(w0.x); wq[8 * gq + 2] = 0.5f * bflo(w0.y); wq[8 * gq + 3] = 0.5f * bfhi(w0.y); wq[8 * gq + 4] = 0.5f * bflo(w0.z); wq[8 * gq + 5] = 0.5f * bfhi(w0.z); wq[8 * gq + 6] = 0.5f * bflo(w0.w); wq[8 * gq + 7] = 0.5f * bfhi(w0.w); }
          v4u A0c = {0u, 0u, 0u, 0u}, A1c = {0u, 0u, 0u, 0u};
          if (r < 8) { const bf16* qrow = PROJ + (rowb + t0 + (r >> 2) + 2 * (r & 3)) * NP; const v4u wv = *(const v4u*)(qrow + PC_WIDX);
              const float wl_[8] = {bflo(wv.x), bfhi(wv.x), bflo(wv.y), bfhi(wv.y), bflo(wv.z), bfhi(wv.z), bflo(wv.w), bfhi(wv.w)};
              float a0[8], a1[8];
#pragma unroll
              for (int j = 0; j < 8; ++j) { a0[j] = 0.f; a1[j] = 0.f; }
#pragma unroll
              for (int hd = 0; hd < 8; ++hd) { const v4u q0 = *(const v4u*)(qrow + PC_QIDX + hd * 32 + 8 * h), q1 = *(const v4u*)(qrow + PC_QIDX + hd * 32 + 16 + 8 * h); const float hw = 0.5f * wl_[hd];
                  a0[0] += hw * bflo(q0.x); a0[1] += hw * bfhi(q0.x); a0[2] += hw * bflo(q0.y); a0[3] += hw * bfhi(q0.y); a0[4] += hw * bflo(q0.z); a0[5] += hw * bfhi(q0.z); a0[6] += hw * bflo(q0.w); a0[7] += hw * bfhi(q0.w);
                  a1[0] += hw * bflo(q1.x); a1[1] += hw * bfhi(q1.x); a1[2] += hw * bflo(q1.y); a1[3] += hw * bfhi(q1.y); a1[4] += hw * bflo(q1.z); a1[5] += hw * bfhi(q1.z); a1[6] += hw * bflo(q1.w); a1[7] += hw * bfhi(q1.w); }
              A0c = (v4u){pk2(a0[0], a0[1]), pk2(a0[2], a0[3]), pk2(a0[4], a0[5]), pk2(a0[6], a0[7])}; A1c = (v4u){pk2(a1[0], a1[1]), pk2(a1[2], a1[3]), pk2(a1[4], a1[5]), pk2(a1[6], a1[7])}; }
          const bf16x8 A0cb = __builtin_bit_cast(bf16x8, A0c), A1cb = __builtin_bit_cast(bf16x8, A1c);
          const bf16* kp = KIDX + (rowb + (size_t)tile0 * 32 + r) * 32 + 8 * h;
#define IDX_LOADG(BG, tb) do { _Pragma("unroll") for (int u = 0; u < 4; ++u) { int tt_ = (tb) + u; tt_ = tt_ < tile1 ? tt_ : tile1 - 1;        \
              const bf16* kn = kp + (size_t)(tt_ - tile0) * 1024; BG[u][0] = *(const bf16x8*)kn; BG[u][1] = *(const bf16x8*)(kn + 16); } } while (0)
#define IDX_ONE(BG, u, tile) { const bf16x8 b0 = BG[u][0], b1 = BG[u][1]; \
              f32x16 da, db, dc; \
              _Pragma("unroll") for (int i = 0; i < 16; ++i) { da[i] = 0.f; db[i] = 0.f; dc[i] = 0.f; } \
              da = __builtin_amdgcn_mfma_f32_32x32x16_bf16(A0a, b0, da, 0, 0, 0); db = __builtin_amdgcn_mfma_f32_32x32x16_bf16(A0b, b0, db, 0, 0, 0); dc = __builtin_amdgcn_mfma_f32_32x32x16_bf16(A0cb, b0, dc, 0, 0, 0); \
              da = __builtin_amdgcn_mfma_f32_32x32x16_bf16(A1a, b1, da, 0, 0, 0); db = __builtin_amdgcn_mfma_f32_32x32x16_bf16(A1b, b1, db, 0, 0, 0); dc = __builtin_amdgcn_mfma_f32_32x32x16_bf16(A1cb, b1, dc, 0, 0, 0); \
              float s0 = dc[0], s1 = dc[1], s2 = dc[2], s3 = dc[3]; \
              _Pragma("unroll") for (int i = 0; i < 8; ++i) { s0 += wq[i] * __builtin_fabsf(da[i]); s1 += wq[8 + i] * __builtin_fabsf(da[8 + i]); s2 += wq[16 + i] * __builtin_fabsf(db[i]); s3 += wq[24 + i] * __builtin_fabsf(db[8 + i]); } \
              float* sp = sbuf + (size_t)h * 8192 + (tile) * 32 + r; \
              sp[0] = __builtin_bit_cast(float, mono_key(s0)); sp[2 * 8192] = __builtin_bit_cast(float, mono_key(s1)); sp[4 * 8192] = __builtin_bit_cast(float, mono_key(s2)); sp[6 * 8192] = __builtin_bit_cast(float, mono_key(s3)); }
#define IDX_TILES_NG(BG, tb) do { _Pragma("unroll") for (int u = 0; u < 4; ++u) IDX_ONE(BG, u, (tb) + u) } while (0)
#define IDX_TILES(BG, tb) do { _Pragma("unroll") for (int u = 0; u < 4; ++u) { if ((tb) + u < tile1) IDX_ONE(BG, u, (tb) + u) } } while (0)
          if (tile0 < tile1) { bf16x8 BA[4][2], BB[4][2];
              IDX_LOADG(BA, tile0);
              int tileb = tile0;
              for (; tileb + 8 <= tile1; tileb += 8) {
                  IDX_LOADG(BB, tileb + 4);
                  IDX_TILES_NG(BA, tileb);
                  IDX_LOADG(BA, tileb + 8);
                  IDX_TILES_NG(BB, tileb + 4); }
              if (tileb < tile1) { IDX_LOADG(BB, tileb + 4); IDX_TILES(BA, tileb); IDX_TILES(BB, tileb + 4); } }
#undef IDX_ONE
#undef IDX_TILES_NG
#undef IDX_LOADG
#undef IDX_TILES
        }
        asm volatile("s_waitcnt vmcnt(0)" ::: "memory");
        __syncthreads();
        const int n = t + 1, nreg = (n + 63) >> 6; const float* sr = sbuf + (size_t)wave * 8192;
        unsigned kk[128];
#ifndef DUP_KK
#define DUP_KK 1
#endif
        for (int repk = 0; repk < DUP_KK; ++repk)
#pragma unroll
        for (int gI = 0; gI < 4; ++gI) {
            if (gI * 32 < nreg) {
                float fv[32];
#pragma unroll
                for (int i = 0; i < 32; ++i) { const int key = lane + 64 * (gI * 32 + i); fv[i] = __hip_atomic_load(sr + (key < n ? key : n - 1), __ATOMIC_RELAXED, __HIP_MEMORY_SCOPE_AGENT); }
#pragma unroll
                for (int i = 0; i < 32; ++i) { const int key = lane + 64 * (gI * 32 + i); kk[gI * 32 + i] = key < n ? __builtin_bit_cast(unsigned, fv[i]) : 0u; }
            } else {
#pragma unroll
                for (int i = 0; i < 32; ++i) kk[gI * 32 + i] = 0u;
            }
        }
        unsigned prefix = 0u, need = 256u; int pos = 0, eqs = 0; const unsigned long long ltm = (1ull << lane) - 1ull;
        bool seldone = false; if (nreg > 16) seldone = dsa2_sampled(wl, kk, nreg, n, lane);
        if (!seldone)
        for (int reps = 0; reps < DUP_SEL; ++reps) { prefix = 0u; need = 256u; pos = 0; eqs = 0;
        dsa2_level<0>(hist, kk, nreg, lane, prefix, need);
        dsa2_level<1>(hist, kk, nreg, lane, prefix, need);
        dsa2_level<2>(hist, kk, nreg, lane, prefix, need);
        const unsigned tau = prefix;
#pragma unroll
        for (int i = 0; i < 128; ++i) { if ((i & ~15) < nreg) { const unsigned k = kk[i]; const bool gt = k > tau, eq = k == tau;
                const unsigned long long me = __ballot(eq);
                const bool take = gt || (eq && (eqs + __builtin_popcountll(me & ltm) < (int)need));
                const unsigned long long mt = __ballot(take);
                if (take) LIST[pos + __builtin_popcountll(mt & ltm)] = lane + 64 * i;
                pos += __builtin_popcountll(mt); eqs += __builtin_popcountll(me); }
            if ((i & 3) == 3) __builtin_amdgcn_sched_barrier(0); } }
        cnt = 256;
    } else {
#pragma unroll
        for (int j = 0; j < 4; ++j) LIST[lane + 64 * j] = lane + 64 * j;
        cnt = t + 1;
    }
    LDS_WAIT();
    int tid2 = tid; asm volatile("" : "+v"(tid2)); const int lane2 = tid2 & 63; const int nn = lane2 & 15, g = lane2 >> 4;
    bf16x8 qf[4];
#pragma unroll
    for (int s = 0; s < 4; ++s) { if (nn < 8) qf[s] = *(const bf16x8*)(PROJ + (rowb + t) * NP + PC_QLAT + nn * 128 + 32 * s + 8 * g); else qf[s] = (bf16x8){0, 0, 0, 0, 0, 0, 0, 0}; }
    f32x4 O[8]; float mrun, lrun;
    LAS unsigned char* buf = wl; const unsigned q4 = (unsigned)(nn >> 2), p = (unsigned)(lane2 & 3); const int nch = (cnt + 31) >> 5;
    for (int repa = 0; repa < DUP_ATT; ++repa) {
#pragma unroll
    for (int c = 0; c < 8; ++c) O[c] = (f32x4){0.f, 0.f, 0.f, 0.f};
    mrun = -INFINITY; lrun = 0.f;
    v4u pre[8];
#pragma unroll
    for (int it = 0; it < 8; ++it) { const int row = it * 4 + g; pre[it] = (v4u){0u, 0u, 0u, 0u}; if (row < cnt) { const int idx = LIST[row]; pre[it] = *(const v4u*)(KVN + (rowb + idx) * 128 + nn * 8); } }
#pragma unroll 1
    for (int ch = 0; ch < nch; ++ch) {
#pragma unroll
        for (int it = 0; it < 8; ++it) *(LAS v4u*)(buf + kv_off(it * 4 + g, nn)) = pre[it];
        if (ch + 1 < nch) {
#pragma unroll
            for (int it = 0; it < 8; ++it) { const int row = (ch + 1) * 32 + it * 4 + g; pre[it] = (v4u){0u, 0u, 0u, 0u}; if (row < cnt) { const int idx = LIST[row]; pre[it] = *(const v4u*)(KVN + (rowb + idx) * 128 + nn * 8); } } }
        LDS_WAIT();
        f32x4 S0 = {0.f, 0.f, 0.f, 0.f}, S1 = {0.f, 0.f, 0.f, 0.f};
        { const unsigned slot0 = 8u * (nn >> 2) + (nn & 3), slot1 = slot0 + 4u;
#pragma unroll
          for (int s = 0; s < 4; ++s) { const bf16x8 a0 = *(const LAS bf16x8*)(buf + kv_off(slot0, 4 * s + g)), a1 = *(const LAS bf16x8*)(buf + kv_off(slot1, 4 * s + g));
              S0 = __builtin_amdgcn_mfma_f32_16x16x32_bf16(a0, qf[s], S0, 0, 0, 0); S1 = __builtin_amdgcn_mfma_f32_16x16x32_bf16(a1, qf[s], S1, 0, 0, 0); } }
        if (ch * 32 + 32 > cnt) {
#pragma unroll
            for (int j = 0; j < 4; ++j) { if (ch * 32 + 8 * g + j >= cnt) S0[j] = -INFINITY; if (ch * 32 + 8 * g + 4 + j >= cnt) S1[j] = -INFINITY; } }
        float mc = fmaxf(fmaxf(fmaxf(S0[0], S0[1]), fmaxf(S0[2], S0[3])), fmaxf(fmaxf(S1[0], S1[1]), fmaxf(S1[2], S1[3])));
        const int lop891_ = lane_op(); mc = fmaxf(mc, SHX(mc, 16, lop891_)); mc = fmaxf(mc, SHX(mc, 32, lop891_));
        const float mnew = fmaxf(mrun, mc); const float alpha = __expf(mrun - mnew); mrun = mnew;
        float ps = 0.f;
#pragma unroll
        for (int j = 0; j < 4; ++j) { S0[j] = __expf(S0[j] - mnew); S1[j] = __expf(S1[j] - mnew); ps += S0[j] + S1[j]; }
        lrun = lrun * alpha + ps;
        v4u w; w.x = pk2(S0[0], S0[1]); w.y = pk2(S0[2], S0[3]); w.z = pk2(S1[0], S1[1]); w.w = pk2(S1[2], S1[3]); const bf16x8 Bp = __builtin_bit_cast(bf16x8, w);
#pragma unroll
        for (int c = 0; c < 8; ++c) { O[c] = O[c] * alpha;
            const v4i16_t lo = __builtin_amdgcn_ds_read_tr16_b64_v4i16((LAS v4i16_t*)(buf + kv_off(8u * g + q4, 2u * c + (p >> 1)) + 8u * (p & 1u)));
            const v4i16_t hi = __builtin_amdgcn_ds_read_tr16_b64_v4i16((LAS v4i16_t*)(buf + kv_off(8u * g + 4u + q4, 2u * c + (p >> 1)) + 8u * (p & 1u)));
            const bf16x8 a = __builtin_shufflevector(lo, hi, 0, 1, 2, 3, 4, 5, 6, 7);
            O[c] = __builtin_amdgcn_mfma_f32_16x16x32_bf16(a, Bp, O[c], 0, 0, 0); }
        LDS_WAIT();
    } }
    const int lop906_ = lane_op(); lrun += SHX(lrun, 16, lop906_); lrun += SHX(lrun, 32, lop906_);
    const float inv = 1.f / lrun;
    if (nn < 8) {
#pragma unroll
        for (int c = 0; c < 8; ++c) { v2u w; w.x = pk2(O[c][0] * inv, O[c][1] * inv); w.y = pk2(O[c][2] * inv, O[c][3] * inv); *(v2u*)(OLAT + (rowb + t) * 1024 + nn * 128 + 16 * c + 4 * g) = w; } }
}

__device__ __forceinline__ unsigned swap23(unsigned r) { return (r & ~12u) | ((r & 4u) << 1) | ((r & 8u) >> 1); }
__device__ __forceinline__ void memattn_unit(LAS unsigned char* lds, const bf16* PROJ, const bf16* MKVl, bf16* BR, int b, int hd, int qblk, int tid) {
    asm volatile("" : "+v"(tid));
    const int lane = tid & 63, wave = __builtin_amdgcn_readfirstlane(tid >> 6), r = lane & 31, hh = lane >> 5;
    LAS unsigned char* kimg = lds; LAS unsigned char* vimg = lds + 65536;
    { const bf16* kb = MKVl + (size_t)b * 256 * 1024 + hd * 128;
#pragma unroll 4
      for (int it = 0; it < 8; ++it) { const int row = it * 32 + (tid >> 4), ch = tid & 15;
          const v4u kv = *(const v4u*)(kb + (size_t)row * 1024 + ch * 8), vv = *(const v4u*)(kb + (size_t)row * 1024 + 512 + ch * 8);
          *(LAS v4u*)(kimg + kv_off(row, ch)) = kv; *(LAS v4u*)(vimg + kv_off(row, ch)) = vv; } }
    const size_t tok = (size_t)b * T + qblk * 256 + wave * 32 + r;
    bf16x8 qf[8];
#pragma unroll
    for (int s = 0; s < 8; ++s) qf[s] = *(const bf16x8*)(PROJ + tok * NP + PC_MQ + hd * 128 + 16 * s + 8 * hh);
    __syncthreads();
    f32x16 S[8];
#pragma unroll
    for (int kap = 0; kap < 8; ++kap) { f32x16 acc;
#pragma unroll
        for (int i = 0; i < 16; ++i) acc[i] = 0.f;
        const unsigned slot = 32u * kap + swap23((unsigned)r);
#pragma unroll
        for (int s = 0; s < 8; ++s) { const bf16x8 a = *(const LAS bf16x8*)(kimg + kv_off(slot, 2 * s + hh)); acc = __builtin_amdgcn_mfma_f32_32x32x16_bf16(a, qf[s], acc, 0, 0, 0); }
        S[kap] = acc; if (kap & 1) __builtin_amdgcn_sched_barrier(0); }
    float mx = -INFINITY;
#pragma unroll
    for (int kap = 0; kap < 8; ++kap)
#pragma unroll
        for (int i = 0; i < 16; ++i) mx = fmaxf(mx, S[kap][i]);
    const int lop945_ = lane_op(); mx = fmaxf(mx, SHX(mx, 32, lop945_));
    const float sc_ = 0.08838834764831845f * 1.4426950408889634f; float sum = 0.f;
#pragma unroll
    for (int kap = 0; kap < 8; ++kap)
#pragma unroll
        for (int i = 0; i < 16; ++i) { const float e = __builtin_amdgcn_exp2f((S[kap][i] - mx) * sc_); S[kap][i] = e; sum += e; }
    const int lop951_ = lane_op(); sum += SHX(sum, 32, lop951_);
    const float inv = 1.f / sum;
    bf16x8 Bp[16];
#pragma unroll
    for (int kap = 0; kap < 8; ++kap)
#pragma unroll
        for (int s = 0; s < 2; ++s) { v4u w; w.x = pk2(S[kap][8 * s], S[kap][8 * s + 1]); w.y = pk2(S[kap][8 * s + 2], S[kap][8 * s + 3]); w.z = pk2(S[kap][8 * s + 4], S[kap][8 * s + 5]); w.w = pk2(S[kap][8 * s + 6], S[kap][8 * s + 7]);
            Bp[2 * kap + s] = __builtin_bit_cast(bf16x8, w); }
    const unsigned blk = (lane >> 4) & 1, q4 = (lane & 15) >> 2, p = lane & 3;
    bf16* orow = BR + tok * 2048 + 1536 + hd * 128;
#pragma unroll
    for (int c = 0; c < 4; ++c) { f32x16 o;
#pragma unroll
        for (int i = 0; i < 16; ++i) o[i] = 0.f;
#pragma unroll
        for (int ks = 0; ks < 16; ++ks) {
            const v4i16_t lo = __builtin_amdgcn_ds_read_tr16_b64_v4i16((LAS v4i16_t*)(vimg + kv_off(16u * ks + 8u * hh + q4, 4u * c + 2u * blk + (p >> 1)) + 8u * (p & 1u)));
            const v4i16_t hi = __builtin_amdgcn_ds_read_tr16_b64_v4i16((LAS v4i16_t*)(vimg + kv_off(16u * ks + 8u * hh + 4u + q4, 4u * c + 2u * blk + (p >> 1)) + 8u * (p & 1u)));
            const bf16x8 a = __builtin_shufflevector(lo, hi, 0, 1, 2, 3, 4, 5, 6, 7);
            o = __builtin_amdgcn_mfma_f32_32x32x16_bf16(a, Bp[ks], o, 0, 0, 0); if ((ks & 3) == 3) __builtin_amdgcn_sched_barrier(0); }
#pragma unroll
        for (int i4 = 0; i4 < 4; ++i4) { v2u w; w.x = pk2(o[4 * i4] * inv, o[4 * i4 + 1] * inv); w.y = pk2(o[4 * i4 + 2] * inv, o[4 * i4 + 3] * inv);
            *(v2u*)(orow + 32 * c + 8 * i4 + 4 * hh) = w; } }
    __syncthreads();
}

__device__ __forceinline__ f32x4 ld4bf(const bf16* p) { const v2u w = *(const v2u*)p; return (f32x4){bflo(w.x), bfhi(w.x), bflo(w.y), bfhi(w.y)}; }
__device__ __forceinline__ void store_row_fp8(const f32x4 (&v)[4], unsigned char* o8, int lane) {
#pragma unroll
    for (int j = 0; j < 4; ++j) *(unsigned*)(o8 + 4 * lane + 256 * j) = q8x4(v[j][0], v[j][1], v[j][2], v[j][3], QS_H);
}
constexpr int PH_PER_LAYER = 10, NPHASE = 2 + NL * PH_PER_LAYER;

__global__ void __launch_bounds__(NWAVES * 64, 2) fwd(Args args) {
    extern __shared__ __attribute__((aligned(16))) unsigned char lds_raw[];
    Frame F;
    F.lds = (LAS unsigned char*)lds_raw;
    F.tid = threadIdx.x; F.lane = F.tid & 63; F.wave = __builtin_amdgcn_readfirstlane(F.tid >> 6);
    const int wave_s = F.wave;
    F.G = gridDim.x; F.gw = blockIdx.x * NWAVES + F.wave; F.NGW = F.G * NWAVES;
    volatile LAS unsigned* MISC = (volatile LAS unsigned*)(F.lds + MISC_OFF);
    for (int u = F.tid; u < (LDS_BYTES - LDSCTL_OFF) / 4; u += NWAVES * 64) ((LAS unsigned*)(F.lds + LDSCTL_OFF))[u] = 0u;
    __syncthreads();
#if ONE_LAUNCH
    XcdBarrier bar = xcd_barrier_post((unsigned*)(args.ws + WS_CTL) + CW_BAR, MISC + 8);
#define GRID_BAR() xcd_barrier(bar, tidq)
#else
#define GRID_BAR() do {} while (0)
#endif
    { volatile LAS unsigned long long* PT = (volatile LAS unsigned long long*)(F.lds + MISC_OFF + 512);
    if (F.tid == 0) {
#pragma unroll
        for (int i = 0; i < 33; ++i) PT[i] = (unsigned long long)args.in[i];
        PT[33] = (unsigned long long)args.out; PT[34] = (unsigned long long)args.ws;
    } }
    const int lo = args.ph_lo, hi = args.ph_hi;
    __syncthreads();
    int ph = 0;
#define IN(k) ((const float*)gptr(ldp(PT, k)))
#ifndef DUP_PHASE
#define DUP_PHASE (-1)
#endif
#ifndef PHMASK
#define PHMASK 0xFFFFull
#endif
#define PHASE_BEGIN(id) if (((PHMASK >> (id)) & 1ull) && lo <= ph && ph < hi) { unsigned ldsb_ = 0u; asm volatile("" : "+s"(ldsb_)); LAS unsigned char* ldsq = (LAS unsigned char*)lds_raw + ldsb_; \
    volatile LAS unsigned long long* PT = (volatile LAS unsigned long long*)(ldsq + MISC_OFF + 512); LAS int* BLK0 = (LAS int*)(ldsq + MISC_OFF + 128); (void)BLK0; unsigned char* ws = gptr(ldp(PT, 34)); int tidq = wave_s * 64 + lane_op(); asm volatile("" : "+v"(tidq)); const int lane = tidq & 63, wave = __builtin_amdgcn_readfirstlane(tidq >> 6); \
    Frame F; F.lds = ldsq; F.tid = tidq; F.lane = lane; F.wave = wave; { const unsigned vb1_ = ((volatile LAS unsigned*)(ldsq + MISC_OFF))[11]; int Gq_ = gridDim.x, bxq_ = __builtin_amdgcn_readfirstlane(vb1_ ? (int)vb1_ - 1 : (int)blockIdx.x); asm volatile("" : "+s"(Gq_), "+s"(bxq_)); F.G = Gq_; F.bx = bxq_; } F.gw = F.bx * NWAVES + wave; F.NGW = F.G * NWAVES; \
    bf16* WinT = (bf16*)(ws + WS_WIN); bf16* WgluT = (bf16*)(ws + WS_WGLU); bf16* WmkvT = (bf16*)(ws + WS_WMKV); bf16* WuvT = (bf16*)(ws + WS_WUV); \
    bf16* WbrT = (bf16*)(ws + WS_WBR); bf16* WoT = (bf16*)(ws + WS_WO); bf16* WupT = (bf16*)(ws + WS_WUP); bf16* WdnT = (bf16*)(ws + WS_WDN); \
    f32x2* S5A = (f32x2*)(ws + WS_S5A); f32x2* S5B = (f32x2*)(ws + WS_S5B); \
    bf16* MEMB = (bf16*)(ws + WS_MEMB); bf16* MKV = (bf16*)(ws + WS_MKV); \
    bf16* Hf = (bf16*)(ws + WS_H); bf16* Hb = (bf16*)(ws + WS_HB); bf16* PROJ = (bf16*)(ws + WS_PROJ); bf16* KVN = (bf16*)(ws + WS_KVN); \
    bf16* OLAT = (bf16*)(ws + WS_OLAT); bf16* BR = (bf16*)(ws + WS_BR); bf16* Zb = (bf16*)(ws + WS_Z); float* MRG = (float*)(ws + WS_MRG); bf16* MRGB = (bf16*)(ws + WS_MRGB); \
    bf16* Vf = (bf16*)(ws + WS_V); bf16* H1 = (bf16*)(ws + WS_H1); bf16* H1B = (bf16*)(ws + WS_H1B); \
    f32x2* SSE = (f32x2*)(ws + WS_SSE); f32x2* SSC = (f32x2*)(ws + WS_SSC); \
    int* TOK = (int*)(ws + WS_TOK); float* GATE = (float*)(ws + WS_GATE); int* SLOT = (int*)(ws + WS_SLOT); \
    bf16* XS = (bf16*)(ws + WS_XS); bf16* ACT = (bf16*)(ws + WS_ACT); bf16* YS = XS; float* SCR = (float*)(ws + WS_SCR); float* GROW = (float*)(ws + WS_SCR); bf16* KIDX = (bf16*)(ws + WS_KIDX); (void)KIDX; bf16* WSSM = (bf16*)(ws + WS_WSSM); bf16* AEXT = (bf16*)(ws + WS_AEXT); bf16* WEW = (bf16*)(ws + WS_WE); (void)WSSM; (void)AEXT; (void)WEW; \
    unsigned* CTLP = (unsigned*)(ws + WS_CTL); float* OUTP = (float*)gptr(ldp(PT, 33)); \
    (void)WinT; (void)WgluT; (void)WmkvT; (void)WuvT; (void)WbrT; (void)WoT; (void)WupT; (void)WdnT; (void)S5A; (void)S5B; (void)MEMB; (void)MKV; (void)Hf; (void)Hb; (void)PROJ; (void)KVN; (void)OLAT; (void)BR; (void)Zb; (void)MRG; (void)MRGB; \
    (void)Vf; (void)H1; (void)H1B; (void)SSE; (void)SSC; (void)TOK; (void)GATE; (void)SLOT; (void)XS; (void)ACT; (void)YS; (void)SCR; (void)GROW; (void)CTLP; (void)OUTP; \
    for (int rep_ = 0; rep_ < (((id) == DUP_PHASE) ? 2 : 1); ++rep_)
#define PHASE_END   if (ph + 1 < hi) GRID_BAR(); } ++ph;

    PHASE_BEGIN(0)
    {
        LAS unsigned char* scr = F.lds + wave * 16384;
        constexpr int I_CKV = 16 * 2, I_QIDX = 16 * 4, I_KIDX = 16, I_WIDX = 16, I_512 = 16 * 8, I_GATE = 16 * 64;
        constexpr int I_WIN = I_CKV + I_QIDX + I_KIDX + I_WIDX + 5 * I_512 + I_GATE;
        constexpr int I_GLU = 8 * 8, I_MKV = 16 * 16, I_BR = 8 * 16, I_WO = 16 * 16, I_UP = 16 * 32, I_DN = 16 * 16;
        constexpr int I_LAYER = I_WIN + I_GLU + I_MKV + 4 * I_BR + I_WO + NE * I_UP + NE * I_DN;
        const float* w_in = IN(4);
        { LAS float* wt = (LAS float*)F.lds; LAS float* uk = wt + 64 * 65;
          for (int it = F.bx; it < NL * 8 * 16; it += F.G) { const int l = it >> 7, h = (it >> 4) & 7, kb = it & 15;
            const float* Wl = w_in + (size_t)l * D * DIN + (size_t)(kb * 64) * DIN + h * 64; const float* wuk = IN(6) + (size_t)l * 128 * 512 + h * 64;
            { float t8[8], u16[16];
#pragma unroll
              for (int j = 0; j < 8; ++j) { const int i = F.tid + 512 * j; t8[j] = Wl[(size_t)(i >> 6) * DIN + (i & 63)]; }
#pragma unroll
              for (int j = 0; j < 16; ++j) { const int i = F.tid + 512 * j; u16[j] = wuk[(size_t)(i >> 6) * 512 + (i & 63)]; }
#pragma unroll
              for (int j = 0; j < 8; ++j) { const int i = F.tid + 512 * j; wt[(i >> 6) * 65 + (i & 63)] = t8[j]; }
#pragma unroll
              for (int j = 0; j < 16; ++j) { const int i = F.tid + 512 * j; uk[(i >> 6) * 65 + (i & 63)] = u16[j]; } }
            __syncthreads();
            const int c = F.tid >> 2, kq = F.tid & 3; float a[16];
#pragma unroll
            for (int j = 0; j < 16; ++j) a[j] = 0.f;
            for (int d = 0; d < 64; ++d) { const float wv = uk[c * 65 + d];
#pragma unroll
                for (int j = 0; j < 16; ++j) a[j] += wv * wt[(kq * 16 + j) * 65 + d]; }
            unsigned char* p = (unsigned char*)WinT + ((size_t)l * NP + PC_QLAT + h * 128 + c) * D + kb * 64 + kq * 16; const float sq = 0.125f * QS_WQL;
            *(v4u*)p = (v4u){q8x4(a[0], a[1], a[2], a[3], sq), q8x4(a[4], a[5], a[6], a[7], sq), q8x4(a[8], a[9], a[10], a[11], sq), q8x4(a[12], a[13], a[14], a[15], sq)};
            __syncthreads(); } }
        { LAS float* APr = (LAS float*)F.lds; LAS float* APi = APr + 33 * 64; LAS float* Br = APi + 33 * 64; LAS float* Bi = Br + 1024; LAS float* Cr = Bi + 1024; LAS float* Ci = Cr + 1024; LAS float* KD = Ci + 1024;
          for (int it = F.bx; it < NL * 32; it += F.G) { const int l = it >> 5, g = it & 31; const int lg = l * 32 + g;
            if (F.tid < 64) { const int p = F.tid; const int idx = lg * 64 + p; const float lr = IN(10)[idx], li = IN(11)[idx], dt = expf(IN(17)[lg]);
                const float er = expf(lr * dt); float sn, cs; sincosf(li * dt, &sn, &cs); const float ar = er * cs, ai = er * sn;
                float xr = 1.f, xi = 0.f;
                for (int d = 0; d <= 32; ++d) { APr[d * 64 + p] = xr; APi[d * 64 + p] = xi; const float nr = xr * ar - xi * ai, ni = xr * ai + xi * ar; xr = nr; xi = ni; }
                const float nr_ = ar - 1.f, ni_ = ai, den = lr * lr + li * li; const float fr_ = (nr_ * lr + ni_ * li) / den, fi_ = (ni_ * lr - nr_ * li) / den;
                { f32x4 br4[4], bi4[4];
#pragma unroll
                  for (int q = 0; q < 4; ++q) { br4[q] = *(const f32x4*)(IN(12) + (size_t)idx * 16 + 4 * q); bi4[q] = *(const f32x4*)(IN(13) + (size_t)idx * 16 + 4 * q); }
#pragma unroll
                  for (int n = 0; n < 16; ++n) { const float br = br4[n >> 2][n & 3], bi = bi4[n >> 2][n & 3]; Br[p * 16 + n] = fr_ * br - fi_ * bi; Bi[p * 16 + n] = fr_ * bi + fi_ * br; } } }
            for (int i = F.tid; i < 1024; i += 512) { Cr[i] = IN(14)[(size_t)lg * 1024 + i]; Ci[i] = IN(15)[(size_t)lg * 1024 + i]; }
            __syncthreads();
            { const int d = F.tid >> 4, n = F.tid & 15; float a[16];
#pragma unroll
              for (int m = 0; m < 16; ++m) a[m] = 0.f;
              for (int p = 0; p < 64; ++p) { const float cr = Cr[n * 64 + p], ci = Ci[n * 64 + p], xr = APr[d * 64 + p], xi = APi[d * 64 + p]; const float gr = cr * xr - ci * xi, gi = cr * xi + ci * xr;
#pragma unroll
                  for (int m = 0; m < 16; ++m) a[m] += gr * Br[p * 16 + m] - gi * Bi[p * 16 + m]; }
              if (d == 0) { const float dn = IN(16)[lg * 16 + n];
#pragma unroll
                  for (int m = 0; m < 16; ++m) if (m == n) a[m] += dn; }
#pragma unroll
              for (int m = 0; m < 16; ++m) KD[(d * 16 + n) * 16 + m] = a[m]; }
            __syncthreads();
            bf16* wb = WSSM + (size_t)lg * 512 * SSM_K;
            for (int q = F.tid; q < 512 * (SSM_K / 8); q += 512) { const int row = q / (SSM_K / 8), ch = q % (SSM_K / 8); const int t = row >> 4, n = row & 15; float v[8];
                if (ch < 64) { const int j = ch >> 1, m0 = (ch & 1) * 8;
#pragma unroll
                    for (int e = 0; e < 8; ++e) v[e] = (j <= t) ? KD[((t - j) * 16 + n) * 16 + m0 + e] : 0.f; }
                else { const int p2 = (ch - 64) * 8, part = p2 >> 6, p0 = p2 & 63;
#pragma unroll
                    for (int e = 0; e < 8; ++e) { const float cr = Cr[n * 64 + p0 + e], ci = Ci[n * 64 + p0 + e], ar = APr[(t + 1) * 64 + p0 + e], ai = APi[(t + 1) * 64 + p0 + e]; v[e] = part ? -(cr * ai + ci * ar) : (cr * ar - ci * ai); } }
                v4u o; o.x = pk2(v[0], v[1]); o.y = pk2(v[2], v[3]); o.z = pk2(v[4], v[5]); o.w = pk2(v[6], v[7]);
                *(v4u*)(wb + (size_t)row * SSM_K + ch * 8) = o; }
            { bf16* we = WEW + (size_t)lg * 256 * 512;
              for (int q = F.tid; q < 256 * 64; q += 512) { const int row = q >> 6, ch = q & 63; v4u o = {0u, 0u, 0u, 0u};
                  if (row < 128) { const int p = row & 63, part = row >> 6, j = ch >> 1, n0 = (ch & 1) * 8; const float ar = APr[(31 - j) * 64 + p], ai = APi[(31 - j) * 64 + p]; float v[8];
#pragma unroll
                      for (int e = 0; e < 8; ++e) { const float br = Br[p * 16 + n0 + e], bi = Bi[p * 16 + n0 + e]; v[e] = part ? (ar * bi + ai * br) : (ar * br - ai * bi); }
                      o.x = pk2(v[0], v[1]); o.y = pk2(v[2], v[3]); o.z = pk2(v[4], v[5]); o.w = pk2(v[6], v[7]); }
                  *(v4u*)(we + (size_t)row * 512 + ch * 8) = o; } }
            __syncthreads(); } }
        for (;;) { int base_ = 0; if (lane == 0) base_ = (int)__hip_atomic_fetch_add(CTLP + CW_Q0, 4u, RLX_AGENT); base_ = __builtin_amdgcn_readfirstlane(base_); if (base_ >= NL * I_LAYER) break;
        for (int it = base_; it < base_ + 4 && it < NL * I_LAYER; ++it) {
            const int l = it / I_LAYER; int r = it % I_LAYER;
            const float* Wl = w_in + (size_t)l * D * DIN; bf16* Wt = (bf16*)((unsigned char*)WinT + (size_t)l * NP * D);
            if (r < I_WIN) {
                if (r < I_CKV) { tr_item64<3>(Wl, DIN, SC_CKV, 128, D, Wt, PC_CKV, scr, r, lane); continue; } r -= I_CKV;
                if (r < I_QIDX) { tr_item64<3>(Wl, DIN, SC_QIDX, 256, D, Wt, PC_QIDX, scr, r, lane); continue; } r -= I_QIDX;
                if (r < I_KIDX) { tr_item64<3>(Wl, DIN, SC_KIDX, 32, D, Wt, PC_KIDX, scr, r, lane); continue; } r -= I_KIDX;
                if (r < I_WIDX) { tr_item64<3>(Wl, DIN, SC_WIDX, 8, D, Wt, PC_WIDX, scr, r, lane); continue; } r -= I_WIDX;
                if (r < 5 * I_512) { const int s = r / I_512; tr_item64<3>(Wl, DIN, SC_CU + 512 * s, 512, D, Wt, PC_CU + 512 * s, scr, r % I_512, lane); continue; } r -= 5 * I_512;
                tr_item64<3>(Wl, DIN, SC_GATE, 4096, D, Wt, PC_GATE, scr, r, lane); continue;
            }
            r -= I_WIN;
            if (r < I_GLU) { tr_item64(IN(18) + (size_t)l * 512 * 512, 512, 0, 512, 512, WgluT + (size_t)l * 512 * 512, 0, scr, r, lane); continue; } r -= I_GLU;
            if (r < I_MKV) { tr_item64(IN(20) + (size_t)l * 1024 * 1024, 1024, 0, 1024, 1024, WmkvT + (size_t)l * 1024 * 1024, 0, scr, r, lane); continue; } r -= I_MKV;
            if (r < 4 * I_BR) { const int b = r / I_BR; tr_item64(IN(21) + ((size_t)l * 4 + b) * 512 * 1024, 1024, 0, 1024, 512, WbrT + ((size_t)l * 4 + b) * 1024 * 512, 0, scr, r % I_BR, lane); continue; } r -= 4 * I_BR;
            if (r < I_WO) { tr_item64(IN(22) + (size_t)l * 1024 * 1024, 1024, 0, 1024, 1024, WoT + (size_t)l * 1024 * 1024, 0, scr, r, lane); continue; } r -= I_WO;
            if (r < NE * I_UP) { const int e = r / I_UP; tr_item64<1>(IN(27) + ((size_t)l * NE + e) * 1024 * 2048, 2048, 0, 2048, 1024, (bf16*)((unsigned char*)WupT + ((size_t)l * NE + e) * 2048 * 1024), 0, scr, r % I_UP, lane); continue; } r -= NE * I_UP;
            { const int e = r / I_DN; tr_item64<2>(IN(29) + ((size_t)l * NE + e) * 1024 * 1024, 1024, 0, 1024, 1024, (bf16*)((unsigned char*)WdnT + ((size_t)l * NE + e) * 1024 * 1024), 0, scr, r % I_DN, lane); }
        } }
        for (int it = F.gw; it < NL * (PC_QIDX - PC_WIDX - 8); it += F.NGW) { const int l = it / (PC_QIDX - PC_WIDX - 8), rr = PC_WIDX + 8 + it % (PC_QIDX - PC_WIDX - 8);
            *((v4u*)((unsigned char*)WinT + ((size_t)l * NP + rr) * D) + lane) = (v4u){0u, 0u, 0u, 0u}; }
        for (int it = F.gw; it < NL * 512; it += F.NGW) { const int l = it / 512, n = it % 512, h = n >> 6, d = n & 63; const float* wuv = IN(7) + (size_t)l * 128 * 512;
            bf16* p = WuvT + ((size_t)l * 512 + n) * 1024;
#pragma unroll
            for (int j = 0; j < 2; ++j) { const int k0 = 8 * lane + 512 * j; float v[8];
#pragma unroll
                for (int q = 0; q < 8; ++q) { const int k = k0 + q; const float x_ = wuv[(size_t)(k & 127) * 512 + h * 64 + d]; v[q] = ((k >> 7) == h) ? x_ : 0.f; }
                v4u o; o.x = pk2(v[0], v[1]); o.y = pk2(v[2], v[3]); o.z = pk2(v[4], v[5]); o.w = pk2(v[6], v[7]); *(v4u*)(p + k0) = o; } }
        for (int it = F.gw; it < NL * 32; it += F.NGW) { const int l = it >> 5, g = it & 31; const int idx = (l * 32 + g) * 64 + lane;
            const float lr = IN(10)[idx], li = IN(11)[idx], dt = expf(IN(17)[l * 32 + g]);
            const float er = expf(lr * dt); float sn, cs; sincosf(li * dt, &sn, &cs); const float ar = er * cs, ai = er * sn;
            S5A[idx] = (f32x2){ar, ai};
            float pr = ar, pi = ai;
#pragma unroll
            for (int q = 0; q < 5; ++q) { const float nr = pr * pr - pi * pi, ni = 2.f * pr * pi; pr = nr; pi = ni; }
            S5A[NL * 32 * 64 + idx] = (f32x2){pr, pi};
            const float nr_ = ar - 1.f, ni_ = ai, den = lr * lr + li * li; const float fr_ = (nr_ * lr + ni_ * li) / den, fi_ = (ni_ * lr - nr_ * li) / den;
            { f32x4 br4[4], bi4[4];
#pragma unroll
              for (int q = 0; q < 4; ++q) { br4[q] = *(const f32x4*)(IN(12) + (size_t)idx * 16 + 4 * q); bi4[q] = *(const f32x4*)(IN(13) + (size_t)idx * 16 + 4 * q); }
#pragma unroll
              for (int n = 0; n < 16; ++n) { const float br = br4[n >> 2][n & 3], bi = bi4[n >> 2][n & 3];
                  S5B[(size_t)idx * 16 + n] = (f32x2){fr_ * br - fi_ * bi, fr_ * bi + fi_ * br}; } } }
        for (int it = F.gw; it < 512; it += F.NGW) { const float* mp = IN(1) + (size_t)it * 1024; f32x4 v[4];
#pragma unroll
            for (int j = 0; j < 4; ++j) v[j] = *(const f32x4*)(mp + 4 * lane + 256 * j);
            store_row_f32_bf16(v, nullptr, MEMB + (size_t)it * 1024, lane); }
        const LnAff aff0 = ln_aff(IN(2), IN(3), lane);
        for (int m = F.gw; m < M; m += F.NGW) { const float* xp = IN(0) + (size_t)m * D; f32x4 v[4];
#pragma unroll
            for (int j = 0; j < 4; ++j) v[j] = *(const f32x4*)(xp + 4 * lane + 256 * j);
            ln_rows_pre(v, aff0); store_row_f32_bf16(v, nullptr, Hf + (size_t)m * D, lane); store_row_fp8(v, (unsigned char*)Hb + (size_t)m * D, lane); }
    }
    PHASE_END

    PHASE_BEGIN(1)
    {
        pg8::Dims g{2048, 2048, 2048}; MkvOrder S{F.G, F.bx, (const char*)MEMB, (const char*)WmkvT}; EpiMkv E{MKV};
        pg8::gemm_phase<EpiMkv, MkvOrder, true, true>(F.lds, g, S, E, F.tid);
    }
    PHASE_END

#define MOE_BLK0() do { if (F.tid < 32) CNTL[F.tid] = (int)__hip_atomic_load(CTLP + CW_CNT + l * 2048 + F.tid * 64, RLX_AGENT); __syncthreads(); \
        if (F.tid < 33) { int acc_ = 0; for (int k_ = 0; k_ < 32; ++k_) acc_ += (k_ < F.tid) ? ((CNTL[k_] + 255) >> 8) : 0; BLK0[F.tid] = acc_; } __syncthreads(); } while (0)
    for (int l = 0; l < NL; ++l) {
        PHASE_BEGIN(2)
        {
            pg8::Dims g{1024, 1024, 1024}; pg8::StaticOrder S; S.init(M, NP, F.G, F.bx, Hb, 1024, (const unsigned char*)WinT + (size_t)l * NP * D, 1024); EpiProjQ E{PROJ, NP, AEXT};
            pg8::gemm_phase<EpiProjQ, pg8::StaticOrder, true, true, true>(F.lds, g, S, E, F.tid);
        }
        PHASE_END

        PHASE_BEGIN(3)
        {
            { const float* kg = IN(5) + (size_t)l * 128; const float* cw = IN(8) + (size_t)l * 3 * 512; const float* cb = IN(9) + (size_t)l * 512;
              const float kg0 = kg[2 * lane], kg1 = kg[2 * lane + 1];
              const int eg_ = (F.G >= 128) ? 64 : 0; const int gw2_ = (F.bx - eg_) * NWAVES + wave, ngw2_ = (F.G - eg_) * NWAVES;
              if (F.bx >= eg_)
#pragma unroll 1
              for (int mb = gw2_; mb < M; mb += 4 * ngw2_) {
                unsigned cw2[4], kx[4]; v4u uu[4][3], gc[4][3], gb[4];
#pragma unroll
                for (int q = 0; q < 4; ++q) { int m = mb + q * ngw2_; m = m < M ? m : mb; const bf16* pr = PROJ + (size_t)m * NP; const int tl = m & (T - 1);
                    cw2[q] = *(const unsigned*)(pr + PC_CKV + 2 * lane); kx[q] = *(const unsigned*)(pr + PC_KIDX + 2 * (lane & 15)); gb[q] = *(const v4u*)(pr + PC_GB + 8 * lane);
#pragma unroll
                    for (int k = 0; k < 3; ++k) { const int back = 2 - k; const bf16* pp = pr - (size_t)(tl >= back ? back : 0) * NP;
                        uu[q][k] = *(const v4u*)(pp + PC_CU + 8 * lane); gc[q][k] = *(const v4u*)(pp + PC_GC + 8 * lane); } }
#pragma unroll
                for (int q = 0; q < 4; ++q) { const int m = mb + q * ngw2_; if (m < M) { const int tl = m & (T - 1);
                    const float c0 = bflo(cw2[q]), c1 = bfhi(cw2[q]);
                    const float rs = 1.f / sqrtf(wave_sum(c0 * c0 + c1 * c1) * (1.f / 128.f) + LN_EPS);
                    *(unsigned*)(KVN + (size_t)m * 128 + 2 * lane) = pk2(c0 * rs * kg0, c1 * rs * kg1);
                    if (lane < 16) *(unsigned*)(KIDX + (size_t)m * 32 + 2 * lane) = kx[q];
                    float y[8];
#pragma unroll
                    for (int i = 0; i < 8; ++i) y[i] = cb[8 * lane + i];
#pragma unroll
                    for (int k = 0; k < 3; ++k) { const int back = 2 - k; if (tl >= back) { const v4u u4 = uu[q][k], g4 = gc[q][k]; const float* wk = cw + k * 512 + 8 * lane;
                            y[0] += wk[0] * bflo(u4.x) * bflo(g4.x); y[1] += wk[1] * bfhi(u4.x) * bfhi(g4.x); y[2] += wk[2] * bflo(u4.y) * bflo(g4.y); y[3] += wk[3] * bfhi(u4.y) * bfhi(g4.y);
                            y[4] += wk[4] * bflo(u4.z) * bflo(g4.z); y[5] += wk[5] * bfhi(u4.z) * bfhi(g4.z); y[6] += wk[6] * bflo(u4.w) * bflo(g4.w); y[7] += wk[7] * bfhi(u4.w) * bfhi(g4.w); } }
                    const v4u b4 = gb[q];
                    v4u o; o.x = pk2(y[0] * bflo(b4.x), y[1] * bfhi(b4.x)); o.y = pk2(y[2] * bflo(b4.y), y[3] * bfhi(b4.y)); o.z = pk2(y[4] * bflo(b4.z), y[5] * bfhi(b4.z)); o.w = pk2(y[6] * bflo(b4.w), y[7] * bfhi(b4.w));
                    *(v4u*)(BR + (size_t)m * 2048 + 512 + 8 * lane) = o; } } } }
            __syncthreads();
            { pg8::Dims g{SSM_K * 2, 1024, 1024}; EOrder S{F.G, F.bx, (const char*)AEXT, (const char*)(WEW + (size_t)l * 32 * 256 * 512)}; EpiE E{(float*)SSE};
              pg8::gemm_phase<EpiE, EOrder, true, true>(F.lds, g, S, E, F.tid); }
            __syncthreads();
            for (int Lx = F.bx; Lx < 64; Lx += F.G) { const int b = Lx & 1, g = Lx >> 1; const f32x2 aL = S5A[NL * 32 * 64 + (l * 32 + g) * 64 + lane];
                f32x2 A32 = aL;
#pragma unroll
                for (int q = 0; q < 5; ++q) A32 = (f32x2){A32[0] * A32[0] - A32[1] * A32[1], 2.f * A32[0] * A32[1]};
                f32x2 e[32];
#pragma unroll
                for (int k = 0; k < 32; ++k) { const float* ep_ = (const float*)SSE + ((size_t)(b * SSM_NC + 32 * wave + k) * 32 + g) * 128 + lane;
                    e[k] = (f32x2){__hip_atomic_load(ep_, __ATOMIC_RELAXED, __HIP_MEMORY_SCOPE_AGENT), __hip_atomic_load(ep_ + 64, __ATOMIC_RELAXED, __HIP_MEMORY_SCOPE_AGENT)}; }
                float hr = 0.f, hi_ = 0.f;
#pragma unroll
                for (int k = 0; k < 32; ++k) { const float nr = aL[0] * hr - aL[1] * hi_ + e[k][0], ni = aL[0] * hi_ + aL[1] * hr + e[k][1]; hr = nr; hi_ = ni; }
                LAS float* LS = (LAS float*)F.lds; LS[(wave * 64 + lane) * 2] = hr; LS[(wave * 64 + lane) * 2 + 1] = hi_;
                __syncthreads();
                hr = 0.f; hi_ = 0.f;
                for (int v = 0; v < wave; ++v) { const float lr = LS[(v * 64 + lane) * 2], li = LS[(v * 64 + lane) * 2 + 1];
                    const float nr = A32[0] * hr - A32[1] * hi_ + lr, ni = A32[0] * hi_ + A32[1] * hr + li; hr = nr; hi_ = ni; }
                bf16* ap = AEXT + ((size_t)(g * 512 + b * 256)) * SSM_K + 512 + lane;
#pragma unroll
                for (int k = 0; k < 32; ++k) { const int c = 32 * wave + k; ap[(size_t)c * SSM_K] = (bf16)f2bf(hr); ap[(size_t)c * SSM_K + 64] = (bf16)f2bf(hi_);
                    const float nr = aL[0] * hr - aL[1] * hi_ + e[k][0], ni = aL[0] * hi_ + aL[1] * hr + e[k][1]; hr = nr; hi_ = ni; }
                __syncthreads(); }
            __syncthreads();
            for (int u = F.bx; u < NB * 4 * (T / 256); u += F.G) { const int qblk = u % (T / 256), hd = (u / (T / 256)) & 3, b = u / (4 * (T / 256));
                memattn_unit(F.lds, PROJ, MKV + (size_t)l * 512 * 1024, BR, b, hd, qblk, F.tid); }
        }
        PHASE_END

        PHASE_BEGIN(4)
        {
            const int half = F.G >> 1; const bool deal79 = (F.G >= 4) && ((M / 8) % F.G == 0) && !(F.G & 1) && (M / 8) / F.G >= 2;
            if (F.bx < half) {
                pg8::Dims g{SSM_K * 2, SSM_K * 2, SSM_K * 2}; SsmOrder S{half, F.bx, (const char*)AEXT, (const char*)(WSSM + (size_t)l * 32 * 512 * SSM_K)}; EpiSsm E{Zb};
                pg8::gemm_phase<EpiSsm, SsmOrder, true, true>(F.lds, g, S, E, F.tid);
            }
            { int par = 0; float* sb0 = SCR + (size_t)F.bx * 2 * 8 * 8192; const int R = (M / 8) / F.G;
              for (int i = 0; ; ++i) { int rk;
                if (deal79) { if (i < R - 1) { const int hb_ = F.bx < half ? 0 : 1, loc_ = F.bx - hb_ * half;
                                  rk = i * F.G + hb_ * half + ((i & 1) ? (half - 1 - loc_) : loc_); }
                              else { if (F.bx < half || i > R) break; const int q = F.bx - half; rk = (R - 1) * F.G + (i == R - 1 ? q : half + (half - 1 - q)); } }
                else rk = (i & 1) ? (i * F.G + (F.G - 1 - F.bx)) : (i * F.G + F.bx);
                if (rk >= M / 8) break;
                const int u = M / 8 - 1 - rk; const int b = u & 1, t0 = (u >> 1) * 8;
                dsa2_unit(F.lds, PROJ, KIDX, KVN, OLAT, sb0 + (size_t)par * 8 * 8192, b, t0, F.tid); if (t0 >= 256) par ^= 1; }
              __syncthreads(); }
        }
        PHASE_END

        PHASE_BEGIN(5)
        {
            const int half = F.G >> 1;
            if (F.bx < half) {
                pg8::Dims g{2048, 2048, 1024}; UvOrder S{half, F.bx, (const char*)OLAT, (const char*)(WuvT + (size_t)l * 512 * 1024)};
                EpiBf16 E{BR, 2048};
                pg8::gemm_phase<EpiBf16, UvOrder, true, true>(F.lds, g, S, E, F.tid);
            } else {
                pg8::Dims g{1024, 1024, 1024}; pg8::StaticOrder S; S.init(M, 512, F.G - half, F.bx - half, Zb, 1024, WgluT + (size_t)l * 512 * 512, 1024);
                EpiGlu E{Zb, 512, IN(19) + (size_t)l * 512, BR + 1024, 2048};
                pg8::gemm_phase<EpiGlu, pg8::StaticOrder, true, true>(F.lds, g, S, E, F.tid);
            }
        }
        PHASE_END

        PHASE_BEGIN(7)
        {
            pg8::Dims g{4096, 1024, 1024}; MergeOrder S{F.G, F.bx, (const char*)BR, (const char*)(WbrT + (size_t)l * 4 * 1024 * 512)};
            EpiMerge E{PROJ + PC_GATE, NP, MRGB};
            pg8::gemm_phase<EpiMerge, MergeOrder, true, true>(F.lds, g, S, E, F.tid);
        }
        PHASE_END

        PHASE_BEGIN(8)
        {
            pg8::Dims g{2048, 2048, 2048}; pg8::StaticOrder S; S.init(M, 1024, F.G, F.bx, MRGB, 2048, WoT + (size_t)l * 1024 * 1024, 2048); EpiWo E{Hf, Vf};
            pg8::gemm_phase<EpiWo, pg8::StaticOrder, true, true>(F.lds, g, S, E, F.tid);
        }
        PHASE_END

        PHASE_BEGIN(9)
        {
            constexpr int HP = 2064, HLO_OFF = 16 * HP, PART_OFF = 66560;
            LAS unsigned char* hhi = F.lds; LAS unsigned char* hlo = F.lds + HLO_OFF; LAS float* part = (LAS float*)(F.lds + PART_OFF);
            LAS unsigned* wcnt = (LAS unsigned*)(F.lds + LDSCTL_OFF + 2048); LAS unsigned* wbase = wcnt + 32; LAS unsigned* asg = wcnt + 64; LAS float* asgg = (LAS float*)(asg + 256);
            const float* wr_ = IN(25) + (size_t)l * 1024 * 32; const float* brt = IN(26) + (size_t)l * 32;
            unsigned* cnt = CTLP + CW_CNT + l * 2048;
            const float* g1 = IN(23) + (size_t)l * D; const float* b1 = IN(24) + (size_t)l * D;
            const int fn = lane & 15, fkq = lane >> 4;
            v4u whi[4][2], wlo[4][2];
#pragma unroll
            for (int ks = 0; ks < 4; ++ks)
#pragma unroll
                for (int mt = 0; mt < 2; ++mt) { unsigned hh[8], ll[8];
#pragma unroll
                    for (int i = 0; i < 8; ++i) { const float f = wr_[(size_t)(128 * wave + 32 * ks + 8 * fkq + i) * 32 + 16 * mt + fn]; hh[i] = f2bf(f); ll[i] = f2bf(f - __builtin_bit_cast(float, hh[i] << 16)); }
                    whi[ks][mt] = (v4u){hh[0] | (hh[1] << 16), hh[2] | (hh[3] << 16), hh[4] | (hh[5] << 16), hh[6] | (hh[7] << 16)};
                    wlo[ks][mt] = (v4u){ll[0] | (ll[1] << 16), ll[2] | (ll[3] << 16), ll[4] | (ll[5] << 16), ll[6] | (ll[7] << 16)}; }
            const LnAff aff1 = ln_aff(g1, b1, lane);
            for (int blk = F.bx; blk < M / 64; blk += F.G) {
                if (F.tid < 32) wcnt[F.tid] = 0u;
                __syncthreads();
                v2u raw[2][4];
#pragma unroll
                for (int tk = 0; tk < 2; ++tk)
#pragma unroll
                    for (int j = 0; j < 4; ++j) raw[tk][j] = *(const v2u*)(Vf + (size_t)(blk * 64 + 2 * wave + tk) * D + 4 * lane + 256 * j);
#pragma unroll 1
                for (int rd = 0; rd < 4; ++rd) { const int m0 = blk * 64 + rd * 16 + 2 * wave;
#pragma unroll
                    for (int tk = 0; tk < 2; ++tk) { f32x4 v[4];
#pragma unroll
                        for (int j = 0; j < 4; ++j) v[j] = (f32x4){bflo(raw[tk][j].x), bfhi(raw[tk][j].x), bflo(raw[tk][j].y), bfhi(raw[tk][j].y)};
                        ln_rows_pre(v, aff1); store_row_f32_bf16(v, nullptr, H1 + (size_t)(m0 + tk) * D, lane); store_row_fp8(v, (unsigned char*)H1B + (size_t)(m0 + tk) * D, lane);
#pragma unroll
                        for (int j = 0; j < 4; ++j) { unsigned hh[4]; float rr[4];
#pragma unroll
                            for (int q = 0; q < 4; ++q) { hh[q] = f2bf(v[j][q]); rr[q] = v[j][q] - __builtin_bit_cast(float, hh[q] << 16); }
                            const int o_ = (2 * wave + tk) * HP + (4 * lane + 256 * j) * 2;
                            *(LAS v2u*)(hhi + o_) = (v2u){hh[0] | (hh[1] << 16), hh[2] | (hh[3] << 16)}; *(LAS v2u*)(hlo + o_) = (v2u){pk2(rr[0], rr[1]), pk2(rr[2], rr[3])}; } }
                    if (rd + 1 < 4) {
#pragma unroll
                        for (int tk = 0; tk < 2; ++tk)
#pragma unroll
                            for (int j = 0; j < 4; ++j) raw[tk][j] = *(const v2u*)(Vf + (size_t)(m0 + 16 + tk) * D + 4 * lane + 256 * j); }
                    __syncthreads();
                    { f32x4 acc[2] = {{0.f, 0.f, 0.f, 0.f}, {0.f, 0.f, 0.f, 0.f}};
#pragma unroll
                      for (int ks = 0; ks < 4; ++ks) { const int ko = fn * HP + (128 * wave + 32 * ks + 8 * fkq) * 2;
                          const bf16x8 bh = *(const LAS bf16x8*)(hhi + ko), bl = *(const LAS bf16x8*)(hlo + ko);
#pragma unroll
                          for (int mt = 0; mt < 2; ++mt) { const bf16x8 ah = __builtin_bit_cast(bf16x8, whi[ks][mt]), al = __builtin_bit_cast(bf16x8, wlo[ks][mt]);
                              acc[mt] = __builtin_amdgcn_mfma_f32_16x16x32_bf16(ah, bh, acc[mt], 0, 0, 0); acc[mt] = __builtin_amdgcn_mfma_f32_16x16x32_bf16(al, bh, acc[mt], 0, 0, 0);
                              acc[mt] = __builtin_amdgcn_mfma_f32_16x16x32_bf16(ah, bl, acc[mt], 0, 0, 0); } }
#pragma unroll
                      for (int mt = 0; mt < 2; ++mt) *(LAS f32x4*)(part + (wave * 16 + fn) * 32 + 16 * mt + 4 * fkq) = acc[mt]; }
                    __syncthreads();
                    const int eq = lane & 7; const int lopr_ = lane_op(); const f32x4 be4 = *(const f32x4*)(brt + 4 * eq);
#pragma unroll 1
                    for (int tk = 0; tk < 2; ++tk) { float cur[4] = {be4[0], be4[1], be4[2], be4[3]};
#pragma unroll
                        for (int w = 0; w < 8; ++w) { const f32x4 p = *(const LAS f32x4*)(part + (w * 16 + 2 * wave + tk) * 32 + 4 * eq);
#pragma unroll
                            for (int j = 0; j < 4; ++j) cur[j] += p[j]; }
                        float val[4]; int idx[4];
#pragma unroll
                        for (int k = 0; k < 4; ++k) { float bv = cur[0]; int bi = 4 * eq;
#pragma unroll
                            for (int j = 1; j < 4; ++j) if (cur[j] > bv) { bv = cur[j]; bi = 4 * eq + j; }
#pragma unroll
                            for (int o = 1; o < 8; o <<= 1) { const float ov = SHX(bv, o, lopr_); const int oi = SHX(bi, o, lopr_); if (ov > bv || (ov == bv && oi < bi)) { bv = ov; bi = oi; } }
                            val[k] = bv; idx[k] = bi;
#pragma unroll
                            for (int j = 0; j < 4; ++j) if (bi == 4 * eq + j) cur[j] = -INFINITY; }
                        const float e1 = __expf(val[1] - val[0]), e2 = __expf(val[2] - val[0]), e3 = __expf(val[3] - val[0]); const float inv = 1.f / (1.f + e1 + e2 + e3);
                        const float gt[4] = {inv, e1 * inv, e2 * inv, e3 * inv};
                        if (lane < 4) { int ee = idx[0]; float gg = gt[0];
#pragma unroll
                            for (int k = 1; k < 4; ++k) if (lane == k) { ee = idx[k]; gg = gt[k]; }
                            const unsigned rank = __hip_atomic_fetch_add(&wcnt[ee], 1u, __ATOMIC_RELAXED, __HIP_MEMORY_SCOPE_WORKGROUP);
                            const int tl_ = rd * 16 + 2 * wave + tk; asg[tl_ * 4 + lane] = (unsigned)ee | (rank << 8); asgg[tl_ * 4 + lane] = gg; } }
                    LDS_WAIT();
                }
                __syncthreads();
                if (F.tid < 32) { const unsigned c = wcnt[F.tid]; wbase[F.tid] = c ? __hip_atomic_fetch_add(cnt + F.tid * 64, c, RLX_AGENT) : 0u; }
                __syncthreads();
                if (F.tid < 256) { const unsigned a_ = asg[F.tid]; const int ee = (int)(a_ & 255u); const unsigned slot = wbase[ee] + (a_ >> 8); const int m = blk * 64 + (F.tid >> 2);
                    TOK[(size_t)ee * M + slot] = m; GATE[(size_t)ee * M + slot] = asgg[F.tid]; SLOT[(size_t)m * 4 + (F.tid & 3)] = ee * M + (int)slot; }
                __syncthreads();
            }
        }
        PHASE_END

        PHASE_BEGIN(11)
        {
            LAS int* CNTL = (LAS int*)(ldsq + MISC_OFF + 272);
            MOE_BLK0();
            for (int mb = F.gw; mb < M; mb += 16 * F.NGW) { const int m = mb + (lane >> 2) * F.NGW;
                if (m < M) { const int sl = SLOT[(size_t)m * 4 + (lane & 3)]; const int e = sl >> 14, s = sl & (M - 1); GROW[(size_t)BLK0[e] * 256 + s] = GATE[(size_t)e * M + s]; } }
            pg8::Dims g{1024, 1024, 1024}; MoeOrder S{F.G, F.bx, 8, BLK0[32] * 8, BLK0, (const char*)H1B, (const char*)WupT + (size_t)l * NE * 2048 * 1024, (size_t)0, (size_t)2048 * 1024, (size_t)256 * 1024, TOK, CNTL};
            EpiUp E{IN(28) + (size_t)l * NE * 2048, (unsigned char*)ACT};
            pg8::gemm_phase<EpiUp, MoeOrder, true, true, true, true>(F.lds, g, S, E, F.tid);
        }
        PHASE_END

        PHASE_BEGIN(12)
        {
            { LAS int* CNTL = (LAS int*)(ldsq + MISC_OFF + 272); MOE_BLK0(); }
            pg8::Dims g{1024, 1024, 1024}; MoeOrder S{F.G, F.bx, 4, BLK0[32] * 4, BLK0, (const char*)ACT, (const char*)WdnT + (size_t)l * NE * 1024 * 1024, (size_t)256 * 1024, (size_t)1024 * 1024, (size_t)256 * 1024, nullptr, nullptr};
            EpiDown E{IN(30) + (size_t)l * NE * 1024, GROW, YS};
            pg8::gemm_phase<EpiDown, MoeOrder, true, true, true>(F.lds, g, S, E, F.tid);
        }
        PHASE_END

        PHASE_BEGIN(13)
        {
            { LAS int* CNTL = (LAS int*)(ldsq + MISC_OFF + 272); MOE_BLK0(); }
#define LL_ISSUE(mm, s4, hh, yy) do { const unsigned ho_ = (unsigned)(mm) * 2048u + 8u * (unsigned)lane; \
                _Pragma("unroll") for (int j = 0; j < 4; ++j) hh[j] = *(const v2u*)((const char*)H1 + ho_ + 512 * j); \
                _Pragma("unroll") for (int k = 0; k < 4; ++k) { const unsigned sl = s4[k]; const unsigned ro_ = ((unsigned)BLK0[sl >> 14] * 256u + (sl & (unsigned)(M - 1))) * 2048u + 8u * (unsigned)lane; \
                    _Pragma("unroll") for (int j = 0; j < 4; ++j) yy[k][j] = *(const v2u*)((const char*)YS + ro_ + 512 * j); } } while (0)
#define LL_FIN(mm, hC, yC) { f32x4 v[4]; \
                  _Pragma("unroll") for (int j = 0; j < 4; ++j) { v[j] = (f32x4){bflo(hC[j].x), bfhi(hC[j].x), bflo(hC[j].y), bfhi(hC[j].y)} * DN_ALPHA; \
                      _Pragma("unroll") for (int k = 0; k < 4; ++k) { const v2u y2 = yC[k][j]; v[j][0] += bflo(y2.x); v[j][1] += bfhi(y2.x); v[j][2] += bflo(y2.y); v[j][3] += bfhi(y2.y); } } \
                  ln_rows_pre(v, aff2); \
                  if (l == NL - 1) store_row_f32_bf16(v, OUTP + (size_t)(mm) * D, nullptr, lane); \
                  else { store_row_f32_bf16(v, nullptr, Hf + (size_t)(mm) * D, lane); store_row_fp8(v, (unsigned char*)Hb + (size_t)(mm) * D, lane); } }
            const LnAff aff2 = ln_aff(IN(31) + (size_t)l * D, IN(32) + (size_t)l * D, lane);
            { int m = F.gw; const int st = F.NGW; v4u sa = *(const v4u*)(SLOT + (size_t)m * 4), sb = *(const v4u*)(SLOT + (size_t)(m + st < M ? m + st : m) * 4);
#pragma unroll 1
              for (; m < M; m += 2 * st) { const bool two = m + st < M; const int m1 = two ? m + st : m; v2u hA[4], yA[4][4], hB[4], yB[4][4];
                  LL_ISSUE(m, sa, hA, yA); LL_ISSUE(m1, sb, hB, yB);
                  { const int n0 = m + 2 * st; if (n0 < M) { sa = *(const v4u*)(SLOT + (size_t)n0 * 4); sb = *(const v4u*)(SLOT + (size_t)(n0 + st < M ? n0 + st : n0) * 4); } }
                  LL_FIN(m, hA, yA)
                  if (two) LL_FIN(m1, hB, yB) } }
#undef LL_FIN
#undef LL_ISSUE
        }
        PHASE_END
    }
#undef PHASE_BEGIN
#undef PHASE_END
}

extern "C" void kernel_launch(void* const* d_in, const int* in_sizes, int n_in, void* d_out, int out_size, void* d_ws, size_t ws_size, hipStream_t stream) {
    static int grid = 0;
    if (grid == 0) {
        if (n_in != 33 || out_size != M * D || ws_size < WS_END) { fprintf(stderr, "kernel_launch: unexpected shapes (n_in %d out %d ws %zu need %zu)\n", n_in, out_size, ws_size, (size_t)WS_END); grid = -1; return; }
        int dev = 0, cus = 0, per_cu = 0;
        if (hipGetDevice(&dev) != hipSuccess || hipDeviceGetAttribute(&cus, hipDeviceAttributeMultiprocessorCount, dev) != hipSuccess) { grid = -1; return; }
        if (hipFuncSetAttribute((const void*)fwd, hipFuncAttributeMaxDynamicSharedMemorySize, LDS_BYTES) != hipSuccess) { fprintf(stderr, "kernel_launch: hipFuncSetAttribute failed\n"); grid = -1; return; }
        if (hipOccupancyMaxActiveBlocksPerMultiprocessor(&per_cu, (const void*)fwd, NWAVES * 64, LDS_BYTES) != hipSuccess || per_cu < 1) fprintf(stderr, "kernel_launch: occupancy query says %d\n", per_cu);
        (void)hipGetLastError();
        grid = cus;
    }
    if (grid < 0) return;
    (void)hipMemsetAsync((char*)d_ws + WS_CTL, 0, CTL_ZERO_BYTES, stream);
    Args a{};
    for (int i = 0; i < 33; ++i) a.in[i] = (const float*)d_in[i];
    a.out = (float*)d_out; a.ws = (unsigned char*)d_ws;
#if ONE_LAUNCH
    a.ph_lo = 0; a.ph_hi = NPHASE;
    hipLaunchKernelGGL(fwd, dim3(grid), dim3(NWAVES * 64), LDS_BYTES, stream, a);
#else
    for (int p = 0; p < NPHASE; ++p) { a.ph_lo = p; a.ph_hi = p + 1; hipLaunchKernelGGL(fwd, dim3(grid), dim3(NWAVES * 64), LDS_BYTES, stream, a); }
#endif
}
```
